# Optimizing an MI355X kernel written in HIP

```python
import math
import jax
import jax.numpy as jnp
from jax import lax
import numpy as np

D_MODEL = 1024
BATCH = 8
SEQ = 4096
DEPTH = 2

CTX_LEN = 256
GRID_W = 64
D_FF = 4 * D_MODEL
N_BRANCH = 3
NORM_EPS = 1e-6

CONV_DIM = D_MODEL // 2
CONV_WIDTH = 31
LN_EPS = 1e-5

ATT_HEADS = 4
ATT_HEAD_DIM = 64
ATT_VAL_DIM = 2 * ATT_HEAD_DIM
ATT_DIM = ATT_HEADS * 2 * ATT_HEAD_DIM
Q_BLOCK = 128
ROPE_BASE = 10000.0
SUBLN_EPS = 1e-5

RWKV_HEADS = 8
RWKV_HEAD_DIM = 64
RWKV_DIM = RWKV_HEADS * RWKV_HEAD_DIM
DECAY_LORA = 64
ICLR_LORA = 64
GATE_LORA = 128
SHIFT_WIDTH = 3
RWKV_IN = 3 * RWKV_DIM + 2 * DECAY_LORA + 2 * ICLR_LORA + GATE_LORA
GN_EPS = 64e-5

IN_SPLITS = (2 * CONV_DIM, ATT_DIM, ATT_DIM, ATT_DIM, RWKV_IN, N_BRANCH * D_MODEL)
RWKV_SPLITS = (RWKV_DIM, RWKV_DIM, RWKV_DIM, DECAY_LORA, DECAY_LORA, ICLR_LORA, ICLR_LORA, GATE_LORA)
D_IN = 2 * CONV_DIM + 3 * ATT_DIM + RWKV_IN + N_BRANCH * D_MODEL

kernel_name = 'hybrid_conv_diffattn_rwkv7_prefix_dit'


def _split(x, sizes):
    cuts, acc = [], 0
    for s in sizes[:-1]:
        acc += s
        cuts.append(acc)
    return jnp.split(x, cuts, axis=-1)


def _rmsnorm(x, gain, eps=NORM_EPS):
    xf = x.astype(jnp.float32)
    y = xf * lax.rsqrt(jnp.mean(xf * xf, axis=-1, keepdims=True) + eps)
    return (y * gain.astype(jnp.float32)).astype(x.dtype)


def _layernorm(x, gain, bias, eps=LN_EPS):
    xf = x.astype(jnp.float32)
    mu = jnp.mean(xf, axis=-1, keepdims=True)
    var = jnp.mean(jnp.square(xf - mu), axis=-1, keepdims=True)
    y = (xf - mu) * lax.rsqrt(var + eps) * gain.astype(jnp.float32) + bias.astype(jnp.float32)
    return y.astype(x.dtype)


def _modulate(x, gain, shift, scale):
    return _rmsnorm(x, gain) * (1.0 + scale) + shift


def _depthwise_conv(x, w):
    return lax.conv_general_dilated(
        x, w[:, None, :].astype(x.dtype), window_strides=(1,), padding='SAME',
        dimension_numbers=('NWC', 'WIO', 'NWC'), feature_group_count=x.shape[-1])


def _sqrelu_mlp(h, w1, w2):
    return jnp.square(jax.nn.relu(h @ w1)) @ w2


def _conv_branch(z, dw_w, dw_b, ln_g, ln_b):
    a, b = jnp.split(z, 2, axis=-1)
    u = a * jax.nn.sigmoid(b)
    u = _depthwise_conv(u, dw_w) + dw_b
    return jax.nn.silu(_layernorm(u, ln_g, ln_b))


def _axial_rope(seq_len):
    t = jnp.arange(seq_len, dtype=jnp.int32)
    row = (t // GRID_W).astype(jnp.float32)
    col = (t % GRID_W).astype(jnp.float32)
    n_pairs = ATT_HEAD_DIM // 4
    inv_freq = ROPE_BASE ** (-jnp.arange(n_pairs, dtype=jnp.float32) / n_pairs)
    ang = jnp.concatenate([row[:, None] * inv_freq, col[:, None] * inv_freq], axis=-1)
    return jnp.cos(ang), jnp.sin(ang)


def _apply_rope(x, cos, sin):
    xp = x.astype(jnp.float32).reshape(x.shape[:-1] + (ATT_HEAD_DIM // 2, 2))
    x0, x1 = xp[..., 0], xp[..., 1]
    out = jnp.stack([x0 * cos - x1 * sin, x0 * sin + x1 * cos], axis=-1)
    return out.reshape(x.shape).astype(x.dtype)


def _qk_heads(u):
    b, t, _ = u.shape
    return u.reshape(b, t, ATT_HEADS, 2, ATT_HEAD_DIM).transpose(0, 2, 3, 1, 4)


def _v_heads(u):
    b, t, _ = u.shape
    return u.reshape(b, t, ATT_HEADS, ATT_VAL_DIM).transpose(0, 2, 1, 3)


def _diff_lambda(lq1, lk1, lq2, lk2, lambda_init):
    f = jnp.float32
    return (jnp.exp(jnp.sum(lq1.astype(f) * lk1.astype(f)))
            - jnp.exp(jnp.sum(lq2.astype(f) * lk2.astype(f))) + lambda_init)


def _diff_attend(q, k, v, lam):
    b, h, _, tq, dh = q.shape
    nblk = tq // Q_BLOCK
    qb = jnp.moveaxis(q.reshape(b, h, 2, nblk, Q_BLOCK, dh), 3, 0)
    scale = 1.0 / math.sqrt(dh)

    def block(qi):
        s = jnp.einsum('bhcqd,bhckd->bhcqk', qi, k).astype(jnp.float32) * scale
        p = jax.nn.softmax(s, axis=-1)
        a = p[:, :, 0] - lam * p[:, :, 1]
        return jnp.einsum('bhqk,bhkd->bhqd', a.astype(v.dtype), v)

    out = lax.map(block, qb)
    return jnp.moveaxis(out, 0, 2).reshape(b, h, tq, v.shape[-1])


def _att_post(o, subln_g, lambda_init):
    o = _rmsnorm(o, subln_g, SUBLN_EPS) * (1.0 - lambda_init)
    b, h, t, dv = o.shape
    return o.transpose(0, 2, 1, 3).reshape(b, t, h * dv)


def _rwkv_prep(z, lp):
    b, t, _ = z.shape
    r, k, v, wf, wb, af, ab, gd = _split(z, RWKV_SPLITS)

    def heads(u):
        return u.reshape(b, t, RWKV_HEADS, RWKV_HEAD_DIM)

    kkf = heads(k * lp['rwkv_kk']).astype(jnp.float32)
    kk = kkf * lax.rsqrt(jnp.maximum(jnp.sum(kkf * kkf, axis=-1, keepdims=True), 1e-24))
    g = jax.nn.sigmoid(gd) @ lp['rwkv_g2']
    dirs = []
    for d, (wd, ad) in enumerate(((wf, af), (wb, ab))):
        w_log = -jax.nn.softplus(-(lp['rwkv_w0'][d] + jnp.tanh(wd) @ lp['rwkv_w2'][d])) - 0.5
        decay = jnp.exp(-jnp.exp(w_log.astype(jnp.float32)))
        a = jax.nn.sigmoid(lp['rwkv_a0'][d] + ad @ lp['rwkv_a2'][d])
        kd = k * (1.0 + (a - 1.0) * lp['rwkv_ka'])
        dirs.append((heads(decay), heads(kd), heads(a)))
    return heads(r), heads(v), kk, g, dirs


def _rwkv_scan(r, w, k, v, kk, a, s0, reverse):
    xs = tuple(jnp.moveaxis(u.astype(jnp.float32), 1, 0) for u in (r, w, k, v, kk, a))

    def step(s, inp):
        r_t, w_t, k_t, v_t, kk_t, a_t = inp
        sa = jnp.einsum('bhij,bhj->bhi', s, -kk_t)
        s = (s * w_t[:, :, None, :] + sa[..., None] * (kk_t * a_t)[:, :, None, :]
             + v_t[..., None] * k_t[:, :, None, :])
        return s, jnp.einsum('bhij,bhj->bhi', s, r_t)

    s_fin, ys = lax.scan(step, s0, xs, reverse=reverse)
    return jnp.moveaxis(ys, 0, 1), s_fin


def _rwkv_out(ys, r, v, kds, g, lp):
    b, t = ys.shape[:2]
    mu = jnp.mean(ys, axis=-1, keepdims=True)
    var = jnp.mean(jnp.square(ys - mu), axis=-1, keepdims=True)
    yn = ((ys - mu) * lax.rsqrt(var + GN_EPS)).reshape(b, t, RWKV_DIM)
    yn = (yn * lp['rwkv_gn_g'] + lp['rwkv_gn_b']).astype(r.dtype)
    bonus = sum(jnp.sum(r * kd * lp['rwkv_rk'], axis=-1, keepdims=True) * v for kd in kds)
    return (yn + bonus.reshape(b, t, RWKV_DIM)) * g


def _rwkv_branch(zc, zl, lp, need_ctx):
    zc = _depthwise_conv(zc, lp['rwkv_shift'])
    zl = _depthwise_conv(zl, lp['rwkv_shift'])
    rc, vc, kkc, gc, dirs_c = _rwkv_prep(zc, lp)
    rl, vl, kkl, gl, dirs_l = _rwkv_prep(zl, lp)
    s0 = jnp.zeros((zl.shape[0], RWKV_HEADS, RWKV_HEAD_DIM, RWKV_HEAD_DIM), jnp.float32)
    ys_c, ys_l = [], []
    for d, reverse in enumerate((False, True)):
        wc, kc, ac = dirs_c[d]
        wl, kl, al = dirs_l[d]
        yc, s_ctx = _rwkv_scan(rc, wc, kc, vc, kkc, ac, s0, reverse)
        yl, _ = _rwkv_scan(rl, wl, kl, vl, kkl, al, s_ctx, reverse)
        ys_c.append(yc)
        ys_l.append(yl)
    y_l = _rwkv_out(ys_l[0] + ys_l[1], rl, vl, [dirs_l[0][1], dirs_l[1][1]], gl, lp)
    if not need_ctx:
        return None, y_l
    y_c = _rwkv_out(ys_c[0] + ys_c[1], rc, vc, [dirs_c[0][1], dirs_c[1][1]], gc, lp)
    return y_c, y_l


def _merge(y_conv, y_att, y_rwkv, gates, lp):
    g1, g2, g3 = jnp.split(jax.nn.sigmoid(gates), N_BRANCH, axis=-1)
    m = (g1 * (y_conv @ lp['p_conv']) + g2 * (y_att @ lp['p_att'])
         + g3 * (y_rwkv @ lp['p_rwkv']))
    return m @ lp['w_out']


def _token_mixer(hc, hl, lp, lambda_init, cos, sin, need_ctx):
    conv_c, q_c, k_c, v_c, rw_c, gate_c = _split(hc @ lp['w_in'], IN_SPLITS)
    conv_l, q_l, k_l, v_l, rw_l, gate_l = _split(hl @ lp['w_in'], IN_SPLITS)
    conv_args = (lp['conv_dw_w'], lp['conv_dw_b'], lp['conv_ln_g'], lp['conv_ln_b'])
    lam = _diff_lambda(lp['att_lq1'], lp['att_lk1'], lp['att_lq2'], lp['att_lk2'], lambda_init)

    kh_c, vh_c = _qk_heads(k_c), _v_heads(v_c)
    keys_l = jnp.concatenate([kh_c, _apply_rope(_qk_heads(k_l), cos, sin)], axis=3)
    vals_l = jnp.concatenate([vh_c, _v_heads(v_l)], axis=2)
    q_lat = _apply_rope(_qk_heads(q_l), cos, sin)
    y_att_l = _att_post(_diff_attend(q_lat, keys_l, vals_l, lam), lp['att_subln_g'], lambda_init)
    y_conv_l = _conv_branch(conv_l, *conv_args)
    y_rw_c, y_rw_l = _rwkv_branch(rw_c, rw_l, lp, need_ctx)
    out_l = _merge(y_conv_l, y_att_l, y_rw_l, gate_l, lp)
    if not need_ctx:
        return None, out_l
    y_conv_c = _conv_branch(conv_c, *conv_args)
    y_att_c = _att_post(_diff_attend(_qk_heads(q_c), kh_c, vh_c, lam), lp['att_subln_g'], lambda_init)
    out_c = _merge(y_conv_c, y_att_c, y_rw_c, gate_c, lp)
    return out_c, out_l


def setup_inputs(seed: int = 0) -> dict:
    key = jax.random.key(seed)
    keys = jax.random.split(key, 64)
    f32 = jnp.float32
    cnt = [0]

    def nxt():
        cnt[0] += 1
        return keys[cnt[0]]

    def nrm(shape, scale):
        return jax.random.normal(nxt(), shape, f32) * scale

    def gain(shape):
        return 1.0 + nrm(shape, 0.02)

    L, D = DEPTH, D_MODEL
    shift_base = jnp.array([0.25, 0.5, 0.25], f32)[None, :, None]
    return {
        'x': nrm((BATCH, SEQ, D), 1.0),
        'c': nrm((BATCH, D), 1.0),
        'ctx': nrm((BATCH, CTX_LEN, D), 1.0),
        'c_ctx': nrm((D,), 1.0),
        'mod_w': nrm((L, D, 6 * D), D ** -0.5),
        'mod_b': nrm((L, 6 * D), 0.01),
        'norm1_g': gain((L, D)),
        'norm2_g': gain((L, D)),
        'w_in': nrm((L, D, D_IN), D ** -0.5),
        'conv_dw_w': nrm((L, CONV_WIDTH, CONV_DIM), CONV_WIDTH ** -0.5),
        'conv_dw_b': nrm((L, CONV_DIM), 0.01),
        'conv_ln_g': gain((L, CONV_DIM)),
        'conv_ln_b': nrm((L, CONV_DIM), 0.01),
        'p_conv': nrm((L, CONV_DIM, D), CONV_DIM ** -0.5),
        'att_lq1': nrm((L, ATT_HEAD_DIM), 0.1),
        'att_lk1': nrm((L, ATT_HEAD_DIM), 0.1),
        'att_lq2': nrm((L, ATT_HEAD_DIM), 0.1),
        'att_lk2': nrm((L, ATT_HEAD_DIM), 0.1),
        'att_subln_g': gain((L, ATT_VAL_DIM)),
        'p_att': nrm((L, ATT_DIM, D), ATT_DIM ** -0.5),
        'rwkv_shift': shift_base + nrm((L, SHIFT_WIDTH, RWKV_IN), 0.05),
        'rwkv_w0': jax.random.uniform(nxt(), (L, 2, RWKV_DIM), f32, -6.0, -1.0),
        'rwkv_w2': nrm((L, 2, DECAY_LORA, RWKV_DIM), 0.3 * DECAY_LORA ** -0.5),
        'rwkv_a0': nrm((L, 2, RWKV_DIM), 0.1),
        'rwkv_a2': nrm((L, 2, ICLR_LORA, RWKV_DIM), 0.3 * ICLR_LORA ** -0.5),
        'rwkv_g2': nrm((L, GATE_LORA, RWKV_DIM), GATE_LORA ** -0.5),
        'rwkv_kk': 0.85 + nrm((L, RWKV_DIM), 0.05),
        'rwkv_ka': 1.0 + nrm((L, RWKV_DIM), 0.05),
        'rwkv_rk': nrm((L, RWKV_HEADS, RWKV_HEAD_DIM), 0.1),
        'rwkv_gn_g': gain((L, RWKV_DIM)),
        'rwkv_gn_b': nrm((L, RWKV_DIM), 0.01),
        'p_rwkv': nrm((L, RWKV_DIM, D), RWKV_DIM ** -0.5),
        'w_out': nrm((L, D, D), D ** -0.5),
        'mlp_w1': nrm((L, D, D_FF), D ** -0.5),
        'mlp_w2': nrm((L, D_FF, D), D_FF ** -0.5),
        'final_g': gain((D,)),
    }


def reference(x, c, ctx, c_ctx, mod_w, mod_b, norm1_g, norm2_g, w_in,
              conv_dw_w, conv_dw_b, conv_ln_g, conv_ln_b, p_conv,
              att_lq1, att_lk1, att_lq2, att_lk2, att_subln_g, p_att,
              rwkv_shift, rwkv_w0, rwkv_w2, rwkv_a0, rwkv_a2, rwkv_g2,
              rwkv_kk, rwkv_ka, rwkv_rk, rwkv_gn_g, rwkv_gn_b, p_rwkv,
              w_out, mlp_w1, mlp_w2, final_g):
    seq = x.shape[1]
    cos, sin = _axial_rope(seq)
    xl, xc = x, ctx
    silu_c = jax.nn.silu(c)
    silu_cc = jax.nn.silu(c_ctx)
    for l in range(DEPTH):
        need_ctx = l < DEPTH - 1
        lambda_init = 0.8 - 0.6 * math.exp(-0.3 * l)
        lp = dict(w_in=w_in[l], conv_dw_w=conv_dw_w[l], conv_dw_b=conv_dw_b[l],
                  conv_ln_g=conv_ln_g[l], conv_ln_b=conv_ln_b[l], p_conv=p_conv[l],
                  att_lq1=att_lq1[l], att_lk1=att_lk1[l], att_lq2=att_lq2[l], att_lk2=att_lk2[l],
                  att_subln_g=att_subln_g[l], p_att=p_att[l],
                  rwkv_shift=rwkv_shift[l], rwkv_w0=rwkv_w0[l], rwkv_w2=rwkv_w2[l],
                  rwkv_a0=rwkv_a0[l], rwkv_a2=rwkv_a2[l], rwkv_g2=rwkv_g2[l],
                  rwkv_kk=rwkv_kk[l], rwkv_ka=rwkv_ka[l], rwkv_rk=rwkv_rk[l],
                  rwkv_gn_g=rwkv_gn_g[l], rwkv_gn_b=rwkv_gn_b[l], p_rwkv=p_rwkv[l],
                  w_out=w_out[l])
        shl1, scl1, gl1, shl2, scl2, gl2 = jnp.split(
            (silu_c @ mod_w[l] + mod_b[l])[:, None, :], 6, axis=-1)
        shc1, scc1, gc1, shc2, scc2, gc2 = jnp.split(
            (silu_cc @ mod_w[l] + mod_b[l])[None, None, :], 6, axis=-1)
        hl = _modulate(xl, norm1_g[l], shl1, scl1)
        hc = _modulate(xc, norm1_g[l], shc1, scc1)
        oc, ol = _token_mixer(hc, hl, lp, lambda_init, cos, sin, need_ctx)
        xl = xl + gl1 * ol
        xl = xl + gl2 * _sqrelu_mlp(_modulate(xl, norm2_g[l], shl2, scl2), mlp_w1[l], mlp_w2[l])
        if need_ctx:
            xc = xc + gc1 * oc
            xc = xc + gc2 * _sqrelu_mlp(_modulate(xc, norm2_g[l], shc2, scc2), mlp_w1[l], mlp_w2[l])
    return _rmsnorm(xl, final_g)
```

```cpp
#include <hip/hip_runtime.h>
#include <hip/hip_cooperative_groups.h>
#include <cstdio>
namespace cg = cooperative_groups;

typedef unsigned short bf16_t;
typedef short bf16x8 __attribute__((ext_vector_type(8)));
typedef float f32x4 __attribute__((ext_vector_type(4)));
typedef float f32x16 __attribute__((ext_vector_type(16)));
typedef unsigned u32x4 __attribute__((ext_vector_type(4)));
#define DEV __device__ __forceinline__
#define PROBE 0

constexpr int T_LAT = 32768, T_ALL = 34816, DM = 1024, DIN = 7552, NZ = 4480, NZP = 4608, DINT = 7680;
constexpr int SEQ = 4096, CTXL = 256, TK = 4352;
constexpr size_t U = 35651584ull;
constexpr size_t O_ZU = 0, O_ZK = U, O_VT = 2 * U, O_ZRW = 3 * U, O_ZRS = 7 * U, O_LIN = 10 * U, O_YCV = 11 * U, O_ZQ = 12 * U;
constexpr size_t O_H0 = 7 * U;
constexpr size_t O_EF = 0, O_EB = 3 * U, O_AF = 4 * U, O_AB = 5 * U, O_G = 2 * U, O_YSF = 6 * U, O_YSB = 10 * U;
constexpr size_t O_HM = 0, O_M = 0, O_HID = 3 * U;
constexpr size_t O_G1 = 3 * U, O_G2 = 7 * U, O_G3 = 9 * U;
constexpr size_t O_WB = 13 * U;
constexpr size_t W_WIN = 0, W_PCV = W_WIN + (size_t)DINT * 1024 * 2, W_PAT = W_PCV + 1048576, W_PRW = W_PAT + 1048576,
                 W_WOUT = W_PRW + 1048576, W_W1 = W_WOUT + 2097152, W_W2 = W_W1 + 8388608, W_LW2 = W_W2 + 8388608,
                 W_LA2 = W_LW2 + 131072, W_LG2 = W_LA2 + 131072, W_END = W_LG2 + 131072;
constexpr size_t O_XC = O_WB + W_END;
constexpr size_t O_MOD = O_XC + 8388608;
constexpr size_t O_BAR = O_MOD + 2 * 9 * 6144 * 4;
constexpr size_t O_GIN = O_BAR + 16384;
constexpr size_t WS_NEED = O_GIN + (size_t)T_ALL * 128 * 2;

constexpr int LDS_BYTES = 139264 + 16;

struct Params {
  const float *x, *c, *ctx, *c_ctx, *mod_w, *mod_b, *norm1_g, *norm2_g, *w_in, *conv_dw_w, *conv_dw_b, *conv_ln_g,
      *conv_ln_b, *p_conv, *att_lq1, *att_lk1, *att_lq2, *att_lk2, *att_subln_g, *p_att, *rwkv_shift, *rwkv_w0, *rwkv_w2,
      *rwkv_a0, *rwkv_a2, *rwkv_g2, *rwkv_kk, *rwkv_ka, *rwkv_rk, *rwkv_gn_g, *rwkv_gn_b, *p_rwkv, *w_out, *mlp_w1,
      *mlp_w2, *final_g;
  float* out;
  char* ws;
};

DEV int ltid() { int t = threadIdx.x; asm volatile("" : "+v"(t)); return t; }
DEV float bf2f(bf16_t h) { return __uint_as_float(((unsigned)h) << 16); }
typedef float f32x2_t __attribute__((ext_vector_type(2)));
typedef __bf16 bf16x2_t __attribute__((ext_vector_type(2)));
DEV unsigned pk2(float lo, float hi) {
  const f32x2_t v = {lo, hi};
  return __builtin_bit_cast(unsigned, __builtin_convertvector(v, bf16x2_t));
}
DEV bf16_t f2bf(float f) { return (bf16_t)(pk2(f, 0.f) & 0xffffu); }
DEV float lo_bf(unsigned u) { return __uint_as_float(u << 16); }
DEV float hi_bf(unsigned u) { return __uint_as_float(u & 0xffff0000u); }
template <int C> DEV float dppf(float v) {
  return __int_as_float(__builtin_amdgcn_update_dpp(0, __float_as_int(v), C, 0xF, 0xF, true));
}
DEV float xor32_sum(float v) {
  const auto r = __builtin_amdgcn_permlane32_swap(__float_as_uint(v), __float_as_uint(v), false, false);
  return __uint_as_float(r[0]) + __uint_as_float(r[1]);
}
DEV float xor32_max(float v) {
  const auto r = __builtin_amdgcn_permlane32_swap(__float_as_uint(v), __float_as_uint(v), false, false);
  return fmaxf(__uint_as_float(r[0]), __uint_as_float(r[1]));
}
DEV float xor16_sum(float v) {
  const auto r = __builtin_amdgcn_permlane16_swap(__float_as_uint(v), __float_as_uint(v), false, false);
  return __uint_as_float(r[0]) + __uint_as_float(r[1]);
}
DEV float wsum(float v) {
  v += dppf<0xB1>(v);
  v += dppf<0x4E>(v);
  v += dppf<0x141>(v);
  v += dppf<0x140>(v);
  v = xor16_sum(v);
  return xor32_sum(v);
}
DEV float sigmoidf_(float x) { return 1.f / (1.f + __expf(-x)); }
DEV float red16(float v) {
  v += dppf<0xB1>(v);
  v += dppf<0x4E>(v);
  v += dppf<0x141>(v);
  v += dppf<0x140>(v);
  return v;
}
DEV int vblock() { const int per = gridDim.x >> 3; return (blockIdx.x & 7) * per + (blockIdx.x >> 3); }
DEV float* xrow(const Params& p, int row) {
  return row < T_LAT ? p.out + (size_t)row * DM : (float*)(p.ws + O_XC) + (size_t)(row - T_LAT) * DM;
}
DEV int modrow(int row) { return row < T_LAT ? (row >> 12) : 8; }

#define XB_TMO      128
#define XB_XCNT(j)  (256  + 64 * (j))
#define XB_XSUB(j)  (1280 + 64 * (j))
#define XB_XGEN(j)  (2304 + 64 * (j))
#define XB_TOP      3328
#define XB_TOPGEN   3392
#define XCD_BAR_WORDS 3456
#define XB_SPIN_CAP (1u << 18)
#define XLAS __attribute__((address_space(3)))

__device__ __forceinline__ unsigned xb_ld(unsigned* p)              { return __hip_atomic_load(p, __ATOMIC_RELAXED, __HIP_MEMORY_SCOPE_AGENT); }
__device__ __forceinline__ unsigned xb_add(unsigned* p, unsigned v) { return __hip_atomic_fetch_add(p, v, __ATOMIC_RELAXED, __HIP_MEMORY_SCOPE_AGENT); }
__device__ __forceinline__ unsigned xb_xcc_id() { return (unsigned)__builtin_amdgcn_s_getreg((3 << 11) | 20) & 0xFu; }
#define XB_SPIN(cond, bar) do { unsigned _sp = 0; while (cond) { __builtin_amdgcn_s_sleep(1); \
    if ((++_sp & 255u) == 0u) { if (xb_ld(&(bar)[XB_TMO])) break; if (_sp > XB_SPIN_CAP) { atomicAdd(&(bar)[XB_TMO], 1u); break; } } } } while (0)

struct XcdBarrier {
    unsigned* bar; unsigned x;
    volatile XLAS unsigned* st;
};

__device__ __forceinline__ XcdBarrier xcd_barrier_post(unsigned* bar, volatile XLAS unsigned* st) {
    XcdBarrier b; b.bar = bar; b.x = xb_xcc_id(); b.st = st;
    if (threadIdx.x == 0) (void)xb_add(&bar[XB_XCNT(b.x)], 1u);
    return b;
}
__device__ __forceinline__ void xcd_barrier_complete(unsigned* bar, unsigned x, unsigned& nloc, unsigned& nx) {
    const unsigned G = gridDim.x * gridDim.y * gridDim.z;
    unsigned sum, cnt, mine, sp = 0u;
    for (;;) {
        sum = 0u; cnt = 0u; mine = 0u;
#pragma unroll
        for (unsigned j = 0; j < 16; ++j) { const unsigned c = xb_ld(&bar[XB_XCNT(j)]); sum += c; cnt += (c > 0u) ? 1u : 0u; mine = (j == x) ? c : mine; }
        if (sum == G) break;
        __builtin_amdgcn_s_sleep(1);
        if ((++sp & 255u) == 0u) { if (xb_ld(&bar[XB_TMO])) break; if (sp > XB_SPIN_CAP) { atomicAdd(&bar[XB_TMO], 1u); break; } }
    }
    nloc = mine > 0u ? mine : 1u; nx = cnt > 0u ? cnt : 1u;
}

__device__ __forceinline__ void xcd_barrier(const XcdBarrier& b) {
    asm volatile("s_waitcnt vmcnt(0)" ::: "memory");
    __syncthreads();
    if (threadIdx.x == 0) {
        unsigned* bar = b.bar;
        __builtin_amdgcn_s_waitcnt(0);
        unsigned nloc = b.st[0], nx = b.st[1];
        if (nloc == 0u) { xcd_barrier_complete(bar, b.x, nloc, nx); b.st[0] = nloc; b.st[1] = nx; }
        const unsigned old = xb_add(&bar[XB_XSUB(b.x)], 1u);
        const unsigned gen = old / nloc;
        if (old + 1u == (gen + 1u) * nloc) {
            __builtin_amdgcn_fence(__ATOMIC_RELEASE, "agent");
            asm volatile("s_waitcnt vmcnt(0)" ::: "memory");
            const unsigned og = xb_add(&bar[XB_TOP], 1u);
            const unsigned tg = og / nx;
            if (og + 1u == (tg + 1u) * nx) xb_add(&bar[XB_TOPGEN], 1u);
            else XB_SPIN(xb_ld(&bar[XB_TOPGEN]) == tg, bar);
            __builtin_amdgcn_fence(__ATOMIC_ACQUIRE, "agent");
            xb_add(&bar[XB_XGEN(b.x)], 1u);
            asm volatile("s_waitcnt vmcnt(0)" ::: "memory");
        } else {
            XB_SPIN(xb_ld(&bar[XB_XGEN(b.x)]) == gen, bar);
            __builtin_amdgcn_fence(__ATOMIC_ACQUIRE, "agent");
            asm volatile("s_waitcnt vmcnt(0)" ::: "memory");
        }
    }
    __syncthreads();
}

namespace pg8 {
#define PG8_LAS __attribute__((address_space(3)))
constexpr int BM = 256, BK = 64, HALF = 128, HTB = HALF * BK * 2, STAGE_BYTES = 8 * HTB, NXCD = 8, WGM = 4;
__host__ __device__ __forceinline__ int lds_byte(int r, int c) { const int st = (r >> 4) * 2 + (c >> 5), rr = r & 15, cc = c & 31, ob = rr * 64 + cc * 2; return st * 1024 + (ob ^ (((ob >> 9) & 1) << 5)); }
__host__ __device__ __forceinline__ void stage_rc(int b, int& R, int& C) { const int st = b / 1024, sb = b % 1024, swz = sb ^ (((sb >> 9) & 1) << 5); R = (st >> 1) * 16 + swz / 64; C = (st & 1) * 32 + (swz % 64) / 2; }
__host__ __device__ __forceinline__ int perm32(int rho) { const int n = rho >> 4, i = rho & 15; return 8 * (i >> 2) + 4 * n + (i & 3); }
struct Unit { int pm, pn; };
struct Gemm { const bf16_t* A; const bf16_t* Bt; int M, N, K; };
struct StaticOrder {
    int nM, nN, nwg, G, c;
    __host__ __device__ void init(int M, int N, int G_, int c_) { nM = M / BM; nN = N / BM; nwg = nM * nN; G = G_; c = c_; }
    __host__ __device__ bool next(int i, Unit& u) const {
        const long L = (long)i * G + c; if (L >= nwg) return false;
        int wgid = (int)L; { const int q = nwg / NXCD, r = nwg % NXCD, xcd = wgid % NXCD, off = wgid / NXCD; wgid = (xcd < r ? xcd * (q + 1) : r * (q + 1) + (xcd - r) * q) + off; }
        const int nig = WGM * nN, gid = wgid / nig, fm = gid * WGM, gsz = (nM - fm) < WGM ? (nM - fm) : WGM;
        u.pm = fm + ((wgid % nig) % gsz); u.pn = (wgid % nig) / gsz; return true;
    }
    __device__ __forceinline__ void a_ready(const Unit&) const {}
    __device__ __forceinline__ void done(const Unit&) const {}
};

template <class Epi, class Sched>
__device__ __forceinline__ void gemm_phase(PG8_LAS unsigned char* lds, const Gemm g, const Sched& S, const Epi& E) {
    const int tid = ltid(), wid = __builtin_amdgcn_readfirstlane(tid >> 6), lane = tid & 63, wr = wid >> 2, wc = wid & 3, fr = lane & 15, fq = lane >> 4;
    const int K = g.K, nt = K / BK;
    unsigned voffA[2], voffB[2];
#pragma unroll
    for (int i = 0; i < 2; ++i) { int R, C; stage_rc(tid * 16 + i * 8192, R, C); const int Rb = Epi::PERM ? ((R & ~31) + perm32(R & 31)) : R;
        voffA[i] = (unsigned)(R * K + C) * 2u; voffB[i] = (unsigned)(Rb * K + C) * 2u; }
    const size_t kstep = (size_t)(BK * 2);
    const size_t hstep = (size_t)HALF * K * 2;
    const size_t tstep = 2 * hstep;
    const unsigned ldsw = (unsigned)wid * 1024u;
    const int aoff = lds_byte(wr * 64 + fr, fq * 8), boff = lds_byte(wc * 32 + fr, fq * 8);
#define PG8_SA(b, h) (((b) * 2 + (h)) * HTB)
#define PG8_SB(b, h) ((4 + (b) * 2 + (h)) * HTB)
#define PG8_STAGE(bufoff, gbase, voff) do { _Pragma("unroll") for (int _i = 0; _i < 2; ++_i) \
        __builtin_amdgcn_global_load_lds((const unsigned*)((const char*)(gbase) + (voff)[_i]), (PG8_LAS unsigned*)(lds + (bufoff) + ldsw + _i * 8192), 16, 0, 0); } while (0)
#define PG8_LDA(dst, b, h) do { _Pragma("unroll") for (int m = 0; m < 4; ++m) _Pragma("unroll") for (int k = 0; k < 2; ++k) dst[m][k] = *(const PG8_LAS bf16x8*)(lds + PG8_SA(b, h) + aoff + m * 2048 + k * 1024); } while (0)
#define PG8_LDB(dst, b, h) do { _Pragma("unroll") for (int n = 0; n < 2; ++n) _Pragma("unroll") for (int k = 0; k < 2; ++k) dst[n][k] = *(const PG8_LAS bf16x8*)(lds + PG8_SB(b, h) + boff + n * 2048 + k * 1024); } while (0)
#define PG8_MMA(ai, bj, At, Bt) do { __builtin_amdgcn_s_setprio(1); _Pragma("unroll") for (int m = 0; m < 4; ++m) _Pragma("unroll") for (int n = 0; n < 2; ++n) _Pragma("unroll") for (int k = 0; k < 2; ++k) \
        acc[ai][bj][m][n] = __builtin_amdgcn_mfma_f32_16x16x32_bf16(Bt[n][k], At[m][k], acc[ai][bj][m][n], 0, 0, 0); __builtin_amdgcn_s_setprio(0); } while (0)
#define PG8_WAIT_V(n) asm volatile("s_waitcnt vmcnt(" #n ")" ::: "memory")
#define PG8_WAIT_L(n) asm volatile("s_waitcnt lgkmcnt(" #n ")" ::: "memory")
#define PG8_BAR __builtin_amdgcn_s_barrier()
#define PG8_SCHED __builtin_amdgcn_sched_barrier(0)
    Unit cur, nxt; int ui = 0;
    if (!S.next(0, cur)) return;
    f32x4 acc[2][2][4][2];
#pragma unroll
    for (int a = 0; a < 2; ++a)
#pragma unroll
        for (int b = 0; b < 2; ++b)
#pragma unroll
            for (int m = 0; m < 4; ++m)
#pragma unroll
                for (int n = 0; n < 2; ++n) acc[a][b][m][n] = (f32x4){0.f, 0.f, 0.f, 0.f};
    bf16x8 At[4][2], B0[2][2], B1[2][2];
    const char* cA = (const char*)g.A + (size_t)cur.pm * tstep; const char* cB = (const char*)g.Bt + (size_t)cur.pn * tstep;
    S.a_ready(cur);
    PG8_STAGE(PG8_SB(0, 0), cB, voffB); PG8_STAGE(PG8_SA(0, 0), cA, voffA); PG8_STAGE(PG8_SB(0, 1), cB + hstep, voffB); PG8_STAGE(PG8_SA(0, 1), cA + hstep, voffA);
    if (wr == 1) PG8_BAR;
    PG8_WAIT_V(4); PG8_BAR;
    PG8_STAGE(PG8_SB(1, 0), cB + kstep, voffB); PG8_STAGE(PG8_SA(1, 0), cA + kstep, voffA); PG8_STAGE(PG8_SB(1, 1), cB + hstep + kstep, voffB);
    PG8_WAIT_V(6); PG8_BAR;
    for (;;) {
        const bool has_next = S.next(ui + 1, nxt);
        const char* nA = has_next ? (const char*)g.A + (size_t)nxt.pm * tstep : cA; const char* nB = has_next ? (const char*)g.Bt + (size_t)nxt.pn * tstep : cB;
        for (int t = 0; t < nt; t += 2) {
            const bool last = (t == nt - 2);
            const char* a1 = cA + (size_t)(t + 1) * kstep;
            const char* a2 = last ? nA : cA + (size_t)(t + 2) * kstep; const char* b2 = last ? nB : cB + (size_t)(t + 2) * kstep;
            const char* a3 = a2 + kstep; const char* b3 = b2 + kstep;
            if (last && has_next) S.a_ready(nxt);
            PG8_LDB(B0, 0, 0); PG8_SCHED; PG8_LDA(At, 0, 0); PG8_STAGE(PG8_SA(1, 1), a1 + hstep, voffA);
            PG8_WAIT_L(8); PG8_BAR; PG8_WAIT_L(0); PG8_MMA(0, 0, At, B0); PG8_BAR; PG8_SCHED;
            PG8_LDB(B1, 0, 1); PG8_STAGE(PG8_SB(0, 0), b2, voffB);
            PG8_BAR; PG8_WAIT_L(0); PG8_MMA(0, 1, At, B1); PG8_BAR;
            PG8_LDA(At, 0, 1); PG8_STAGE(PG8_SA(0, 0), a2, voffA);
            PG8_BAR; PG8_WAIT_L(0); PG8_MMA(1, 0, At, B0); PG8_BAR; PG8_SCHED;
            PG8_STAGE(PG8_SB(0, 1), b2 + hstep, voffB);
            PG8_WAIT_V(6); PG8_BAR; PG8_MMA(1, 1, At, B1); PG8_BAR;
            PG8_LDB(B0, 1, 0); PG8_SCHED; PG8_LDA(At, 1, 0); PG8_STAGE(PG8_SA(0, 1), a2 + hstep, voffA);
            PG8_WAIT_L(8); PG8_BAR; PG8_WAIT_L(0); PG8_MMA(0, 0, At, B0); PG8_BAR; PG8_SCHED;
            PG8_LDB(B1, 1, 1); PG8_STAGE(PG8_SB(1, 0), b3, voffB);
            PG8_BAR; PG8_WAIT_L(0); PG8_MMA(0, 1, At, B1); PG8_BAR;
            PG8_LDA(At, 1, 1); PG8_STAGE(PG8_SA(1, 0), a3, voffA);
            PG8_BAR; PG8_WAIT_L(0); PG8_MMA(1, 0, At, B0); PG8_BAR; PG8_SCHED;
            PG8_STAGE(PG8_SB(1, 1), b3 + hstep, voffB);
            PG8_WAIT_V(6); PG8_BAR; PG8_MMA(1, 1, At, B1); PG8_BAR;
        }
        if constexpr (!Epi::AFTER_DRAIN) { E(acc, cur, wr, wc, fr, fq); S.done(cur); }
        if (!has_next) break;
#pragma unroll
        for (int a = 0; a < 2; ++a)
#pragma unroll
            for (int b = 0; b < 2; ++b)
#pragma unroll
                for (int m = 0; m < 4; ++m)
#pragma unroll
                    for (int n = 0; n < 2; ++n) acc[a][b][m][n] = (f32x4){0.f, 0.f, 0.f, 0.f};
        cur = nxt; cA = nA; cB = nB; ++ui;
    }
    PG8_WAIT_V(0);
    if (wr == 0) PG8_BAR;
    PG8_BAR;
    if constexpr (Epi::AFTER_DRAIN) { E.fused(acc, cur, wr, wc, fr, fq, lds, wid, lane); S.done(cur); }
#undef PG8_SA
#undef PG8_SB
#undef PG8_STAGE
#undef PG8_LDA
#undef PG8_LDB
#undef PG8_MMA
#undef PG8_WAIT_V
#undef PG8_WAIT_L
#undef PG8_BAR
#undef PG8_SCHED
}

}

constexpr int SROW = 144;
constexpr int A_ST = 256 * SROW, B_ST = 128 * SROW, ST_BYTES = A_ST + B_ST;

DEV void gemm_kloop(f32x4 (&acc)[4][4], const bf16_t* __restrict__ A, int lda, const bf16_t* __restrict__ Bt, int ldb,
                    int K, char* smem) {
  const int tid = ltid(), lane = tid & 63, w = tid >> 6, wm = w >> 1, wn = w & 1;
  const int fr = lane & 15, fq = lane >> 4;
  const int lrow = tid >> 3, lch = tid & 7;
  const bf16_t* ga = A + (size_t)lrow * lda + lch * 8;
  const bf16_t* gb = Bt + (size_t)lrow * ldb + lch * 8;
  u32x4 ra[4], rb[2];
#pragma unroll
  for (int i = 0; i < 4; ++i) ra[i] = *(const u32x4*)(ga + (size_t)(64 * i) * lda);
#pragma unroll
  for (int i = 0; i < 2; ++i) rb[i] = *(const u32x4*)(gb + (size_t)(64 * i) * ldb);
  char* swa = smem + lrow * SROW + lch * 16;
  char* swb = swa + A_ST;
  __syncthreads();
#pragma unroll
  for (int i = 0; i < 4; ++i) *(u32x4*)(swa + i * 64 * SROW) = ra[i];
#pragma unroll
  for (int i = 0; i < 2; ++i) *(u32x4*)(swb + i * 64 * SROW) = rb[i];
  __syncthreads();
  const int nk = K >> 6;
  const char* sra = smem + (wm * 64 + fr) * SROW + fq * 16;
  const char* srb = smem + A_ST + (wn * 64 + fr) * SROW + fq * 16;
  for (int kt = 0; kt < nk; ++kt) {
    const int cur = kt & 1;
    if (kt + 1 < nk) {
#pragma unroll
      for (int i = 0; i < 4; ++i) ra[i] = *(const u32x4*)(ga + (size_t)(64 * i) * lda + (kt + 1) * 64);
#pragma unroll
      for (int i = 0; i < 2; ++i) rb[i] = *(const u32x4*)(gb + (size_t)(64 * i) * ldb + (kt + 1) * 64);
    }
#pragma unroll
    for (int ks = 0; ks < 2; ++ks) {
      bf16x8 af[4], bfr[4];
#pragma unroll
      for (int mi = 0; mi < 4; ++mi) af[mi] = *(const bf16x8*)(sra + cur * ST_BYTES + mi * 16 * SROW + ks * 64);
#pragma unroll
      for (int ni = 0; ni < 4; ++ni) bfr[ni] = *(const bf16x8*)(srb + cur * ST_BYTES + ni * 16 * SROW + ks * 64);
#pragma unroll
      for (int mi = 0; mi < 4; ++mi)
#pragma unroll
        for (int ni = 0; ni < 4; ++ni)
          acc[mi][ni] = __builtin_amdgcn_mfma_f32_16x16x32_bf16(bfr[ni], af[mi], acc[mi][ni], 0, 0, 0);
    }
    if (kt + 1 < nk) {
      const int nx = cur ^ 1;
#pragma unroll
      for (int i = 0; i < 4; ++i) *(u32x4*)(swa + nx * ST_BYTES + i * 64 * SROW) = ra[i];
#pragma unroll
      for (int i = 0; i < 2; ++i) *(u32x4*)(swb + nx * ST_BYTES + i * 64 * SROW) = rb[i];
    }
    __syncthreads();
  }
}
DEV void zero_acc(f32x4 (&acc)[4][4]) {
#pragma unroll
  for (int a = 0; a < 4; ++a)
#pragma unroll
    for (int b = 0; b < 4; ++b) acc[a][b] = (f32x4){0.f, 0.f, 0.f, 0.f};
}
DEV void tile_pm_pn(int L, int nN, int& pm, int& pn) {
  const int g = L / (4 * nN), wi = L % (4 * nN);
  pm = g * 4 + (wi & 3);
  pn = wi >> 2;
}

DEV int conv_srccol(int n) {
  const int tile = n >> 8, w = n & 255;
  return w < 128 ? tile * 128 + w : 512 + tile * 128 + (w - 128);
}
DEV void cvt_job(const float* __restrict__ src, int K, int N, int ldsrc, bf16_t* __restrict__ dst, int nperm, int& tbase, char* smem) {
  float* lds = (float*)smem;
  const int nkt = K >> 6, nnt = N >> 6, cnt = nkt * nnt;
  const int G = gridDim.x;
  const int first = (int)((blockIdx.x + G - (tbase % G)) % G);
  const int tid = ltid();
  for (int t = first; t < cnt; t += G) {
    const int kt = t % nkt, nt = t / nkt;
    const int ty = tid >> 4, tx = tid & 15;
    const int n = nt * 64 + tx * 4;
    const int sc = (n < nperm) ? conv_srccol(n) : n;
#pragma unroll
    for (int i = 0; i < 2; ++i) {
      const int k = ty + 32 * i;
      const float4 v = *(const float4*)(src + (size_t)(kt * 64 + k) * ldsrc + sc);
      float* d = lds + k * 65 + tx * 4;
      d[0] = v.x; d[1] = v.y; d[2] = v.z; d[3] = v.w;
    }
    __syncthreads();
    {
      const int nn = tid >> 3, kc = tid & 7;
      float v[8];
#pragma unroll
      for (int j = 0; j < 8; ++j) v[j] = lds[(kc * 8 + j) * 65 + nn];
      uint4 o;
      o.x = pk2(v[0], v[1]); o.y = pk2(v[2], v[3]); o.z = pk2(v[4], v[5]); o.w = pk2(v[6], v[7]);
      *(uint4*)(dst + (size_t)(nt * 64 + nn) * K + kt * 64 + kc * 8) = o;
    }
    __syncthreads();
  }
  tbase += cnt;
}
DEV void cvt_phase(const Params& p, int l, char* smem) {
  char* wb = p.ws + O_WB;
  int tb = 0;
  const float* win = p.w_in + (size_t)l * 1024 * DIN;
  cvt_job(win, 1024, NZ, DIN, (bf16_t*)(wb + W_WIN), 1024, tb, smem);
  cvt_job(win + NZ, 1024, 3072, DIN, (bf16_t*)(wb + W_WIN) + (size_t)NZP * 1024, 0, tb, smem);
  cvt_job(p.mlp_w1 + (size_t)l * 1024 * 4096, 1024, 4096, 4096, (bf16_t*)(wb + W_W1), 0, tb, smem);
  cvt_job(p.mlp_w2 + (size_t)l * 4096 * 1024, 4096, 1024, 1024, (bf16_t*)(wb + W_W2), 0, tb, smem);
  cvt_job(p.w_out + (size_t)l * 1024 * 1024, 1024, 1024, 1024, (bf16_t*)(wb + W_WOUT), 0, tb, smem);
  cvt_job(p.p_conv + (size_t)l * 512 * 1024, 512, 1024, 1024, (bf16_t*)(wb + W_PCV), 0, tb, smem);
  cvt_job(p.p_att + (size_t)l * 512 * 1024, 512, 1024, 1024, (bf16_t*)(wb + W_PAT), 0, tb, smem);
  cvt_job(p.p_rwkv + (size_t)l * 512 * 1024, 512, 1024, 1024, (bf16_t*)(wb + W_PRW), 0, tb, smem);
  for (int d = 0; d < 2; ++d) {
    cvt_job(p.rwkv_w2 + (size_t)(l * 2 + d) * 64 * 512, 64, 512, 512, (bf16_t*)(wb + W_LW2) + d * 512 * 64, 0, tb, smem);
    cvt_job(p.rwkv_a2 + (size_t)(l * 2 + d) * 64 * 512, 64, 512, 512, (bf16_t*)(wb + W_LA2) + d * 512 * 64, 0, tb, smem);
  }
  cvt_job(p.rwkv_g2 + (size_t)l * 128 * 512, 128, 512, 512, (bf16_t*)(wb + W_LG2), 0, tb, smem);
}

DEV void mod_phase(const Params& p, char* smem) {
  float* sc = (float*)smem;
  float* red = sc + 9 * 1024;
  float* MOD = (float*)(p.ws + O_MOD);
  const int tid = ltid();
  if ((int)blockIdx.x >= 192) return;
  for (int i = tid; i < 9 * 1024; i += 512) {
    const int r = i >> 10, k = i & 1023;
    const float v = r < 8 ? p.c[r * 1024 + k] : p.c_ctx[k];
    sc[i] = v / (1.f + __expf(-v));
  }
  __syncthreads();
  for (int tile = blockIdx.x; tile < 192; tile += gridDim.x) {
    const int l = tile / 96, n0 = (tile % 96) * 64;
    const int kq = tid >> 6, col = tid & 63;
    float acc[9];
#pragma unroll
    for (int r = 0; r < 9; ++r) acc[r] = 0.f;
    const float* wp = p.mod_w + ((size_t)l * 1024 + kq * 128) * 6144 + n0 + col;
#pragma unroll 32
    for (int k = 0; k < 128; ++k) {
      const float wv = wp[(size_t)k * 6144];
#pragma unroll
      for (int r = 0; r < 9; ++r) acc[r] += sc[r * 1024 + kq * 128 + k] * wv;
    }
#pragma unroll
    for (int r = 0; r < 9; ++r) red[(kq * 9 + r) * 64 + col] = acc[r];
    __syncthreads();
    for (int idx = tid; idx < 576; idx += 512) {
      const int r = idx >> 6, cc = idx & 63;
      float s = p.mod_b[l * 6144 + n0 + cc];
#pragma unroll
      for (int q = 0; q < 8; ++q) s += red[(q * 9 + r) * 64 + cc];
      MOD[(size_t)(l * 9 + r) * 6144 + n0 + cc] = s;
    }
    __syncthreads();
  }
}

DEV void norm_phase(const Params& p, int l, int which, bf16_t* __restrict__ Hd, bool first, int nrows = T_ALL) {
  const float* g = (which ? p.norm2_g : p.norm1_g) + l * 1024;
  const float* MOD = (const float*)(p.ws + O_MOD);
  const int lane = ltid() & 63, w = ltid() >> 6;
  const int stride = gridDim.x * 8;
  f32x4 gg[4];
#pragma unroll
  for (int i = 0; i < 4; ++i) gg[i] = *(const f32x4*)(g + i * 256 + lane * 4);
  auto srcp = [&](int row) -> const float* {
    if (first) return row < T_LAT ? p.x + (size_t)row * DM : p.ctx + (size_t)(row - T_LAT) * DM;
    return xrow(p, row);
  };
  int row = blockIdx.x * 8 + w;
  f32x4 nv[4];
  if (row < nrows) {
    const float* s = srcp(row);
#pragma unroll
    for (int i = 0; i < 4; ++i) nv[i] = *(const f32x4*)(s + i * 256 + lane * 4);
  }
  for (; row < nrows; row += stride) {
    f32x4 v[4];
#pragma unroll
    for (int i = 0; i < 4; ++i) v[i] = nv[i];
    if (row + stride < nrows) {
      const float* s = srcp(row + stride);
#pragma unroll
      for (int i = 0; i < 4; ++i) nv[i] = *(const f32x4*)(s + i * 256 + lane * 4);
    }
    const float* md = MOD + (size_t)(l * 9 + modrow(row)) * 6144 + which * 3072;
    f32x4 sh[4], scl[4];
#pragma unroll
    for (int i = 0; i < 4; ++i) { sh[i] = *(const f32x4*)(md + i * 256 + lane * 4); scl[i] = *(const f32x4*)(md + 1024 + i * 256 + lane * 4); }
    float ss = 0.f;
#pragma unroll
    for (int i = 0; i < 4; ++i) ss += v[i][0] * v[i][0] + v[i][1] * v[i][1] + v[i][2] * v[i][2] + v[i][3] * v[i][3];
    if (first) {
      float* xr = xrow(p, row);
#pragma unroll
      for (int i = 0; i < 4; ++i) *(f32x4*)(xr + i * 256 + lane * 4) = v[i];
    }
    const float rs = rsqrtf(wsum(ss) * (1.f / 1024.f) + 1e-6f);
#pragma unroll
    for (int i = 0; i < 4; ++i) {
      const int c = i * 256 + lane * 4;
      const f32x4 h = v[i] * rs * gg[i] * (scl[i] + 1.f) + sh[i];
      uint2 o;
      o.x = pk2(h[0], h[1]); o.y = pk2(h[2], h[3]);
      *(uint2*)(Hd + (size_t)row * DM + c) = o;
    }
  }
}

DEV void rope2(float a, float b, float ang, float& o0, float& o1) {
  const float cs = __cosf(ang), sn = __sinf(ang);
  o0 = a * cs - b * sn;
  o1 = a * sn + b * cs;
}
struct EpiIn {
  static constexpr bool PERM = true, AFTER_DRAIN = false;
  bf16_t *ZU, *ZQ, *ZK, *VT, *ZRW;
  DEV void operator()(const f32x4 (&acc)[2][2][4][2], const pg8::Unit& u, int wr, int wc, int fr, int fq) const {
    const int row0 = u.pm * 256 + wr * 64 + fr, cl = wc * 32 + 8 * fq, pn = u.pn;
    if (pn < 4) {
#pragma unroll
      for (int ai = 0; ai < 2; ++ai)
#pragma unroll
        for (int m = 0; m < 4; ++m) {
          const int row = row0 + ai * 128 + m * 16;
          const f32x4 a0 = acc[ai][0][m][0], a1 = acc[ai][0][m][1], b0 = acc[ai][1][m][0], b1 = acc[ai][1][m][1];
          u32x4 o;
          o[0] = pk2(a0[0] * sigmoidf_(b0[0]), a0[1] * sigmoidf_(b0[1]));
          o[1] = pk2(a0[2] * sigmoidf_(b0[2]), a0[3] * sigmoidf_(b0[3]));
          o[2] = pk2(a1[0] * sigmoidf_(b1[0]), a1[1] * sigmoidf_(b1[1]));
          o[3] = pk2(a1[2] * sigmoidf_(b1[2]), a1[3] * sigmoidf_(b1[3]));
          *(u32x4*)(ZU + (size_t)row * 512 + pn * 128 + cl) = o;
        }
    } else if (pn < 8) {
      const bool isq = pn < 6;
      bf16_t* Z = isq ? ZQ : ZK;
      const float qs = isq ? 0.125f * 1.4426950408889634f : 1.f;
      const int cbase = (pn - (isq ? 4 : 6)) * 256 + cl;
#pragma unroll
      for (int ai = 0; ai < 2; ++ai)
#pragma unroll
        for (int m = 0; m < 4; ++m) {
          const int row = row0 + ai * 128 + m * 16;
#pragma unroll
          for (int bj = 0; bj < 2; ++bj) {
            const int c = cbase + bj * 128;
            float v[8];
#pragma unroll
            for (int j = 0; j < 4; ++j) { v[j] = acc[ai][bj][m][0][j]; v[4 + j] = acc[ai][bj][m][1][j]; }
            if (row < T_LAT) {
              const int t = row & 4095, d = c & 63, p0 = d >> 1;
              const float pos = (float)((p0 < 16) ? (t >> 6) : (t & 63));
              const int fi = p0 & 15;
#pragma unroll
              for (int q = 0; q < 4; ++q) {
                const float fr_ = exp2f(-(float)(fi + q) * 0.8304820237218406f);
                float o0, o1;
                rope2(v[2 * q], v[2 * q + 1], pos * fr_, o0, o1);
                v[2 * q] = o0; v[2 * q + 1] = o1;
              }
            }
            u32x4 o;
            o[0] = pk2(v[0] * qs, v[1] * qs); o[1] = pk2(v[2] * qs, v[3] * qs);
            o[2] = pk2(v[4] * qs, v[5] * qs); o[3] = pk2(v[6] * qs, v[7] * qs);
            *(u32x4*)(Z + (size_t)row * 512 + c) = o;
          }
        }
    } else if (pn < 10) {
#pragma unroll
      for (int ai = 0; ai < 2; ++ai)
#pragma unroll
        for (int m = 0; m < 4; ++m) {
          const int row = row0 + ai * 128 + m * 16;
          int b, kidx;
          if (row < T_LAT) { b = row >> 12; kidx = 256 + (row & 4095); } else { b = (row - T_LAT) >> 8; kidx = (row - T_LAT) & 255; }
#pragma unroll
          for (int bj = 0; bj < 2; ++bj) {
            const int head = (pn - 8) * 2 + bj;
            bf16_t* dst = VT + ((size_t)((b * 4 + head) * 128 + cl)) * TK + kidx;
#pragma unroll
            for (int j = 0; j < 4; ++j) {
              dst[(size_t)j * TK] = f2bf(acc[ai][bj][m][0][j]);
              dst[(size_t)(4 + j) * TK] = f2bf(acc[ai][bj][m][1][j]);
            }
          }
        }
    } else {
#pragma unroll
      for (int ai = 0; ai < 2; ++ai)
#pragma unroll
        for (int m = 0; m < 4; ++m) {
          const int row = row0 + ai * 128 + m * 16;
#pragma unroll
          for (int bj = 0; bj < 2; ++bj) {
            const int c = (pn - 10) * 256 + bj * 128 + cl;
            if (c < 1920) {
              u32x4 o;
              o[0] = pk2(acc[ai][bj][m][0][0], acc[ai][bj][m][0][1]); o[1] = pk2(acc[ai][bj][m][0][2], acc[ai][bj][m][0][3]);
              o[2] = pk2(acc[ai][bj][m][1][0], acc[ai][bj][m][1][1]); o[3] = pk2(acc[ai][bj][m][1][2], acc[ai][bj][m][1][3]);
              *(u32x4*)(ZRW + (size_t)row * 1920 + c) = o;
            }
          }
        }
    }
  }
};
DEV void gemm_in_phase(const Params& p, char* smem) {
  EpiIn E;
  E.ZU = (bf16_t*)(p.ws + O_ZU); E.ZQ = (bf16_t*)(p.ws + O_ZQ); E.ZK = (bf16_t*)(p.ws + O_ZK);
  E.VT = (bf16_t*)(p.ws + O_VT); E.ZRW = (bf16_t*)(p.ws + O_ZRW);
  pg8::Gemm g;
  g.A = (const bf16_t*)(p.ws + O_H0); g.Bt = (const bf16_t*)(p.ws + O_WB + W_WIN); g.M = T_ALL; g.N = NZP; g.K = 1024;
  pg8::StaticOrder S;
  S.init(g.M, g.N, (int)gridDim.x, (int)blockIdx.x);
  __syncthreads();
  pg8::gemm_phase<EpiIn, pg8::StaticOrder>((PG8_LAS unsigned char*)smem, g, S, E);
  __syncthreads();
}

constexpr int KROW = 272, VROW = 144, ATT_ST = 64 * KROW + 128 * VROW;
constexpr int ATT2_ST = 2 * 128 * KROW;
DEV int key_of_slot(int x) { return (x & 0x13) | ((x & 8) >> 1) | ((x & 4) << 1); }

DEV void attn_tile(const Params& p, int l, int tile, char* smem, bool do_store = true) {
  bf16_t* ZQ = (bf16_t*)(p.ws + O_ZQ);
  const bf16_t* ZK = (const bf16_t*)(p.ws + O_ZK);
  const bf16_t* VT = (const bf16_t*)(p.ws + O_VT);
  int b, head, q0, nkeys, qbase;
  if (tile < 1024) { b = tile >> 7; head = (tile >> 5) & 3; q0 = (tile & 31) * 128; nkeys = TK; qbase = b * SEQ; }
  else { const int tt = tile - 1024; b = tt >> 3; head = (tt >> 1) & 3; q0 = (tt & 1) * 128; nkeys = CTXL; qbase = T_LAT + b * CTXL; }
  const int tid = ltid(), lane = tid & 63, w = tid >> 6, ql = lane & 31, hh = lane >> 5, map = w >> 2, qg = w & 3;
  const int qrow = qbase + q0 + qg * 32 + ql;
  const float lam_init = l == 0 ? 0.2f : 0.35550907f;
  float lam;
  {
    const float a1 = p.att_lq1[l * 64 + lane] * p.att_lk1[l * 64 + lane];
    const float a2 = p.att_lq2[l * 64 + lane] * p.att_lk2[l * 64 + lane];
    lam = __expf(wsum(a1)) - __expf(wsum(a2)) + lam_init;
  }
  bf16x8 qf[4];
#pragma unroll
  for (int s = 0; s < 4; ++s) qf[s] = *(const bf16x8*)(ZQ + (size_t)qrow * 512 + head * 128 + map * 64 + s * 16 + hh * 8);
  f32x16 o[4];
#pragma unroll
  for (int dt = 0; dt < 4; ++dt)
#pragma unroll
    for (int e = 0; e < 16; ++e) o[dt][e] = 0.f;
  float m = -1e30f, lsum = 0.f;
  const int kr0 = tid >> 4, kch = tid & 15;
  const int vr0 = tid >> 4, vch = tid & 15;
  const bf16_t* vtb = VT + ((size_t)((b * 4 + head) * 128)) * TK;
  u32x4 kreg[4], vreg[4];
  auto gload = [&](int kt) {
    const int k0 = kt * 128;
#pragma unroll
    for (int i = 0; i < 4; ++i) {
      const int kidx = k0 + kr0 + 32 * i;
      const int krow = kidx < CTXL ? T_LAT + b * CTXL + kidx : b * SEQ + kidx - CTXL;
      kreg[i] = *(const u32x4*)(ZK + (size_t)krow * 512 + head * 128 + kch * 8);
      vreg[i] = *(const u32x4*)(vtb + (size_t)(vr0 + 32 * i) * TK + k0 + vch * 8);
    }
  };
  auto lstore = [&](int st) {
    char* Ks = smem + st * ATT2_ST;
    char* Vs = Ks + 128 * KROW;
#pragma unroll
    for (int i = 0; i < 4; ++i) {
      *(u32x4*)(Ks + (kr0 + 32 * i) * KROW + kch * 16) = kreg[i];
      *(u32x4*)(Vs + (vr0 + 32 * i) * KROW + vch * 16) = vreg[i];
    }
  };
  const int nkt = nkeys >> 7;
  gload(0);
  __syncthreads();
  lstore(0);
  __syncthreads();
  const int kos = key_of_slot(ql);
  for (int kt = 0; kt < nkt; ++kt) {
    const int cur = kt & 1;
    if (kt + 1 < nkt) gload(kt + 1);
    const char* Ks = smem + cur * ATT2_ST;
    const char* Vs = Ks + 128 * KROW;
#pragma unroll
    for (int h2 = 0; h2 < 2; ++h2) {
    const char* kp = Ks + (h2 * 64 + kos) * KROW + (map * 64 + hh * 8) * 2;
    const char* vp = Vs + ql * KROW + hh * 16 + h2 * 128;
    bf16x8 kf0[4], kf1[4];
#pragma unroll
    for (int ks = 0; ks < 4; ++ks) { kf0[ks] = *(const bf16x8*)(kp + ks * 32); kf1[ks] = *(const bf16x8*)(kp + 32 * KROW + ks * 32); }
    f32x16 s0, s1;
#pragma unroll
    for (int e = 0; e < 16; ++e) { s0[e] = 0.f; s1[e] = 0.f; }
#pragma unroll
    for (int ks = 0; ks < 4; ++ks) s0 = __builtin_amdgcn_mfma_f32_32x32x16_bf16(kf0[ks], qf[ks], s0, 0, 0, 0);
#pragma unroll
    for (int ks = 0; ks < 4; ++ks) s1 = __builtin_amdgcn_mfma_f32_32x32x16_bf16(kf1[ks], qf[ks], s1, 0, 0, 0);
    bf16x8 vf[8];
#pragma unroll
    for (int dt = 0; dt < 4; ++dt)
#pragma unroll
      for (int k2 = 0; k2 < 2; ++k2) vf[dt * 2 + k2] = *(const bf16x8*)(vp + dt * 32 * KROW + (k2 * 16) * 2);
    float mx = fmaxf(s0[0], s1[0]);
#pragma unroll
    for (int e = 1; e < 16; ++e) mx = fmaxf(mx, fmaxf(s0[e], s1[e]));
    mx = xor32_max(mx);
    const float mnew = (mx > m + 8.f) ? mx : m;
    if (__any(mnew > m)) {
      const float alpha = __builtin_amdgcn_exp2f(m - mnew);
      lsum *= alpha;
#pragma unroll
      for (int dt = 0; dt < 4; ++dt)
#pragma unroll
        for (int e = 0; e < 16; ++e) o[dt][e] *= alpha;
    }
    m = mnew;
    bf16x8 pb0[2], pb1[2];
    {
      float pe[16];
#pragma unroll
      for (int e = 0; e < 16; ++e) { pe[e] = __builtin_amdgcn_exp2f(s0[e] - m); lsum += pe[e]; }
#pragma unroll
      for (int k2 = 0; k2 < 2; ++k2) {
        u32x4 u;
        u[0] = pk2(pe[8 * k2 + 0], pe[8 * k2 + 1]); u[1] = pk2(pe[8 * k2 + 2], pe[8 * k2 + 3]);
        u[2] = pk2(pe[8 * k2 + 4], pe[8 * k2 + 5]); u[3] = pk2(pe[8 * k2 + 6], pe[8 * k2 + 7]);
        pb0[k2] = __builtin_bit_cast(bf16x8, u);
      }
    }
#pragma unroll
    for (int dt = 0; dt < 4; ++dt)
#pragma unroll
      for (int k2 = 0; k2 < 2; ++k2) o[dt] = __builtin_amdgcn_mfma_f32_32x32x16_bf16(vf[dt * 2 + k2], pb0[k2], o[dt], 0, 0, 0);
#pragma unroll
    for (int dt = 0; dt < 4; ++dt)
#pragma unroll
      for (int k2 = 0; k2 < 2; ++k2) vf[dt * 2 + k2] = *(const bf16x8*)(vp + dt * 32 * KROW + (32 + k2 * 16) * 2);
    {
      float pe[16];
#pragma unroll
      for (int e = 0; e < 16; ++e) { pe[e] = __builtin_amdgcn_exp2f(s1[e] - m); lsum += pe[e]; }
#pragma unroll
      for (int k2 = 0; k2 < 2; ++k2) {
        u32x4 u;
        u[0] = pk2(pe[8 * k2 + 0], pe[8 * k2 + 1]); u[1] = pk2(pe[8 * k2 + 2], pe[8 * k2 + 3]);
        u[2] = pk2(pe[8 * k2 + 4], pe[8 * k2 + 5]); u[3] = pk2(pe[8 * k2 + 6], pe[8 * k2 + 7]);
        pb1[k2] = __builtin_bit_cast(bf16x8, u);
      }
    }
#pragma unroll
    for (int dt = 0; dt < 4; ++dt)
#pragma unroll
      for (int k2 = 0; k2 < 2; ++k2) o[dt] = __builtin_amdgcn_mfma_f32_32x32x16_bf16(vf[dt * 2 + k2], pb1[k2], o[dt], 0, 0, 0);
    }
    if (kt + 1 < nkt) lstore(cur ^ 1);
    __syncthreads();
  }
  const float ltot = xor32_sum(lsum);
  float* ex = (float*)smem;
  if (map == 1) {
    const float c2 = lam / ltot;
#pragma unroll
    for (int dt = 0; dt < 4; ++dt)
#pragma unroll
      for (int e = 0; e < 16; ++e) {
        const int dv = dt * 32 + 8 * (e >> 2) + 4 * hh + (e & 3);
        ex[(qg * 128 + dv) * 32 + ql] = o[dt][e] * c2;
      }
  }
  __syncthreads();
  if (map == 0 && do_store) {
    const float c1 = 1.f / ltot;
    float ss = 0.f;
#pragma unroll
    for (int dt = 0; dt < 4; ++dt)
#pragma unroll
      for (int e = 0; e < 16; ++e) {
        const int dv = dt * 32 + 8 * (e >> 2) + 4 * hh + (e & 3);
        const float v = o[dt][e] * c1 - ex[(qg * 128 + dv) * 32 + ql];
        o[dt][e] = v;
        ss += v * v;
      }
    ss = xor32_sum(ss);
    const float rs = rsqrtf(ss * (1.f / 128.f) + 1e-5f) * (1.f - lam_init);
    const float* sg = p.att_subln_g + l * 128;
#pragma unroll
    for (int dt = 0; dt < 4; ++dt)
#pragma unroll
      for (int i = 0; i < 4; ++i) {
        const int dv = dt * 32 + 8 * i + 4 * hh;
        const float4 g4 = *(const float4*)(sg + dv);
        uint2 u;
        u.x = pk2(o[dt][4 * i + 0] * rs * g4.x, o[dt][4 * i + 1] * rs * g4.y);
        u.y = pk2(o[dt][4 * i + 2] * rs * g4.z, o[dt][4 * i + 3] * rs * g4.w);
        *(uint2*)(ZQ + (size_t)qrow * 512 + head * 128 + dv) = u;
      }
  }
  __syncthreads();
}

DEV void conv_tile(const Params& p, int l, int tile, char* smem) {
  const bf16_t* ZU = (const bf16_t*)(p.ws + O_ZU);
  bf16_t* YCV = (bf16_t*)(p.ws + O_YCV);
  const int r0 = tile * 32;
  int s_lo, s_hi;
  if (r0 < T_LAT) { s_lo = r0 & ~4095; s_hi = s_lo + SEQ; } else { s_lo = T_LAT + ((r0 - T_LAT) & ~255); s_hi = s_lo + CTXL; }
  const int tid = ltid(), lane = tid & 63, w = tid >> 6, c0 = lane * 8;
  const int t0 = r0 + w * 4;
  const float* wp = p.conv_dw_w + (size_t)l * 31 * 512 + c0;
  float acc[4][8];
  {
    const f32x4 b0 = *(const f32x4*)(p.conv_dw_b + l * 512 + c0), b1 = *(const f32x4*)(p.conv_dw_b + l * 512 + c0 + 4);
#pragma unroll
    for (int t = 0; t < 4; ++t)
#pragma unroll
      for (int j = 0; j < 4; ++j) { acc[t][j] = b0[j]; acc[t][4 + j] = b1[j]; }
  }
  f32x4 wk[4][2];
#pragma unroll
  for (int q = 0; q < 4; ++q) { wk[q][0] = (f32x4){0.f, 0.f, 0.f, 0.f}; wk[q][1] = (f32x4){0.f, 0.f, 0.f, 0.f}; }
#pragma unroll 4
  for (int s = 0; s < 36; ++s) {
    const int rr = t0 - 15 + s;
    u32x4 uv = {0u, 0u, 0u, 0u};
    if (rr >= s_lo && rr < s_hi) uv = *(const u32x4*)(ZU + (size_t)rr * 512 + c0);
    float u[8];
#pragma unroll
    for (int q = 0; q < 4; ++q) { u[2 * q] = lo_bf(uv[q]); u[2 * q + 1] = hi_bf(uv[q]); }
#pragma unroll
    for (int q = 3; q > 0; --q) { wk[q][0] = wk[q - 1][0]; wk[q][1] = wk[q - 1][1]; }
    wk[0][0] = (f32x4){0.f, 0.f, 0.f, 0.f}; wk[0][1] = (f32x4){0.f, 0.f, 0.f, 0.f};
    if (s <= 30) { wk[0][0] = *(const f32x4*)(wp + s * 512); wk[0][1] = *(const f32x4*)(wp + s * 512 + 4); }
#pragma unroll
    for (int t = 0; t < 4; ++t) {
#pragma unroll
      for (int j = 0; j < 4; ++j) { acc[t][j] += wk[t][0][j] * u[j]; acc[t][4 + j] += wk[t][1][j] * u[4 + j]; }
    }
  }
  const f32x4 g0 = *(const f32x4*)(p.conv_ln_g + l * 512 + c0), g1 = *(const f32x4*)(p.conv_ln_g + l * 512 + c0 + 4);
  const f32x4 e0 = *(const f32x4*)(p.conv_ln_b + l * 512 + c0), e1 = *(const f32x4*)(p.conv_ln_b + l * 512 + c0 + 4);
#pragma unroll
  for (int t = 0; t < 4; ++t) {
    float s1 = 0.f;
#pragma unroll
    for (int j = 0; j < 8; ++j) s1 += acc[t][j];
    const float mu = wsum(s1) * (1.f / 512.f);
    float s2 = 0.f;
#pragma unroll
    for (int j = 0; j < 8; ++j) { acc[t][j] -= mu; s2 += acc[t][j] * acc[t][j]; }
    const float rs = rsqrtf(wsum(s2) * (1.f / 512.f) + 1e-5f);
    float y[8];
#pragma unroll
    for (int j = 0; j < 4; ++j) {
      const float z0 = acc[t][j] * rs * g0[j] + e0[j], z1 = acc[t][4 + j] * rs * g1[j] + e1[j];
      y[j] = z0 * sigmoidf_(z0); y[4 + j] = z1 * sigmoidf_(z1);
    }
    u32x4 o;
    o[0] = pk2(y[0], y[1]); o[1] = pk2(y[2], y[3]); o[2] = pk2(y[4], y[5]); o[3] = pk2(y[6], y[7]);
    *(u32x4*)(YCV + (size_t)(t0 + t) * 512 + c0) = o;
  }
}

DEV void shift_tile(const Params& p, int l, int tile) {
  const bf16_t* ZRW = (const bf16_t*)(p.ws + O_ZRW);
  bf16_t* ZRS = (bf16_t*)(p.ws + O_ZRS);
  const int r0 = tile * 32;
  int s_lo, s_hi;
  if (r0 < T_LAT) { s_lo = r0 & ~4095; s_hi = s_lo + SEQ; } else { s_lo = T_LAT + ((r0 - T_LAT) & ~255); s_hi = s_lo + CTXL; }
  const int tid = ltid();
  if (tid >= 480) return;
  const int half = tid >= 240 ? 1 : 0, ch = tid - half * 240, col = ch * 8;
  const int rb = r0 + half * 16;
  u32x4 rows[18];
#pragma unroll
  for (int i = 0; i < 18; ++i) {
    const int rr = rb - 1 + i;
    rows[i] = (u32x4){0u, 0u, 0u, 0u};
    if (rr >= s_lo && rr < s_hi) rows[i] = *(const u32x4*)(ZRW + (size_t)rr * 1920 + col);
  }
  const float* sw = p.rwkv_shift + (size_t)l * 3 * 1920 + col;
  float w0[8], w1[8], w2[8];
#pragma unroll
  for (int j = 0; j < 8; ++j) { w0[j] = sw[j]; w1[j] = sw[1920 + j]; w2[j] = sw[3840 + j]; }
  const int act = (col >= 1536 && col < 1664) ? 1 : (col >= 1792 ? 2 : 0);
#pragma unroll
  for (int i = 0; i < 16; ++i) {
    const int row = rb + i;
    const u32x4 pv = rows[i], cu = rows[i + 1], nx = rows[i + 2];
    float y[8];
#pragma unroll
    for (int q = 0; q < 4; ++q) {
      y[2 * q] = w0[2 * q] * lo_bf(pv[q]) + w1[2 * q] * lo_bf(cu[q]) + w2[2 * q] * lo_bf(nx[q]);
      y[2 * q + 1] = w0[2 * q + 1] * hi_bf(pv[q]) + w1[2 * q + 1] * hi_bf(cu[q]) + w2[2 * q + 1] * hi_bf(nx[q]);
    }
    if (act == 1) {
#pragma unroll
      for (int j = 0; j < 8; ++j) y[j] = 1.f - 2.f / (1.f + __expf(2.f * y[j]));
    } else if (act == 2) {
#pragma unroll
      for (int j = 0; j < 8; ++j) y[j] = sigmoidf_(y[j]);
    }
    u32x4 o;
    o[0] = pk2(y[0], y[1]); o[1] = pk2(y[2], y[3]); o[2] = pk2(y[4], y[5]); o[3] = pk2(y[6], y[7]);
    if (col < 1536) *(u32x4*)(ZRS + (size_t)row * 1536 + col) = o;
    else if (col < 1792) *(u32x4*)((bf16_t*)(p.ws + O_LIN) + (size_t)row * 256 + (col - 1536)) = o;
    else *(u32x4*)((bf16_t*)(p.ws + O_GIN) + (size_t)row * 128 + (col - 1792)) = o;
  }
}

DEV void branch_phase(const Params& p, int l, char* smem) {
  const bool last = (l == 1);
  if (PROBE & 2) for (int L = vblock(); L < 1088; L += gridDim.x) attn_tile(p, l, L, smem, false);
  if (PROBE & 4) for (int L = vblock() + 1088; L < 3 * 1088; L += gridDim.x) { if (L < 2176) conv_tile(p, l, L - 1088, smem); else shift_tile(p, l, L - 2176); }
  for (int L = vblock(); L < 3 * 1088; L += gridDim.x) {
    if (L < 1088) { if (!(last && L >= 1024)) attn_tile(p, l, L, smem); }
    else if (L < 2176) { if (!(last && L - 1088 >= 1024)) conv_tile(p, l, L - 1088, smem); }
    else shift_tile(p, l, L - 2176);
  }
}

DEV void lora_phase(const Params& p, int l, char* smem, bool gjob) {
  const bf16_t* LIN = (const bf16_t*)(p.ws + O_LIN);
  const int lane = ltid() & 63, w = ltid() >> 6, wm = w >> 1, wn = w & 1, fr = lane & 15, fq = lane >> 4;
  const int ntile = gjob ? 544 : 4 * 544;
  for (int L = vblock(); L < ntile; L += gridDim.x) {
    const int job = gjob ? 4 : L / 544, t = L - (gjob ? 0 : job * 544), pm = t >> 2, pn = t & 3;
    const int row0 = pm * 256, col0 = pn * 128;
    const bf16_t* A;
    const bf16_t* Bt;
    bf16_t* O;
    int K = 64, lda = 256;
    const float* bias = nullptr;
    if (job == 0) { A = LIN; Bt = (const bf16_t*)(p.ws + O_WB + W_LW2); O = (bf16_t*)(p.ws + O_EF); bias = p.rwkv_w0 + (l * 2 + 0) * 512; }
    else if (job == 1) { A = LIN + 64; Bt = (const bf16_t*)(p.ws + O_WB + W_LW2) + 512 * 64; O = (bf16_t*)(p.ws + O_EB); bias = p.rwkv_w0 + (l * 2 + 1) * 512; }
    else if (job == 2) { A = LIN + 128; Bt = (const bf16_t*)(p.ws + O_WB + W_LA2); O = (bf16_t*)(p.ws + O_AF); bias = p.rwkv_a0 + (l * 2 + 0) * 512; }
    else if (job == 3) { A = LIN + 192; Bt = (const bf16_t*)(p.ws + O_WB + W_LA2) + 512 * 64; O = (bf16_t*)(p.ws + O_AB); bias = p.rwkv_a0 + (l * 2 + 1) * 512; }
    else { A = (const bf16_t*)(p.ws + O_GIN); Bt = (const bf16_t*)(p.ws + O_WB + W_LG2); O = (bf16_t*)(p.ws + O_G); K = 128; lda = 128; }
    f32x4 acc[4][4];
    zero_acc(acc);
    gemm_kloop(acc, A + (size_t)row0 * lda, lda, Bt + (size_t)col0 * K, K, K, smem);
#pragma unroll
    for (int mi = 0; mi < 4; ++mi) {
      const int row = row0 + wm * 64 + mi * 16 + fr;
#pragma unroll
      for (int ni = 0; ni < 4; ++ni) {
        const int c = col0 + wn * 64 + ni * 16 + fq * 4;
        float v[4];
#pragma unroll
        for (int j = 0; j < 4; ++j) {
          float z = acc[mi][ni][j];
          if (job < 4) z = sigmoidf_(z + bias[c + j]);
          if (job < 2) z *= 0.6065306597126334f;
          v[j] = z;
        }
        uint2 o;
        o.x = pk2(v[0], v[1]); o.y = pk2(v[2], v[3]);
        *(uint2*)(O + (size_t)row * 512 + c) = o;
      }
    }
  }
}

DEV int scan_row(int step, int dir, int b) {
  if (step < CTXL) { const int t = dir ? (CTXL - 1 - step) : step; return T_LAT + b * CTXL + t; }
  const int s2 = step - CTXL;
  const int t = dir ? (SEQ - 1 - s2) : s2;
  return b * SEQ + t;
}
DEV float red8(float v) {
  v += dppf<0xB1>(v);
  v += dppf<0x4E>(v);
  v += dppf<0x141>(v);
  return v;
}
struct ScanOps { f32x4 nkk0, nkk1, w0, w1, kka0, kka1, kd0, kd1, r0, r1; float v; };
DEV void scan_tile(const Params& p, int l, int tile, char* smem) {
  const int half = tile & 1, dir = (tile >> 1) & 1, h = (tile >> 2) & 7, b = tile >> 5;
  float* arr = (float*)smem;
  float* ybuf = arr + 2 * 32 * 384;
  const bf16_t* ZRS = (const bf16_t*)(p.ws + O_ZRS);
  const bf16_t* E = (const bf16_t*)(p.ws + (dir ? O_EB : O_EF));
  const bf16_t* Aa = (const bf16_t*)(p.ws + (dir ? O_AB : O_AF));
  bf16_t* YS = (bf16_t*)(p.ws + (dir ? O_YSB : O_YSF));
  const int tid = ltid(), lane = tid & 63;
  const int w = __builtin_amdgcn_readfirstlane(tid >> 6);
  const int col = h * 64 + lane;
  const float kkp = p.rwkv_kk[l * 512 + col], kap = p.rwkv_ka[l * 512 + col];
  auto produce = [&](int ch, int buf, int pw, int npw) {
#pragma unroll
    for (int i0 = 0; i0 < 32; i0 += 4 * npw) {
      bf16_t rr[4], rk[4], rv[4], re[4], ra[4];
#pragma unroll
      for (int i = 0; i < 4; ++i) {
        const int R = scan_row(ch * 32 + i0 + pw + npw * i, dir, b);
        rr[i] = ZRS[(size_t)R * 1536 + col];
        rk[i] = ZRS[(size_t)R * 1536 + 512 + col];
        rv[i] = ZRS[(size_t)R * 1536 + 1024 + col];
        re[i] = E[(size_t)R * 512 + col];
        ra[i] = Aa[(size_t)R * 512 + col];
      }
#pragma unroll
      for (int i = 0; i < 4; ++i) {
        const int sl = i0 + pw + npw * i;
        const float r = bf2f(rr[i]), k = bf2f(rk[i]), v = bf2f(rv[i]), e = bf2f(re[i]), a = bf2f(ra[i]);
        const float kkv = k * kkp;
        const float inv = rsqrtf(fmaxf(wsum(kkv * kkv), 1e-24f));
        const float kk = kkv * inv;
        float* d = arr + (buf * 32 + sl) * 384 + lane;
        d[0] = -kk;
        d[64] = __expf(-e);
        d[128] = kk * a;
        d[192] = k * (1.f + (a - 1.f) * kap);
        d[256] = r;
        d[320] = v;
      }
    }
  };
  auto flush = [&](int ch, int buf, int t256) {
#pragma unroll
    for (int q = 0; q < 2; ++q) {
      const int idx = t256 + 256 * q, sl = idx >> 4, rp = (idx & 15) * 2;
      const int R = scan_row(ch * 32 + sl, dir, b);
      const float* yb = ybuf + buf * 1024 + sl * 32 + rp;
      *(unsigned*)(YS + (size_t)R * 512 + h * 64 + half * 32 + rp) = pk2(yb[0], yb[1]);
    }
  };
  __syncthreads();
  produce(0, 0, w, 8);
  __syncthreads();
  f32x4 S0 = {0.f, 0.f, 0.f, 0.f}, S1 = {0.f, 0.f, 0.f, 0.f};
  const int r8 = lane >> 3, cg = lane & 7;
  for (int ch = 0; ch < 136; ++ch) {
    const int buf = ch & 1;
    if (w < 4) {
      const float* cb = arr + buf * 32 * 384;
      const int vo = 320 + half * 32 + w * 8 + r8;
      float* yw = ybuf + buf * 1024 + cg * 32 + w * 8 + r8;
      auto ldops = [&](ScanOps& o, int sl) {
        const f32x4* b4 = (const f32x4*)(cb + sl * 384);
        o.nkk0 = b4[cg * 2]; o.nkk1 = b4[cg * 2 + 1];
        o.w0 = b4[16 + cg * 2]; o.w1 = b4[16 + cg * 2 + 1];
        o.kka0 = b4[32 + cg * 2]; o.kka1 = b4[32 + cg * 2 + 1];
        o.kd0 = b4[48 + cg * 2]; o.kd1 = b4[48 + cg * 2 + 1];
        o.r0 = b4[64 + cg * 2]; o.r1 = b4[64 + cg * 2 + 1];
        o.v = cb[sl * 384 + vo];
      };
      float ykeep = 0.f;
      auto step = [&](const ScanOps& o, int sl) {
        const f32x4 sA = S0 * o.nkk0 + S1 * o.nkk1;
        const float sa = red8((sA[0] + sA[1]) + (sA[2] + sA[3]));
        S0 = S0 * o.w0 + (o.kka0 * sa + o.kd0 * o.v);
        S1 = S1 * o.w1 + (o.kka1 * sa + o.kd1 * o.v);
        const f32x4 yA = S0 * o.r0 + S1 * o.r1;
        const float y = red8((yA[0] + yA[1]) + (yA[2] + yA[3]));
        ykeep = (cg == (sl & 7)) ? y : ykeep;
      };
      ScanOps oa, ob;
      ldops(oa, 0);
#pragma unroll
      for (int s8 = 0; s8 < 32; s8 += 8) {
#pragma unroll
        for (int q = 0; q < 8; q += 2) {
          ldops(ob, s8 + q + 1);
          step(oa, s8 + q);
          ldops(oa, (s8 + q + 2) & 31);
          step(ob, s8 + q + 1);
        }
        yw[s8 * 32] = ykeep;
      }
    } else {
      const int pw = w - 4;
      if (ch > 0) flush(ch - 1, buf ^ 1, tid - 256);
      if (ch + 1 < 136) produce(ch + 1, buf ^ 1, pw, 4);
    }
    __syncthreads();
  }
  if (w >= 4) flush(135, 1, tid - 256);
  __syncthreads();
}
DEV void scan_phase(const Params& p, int l, char* smem) {
  for (int L = blockIdx.x; L < 256; L += gridDim.x) scan_tile(p, l, L, smem);
}

DEV void unpack8(const u32x4 u, float (&f)[8]) {
#pragma unroll
  for (int q = 0; q < 4; ++q) { f[2 * q] = lo_bf(u[q]); f[2 * q + 1] = hi_bf(u[q]); }
}
DEV void post_phase(const Params& p, int l, int nrows) {
  const bf16_t* ZRS = (const bf16_t*)(p.ws + O_ZRS);
  const bf16_t* AF = (const bf16_t*)(p.ws + O_AF);
  const bf16_t* AB = (const bf16_t*)(p.ws + O_AB);
  const bf16_t* G = (const bf16_t*)(p.ws + O_G);
  bf16_t* YSF = (bf16_t*)(p.ws + O_YSF);
  const bf16_t* YSB = (const bf16_t*)(p.ws + O_YSB);
  const int lane = ltid() & 63, w = ltid() >> 6, c0 = lane * 8;
  float gng[8], gnb[8], kaw[8], rkw[8];
#pragma unroll
  for (int j = 0; j < 8; ++j) {
    gng[j] = p.rwkv_gn_g[l * 512 + c0 + j]; gnb[j] = p.rwkv_gn_b[l * 512 + c0 + j];
    kaw[j] = p.rwkv_ka[l * 512 + c0 + j]; rkw[j] = p.rwkv_rk[l * 512 + c0 + j];
  }
  const int stride = gridDim.x * 8;
  int row = blockIdx.x * 8 + w;
  u32x4 q_ysf, q_ysb, q_r, q_k, q_v, q_af, q_ab, q_g;
  auto gl = [&](int rw) {
    q_ysf = *(const u32x4*)(YSF + (size_t)rw * 512 + c0); q_ysb = *(const u32x4*)(YSB + (size_t)rw * 512 + c0);
    q_r = *(const u32x4*)(ZRS + (size_t)rw * 1536 + c0); q_k = *(const u32x4*)(ZRS + (size_t)rw * 1536 + 512 + c0);
    q_v = *(const u32x4*)(ZRS + (size_t)rw * 1536 + 1024 + c0);
    q_af = *(const u32x4*)(AF + (size_t)rw * 512 + c0); q_ab = *(const u32x4*)(AB + (size_t)rw * 512 + c0);
    q_g = *(const u32x4*)(G + (size_t)rw * 512 + c0);
  };
  if (row < nrows) gl(row);
  for (; row < nrows; row += stride) {
    float ysf[8], ysb[8], r[8], k[8], v[8], af[8], ab[8], g[8];
    unpack8(q_ysf, ysf); unpack8(q_ysb, ysb); unpack8(q_r, r); unpack8(q_k, k); unpack8(q_v, v);
    unpack8(q_af, af); unpack8(q_ab, ab); unpack8(q_g, g);
    if (row + stride < nrows) gl(row + stride);
    float ys[8], s1 = 0.f, bp = 0.f;
#pragma unroll
    for (int j = 0; j < 8; ++j) {
      ys[j] = ysf[j] + ysb[j]; s1 += ys[j];
      bp += r[j] * k[j] * rkw[j] * (2.f + (af[j] + ab[j] - 2.f) * kaw[j]);
    }
    const float mu = red8(s1) * (1.f / 64.f);
    const float bon = red8(bp);
    float s2 = 0.f;
#pragma unroll
    for (int j = 0; j < 8; ++j) { ys[j] -= mu; s2 += ys[j] * ys[j]; }
    const float rs = rsqrtf(red8(s2) * (1.f / 64.f) + 64e-5f);
    float o[8];
#pragma unroll
    for (int j = 0; j < 8; ++j) o[j] = (ys[j] * rs * gng[j] + gnb[j] + bon * v[j]) * g[j];
    u32x4 ov;
    ov[0] = pk2(o[0], o[1]); ov[1] = pk2(o[2], o[3]); ov[2] = pk2(o[4], o[5]); ov[3] = pk2(o[6], o[7]);
    *(u32x4*)(YSF + (size_t)row * 512 + c0) = ov;
  }
}

struct EpiGate {
  static constexpr bool PERM = true, AFTER_DRAIN = false;
  char* ws;
  DEV void operator()(const f32x4 (&acc)[2][2][4][2], const pg8::Unit& u, int wr, int wc, int fr, int fq) const {
    const int b = u.pn >> 2, pn = u.pn & 3;
    bf16_t* G = (bf16_t*)(ws + (b == 0 ? O_G1 : (b == 1 ? O_G2 : O_G3)));
    const int row0 = u.pm * 256 + wr * 64 + fr, col0 = pn * 256 + wc * 32 + 8 * fq;
#pragma unroll
    for (int ai = 0; ai < 2; ++ai)
#pragma unroll
      for (int m = 0; m < 4; ++m) {
        const int row = row0 + ai * 128 + m * 16;
#pragma unroll
        for (int bj = 0; bj < 2; ++bj) {
          const f32x4 a0 = acc[ai][bj][m][0], a1 = acc[ai][bj][m][1];
          u32x4 o;
          o[0] = pk2(sigmoidf_(a0[0]), sigmoidf_(a0[1])); o[1] = pk2(sigmoidf_(a0[2]), sigmoidf_(a0[3]));
          o[2] = pk2(sigmoidf_(a1[0]), sigmoidf_(a1[1])); o[3] = pk2(sigmoidf_(a1[2]), sigmoidf_(a1[3]));
          *(u32x4*)(G + (size_t)row * DM + col0 + bj * 128) = o;
        }
      }
  }
};
DEV void gate_phase(const Params& p, int nrows, char* smem) {
  EpiGate E;
  E.ws = p.ws;
  pg8::Gemm g;
  g.A = (const bf16_t*)(p.ws + O_HM); g.Bt = (const bf16_t*)(p.ws + O_WB + W_WIN) + (size_t)NZP * 1024; g.M = nrows; g.N = 3072; g.K = 1024;
  pg8::StaticOrder S;
  S.init(g.M, g.N, (int)gridDim.x, (int)blockIdx.x);
  __syncthreads();
  pg8::gemm_phase<EpiGate, pg8::StaticOrder>((PG8_LAS unsigned char*)smem, g, S, E);
  __syncthreads();
}
struct MergeOrder {
  pg8::StaticOrder base;
  DEV bool next(int i, pg8::Unit& u) const {
    const int j = i / 3, b = i - 3 * j;
    pg8::Unit t;
    if (!base.next(j, t)) return false;
    u.pm = t.pm + 136 * (b == 0 ? 11 : (b == 1 ? 12 : 6));
    u.pn = t.pn + 4 * b;
    return true;
  }
  DEV void a_ready(const pg8::Unit&) const {}
  DEV void done(const pg8::Unit&) const {}
};
struct EpiMerge {
  static constexpr bool PERM = true, AFTER_DRAIN = false;
  char* ws;
  DEV void operator()(const f32x4 (&acc)[2][2][4][2], const pg8::Unit& u, int wr, int wc, int fr, int fq) const {
    const int b = u.pn >> 2, pn = u.pn & 3, pm = u.pm - 136 * (b == 0 ? 11 : (b == 1 ? 12 : 6));
    const bf16_t* G = (const bf16_t*)(ws + (b == 0 ? O_G1 : (b == 1 ? O_G2 : O_G3)));
    bf16_t* M = (bf16_t*)(ws + O_M);
    const int row0 = pm * 256 + wr * 64 + fr, col0 = pn * 256 + wc * 32 + 8 * fq;
#pragma unroll
    for (int ai = 0; ai < 2; ++ai)
#pragma unroll
      for (int m = 0; m < 4; ++m) {
        const int row = row0 + ai * 128 + m * 16;
#pragma unroll
        for (int bj = 0; bj < 2; ++bj) {
          const size_t off = (size_t)row * DM + col0 + bj * 128;
          const u32x4 gv = *(const u32x4*)(G + off);
          u32x4 mv = {0u, 0u, 0u, 0u};
          if (b > 0) mv = *(const u32x4*)(M + off);
          const f32x4 a0 = acc[ai][bj][m][0], a1 = acc[ai][bj][m][1];
          u32x4 o;
          o[0] = pk2(lo_bf(mv[0]) + lo_bf(gv[0]) * a0[0], hi_bf(mv[0]) + hi_bf(gv[0]) * a0[1]);
          o[1] = pk2(lo_bf(mv[1]) + lo_bf(gv[1]) * a0[2], hi_bf(mv[1]) + hi_bf(gv[1]) * a0[3]);
          o[2] = pk2(lo_bf(mv[2]) + lo_bf(gv[2]) * a1[0], hi_bf(mv[2]) + hi_bf(gv[2]) * a1[1]);
          o[3] = pk2(lo_bf(mv[3]) + lo_bf(gv[3]) * a1[2], hi_bf(mv[3]) + hi_bf(gv[3]) * a1[3]);
          *(u32x4*)(M + off) = o;
        }
      }
  }
};
DEV void merge_phase(const Params& p, int nrows, char* smem) {
  EpiMerge E;
  E.ws = p.ws;
  pg8::Gemm g;
  g.A = (const bf16_t*)p.ws; g.Bt = (const bf16_t*)(p.ws + O_WB + W_PCV); g.M = nrows; g.N = 1024; g.K = 512;
  MergeOrder S;
  S.base.init(g.M, g.N, (int)gridDim.x, (int)blockIdx.x);
  __syncthreads();
  pg8::gemm_phase<EpiMerge, MergeOrder>((PG8_LAS unsigned char*)smem, g, S, E);
  __syncthreads();
}

struct EpiResid {
  static constexpr bool PERM = false, AFTER_DRAIN = false;
  float* out; float* xc; const float* mod; bool store;
  DEV void operator()(const f32x4 (&acc)[2][2][4][2], const pg8::Unit& u, int wr, int wc, int fr, int fq) const {
    const int row0 = u.pm * 256 + wr * 64 + fr, col0 = u.pn * 256 + wc * 32 + 4 * fq;
#pragma unroll
    for (int ai = 0; ai < 2; ++ai)
#pragma unroll
      for (int m = 0; m < 4; ++m) {
        const int row = row0 + ai * 128 + m * 16;
        float* xr = row < T_LAT ? out + (size_t)row * DM : xc + (size_t)(row - T_LAT) * DM;
        const float* gt = mod + (size_t)modrow(row) * 6144;
#pragma unroll
        for (int bj = 0; bj < 2; ++bj)
#pragma unroll
          for (int n = 0; n < 2; ++n) {
            const int c = col0 + bj * 128 + n * 16;
            const f32x4 g4 = *(const f32x4*)(gt + c);
            f32x4 xv = *(f32x4*)(xr + c);
            xv += g4 * acc[ai][bj][m][n];
            if (store) *(f32x4*)(xr + c) = xv;
          }
      }
  }
};
DEV void resid_gemm_phase(const Params& p, int l, const bf16_t* A, int K, const bf16_t* Wt, int goff, int nrows, char* smem, bool store = true) {
  EpiResid E;
  E.store = store;
  E.out = p.out; E.xc = (float*)(p.ws + O_XC); E.mod = (const float*)(p.ws + O_MOD) + (size_t)l * 9 * 6144 + goff;
  pg8::Gemm g;
  g.A = A; g.Bt = Wt; g.M = nrows; g.N = 1024; g.K = K;
  pg8::StaticOrder S;
  S.init(g.M, g.N, (int)gridDim.x, (int)blockIdx.x);
  __syncthreads();
  pg8::gemm_phase<EpiResid, pg8::StaticOrder>((PG8_LAS unsigned char*)smem, g, S, E);
  __syncthreads();
}

struct EpiMlp1 {
  static constexpr bool PERM = true, AFTER_DRAIN = false;
  bf16_t* HID;
  DEV void operator()(const f32x4 (&acc)[2][2][4][2], const pg8::Unit& u, int wr, int wc, int fr, int fq) const {
    const int row0 = u.pm * 256 + wr * 64 + fr, col0 = u.pn * 256 + wc * 32 + 8 * fq;
#pragma unroll
    for (int ai = 0; ai < 2; ++ai)
#pragma unroll
      for (int m = 0; m < 4; ++m) {
        const int row = row0 + ai * 128 + m * 16;
#pragma unroll
        for (int bj = 0; bj < 2; ++bj) {
          float v[8];
#pragma unroll
          for (int j = 0; j < 4; ++j) {
            const float r0 = fmaxf(acc[ai][bj][m][0][j], 0.f), r1 = fmaxf(acc[ai][bj][m][1][j], 0.f);
            v[j] = r0 * r0; v[4 + j] = r1 * r1;
          }
          u32x4 o;
          o[0] = pk2(v[0], v[1]); o[1] = pk2(v[2], v[3]); o[2] = pk2(v[4], v[5]); o[3] = pk2(v[6], v[7]);
          *(u32x4*)(HID + (size_t)row * 4096 + col0 + bj * 128) = o;
        }
      }
  }
};
DEV void mlp1_phase(const Params& p, int nrows, char* smem) {
  EpiMlp1 E;
  E.HID = (bf16_t*)(p.ws + O_HID);
  pg8::Gemm g;
  g.A = (const bf16_t*)(p.ws + O_HM); g.Bt = (const bf16_t*)(p.ws + O_WB + W_W1); g.M = nrows; g.N = 4096; g.K = 1024;
  pg8::StaticOrder S;
  S.init(g.M, g.N, (int)gridDim.x, (int)blockIdx.x);
  __syncthreads();
  pg8::gemm_phase<EpiMlp1, pg8::StaticOrder>((PG8_LAS unsigned char*)smem, g, S, E);
  __syncthreads();
}

DEV void final_phase(const Params& p) {
  const int lane = ltid() & 63, w = ltid() >> 6;
  const int stride = gridDim.x * 8;
  f32x4 g[4];
#pragma unroll
  for (int i = 0; i < 4; ++i) g[i] = *(const f32x4*)(p.final_g + i * 256 + lane * 4);
  int row = blockIdx.x * 8 + w;
  f32x4 nv[4];
  if (row < T_LAT) {
#pragma unroll
    for (int i = 0; i < 4; ++i) nv[i] = *(const f32x4*)(p.out + (size_t)row * DM + i * 256 + lane * 4);
  }
  for (; row < T_LAT; row += stride) {
    float* xr = p.out + (size_t)row * DM;
    f32x4 v[4];
#pragma unroll
    for (int i = 0; i < 4; ++i) v[i] = nv[i];
    if (row + stride < T_LAT) {
#pragma unroll
      for (int i = 0; i < 4; ++i) nv[i] = *(const f32x4*)(p.out + (size_t)(row + stride) * DM + i * 256 + lane * 4);
    }
    float ss = 0.f;
#pragma unroll
    for (int i = 0; i < 4; ++i) ss += v[i][0] * v[i][0] + v[i][1] * v[i][1] + v[i][2] * v[i][2] + v[i][3] * v[i][3];
    const float rs = rsqrtf(wsum(ss) * (1.f / 1024.f) + 1e-6f);
#pragma unroll
    for (int i = 0; i < 4; ++i) *(f32x4*)(xr + i * 256 + lane * 4) = v[i] * rs * g[i];
  }
}

constexpr int N_PHASES = 26;
__global__ void __launch_bounds__(512) fwd_megakernel(Params p, int ph_lo, int ph_hi) {
  extern __shared__ __attribute__((aligned(16))) char smem[];
  cg::grid_group grid = cg::this_grid();
  volatile XLAS unsigned* st = (volatile XLAS unsigned*)(smem + 139264);
  if (threadIdx.x == 0) { st[0] = 0u; st[1] = 0u; st[2] = 0u; st[3] = 0u; }
  __syncthreads();
  const XcdBarrier xb = xcd_barrier_post((unsigned*)(p.ws + O_BAR), st);
  if (ph_hi > 1000) grid.sync();
  for (int ph = ph_lo; ph < ph_hi; ++ph) {
    if (ph == 0) {
      cvt_phase(p, 0, smem);
      mod_phase(p, smem);
    } else if (ph == N_PHASES - 1) {
      final_phase(p);
    } else {
      const int l = (ph - 1) / 12, sp = (ph - 1) % 12;
      const int nrows = (l == 1) ? T_LAT : T_ALL;
      switch (sp) {
        case 0:
          if (l > 0) cvt_phase(p, l, smem);
          norm_phase(p, l, 0, (bf16_t*)(p.ws + O_H0), l == 0);
          break;
        case 1: gemm_in_phase(p, smem); break;
        case 2: branch_phase(p, l, smem); break;
        case 3:
          lora_phase(p, l, smem, false);
          lora_phase(p, l, smem, true);
          break;
        case 4: scan_phase(p, l, smem); break;
        case 5:
          post_phase(p, l, nrows);
          norm_phase(p, l, 0, (bf16_t*)(p.ws + O_HM), false, nrows);
          break;
        case 6: gate_phase(p, nrows, smem); break;
        case 7: merge_phase(p, nrows, smem); break;
        case 8: resid_gemm_phase(p, l, (const bf16_t*)(p.ws + O_M), 1024, (const bf16_t*)(p.ws + O_WB + W_WOUT), 2048, nrows, smem); break;
        case 9: norm_phase(p, l, 1, (bf16_t*)(p.ws + O_HM), false, nrows); break;
        case 10: mlp1_phase(p, nrows, smem); break;
        case 11: resid_gemm_phase(p, l, (const bf16_t*)(p.ws + O_HID), 4096, (const bf16_t*)(p.ws + O_WB + W_W2), 5120, nrows, smem); break;
      }
    }
    if (ph + 1 < ph_hi) xcd_barrier(xb);
  }
}

extern "C" void kernel_launch(void* const* d_in, const int* in_sizes, int n_in, void* d_out, int out_size, void* d_ws,
                              size_t ws_size, hipStream_t stream) {
  Params p{};
  const float** pp = (const float**)&p;
  for (int i = 0; i < 36; ++i) pp[i] = (const float*)d_in[i];
  p.out = (float*)d_out;
  p.ws = (char*)d_ws;
  static int grid_blocks = 0;
  if (!grid_blocks) {
    hipFuncSetAttribute((const void*)fwd_megakernel, hipFuncAttributeMaxDynamicSharedMemorySize, LDS_BYTES);
    int dev = 0, cus = 0, per_cu = 0;
    hipGetDevice(&dev);
    hipDeviceGetAttribute(&cus, hipDeviceAttributeMultiprocessorCount, dev);
    hipOccupancyMaxActiveBlocksPerMultiprocessor(&per_cu, fwd_megakernel, 512, LDS_BYTES);
    if (per_cu < 1) per_cu = 1;
    grid_blocks = cus * per_cu;
    grid_blocks &= ~7;
  }
  if (ws_size < WS_NEED) fprintf(stderr, "workspace too small: %zu < %zu\n", ws_size, (size_t)WS_NEED);
#ifndef MULTI_LAUNCH
#define MULTI_LAUNCH 0
#endif
#if MULTI_LAUNCH
  for (int ph = 0; ph < N_PHASES; ++ph)
    hipLaunchKernelGGL(fwd_megakernel, dim3(grid_blocks), dim3(512), LDS_BYTES, stream, p, ph, ph + 1);
#else
  hipMemsetAsync((char*)d_ws + O_BAR, 0, 16384, stream);
  int lo = 0, hi = N_PHASES;
  void* args[] = {&p, &lo, &hi};
  hipError_t e = hipLaunchCooperativeKernel((const void*)fwd_megakernel, dim3(grid_blocks), dim3(512), args, LDS_BYTES, stream);
  if (e != hipSuccess) fprintf(stderr, "cooperative launch failed: %s (grid %d)\n", hipGetErrorString(e), grid_blocks);
#endif
}
```

```cpp
#include <hip/hip_runtime.h>
#include <hip/hip_cooperative_groups.h>
#include <cstdio>
namespace cg = cooperative_groups;

typedef unsigned short bf16_t;
typedef short bf16x8 __attribute__((ext_vector_type(8)));
typedef float f32x4 __attribute__((ext_vector_type(4)));
typedef float f32x16 __attribute__((ext_vector_type(16)));
typedef unsigned u32x4 __attribute__((ext_vector_type(4)));
#define DEV __device__ __forceinline__
#define PROBE 0

constexpr int T_LAT = 32768, T_ALL = 34816, DM = 1024, DIN = 7552, NZ = 4480, NZP = 4608, DINT = 7680;
constexpr int SEQ = 4096, CTXL = 256, TK = 4352;
constexpr size_t U = 35651584ull;
constexpr size_t O_ZU = 0, O_ZK = U, O_VT = 2 * U, O_ZRW = 3 * U, O_ZRS = 7 * U, O_LIN = 10 * U, O_YCV = 11 * U, O_ZQ = 12 * U;
constexpr size_t O_H0 = 7 * U;
constexpr size_t O_EF = 0, O_EB = 3 * U, O_AF = 4 * U, O_AB = 5 * U, O_G = 2 * U, O_YSF = 6 * U, O_YSB = 10 * U;
constexpr size_t O_HM = 0, O_M = 0, O_HID = 3 * U;
constexpr size_t O_G1 = 3 * U, O_G2 = 7 * U, O_G3 = 9 * U;
constexpr size_t O_WB = 13 * U;
constexpr size_t W_WIN = 0, W_PCV = W_WIN + (size_t)DINT * 1024 * 2, W_PAT = W_PCV + 1048576, W_PRW = W_PAT + 1048576,
                 W_WOUT = W_PRW + 1048576, W_W1 = W_WOUT + 2097152, W_W2 = W_W1 + 8388608, W_LW2 = W_W2 + 8388608,
                 W_LA2 = W_LW2 + 131072, W_LG2 = W_LA2 + 131072, W_END = W_LG2 + 131072;
constexpr size_t O_XC = O_WB + W_END;
constexpr size_t O_MOD = O_XC + 8388608;
constexpr size_t O_BAR = O_MOD + 2 * 9 * 6144 * 4;
constexpr size_t O_GIN = O_BAR + 16384;
constexpr size_t WS_NEED = O_GIN + (size_t)T_ALL * 128 * 2;

constexpr int LDS_BYTES = 139264 + 16;

struct Params {
  const float *x, *c, *ctx, *c_ctx, *mod_w, *mod_b, *norm1_g, *norm2_g, *w_in, *conv_dw_w, *conv_dw_b, *conv_ln_g,
      *conv_ln_b, *p_conv, *att_lq1, *att_lk1, *att_lq2, *att_lk2, *att_subln_g, *p_att, *rwkv_shift, *rwkv_w0, *rwkv_w2,
      *rwkv_a0, *rwkv_a2, *rwkv_g2, *rwkv_kk, *rwkv_ka, *rwkv_rk, *rwkv_gn_g, *rwkv_gn_b, *p_rwkv, *w_out, *mlp_w1,
      *mlp_w2, *final_g;
  float* out;
  char* ws;
};

DEV int ltid() { int t = threadIdx.x; asm volatile("" : "+v"(t)); return t; }
DEV float bf2f(bf16_t h) { return __uint_as_float(((unsigned)h) << 16); }
typedef float f32x2_t __attribute__((ext_vector_type(2)));
typedef __bf16 bf16x2_t __attribute__((ext_vector_type(2)));
DEV unsigned pk2(float lo, float hi) {
  const f32x2_t v = {lo, hi};
  return __builtin_bit_cast(unsigned, __builtin_convertvector(v, bf16x2_t));
}
DEV bf16_t f2bf(float f) { return (bf16_t)(pk2(f, 0.f) & 0xffffu); }
DEV float lo_bf(unsigned u) { return __uint_as_float(u << 16); }
DEV float hi_bf(unsigned u) { return __uint_as_float(u & 0xffff0000u); }
template <int C> DEV float dppf(float v) {
  return __int_as_float(__builtin_amdgcn_update_dpp(0, __float_as_int(v), C, 0xF, 0xF, true));
}
DEV float xor32_sum(float v) {
  const auto r = __builtin_amdgcn_permlane32_swap(__float_as_uint(v), __float_as_uint(v), false, false);
  return __uint_as_float(r[0]) + __uint_as_float(r[1]);
}
DEV float xor32_max(float v) {
  const auto r = __builtin_amdgcn_permlane32_swap(__float_as_uint(v), __float_as_uint(v), false, false);
  return fmaxf(__uint_as_float(r[0]), __uint_as_float(r[1]));
}
DEV float xor16_sum(float v) {
  const auto r = __builtin_amdgcn_permlane16_swap(__float_as_uint(v), __float_as_uint(v), false, false);
  return __uint_as_float(r[0]) + __uint_as_float(r[1]);
}
DEV float wsum(float v) {
  v += dppf<0xB1>(v);
  v += dppf<0x4E>(v);
  v += dppf<0x141>(v);
  v += dppf<0x140>(v);
  v = xor16_sum(v);
  return xor32_sum(v);
}
DEV float sigmoidf_(float x) { return 1.f / (1.f + __expf(-x)); }
DEV float red16(float v) {
  v += dppf<0xB1>(v);
  v += dppf<0x4E>(v);
  v += dppf<0x141>(v);
  v += dppf<0x140>(v);
  return v;
}
DEV int vblock() { const int per = gridDim.x >> 3; return (blockIdx.x & 7) * per + (blockIdx.x >> 3); }
DEV float* xrow(const Params& p, int row) {
  return row < T_LAT ? p.out + (size_t)row * DM : (float*)(p.ws + O_XC) + (size_t)(row - T_LAT) * DM;
}
DEV int modrow(int row) { return row < T_LAT ? (row >> 12) : 8; }

#define XB_TMO      128
#define XB_XCNT(j)  (256  + 64 * (j))
#define XB_XSUB(j)  (1280 + 64 * (j))
#define XB_XGEN(j)  (2304 + 64 * (j))
#define XB_TOP      3328
#define XB_TOPGEN   3392
#define XCD_BAR_WORDS 3456
#define XB_SPIN_CAP (1u << 18)
#define XLAS __attribute__((address_space(3)))

__device__ __forceinline__ unsigned xb_ld(unsigned* p)              { return __hip_atomic_load(p, __ATOMIC_RELAXED, __HIP_MEMORY_SCOPE_AGENT); }
__device__ __forceinline__ unsigned xb_add(unsigned* p, unsigned v) { return __hip_atomic_fetch_add(p, v, __ATOMIC_RELAXED, __HIP_MEMORY_SCOPE_AGENT); }
__device__ __forceinline__ unsigned xb_xcc_id() { return (unsigned)__builtin_amdgcn_s_getreg((3 << 11) | 20) & 0xFu; }
#define XB_SPIN(cond, bar) do { unsigned _sp = 0; while (cond) { __builtin_amdgcn_s_sleep(1); \
    if ((++_sp & 255u) == 0u) { if (xb_ld(&(bar)[XB_TMO])) break; if (_sp > XB_SPIN_CAP) { atomicAdd(&(bar)[XB_TMO], 1u); break; } } } } while (0)

struct XcdBarrier {
    unsigned* bar; unsigned x;
    volatile XLAS unsigned* st;
};

__device__ __forceinline__ XcdBarrier xcd_barrier_post(unsigned* bar, volatile XLAS unsigned* st) {
    XcdBarrier b; b.bar = bar; b.x = xb_xcc_id(); b.st = st;
    if (threadIdx.x == 0) (void)xb_add(&bar[XB_XCNT(b.x)], 1u);
    return b;
}
__device__ __forceinline__ void xcd_barrier_complete(unsigned* bar, unsigned x, unsigned& nloc, unsigned& nx) {
    const unsigned G = gridDim.x * gridDim.y * gridDim.z;
    unsigned sum, cnt, mine, sp = 0u;
    for (;;) {
        sum = 0u; cnt = 0u; mine = 0u;
#pragma unroll
        for (unsigned j = 0; j < 16; ++j) { const unsigned c = xb_ld(&bar[XB_XCNT(j)]); sum += c; cnt += (c > 0u) ? 1u : 0u; mine = (j == x) ? c : mine; }
        if (sum == G) break;
        __builtin_amdgcn_s_sleep(1);
        if ((++sp & 255u) == 0u) { if (xb_ld(&bar[XB_TMO])) break; if (sp > XB_SPIN_CAP) { atomicAdd(&bar[XB_TMO], 1u); break; } }
    }
    nloc = mine > 0u ? mine : 1u; nx = cnt > 0u ? cnt : 1u;
}

__device__ __forceinline__ void xcd_barrier(const XcdBarrier& b) {
    asm volatile("s_waitcnt vmcnt(0)" ::: "memory");
    __syncthreads();
    if (threadIdx.x == 0) {
        unsigned* bar = b.bar;
        __builtin_amdgcn_s_waitcnt(0);
        unsigned nloc = b.st[0], nx = b.st[1];
        if (nloc == 0u) { xcd_barrier_complete(bar, b.x, nloc, nx); b.st[0] = nloc; b.st[1] = nx; }
        const unsigned old = xb_add(&bar[XB_XSUB(b.x)], 1u);
        const unsigned gen = old / nloc;
        if (old + 1u == (gen + 1u) * nloc) {
            __builtin_amdgcn_fence(__ATOMIC_RELEASE, "agent");
            asm volatile("s_waitcnt vmcnt(0)" ::: "memory");
            const unsigned og = xb_add(&bar[XB_TOP], 1u);
            const unsigned tg = og / nx;
            if (og + 1u == (tg + 1u) * nx) xb_add(&bar[XB_TOPGEN], 1u);
            else XB_SPIN(xb_ld(&bar[XB_TOPGEN]) == tg, bar);
            __builtin_amdgcn_fence(__ATOMIC_ACQUIRE, "agent");
            xb_add(&bar[XB_XGEN(b.x)], 1u);
            asm volatile("s_waitcnt vmcnt(0)" ::: "memory");
        } else {
            XB_SPIN(xb_ld(&bar[XB_XGEN(b.x)]) == gen, bar);
            __builtin_amdgcn_fence(__ATOMIC_ACQUIRE, "agent");
            asm volatile("s_waitcnt vmcnt(0)" ::: "memory");
        }
    }
    __syncthreads();
}

namespace pg8 {
#define PG8_LAS __attribute__((address_space(3)))
constexpr int BM = 256, BK = 64, HALF = 128, HTB = HALF * BK * 2, STAGE_BYTES = 8 * HTB, NXCD = 8, WGM = 4;
__host__ __device__ __forceinline__ int lds_byte(int r, int c) { const int st = (r >> 4) * 2 + (c >> 5), rr = r & 15, cc = c & 31, ob = rr * 64 + cc * 2; return st * 1024 + (ob ^ (((ob >> 9) & 1) << 5)); }
__host__ __device__ __forceinline__ void stage_rc(int b, int& R, int& C) { const int st = b / 1024, sb = b % 1024, swz = sb ^ (((sb >> 9) & 1) << 5); R = (st >> 1) * 16 + swz / 64; C = (st & 1) * 32 + (swz % 64) / 2; }
__host__ __device__ __forceinline__ int perm32(int rho) { const int n = rho >> 4, i = rho & 15; return 8 * (i >> 2) + 4 * n + (i & 3); }
struct Unit { int pm, pn; };
struct Gemm { const bf16_t* A; const bf16_t* Bt; int M, N, K; };
struct StaticOrder {
    int nM, nN, nwg, G, c;
    __host__ __device__ void init(int M, int N, int G_, int c_) { nM = M / BM; nN = N / BM; nwg = nM * nN; G = G_; c = c_; }
    __host__ __device__ bool next(int i, Unit& u) const {
        const long L = (long)i * G + c; if (L >= nwg) return false;
        int wgid = (int)L; { const int q = nwg / NXCD, r = nwg % NXCD, xcd = wgid % NXCD, off = wgid / NXCD; wgid = (xcd < r ? xcd * (q + 1) : r * (q + 1) + (xcd - r) * q) + off; }
        const int nig = WGM * nN, gid = wgid / nig, fm = gid * WGM, gsz = (nM - fm) < WGM ? (nM - fm) : WGM;
        u.pm = fm + ((wgid % nig) % gsz); u.pn = (wgid % nig) / gsz; return true;
    }
    __device__ __forceinline__ void a_ready(const Unit&) const {}
    __device__ __forceinline__ void done(const Unit&) const {}
};

template <class Epi, class Sched>
__device__ __forceinline__ void gemm_phase(PG8_LAS unsigned char* lds, const Gemm g, const Sched& S, const Epi& E) {
    const int tid = ltid(), wid = __builtin_amdgcn_readfirstlane(tid >> 6), lane = tid & 63, wr = wid >> 2, wc = wid & 3, fr = lane & 15, fq = lane >> 4;
    const int K = g.K, nt = K / BK;
    unsigned voffA[2], voffB[2];
#pragma unroll
    for (int i = 0; i < 2; ++i) { int R, C; stage_rc(tid * 16 + i * 8192, R, C); const int Rb = Epi::PERM ? ((R & ~31) + perm32(R & 31)) : R;
        voffA[i] = (unsigned)(R * K + C) * 2u; voffB[i] = (unsigned)(Rb * K + C) * 2u; }
    const size_t kstep = (size_t)(BK * 2);
    const size_t hstep = (size_t)HALF * K * 2;
    const size_t tstep = 2 * hstep;
    const unsigned ldsw = (unsigned)wid * 1024u;
    const int aoff = lds_byte(wr * 64 + fr, fq * 8), boff = lds_byte(wc * 32 + fr, fq * 8);
#define PG8_SA(b, h) (((b) * 2 + (h)) * HTB)
#define PG8_SB(b, h) ((4 + (b) * 2 + (h)) * HTB)
#define PG8_STAGE(bufoff, gbase, voff) do { _Pragma("unroll") for (int _i = 0; _i < 2; ++_i) \
        __builtin_amdgcn_global_load_lds((const unsigned*)((const char*)(gbase) + (voff)[_i]), (PG8_LAS unsigned*)(lds + (bufoff) + ldsw + _i * 8192), 16, 0, 0); } while (0)
#define PG8_LDA(dst, b, h) do { _Pragma("unroll") for (int m = 0; m < 4; ++m) _Pragma("unroll") for (int k = 0; k < 2; ++k) dst[m][k] = *(const PG8_LAS bf16x8*)(lds + PG8_SA(b, h) + aoff + m * 2048 + k * 1024); } while (0)
#define PG8_LDB(dst, b, h) do { _Pragma("unroll") for (int n = 0; n < 2; ++n) _Pragma("unroll") for (int k = 0; k < 2; ++k) dst[n][k] = *(const PG8_LAS bf16x8*)(lds + PG8_SB(b, h) + boff + n * 2048 + k * 1024); } while (0)
#define PG8_MMA(ai, bj, At, Bt) do { __builtin_amdgcn_s_setprio(1); _Pragma("unroll") for (int m = 0; m < 4; ++m) _Pragma("unroll") for (int n = 0; n < 2; ++n) _Pragma("unroll") for (int k = 0; k < 2; ++k) \
        acc[ai][bj][m][n] = __builtin_amdgcn_mfma_f32_16x16x32_bf16(Bt[n][k], At[m][k], acc[ai][bj][m][n], 0, 0, 0); __builtin_amdgcn_s_setprio(0); } while (0)
#define PG8_WAIT_V(n) asm volatile("s_waitcnt vmcnt(" #n ")" ::: "memory")
#define PG8_WAIT_L(n) asm volatile("s_waitcnt lgkmcnt(" #n ")" ::: "memory")
#define PG8_BAR __builtin_amdgcn_s_barrier()
#define PG8_SCHED __builtin_amdgcn_sched_barrier(0)
    Unit cur, nxt; int ui = 0;
    if (!S.next(0, cur)) return;
    f32x4 acc[2][2][4][2];
#pragma unroll
    for (int a = 0; a < 2; ++a)
#pragma unroll
        for (int b = 0; b < 2; ++b)
#pragma unroll
            for (int m = 0; m < 4; ++m)
#pragma unroll
                for (int n = 0; n < 2; ++n) acc[a][b][m][n] = (f32x4){0.f, 0.f, 0.f, 0.f};
    bf16x8 At[4][2], B0[2][2], B1[2][2];
    const char* cA = (const char*)g.A + (size_t)cur.pm * tstep; const char* cB = (const char*)g.Bt + (size_t)cur.pn * tstep;
    S.a_ready(cur);
    PG8_STAGE(PG8_SB(0, 0), cB, voffB); PG8_STAGE(PG8_SA(0, 0), cA, voffA); PG8_STAGE(PG8_SB(0, 1), cB + hstep, voffB); PG8_STAGE(PG8_SA(0, 1), cA + hstep, voffA);
    if (wr == 1) PG8_BAR;
    PG8_WAIT_V(4); PG8_BAR;
    PG8_STAGE(PG8_SB(1, 0), cB + kstep, voffB); PG8_STAGE(PG8_SA(1, 0), cA + kstep, voffA); PG8_STAGE(PG8_SB(1, 1), cB + hstep + kstep, voffB);
    PG8_WAIT_V(6); PG8_BAR;
    for (;;) {
        const bool has_next = S.next(ui + 1, nxt);
        const char* nA = has_next ? (const char*)g.A + (size_t)nxt.pm * tstep : cA; const char* nB = has_next ? (const char*)g.Bt + (size_t)nxt.pn * tstep : cB;
        for (int t = 0; t < nt; t += 2) {
            const bool last = (t == nt - 2);
            const char* a1 = cA + (size_t)(t + 1) * kstep;
            const char* a2 = last ? nA : cA + (size_t)(t + 2) * kstep; const char* b2 = last ? nB : cB + (size_t)(t + 2) * kstep;
            const char* a3 = a2 + kstep; const char* b3 = b2 + kstep;
            if (last && has_next) S.a_ready(nxt);
            PG8_LDB(B0, 0, 0); PG8_SCHED; PG8_LDA(At, 0, 0); PG8_STAGE(PG8_SA(1, 1), a1 + hstep, voffA);
            PG8_WAIT_L(8); PG8_BAR; PG8_WAIT_L(0); PG8_MMA(0, 0, At, B0); PG8_BAR; PG8_SCHED;
            PG8_LDB(B1, 0, 1); PG8_STAGE(PG8_SB(0, 0), b2, voffB);
            PG8_BAR; PG8_WAIT_L(0); PG8_MMA(0, 1, At, B1); PG8_BAR;
            PG8_LDA(At, 0, 1); PG8_STAGE(PG8_SA(0, 0), a2, voffA);
            PG8_BAR; PG8_WAIT_L(0); PG8_MMA(1, 0, At, B0); PG8_BAR; PG8_SCHED;
            PG8_STAGE(PG8_SB(0, 1), b2 + hstep, voffB);
            PG8_WAIT_V(6); PG8_BAR; PG8_MMA(1, 1, At, B1); PG8_BAR;
            PG8_LDB(B0, 1, 0); PG8_SCHED; PG8_LDA(At, 1, 0); PG8_STAGE(PG8_SA(0, 1), a2 + hstep, voffA);
            PG8_WAIT_L(8); PG8_BAR; PG8_WAIT_L(0); PG8_MMA(0, 0, At, B0); PG8_BAR; PG8_SCHED;
            PG8_LDB(B1, 1, 1); PG8_STAGE(PG8_SB(1, 0), b3, voffB);
            PG8_BAR; PG8_WAIT_L(0); PG8_MMA(0, 1, At, B1); PG8_BAR;
            PG8_LDA(At, 1, 1); PG8_STAGE(PG8_SA(1, 0), a3, voffA);
            PG8_BAR; PG8_WAIT_L(0); PG8_MMA(1, 0, At, B0); PG8_BAR; PG8_SCHED;
            PG8_STAGE(PG8_SB(1, 1), b3 + hstep, voffB);
            PG8_WAIT_V(6); PG8_BAR; PG8_MMA(1, 1, At, B1); PG8_BAR;
        }
        if constexpr (!Epi::AFTER_DRAIN) { E(acc, cur, wr, wc, fr, fq); S.done(cur); }
        if (!has_next) break;
#pragma unroll
        for (int a = 0; a < 2; ++a)
#pragma unroll
            for (int b = 0; b < 2; ++b)
#pragma unroll
                for (int m = 0; m < 4; ++m)
#pragma unroll
                    for (int n = 0; n < 2; ++n) acc[a][b][m][n] = (f32x4){0.f, 0.f, 0.f, 0.f};
        cur = nxt; cA = nA; cB = nB; ++ui;
    }
    PG8_WAIT_V(0);
    if (wr == 0) PG8_BAR;
    PG8_BAR;
    if constexpr (Epi::AFTER_DRAIN) { E.fused(acc, cur, wr, wc, fr, fq, lds, wid, lane); S.done(cur); }
#undef PG8_SA
#undef PG8_SB
#undef PG8_STAGE
#undef PG8_LDA
#undef PG8_LDB
#undef PG8_MMA
#undef PG8_WAIT_V
#undef PG8_WAIT_L
#undef PG8_BAR
#undef PG8_SCHED
}

}

constexpr int SROW = 144;
constexpr int A_ST = 256 * SROW, B_ST = 128 * SROW, ST_BYTES = A_ST + B_ST;

DEV void gemm_kloop(f32x4 (&acc)[4][4], const bf16_t* __restrict__ A, int lda, const bf16_t* __restrict__ Bt, int ldb,
                    int K, char* smem) {
  const int tid = ltid(), lane = tid & 63, w = tid >> 6, wm = w >> 1, wn = w & 1;
  const int fr = lane & 15, fq = lane >> 4;
  const int lrow = tid >> 3, lch = tid & 7;
  const bf16_t* ga = A + (size_t)lrow * lda + lch * 8;
  const bf16_t* gb = Bt + (size_t)lrow * ldb + lch * 8;
  u32x4 ra[4], rb[2];
#pragma unroll
  for (int i = 0; i < 4; ++i) ra[i] = *(const u32x4*)(ga + (size_t)(64 * i) * lda);
#pragma unroll
  for (int i = 0; i < 2; ++i) rb[i] = *(const u32x4*)(gb + (size_t)(64 * i) * ldb);
  char* swa = smem + lrow * SROW + lch * 16;
  char* swb = swa + A_ST;
  __syncthreads();
#pragma unroll
  for (int i = 0; i < 4; ++i) *(u32x4*)(swa + i * 64 * SROW) = ra[i];
#pragma unroll
  for (int i = 0; i < 2; ++i) *(u32x4*)(swb + i * 64 * SROW) = rb[i];
  __syncthreads();
  const int nk = K >> 6;
  const char* sra = smem + (wm * 64 + fr) * SROW + fq * 16;
  const char* srb = smem + A_ST + (wn * 64 + fr) * SROW + fq * 16;
  for (int kt = 0; kt < nk; ++kt) {
    const int cur = kt & 1;
    if (kt + 1 < nk) {
#pragma unroll
      for (int i = 0; i < 4; ++i) ra[i] = *(const u32x4*)(ga + (size_t)(64 * i) * lda + (kt + 1) * 64);
#pragma unroll
      for (int i = 0; i < 2; ++i) rb[i] = *(const u32x4*)(gb + (size_t)(64 * i) * ldb + (kt + 1) * 64);
    }
#pragma unroll
    for (int ks = 0; ks < 2; ++ks) {
      bf16x8 af[4], bfr[4];
#pragma unroll
      for (int mi = 0; mi < 4; ++mi) af[mi] = *(const bf16x8*)(sra + cur * ST_BYTES + mi * 16 * SROW + ks * 64);
#pragma unroll
      for (int ni = 0; ni < 4; ++ni) bfr[ni] = *(const bf16x8*)(srb + cur * ST_BYTES + ni * 16 * SROW + ks * 64);
#pragma unroll
      for (int mi = 0; mi < 4; ++mi)
#pragma unroll
        for (int ni = 0; ni < 4; ++ni)
          acc[mi][ni] = __builtin_amdgcn_mfma_f32_16x16x32_bf16(bfr[ni], af[mi], acc[mi][ni], 0, 0, 0);
    }
    if (kt + 1 < nk) {
      const int nx = cur ^ 1;
#pragma unroll
      for (int i = 0; i < 4; ++i) *(u32x4*)(swa + nx * ST_BYTES + i * 64 * SROW) = ra[i];
#pragma unroll
      for (int i = 0; i < 2; ++i) *(u32x4*)(swb + nx * ST_BYTES + i * 64 * SROW) = rb[i];
    }
    __syncthreads();
  }
}
DEV void zero_acc(f32x4 (&acc)[4][4]) {
#pragma unroll
  for (int a = 0; a < 4; ++a)
#pragma unroll
    for (int b = 0; b < 4; ++b) acc[a][b] = (f32x4){0.f, 0.f, 0.f, 0.f};
}
DEV void tile_pm_pn(int L, int nN, int& pm, int& pn) {
  const int g = L / (4 * nN), wi = L % (4 * nN);
  pm = g * 4 + (wi & 3);
  pn = wi >> 2;
}

DEV int conv_srccol(int n) {
  const int tile = n >> 8, w = n & 255;
  return w < 128 ? tile * 128 + w : 512 + tile * 128 + (w - 128);
}
DEV void cvt_job(const float* __restrict__ src, int K, int N, int ldsrc, bf16_t* __restrict__ dst, int nperm, int& tbase, char* smem) {
  float* lds = (float*)smem;
  const int nkt = K >> 6, nnt = N >> 6, cnt = nkt * nnt;
  const int G = gridDim.x;
  const int first = (int)((blockIdx.x + G - (tbase % G)) % G);
  const int tid = ltid();
  for (int t = first; t < cnt; t += G) {
    const int kt = t % nkt, nt = t / nkt;
    const int ty = tid >> 4, tx = tid & 15;
    const int n = nt * 64 + tx * 4;
    const int sc = (n < nperm) ? conv_srccol(n) : n;
#pragma unroll
    for (int i = 0; i < 2; ++i) {
      const int k = ty + 32 * i;
      const float4 v = *(const float4*)(src + (size_t)(kt * 64 + k) * ldsrc + sc);
      float* d = lds + k * 65 + tx * 4;
      d[0] = v.x; d[1] = v.y; d[2] = v.z; d[3] = v.w;
    }
    __syncthreads();
    {
      const int nn = tid >> 3, kc = tid & 7;
      float v[8];
#pragma unroll
      for (int j = 0; j < 8; ++j) v[j] = lds[(kc * 8 + j) * 65 + nn];
      uint4 o;
      o.x = pk2(v[0], v[1]); o.y = pk2(v[2], v[3]); o.z = pk2(v[4], v[5]); o.w = pk2(v[6], v[7]);
      *(uint4*)(dst + (size_t)(nt * 64 + nn) * K + kt * 64 + kc * 8) = o;
    }
    __syncthreads();
  }
  tbase += cnt;
}
DEV void cvt_phase(const Params& p, int l, char* smem) {
  char* wb = p.ws + O_WB;
  int tb = 0;
  const float* win = p.w_in + (size_t)l * 1024 * DIN;
  cvt_job(win, 1024, NZ, DIN, (bf16_t*)(wb + W_WIN), 1024, tb, smem);
  cvt_job(win + NZ, 1024, 3072, DIN, (bf16_t*)(wb + W_WIN) + (size_t)NZP * 1024, 0, tb, smem);
  cvt_job(p.mlp_w1 + (size_t)l * 1024 * 4096, 1024, 4096, 4096, (bf16_t*)(wb + W_W1), 0, tb, smem);
  cvt_job(p.mlp_w2 + (size_t)l * 4096 * 1024, 4096, 1024, 1024, (bf16_t*)(wb + W_W2), 0, tb, smem);
  cvt_job(p.w_out + (size_t)l * 1024 * 1024, 1024, 1024, 1024, (bf16_t*)(wb + W_WOUT), 0, tb, smem);
  cvt_job(p.p_conv + (size_t)l * 512 * 1024, 512, 1024, 1024, (bf16_t*)(wb + W_PCV), 0, tb, smem);
  cvt_job(p.p_att + (size_t)l * 512 * 1024, 512, 1024, 1024, (bf16_t*)(wb + W_PAT), 0, tb, smem);
  cvt_job(p.p_rwkv + (size_t)l * 512 * 1024, 512, 1024, 1024, (bf16_t*)(wb + W_PRW), 0, tb, smem);
  for (int d = 0; d < 2; ++d) {
    cvt_job(p.rwkv_w2 + (size_t)(l * 2 + d) * 64 * 512, 64, 512, 512, (bf16_t*)(wb + W_LW2) + d * 512 * 64, 0, tb, smem);
    cvt_job(p.rwkv_a2 + (size_t)(l * 2 + d) * 64 * 512, 64, 512, 512, (bf16_t*)(wb + W_LA2) + d * 512 * 64, 0, tb, smem);
  }
  cvt_job(p.rwkv_g2 + (size_t)l * 128 * 512, 128, 512, 512, (bf16_t*)(wb + W_LG2), 0, tb, smem);
}

DEV void mod_phase(const Params& p, char* smem) {
  float* sc = (float*)smem;
  float* red = sc + 9 * 1024;
  float* MOD = (float*)(p.ws + O_MOD);
  const int tid = ltid();
  if ((int)blockIdx.x >= 192) return;
  for (int i = tid; i < 9 * 1024; i += 512) {
    const int r = i >> 10, k = i & 1023;
    const float v = r < 8 ? p.c[r * 1024 + k] : p.c_ctx[k];
    sc[i] = v / (1.f + __expf(-v));
  }
  __syncthreads();
  for (int tile = blockIdx.x; tile < 192; tile += gridDim.x) {
    const int l = tile / 96, n0 = (tile % 96) * 64;
    const int kq = tid >> 6, col = tid & 63;
    float acc[9];
#pragma unroll
    for (int r = 0; r < 9; ++r) acc[r] = 0.f;
    const float* wp = p.mod_w + ((size_t)l * 1024 + kq * 128) * 6144 + n0 + col;
#pragma unroll 32
    for (int k = 0; k < 128; ++k) {
      const float wv = wp[(size_t)k * 6144];
#pragma unroll
      for (int r = 0; r < 9; ++r) acc[r] += sc[r * 1024 + kq * 128 + k] * wv;
    }
#pragma unroll
    for (int r = 0; r < 9; ++r) red[(kq * 9 + r) * 64 + col] = acc[r];
    __syncthreads();
    for (int idx = tid; idx < 576; idx += 512) {
      const int r = idx >> 6, cc = idx & 63;
      float s = p.mod_b[l * 6144 + n0 + cc];
#pragma unroll
      for (int q = 0; q < 8; ++q) s += red[(q * 9 + r) * 64 + cc];
      MOD[(size_t)(l * 9 + r) * 6144 + n0 + cc] = s;
    }
    __syncthreads();
  }
}

DEV void norm_phase(const Params& p, int l, int which, bf16_t* __restrict__ Hd, bool first, int nrows = T_ALL) {
  const float* g = (which ? p.norm2_g : p.norm1_g) + l * 1024;
  const float* MOD = (const float*)(p.ws + O_MOD);
  const int lane = ltid() & 63, w = ltid() >> 6;
  const int stride = gridDim.x * 8;
  f32x4 gg[4];
#pragma unroll
  for (int i = 0; i < 4; ++i) gg[i] = *(const f32x4*)(g + i * 256 + lane * 4);
  auto srcp = [&](int row) -> const float* {
    if (first) return row < T_LAT ? p.x + (size_t)row * DM : p.ctx + (size_t)(row - T_LAT) * DM;
    return xrow(p, row);
  };
  int row = blockIdx.x * 8 + w;
  f32x4 nv[4];
  if (row < nrows) {
    const float* s = srcp(row);
#pragma unroll
    for (int i = 0; i < 4; ++i) nv[i] = *(const f32x4*)(s + i * 256 + lane * 4);
  }
  for (; row < nrows; row += stride) {
    f32x4 v[4];
#pragma unroll
    for (int i = 0; i < 4; ++i) v[i] = nv[i];
    if (row + stride < nrows) {
      const float* s = srcp(row + stride);
#pragma unroll
      for (int i = 0; i < 4; ++i) nv[i] = *(const f32x4*)(s + i * 256 + lane * 4);
    }
    const float* md = MOD + (size_t)(l * 9 + modrow(row)) * 6144 + which * 3072;
    f32x4 sh[4], scl[4];
#pragma unroll
    for (int i = 0; i < 4; ++i) { sh[i] = *(const f32x4*)(md + i * 256 + lane * 4); scl[i] = *(const f32x4*)(md + 1024 + i * 256 + lane * 4); }
    float ss = 0.f;
#pragma unroll
    for (int i = 0; i < 4; ++i) ss += v[i][0] * v[i][0] + v[i][1] * v[i][1] + v[i][2] * v[i][2] + v[i][3] * v[i][3];
    if (first) {
      float* xr = xrow(p, row);
#pragma unroll
      for (int i = 0; i < 4; ++i) *(f32x4*)(xr + i * 256 + lane * 4) = v[i];
    }
    const float rs = rsqrtf(wsum(ss) * (1.f / 1024.f) + 1e-6f);
#pragma unroll
    for (int i = 0; i < 4; ++i) {
      const int c = i * 256 + lane * 4;
      const f32x4 h = v[i] * rs * gg[i] * (scl[i] + 1.f) + sh[i];
      uint2 o;
      o.x = pk2(h[0], h[1]); o.y = pk2(h[2], h[3]);
      *(uint2*)(Hd + (size_t)row * DM + c) = o;
    }
  }
}

DEV void rope2(float a, float b, float ang, float& o0, float& o1) {
  const float cs = __cosf(ang), sn = __sinf(ang);
  o0 = a * cs - b * sn;
  o1 = a * sn + b * cs;
}
struct EpiIn {
  static constexpr bool PERM = true, AFTER_DRAIN = false;
  bf16_t *ZU, *ZQ, *ZK, *VT, *ZRW;
  DEV void operator()(const f32x4 (&acc)[2][2][4][2], const pg8::Unit& u, int wr, int wc, int fr, int fq) const {
    const int row0 = u.pm * 256 + wr * 64 + fr, cl = wc * 32 + 8 * fq, pn = u.pn;
    if (pn < 4) {
#pragma unroll
      for (int ai = 0; ai < 2; ++ai)
#pragma unroll
        for (int m = 0; m < 4; ++m) {
          const int row = row0 + ai * 128 + m * 16;
          const f32x4 a0 = acc[ai][0][m][0], a1 = acc[ai][0][m][1], b0 = acc[ai][1][m][0], b1 = acc[ai][1][m][1];
          u32x4 o;
          o[0] = pk2(a0[0] * sigmoidf_(b0[0]), a0[1] * sigmoidf_(b0[1]));
          o[1] = pk2(a0[2] * sigmoidf_(b0[2]), a0[3] * sigmoidf_(b0[3]));
          o[2] = pk2(a1[0] * sigmoidf_(b1[0]), a1[1] * sigmoidf_(b1[1]));
          o[3] = pk2(a1[2] * sigmoidf_(b1[2]), a1[3] * sigmoidf_(b1[3]));
          *(u32x4*)(ZU + (size_t)row * 512 + pn * 128 + cl) = o;
        }
    } else if (pn < 8) {
      const bool isq = pn < 6;
      bf16_t* Z = isq ? ZQ : ZK;
      const float qs = isq ? 0.125f * 1.4426950408889634f : 1.f;
      const int cbase = (pn - (isq ? 4 : 6)) * 256 + cl;
#pragma unroll
      for (int ai = 0; ai < 2; ++ai)
#pragma unroll
        for (int m = 0; m < 4; ++m) {
          const int row = row0 + ai * 128 + m * 16;
#pragma unroll
          for (int bj = 0; bj < 2; ++bj) {
            const int c = cbase + bj * 128;
            float v[8];
#pragma unroll
            for (int j = 0; j < 4; ++j) { v[j] = acc[ai][bj][m][0][j]; v[4 + j] = acc[ai][bj][m][1][j]; }
            if (row < T_LAT) {
              const int t = row & 4095, d = c & 63, p0 = d >> 1;
              const float pos = (float)((p0 < 16) ? (t >> 6) : (t & 63));
              const int fi = p0 & 15;
#pragma unroll
              for (int q = 0; q < 4; ++q) {
                const float fr_ = exp2f(-(float)(fi + q) * 0.8304820237218406f);
                float o0, o1;
                rope2(v[2 * q], v[2 * q + 1], pos * fr_, o0, o1);
                v[2 * q] = o0; v[2 * q + 1] = o1;
              }
            }
            u32x4 o;
            o[0] = pk2(v[0] * qs, v[1] * qs); o[1] = pk2(v[2] * qs, v[3] * qs);
            o[2] = pk2(v[4] * qs, v[5] * qs); o[3] = pk2(v[6] * qs, v[7] * qs);
            *(u32x4*)(Z + (size_t)row * 512 + c) = o;
          }
        }
    } else if (pn < 10) {
#pragma unroll
      for (int ai = 0; ai < 2; ++ai)
#pragma unroll
        for (int m = 0; m < 4; ++m) {
          const int row = row0 + ai * 128 + m * 16;
          int b, kidx;
          if (row < T_LAT) { b = row >> 12; kidx = 256 + (row & 4095); } else { b = (row - T_LAT) >> 8; kidx = (row - T_LAT) & 255; }
#pragma unroll
          for (int bj = 0; bj < 2; ++bj) {
            const int head = (pn - 8) * 2 + bj;
            bf16_t* dst = VT + ((size_t)((b * 4 + head) * 128 + cl)) * TK + kidx;
#pragma unroll
            for (int j = 0; j < 4; ++j) {
              dst[(size_t)j * TK] = f2bf(acc[ai][bj][m][0][j]);
              dst[(size_t)(4 + j) * TK] = f2bf(acc[ai][bj][m][1][j]);
            }
          }
        }
    } else {
#pragma unroll
      for (int ai = 0; ai < 2; ++ai)
#pragma unroll
        for (int m = 0; m < 4; ++m) {
          const int row = row0 + ai * 128 + m * 16;
#pragma unroll
          for (int bj = 0; bj < 2; ++bj) {
            const int c = (pn - 10) * 256 + bj * 128 + cl;
            if (c < 1920) {
              u32x4 o;
              o[0] = pk2(acc[ai][bj][m][0][0], acc[ai][bj][m][0][1]); o[1] = pk2(acc[ai][bj][m][0][2], acc[ai][bj][m][0][3]);
              o[2] = pk2(acc[ai][bj][m][1][0], acc[ai][bj][m][1][1]); o[3] = pk2(acc[ai][bj][m][1][2], acc[ai][bj][m][1][3]);
              *(u32x4*)(ZRW + (size_t)row * 1920 + c) = o;
            }
          }
        }
    }
  }
};
DEV void gemm_in_phase(const Params& p, char* smem) {
  EpiIn E;
  E.ZU = (bf16_t*)(p.ws + O_ZU); E.ZQ = (bf16_t*)(p.ws + O_ZQ); E.ZK = (bf16_t*)(p.ws + O_ZK);
  E.VT = (bf16_t*)(p.ws + O_VT); E.ZRW = (bf16_t*)(p.ws + O_ZRW);
  pg8::Gemm g;
  g.A = (const bf16_t*)(p.ws + O_H0); g.Bt = (const bf16_t*)(p.ws + O_WB + W_WIN); g.M = T_ALL; g.N = NZP; g.K = 1024;
  pg8::StaticOrder S;
  S.init(g.M, g.N, (int)gridDim.x, (int)blockIdx.x);
  __syncthreads();
  pg8::gemm_phase<EpiIn, pg8::StaticOrder>((PG8_LAS unsigned char*)smem, g, S, E);
  __syncthreads();
}

constexpr int KROW = 272, VROW = 144, ATT_ST = 64 * KROW + 128 * VROW;
constexpr int ATT2_ST = 2 * 128 * KROW;
DEV int key_of_slot(int x) { return (x & 0x13) | ((x & 8) >> 1) | ((x & 4) << 1); }

DEV void attn_tile(const Params& p, int l, int tile, char* smem, bool do_store = true) {
  bf16_t* ZQ = (bf16_t*)(p.ws + O_ZQ);
  const bf16_t* ZK = (const bf16_t*)(p.ws + O_ZK);
  const bf16_t* VT = (const bf16_t*)(p.ws + O_VT);
  int b, head, q0, nkeys, qbase;
  if (tile < 1024) { b = tile >> 7; head = (tile >> 5) & 3; q0 = (tile & 31) * 128; nkeys = TK; qbase = b * SEQ; }
  else { const int tt = tile - 1024; b = tt >> 3; head = (tt >> 1) & 3; q0 = (tt & 1) * 128; nkeys = CTXL; qbase = T_LAT + b * CTXL; }
  const int tid = ltid(), lane = tid & 63, w = tid >> 6, ql = lane & 31, hh = lane >> 5, map = w >> 2, qg = w & 3;
  const int qrow = qbase + q0 + qg * 32 + ql;
  const float lam_init = l == 0 ? 0.2f : 0.35550907f;
  float lam;
  {
    const float a1 = p.att_lq1[l * 64 + lane] * p.att_lk1[l * 64 + lane];
    const float a2 = p.att_lq2[l * 64 + lane] * p.att_lk2[l * 64 + lane];
    lam = __expf(wsum(a1)) - __expf(wsum(a2)) + lam_init;
  }
  bf16x8 qf[4];
#pragma unroll
  for (int s = 0; s < 4; ++s) qf[s] = *(const bf16x8*)(ZQ + (size_t)qrow * 512 + head * 128 + map * 64 + s * 16 + hh * 8);
  f32x16 o[4];
#pragma unroll
  for (int dt = 0; dt < 4; ++dt)
#pragma unroll
    for (int e = 0; e < 16; ++e) o[dt][e] = 0.f;
  float m = -1e30f, lsum = 0.f;
  const int kr0 = tid >> 4, kch = tid & 15;
  const int vr0 = tid >> 4, vch = tid & 15;
  const bf16_t* vtb = VT + ((size_t)((b * 4 + head) * 128)) * TK;
  u32x4 kreg[4], vreg[4];
  auto gload = [&](int kt) {
    const int k0 = kt * 128;
#pragma unroll
    for (int i = 0; i < 4; ++i) {
      const int kidx = k0 + kr0 + 32 * i;
      const int krow = kidx < CTXL ? T_LAT + b * CTXL + kidx : b * SEQ + kidx - CTXL;
      kreg[i] = *(const u32x4*)(ZK + (size_t)krow * 512 + head * 128 + kch * 8);
      vreg[i] = *(const u32x4*)(vtb + (size_t)(vr0 + 32 * i) * TK + k0 + vch * 8);
    }
  };
  auto lstore = [&](int st) {
    char* Ks = smem + st * ATT2_ST;
    char* Vs = Ks + 128 * KROW;
#pragma unroll
    for (int i = 0; i < 4; ++i) {
      *(u32x4*)(Ks + (kr0 + 32 * i) * KROW + kch * 16) = kreg[i];
      *(u32x4*)(Vs + (vr0 + 32 * i) * KROW + vch * 16) = vreg[i];
    }
  };
  const int nkt = nkeys >> 7;
  gload(0);
  __syncthreads();
  lstore(0);
  __syncthreads();
  const int kos = key_of_slot(ql);
  for (int kt = 0; kt < nkt; ++kt) {
    const int cur = kt & 1;
    if (kt + 1 < nkt) gload(kt + 1);
    const char* Ks = smem + cur * ATT2_ST;
    const char* Vs = Ks + 128 * KROW;
#pragma unroll
    for (int h2 = 0; h2 < 2; ++h2) {
    const char* kp = Ks + (h2 * 64 + kos) * KROW + (map * 64 + hh * 8) * 2;
    const char* vp = Vs + ql * KROW + hh * 16 + h2 * 128;
    bf16x8 kf0[4], kf1[4];
#pragma unroll
    for (int ks = 0; ks < 4; ++ks) { kf0[ks] = *(const bf16x8*)(kp + ks * 32); kf1[ks] = *(const bf16x8*)(kp + 32 * KROW + ks * 32); }
    f32x16 s0, s1;
#pragma unroll
    for (int e = 0; e < 16; ++e) { s0[e] = 0.f; s1[e] = 0.f; }
#pragma unroll
    for (int ks = 0; ks < 4; ++ks) s0 = __builtin_amdgcn_mfma_f32_32x32x16_bf16(kf0[ks], qf[ks], s0, 0, 0, 0);
#pragma unroll
    for (int ks = 0; ks < 4; ++ks) s1 = __builtin_amdgcn_mfma_f32_32x32x16_bf16(kf1[ks], qf[ks], s1, 0, 0, 0);
    bf16x8 vf[8];
#pragma unroll
    for (int dt = 0; dt < 4; ++dt)
#pragma unroll
      for (int k2 = 0; k2 < 2; ++k2) vf[dt * 2 + k2] = *(const bf16x8*)(vp + dt * 32 * KROW + (k2 * 16) * 2);
    float mx = fmaxf(s0[0], s1[0]);
#pragma unroll
    for (int e = 1; e < 16; ++e) mx = fmaxf(mx, fmaxf(s0[e], s1[e]));
    mx = xor32_max(mx);
    const float mnew = (mx > m + 8.f) ? mx : m;
    if (__any(mnew > m)) {
      const float alpha = __builtin_amdgcn_exp2f(m - mnew);
      lsum *= alpha;
#pragma unroll
      for (int dt = 0; dt < 4; ++dt)
#pragma unroll
        for (int e = 0; e < 16; ++e) o[dt][e] *= alpha;
    }
    m = mnew;
    bf16x8 pb0[2], pb1[2];
    {
      float pe[16];
#pragma unroll
      for (int e = 0; e < 16; ++e) { pe[e] = __builtin_amdgcn_exp2f(s0[e] - m); lsum += pe[e]; }
#pragma unroll
      for (int k2 = 0; k2 < 2; ++k2) {
        u32x4 u;
        u[0] = pk2(pe[8 * k2 + 0], pe[8 * k2 + 1]); u[1] = pk2(pe[8 * k2 + 2], pe[8 * k2 + 3]);
        u[2] = pk2(pe[8 * k2 + 4], pe[8 * k2 + 5]); u[3] = pk2(pe[8 * k2 + 6], pe[8 * k2 + 7]);
        pb0[k2] = __builtin_bit_cast(bf16x8, u);
      }
    }
#pragma unroll
    for (int dt = 0; dt < 4; ++dt)
#pragma unroll
      for (int k2 = 0; k2 < 2; ++k2) o[dt] = __builtin_amdgcn_mfma_f32_32x32x16_bf16(vf[dt * 2 + k2], pb0[k2], o[dt], 0, 0, 0);
#pragma unroll
    for (int dt = 0; dt < 4; ++dt)
#pragma unroll
      for (int k2 = 0; k2 < 2; ++k2) vf[dt * 2 + k2] = *(const bf16x8*)(vp + dt * 32 * KROW + (32 + k2 * 16) * 2);
    {
      float pe[16];
#pragma unroll
      for (int e = 0; e < 16; ++e) { pe[e] = __builtin_amdgcn_exp2f(s1[e] - m); lsum += pe[e]; }
#pragma unroll
      for (int k2 = 0; k2 < 2; ++k2) {
        u32x4 u;
        u[0] = pk2(pe[8 * k2 + 0], pe[8 * k2 + 1]); u[1] = pk2(pe[8 * k2 + 2], pe[8 * k2 + 3]);
        u[2] = pk2(pe[8 * k2 + 4], pe[8 * k2 + 5]); u[3] = pk2(pe[8 * k2 + 6], pe[8 * k2 + 7]);
        pb1[k2] = __builtin_bit_cast(bf16x8, u);
      }
    }
#pragma unroll
    for (int dt = 0; dt < 4; ++dt)
#pragma unroll
      for (int k2 = 0; k2 < 2; ++k2) o[dt] = __builtin_amdgcn_mfma_f32_32x32x16_bf16(vf[dt * 2 + k2], pb1[k2], o[dt], 0, 0, 0);
    }
    if (kt + 1 < nkt) lstore(cur ^ 1);
    __syncthreads();
  }
  const float ltot = xor32_sum(lsum);
  float* ex = (float*)smem;
  if (map == 1) {
    const float c2 = lam / ltot;
#pragma unroll
    for (int dt = 0; dt < 4; ++dt)
#pragma unroll
      for (int e = 0; e < 16; ++e) {
        const int dv = dt * 32 + 8 * (e >> 2) + 4 * hh + (e & 3);
        ex[(qg * 128 + dv) * 32 + ql] = o[dt][e] * c2;
      }
  }
  __syncthreads();
  if (map == 0 && do_store) {
    const float c1 = 1.f / ltot;
    float ss = 0.f;
#pragma unroll
    for (int dt = 0; dt < 4; ++dt)
#pragma unroll
      for (int e = 0; e < 16; ++e) {
        const int dv = dt * 32 + 8 * (e >> 2) + 4 * hh + (e & 3);
        const float v = o[dt][e] * c1 - ex[(qg * 128 + dv) * 32 + ql];
        o[dt][e] = v;
        ss += v * v;
      }
    ss = xor32_sum(ss);
    const float rs = rsqrtf(ss * (1.f / 128.f) + 1e-5f) * (1.f - lam_init);
    const float* sg = p.att_subln_g + l * 128;
#pragma unroll
    for (int dt = 0; dt < 4; ++dt)
#pragma unroll
      for (int i = 0; i < 4; ++i) {
        const int dv = dt * 32 + 8 * i + 4 * hh;
        const float4 g4 = *(const float4*)(sg + dv);
        uint2 u;
        u.x = pk2(o[dt][4 * i + 0] * rs * g4.x, o[dt][4 * i + 1] * rs * g4.y);
        u.y = pk2(o[dt][4 * i + 2] * rs * g4.z, o[dt][4 * i + 3] * rs * g4.w);
        *(uint2*)(ZQ + (size_t)qrow * 512 + head * 128 + dv) = u;
      }
  }
  __syncthreads();
}

DEV void conv_tile(const Params& p, int l, int tile, char* smem) {
  const bf16_t* ZU = (const bf16_t*)(p.ws + O_ZU);
  bf16_t* YCV = (bf16_t*)(p.ws + O_YCV);
  const int r0 = tile * 32;
  int s_lo, s_hi;
  if (r0 < T_LAT) { s_lo = r0 & ~4095; s_hi = s_lo + SEQ; } else { s_lo = T_LAT + ((r0 - T_LAT) & ~255); s_hi = s_lo + CTXL; }
  const int tid = ltid(), lane = tid & 63, w = tid >> 6, c0 = lane * 8;
  const int t0 = r0 + w * 4;
  const float* wp = p.conv_dw_w + (size_t)l * 31 * 512 + c0;
  float acc[4][8];
  {
    const f32x4 b0 = *(const f32x4*)(p.conv_dw_b + l * 512 + c0), b1 = *(const f32x4*)(p.conv_dw_b + l * 512 + c0 + 4);
#pragma unroll
    for (int t = 0; t < 4; ++t)
#pragma unroll
      for (int j = 0; j < 4; ++j) { acc[t][j] = b0[j]; acc[t][4 + j] = b1[j]; }
  }
  f32x4 wk[4][2];
#pragma unroll
  for (int q = 0; q < 4; ++q) { wk[q][0] = (f32x4){0.f, 0.f, 0.f, 0.f}; wk[q][1] = (f32x4){0.f, 0.f, 0.f, 0.f}; }
#pragma unroll 4
  for (int s = 0; s < 36; ++s) {
    const int rr = t0 - 15 + s;
    u32x4 uv = {0u, 0u, 0u, 0u};
    if (rr >= s_lo && rr < s_hi) uv = *(const u32x4*)(ZU + (size_t)rr * 512 + c0);
    float u[8];
#pragma unroll
    for (int q = 0; q < 4; ++q) { u[2 * q] = lo_bf(uv[q]); u[2 * q + 1] = hi_bf(uv[q]); }
#pragma unroll
    for (int q = 3; q > 0; --q) { wk[q][0] = wk[q - 1][0]; wk[q][1] = wk[q - 1][1]; }
    wk[0][0] = (f32x4){0.f, 0.f, 0.f, 0.f}; wk[0][1] = (f32x4){0.f, 0.f, 0.f, 0.f};
    if (s <= 30) { wk[0][0] = *(const f32x4*)(wp + s * 512); wk[0][1] = *(const f32x4*)(wp + s * 512 + 4); }
#pragma unroll
    for (int t = 0; t < 4; ++t) {
#pragma unroll
      for (int j = 0; j < 4; ++j) { acc[t][j] += wk[t][0][j] * u[j]; acc[t][4 + j] += wk[t][1][j] * u[4 + j]; }
    }
  }
  const f32x4 g0 = *(const f32x4*)(p.conv_ln_g + l * 512 + c0), g1 = *(const f32x4*)(p.conv_ln_g + l * 512 + c0 + 4);
  const f32x4 e0 = *(const f32x4*)(p.conv_ln_b + l * 512 + c0), e1 = *(const f32x4*)(p.conv_ln_b + l * 512 + c0 + 4);
#pragma unroll
  for (int t = 0; t < 4; ++t) {
    float s1 = 0.f;
#pragma unroll
    for (int j = 0; j < 8; ++j) s1 += acc[t][j];
    const float mu = wsum(s1) * (1.f / 512.f);
    float s2 = 0.f;
#pragma unroll
    for (int j = 0; j < 8; ++j) { acc[t][j] -= mu; s2 += acc[t][j] * acc[t][j]; }
    const float rs = rsqrtf(wsum(s2) * (1.f / 512.f) + 1e-5f);
    float y[8];
#pragma unroll
    for (int j = 0; j < 4; ++j) {
      const float z0 = acc[t][j] * rs * g0[j] + e0[j], z1 = acc[t][4 + j] * rs * g1[j] + e1[j];
      y[j] = z0 * sigmoidf_(z0); y[4 + j] = z1 * sigmoidf_(z1);
    }
    u32x4 o;
    o[0] = pk2(y[0], y[1]); o[1] = pk2(y[2], y[3]); o[2] = pk2(y[4], y[5]); o[3] = pk2(y[6], y[7]);
    *(u32x4*)(YCV + (size_t)(t0 + t) * 512 + c0) = o;
  }
}

DEV void shift_tile(const Params& p, int l, int tile) {
  const bf16_t* ZRW = (const bf16_t*)(p.ws + O_ZRW);
  bf16_t* ZRS = (bf16_t*)(p.ws + O_ZRS);
  const int r0 = tile * 32;
  int s_lo, s_hi;
  if (r0 < T_LAT) { s_lo = r0 & ~4095; s_hi = s_lo + SEQ; } else { s_lo = T_LAT + ((r0 - T_LAT) & ~255); s_hi = s_lo + CTXL; }
  const int tid = ltid();
  if (tid >= 480) return;
  const int half = tid >= 240 ? 1 : 0, ch = tid - half * 240, col = ch * 8;
  const int rb = r0 + half * 16;
  u32x4 rows[18];
#pragma unroll
  for (int i = 0; i < 18; ++i) {
    const int rr = rb - 1 + i;
    rows[i] = (u32x4){0u, 0u, 0u, 0u};
    if (rr >= s_lo && rr < s_hi) rows[i] = *(const u32x4*)(ZRW + (size_t)rr * 1920 + col);
  }
  const float* sw = p.rwkv_shift + (size_t)l * 3 * 1920 + col;
  float w0[8], w1[8], w2[8];
#pragma unroll
  for (int j = 0; j < 8; ++j) { w0[j] = sw[j]; w1[j] = sw[1920 + j]; w2[j] = sw[3840 + j]; }
  const int act = (col >= 1536 && col < 1664) ? 1 : (col >= 1792 ? 2 : 0);
#pragma unroll
  for (int i = 0; i < 16; ++i) {
    const int row = rb + i;
    const u32x4 pv = rows[i], cu = rows[i + 1], nx = rows[i + 2];
    float y[8];
#pragma unroll
    for (int q = 0; q < 4; ++q) {
      y[2 * q] = w0[2 * q] * lo_bf(pv[q]) + w1[2 * q] * lo_bf(cu[q]) + w2[2 * q] * lo_bf(nx[q]);
      y[2 * q + 1] = w0[2 * q + 1] * hi_bf(pv[q]) + w1[2 * q + 1] * hi_bf(cu[q]) + w2[2 * q + 1] * hi_bf(nx[q]);
    }
    if (act == 1) {
#pragma unroll
      for (int j = 0; j < 8; ++j) y[j] = 1.f - 2.f / (1.f + __expf(2.f * y[j]));
    } else if (act == 2) {
#pragma unroll
      for (int j = 0; j < 8; ++j) y[j] = sigmoidf_(y[j]);
    }
    u32x4 o;
    o[0] = pk2(y[0], y[1]); o[1] = pk2(y[2], y[3]); o[2] = pk2(y[4], y[5]); o[3] = pk2(y[6], y[7]);
    if (col < 1536) *(u32x4*)(ZRS + (size_t)row * 1536 + col) = o;
    else if (col < 1792) *(u32x4*)((bf16_t*)(p.ws + O_LIN) + (size_t)row * 256 + (col - 1536)) = o;
    else *(u32x4*)((bf16_t*)(p.ws + O_GIN) + (size_t)row * 128 + (col - 1792)) = o;
  }
}

DEV void branch_phase(const Params& p, int l, char* smem) {
  const bool last = (l == 1);
  if (PROBE & 2) for (int L = vblock(); L < 1088; L += gridDim.x) attn_tile(p, l, L, smem, false);
  if (PROBE & 4) for (int L = vblock() + 1088; L < 3 * 1088; L += gridDim.x) { if (L < 2176) conv_tile(p, l, L - 1088, smem); else shift_tile(p, l, L - 2176); }
  for (int L = vblock(); L < 3 * 1088; L += gridDim.x) {
    if (L < 1088) { if (!(last && L >= 1024)) attn_tile(p, l, L, smem); }
    else if (L < 2176) { if (!(last && L - 1088 >= 1024)) conv_tile(p, l, L - 1088, smem); }
    else shift_tile(p, l, L - 2176);
  }
}

DEV void lora_phase(const Params& p, int l, char* smem, bool gjob) {
  const bf16_t* LIN = (const bf16_t*)(p.ws + O_LIN);
  const int lane = ltid() & 63, w = ltid() >> 6, wm = w >> 1, wn = w & 1, fr = lane & 15, fq = lane >> 4;
  const int ntile = gjob ? 544 : 4 * 544;
  for (int L = vblock(); L < ntile; L += gridDim.x) {
    const int job = gjob ? 4 : L / 544, t = L - (gjob ? 0 : job * 544), pm = t >> 2, pn = t & 3;
    const int row0 = pm * 256, col0 = pn * 128;
    const bf16_t* A;
    const bf16_t* Bt;
    bf16_t* O;
    int K = 64, lda = 256;
    const float* bias = nullptr;
    if (job == 0) { A = LIN; Bt = (const bf16_t*)(p.ws + O_WB + W_LW2); O = (bf16_t*)(p.ws + O_EF); bias = p.rwkv_w0 + (l * 2 + 0) * 512; }
    else if (job == 1) { A = LIN + 64; Bt = (const bf16_t*)(p.ws + O_WB + W_LW2) + 512 * 64; O = (bf16_t*)(p.ws + O_EB); bias = p.rwkv_w0 + (l * 2 + 1) * 512; }
    else if (job == 2) { A = LIN + 128; Bt = (const bf16_t*)(p.ws + O_WB + W_LA2); O = (bf16_t*)(p.ws + O_AF); bias = p.rwkv_a0 + (l * 2 + 0) * 512; }
    else if (job == 3) { A = LIN + 192; Bt = (const bf16_t*)(p.ws + O_WB + W_LA2) + 512 * 64; O = (bf16_t*)(p.ws + O_AB); bias = p.rwkv_a0 + (l * 2 + 1) * 512; }
    else { A = (const bf16_t*)(p.ws + O_GIN); Bt = (const bf16_t*)(p.ws + O_WB + W_LG2); O = (bf16_t*)(p.ws + O_G); K = 128; lda = 128; }
    f32x4 acc[4][4];
    zero_acc(acc);
    gemm_kloop(acc, A + (size_t)row0 * lda, lda, Bt + (size_t)col0 * K, K, K, smem);
#pragma unroll
    for (int mi = 0; mi < 4; ++mi) {
      const int row = row0 + wm * 64 + mi * 16 + fr;
#pragma unroll
      for (int ni = 0; ni < 4; ++ni) {
        const int c = col0 + wn * 64 + ni * 16 + fq * 4;
        float v[4];
#pragma unroll
        for (int j = 0; j < 4; ++j) {
          float z = acc[mi][ni][j];
          if (job < 4) z = sigmoidf_(z + bias[c + j]);
          if (job < 2) z *= 0.6065306597126334f;
          v[j] = z;
        }
        uint2 o;
        o.x = pk2(v[0], v[1]); o.y = pk2(v[2], v[3]);
        *(uint2*)(O + (size_t)row * 512 + c) = o;
      }
    }
  }
}

DEV void lora64_phase(const Params& p, int l, char* smem) {
  const bf16_t* LIN = (const bf16_t*)(p.ws + O_LIN);
  const int tid = ltid(), lane = tid & 63, w = tid >> 6, wm = w >> 1, wn = w & 1, fr = lane & 15, fq = lane >> 4;
  const int lrow = tid >> 3, lch = tid & 7;
  u32x4 ra[4], rb[2];
  auto issue = [&](int L) {
    const int job = L / 544, t = L - job * 544, pm = t >> 2, pn = t & 3;
    const bf16_t* A = LIN + job * 64 + (size_t)(pm * 256 + lrow) * 256 + lch * 8;
    const bf16_t* Bt = (const bf16_t*)(p.ws + O_WB + ((job & 2) ? W_LA2 : W_LW2)) + (job & 1) * 512 * 64 + (size_t)(pn * 128 + lrow) * 64 + lch * 8;
#pragma unroll
    for (int i = 0; i < 4; ++i) ra[i] = *(const u32x4*)(A + (size_t)(64 * i) * 256);
#pragma unroll
    for (int i = 0; i < 2; ++i) rb[i] = *(const u32x4*)(Bt + (size_t)(64 * i) * 64);
  };
  char* swa = smem + lrow * SROW + lch * 16;
  char* swb = swa + A_ST;
  const char* sra = smem + (wm * 64 + fr) * SROW + fq * 16;
  const char* srb = smem + A_ST + (wn * 64 + fr) * SROW + fq * 16;
  int L = vblock();
  if (L < 4 * 544) issue(L);
  for (; L < 4 * 544; L += gridDim.x) {
    const int job = L / 544, t = L - job * 544, pm = t >> 2, pn = t & 3;
    const int row0 = pm * 256, col0 = pn * 128;
    __syncthreads();
#pragma unroll
    for (int i = 0; i < 4; ++i) *(u32x4*)(swa + i * 64 * SROW) = ra[i];
#pragma unroll
    for (int i = 0; i < 2; ++i) *(u32x4*)(swb + i * 64 * SROW) = rb[i];
    __syncthreads();
    if (L + (int)gridDim.x < 4 * 544) issue(L + gridDim.x);
    f32x4 acc[4][4];
    zero_acc(acc);
#pragma unroll
    for (int ks = 0; ks < 2; ++ks) {
      bf16x8 af[4], bfr[4];
#pragma unroll
      for (int mi = 0; mi < 4; ++mi) af[mi] = *(const bf16x8*)(sra + mi * 16 * SROW + ks * 64);
#pragma unroll
      for (int ni = 0; ni < 4; ++ni) bfr[ni] = *(const bf16x8*)(srb + ni * 16 * SROW + ks * 64);
#pragma unroll
      for (int mi = 0; mi < 4; ++mi)
#pragma unroll
        for (int ni = 0; ni < 4; ++ni) acc[mi][ni] = __builtin_amdgcn_mfma_f32_16x16x32_bf16(bfr[ni], af[mi], acc[mi][ni], 0, 0, 0);
    }
    bf16_t* O = (bf16_t*)(p.ws + (job == 0 ? O_EF : (job == 1 ? O_EB : (job == 2 ? O_AF : O_AB))));
    const float* bias = ((job & 2) ? p.rwkv_a0 : p.rwkv_w0) + (l * 2 + (job & 1)) * 512;
    const float sc = job < 2 ? 0.6065306597126334f : 1.f;
#pragma unroll
    for (int mi = 0; mi < 4; ++mi) {
      const int row = row0 + wm * 64 + mi * 16 + fr;
#pragma unroll
      for (int ni = 0; ni < 4; ++ni) {
        const int c = col0 + wn * 64 + ni * 16 + fq * 4;
        const f32x4 z = acc[mi][ni] + *(const f32x4*)(bias + c);
        uint2 o;
        o.x = pk2(sc * sigmoidf_(z[0]), sc * sigmoidf_(z[1])); o.y = pk2(sc * sigmoidf_(z[2]), sc * sigmoidf_(z[3]));
        *(uint2*)(O + (size_t)row * 512 + c) = o;
      }
    }
  }
  __syncthreads();
}

DEV int scan_row(int step, int dir, int b) {
  if (step < CTXL) { const int t = dir ? (CTXL - 1 - step) : step; return T_LAT + b * CTXL + t; }
  const int s2 = step - CTXL;
  const int t = dir ? (SEQ - 1 - s2) : s2;
  return b * SEQ + t;
}
DEV float red8(float v) {
  v += dppf<0xB1>(v);
  v += dppf<0x4E>(v);
  v += dppf<0x141>(v);
  return v;
}
struct ScanOps { f32x4 nkk0, nkk1, w0, w1, kka0, kka1, kd0, kd1, r0, r1; float v; };
DEV void scan_tile(const Params& p, int l, int tile, char* smem) {
  const int half = tile & 1, dir = (tile >> 1) & 1, h = (tile >> 2) & 7, b = tile >> 5;
  float* arr = (float*)smem;
  float* ybuf = arr + 2 * 32 * 384;
  const bf16_t* ZRS = (const bf16_t*)(p.ws + O_ZRS);
  const bf16_t* E = (const bf16_t*)(p.ws + (dir ? O_EB : O_EF));
  const bf16_t* Aa = (const bf16_t*)(p.ws + (dir ? O_AB : O_AF));
  bf16_t* YS = (bf16_t*)(p.ws + (dir ? O_YSB : O_YSF));
  const int tid = ltid(), lane = tid & 63;
  const int w = __builtin_amdgcn_readfirstlane(tid >> 6);
  const int col = h * 64 + lane;
  const float kkp = p.rwkv_kk[l * 512 + col], kap = p.rwkv_ka[l * 512 + col];
  auto produce = [&](int ch, int buf, int pw, int npw) {
#pragma unroll
    for (int i0 = 0; i0 < 32; i0 += 4 * npw) {
      bf16_t rr[4], rk[4], rv[4], re[4], ra[4];
#pragma unroll
      for (int i = 0; i < 4; ++i) {
        const int R = scan_row(ch * 32 + i0 + pw + npw * i, dir, b);
        rr[i] = ZRS[(size_t)R * 1536 + col];
        rk[i] = ZRS[(size_t)R * 1536 + 512 + col];
        rv[i] = ZRS[(size_t)R * 1536 + 1024 + col];
        re[i] = E[(size_t)R * 512 + col];
        ra[i] = Aa[(size_t)R * 512 + col];
      }
#pragma unroll
      for (int i = 0; i < 4; ++i) {
        const int sl = i0 + pw + npw * i;
        const float r = bf2f(rr[i]), k = bf2f(rk[i]), v = bf2f(rv[i]), e = bf2f(re[i]), a = bf2f(ra[i]);
        const float kkv = k * kkp;
        const float inv = rsqrtf(fmaxf(wsum(kkv * kkv), 1e-24f));
        const float kk = kkv * inv;
        float* d = arr + (buf * 32 + sl) * 384 + lane;
        d[0] = -kk;
        d[64] = __expf(-e);
        d[128] = kk * a;
        d[192] = k * (1.f + (a - 1.f) * kap);
        d[256] = r;
        d[320] = v;
      }
    }
  };
  auto flush = [&](int ch, int buf, int t256) {
#pragma unroll
    for (int q = 0; q < 2; ++q) {
      const int idx = t256 + 256 * q, sl = idx >> 4, rp = (idx & 15) * 2;
      const int R = scan_row(ch * 32 + sl, dir, b);
      const float* yb = ybuf + buf * 1024 + sl * 32 + rp;
      *(unsigned*)(YS + (size_t)R * 512 + h * 64 + half * 32 + rp) = pk2(yb[0], yb[1]);
    }
  };
  __syncthreads();
  produce(0, 0, w, 8);
  __syncthreads();
  f32x4 S0 = {0.f, 0.f, 0.f, 0.f}, S1 = {0.f, 0.f, 0.f, 0.f};
  const int r8 = lane >> 3, cg = lane & 7;
  for (int ch = 0; ch < 136; ++ch) {
    const int buf = ch & 1;
    if (w < 4) {
      const float* cb = arr + buf * 32 * 384;
      const int vo = 320 + half * 32 + w * 8 + r8;
      float* yw = ybuf + buf * 1024 + cg * 32 + w * 8 + r8;
      auto ldops = [&](ScanOps& o, int sl) {
        const f32x4* b4 = (const f32x4*)(cb + sl * 384);
        o.nkk0 = b4[cg * 2]; o.nkk1 = b4[cg * 2 + 1];
        o.w0 = b4[16 + cg * 2]; o.w1 = b4[16 + cg * 2 + 1];
        o.kka0 = b4[32 + cg * 2]; o.kka1 = b4[32 + cg * 2 + 1];
        o.kd0 = b4[48 + cg * 2]; o.kd1 = b4[48 + cg * 2 + 1];
        o.r0 = b4[64 + cg * 2]; o.r1 = b4[64 + cg * 2 + 1];
        o.v = cb[sl * 384 + vo];
      };
      float ykeep = 0.f;
      auto step = [&](const ScanOps& o, int sl) {
        const f32x4 sA = S0 * o.nkk0 + S1 * o.nkk1;
        const float sa = red8((sA[0] + sA[1]) + (sA[2] + sA[3]));
        S0 = S0 * o.w0 + (o.kka0 * sa + o.kd0 * o.v);
        S1 = S1 * o.w1 + (o.kka1 * sa + o.kd1 * o.v);
        const f32x4 yA = S0 * o.r0 + S1 * o.r1;
        const float y = red8((yA[0] + yA[1]) + (yA[2] + yA[3]));
        ykeep = (cg == (sl & 7)) ? y : ykeep;
      };
      ScanOps oa, ob;
      ldops(oa, 0);
#pragma unroll
      for (int s8 = 0; s8 < 32; s8 += 8) {
#pragma unroll
        for (int q = 0; q < 8; q += 2) {
          ldops(ob, s8 + q + 1);
          step(oa, s8 + q);
          ldops(oa, (s8 + q + 2) & 31);
          step(ob, s8 + q + 1);
        }
        yw[s8 * 32] = ykeep;
      }
    } else {
      const int pw = w - 4;
      if (ch > 0) flush(ch - 1, buf ^ 1, tid - 256);
      if (ch + 1 < 136) produce(ch + 1, buf ^ 1, pw, 4);
    }
    __syncthreads();
  }
  if (w >= 4) flush(135, 1, tid - 256);
  __syncthreads();
}
DEV void scan_phase(const Params& p, int l, char* smem) {
  for (int L = blockIdx.x; L < 256; L += gridDim.x) scan_tile(p, l, L, smem);
}

DEV void unpack8(const u32x4 u, float (&f)[8]) {
#pragma unroll
  for (int q = 0; q < 4; ++q) { f[2 * q] = lo_bf(u[q]); f[2 * q + 1] = hi_bf(u[q]); }
}
DEV void post_phase(const Params& p, int l, int nrows) {
  const bf16_t* ZRS = (const bf16_t*)(p.ws + O_ZRS);
  const bf16_t* AF = (const bf16_t*)(p.ws + O_AF);
  const bf16_t* AB = (const bf16_t*)(p.ws + O_AB);
  const bf16_t* G = (const bf16_t*)(p.ws + O_G);
  bf16_t* YSF = (bf16_t*)(p.ws + O_YSF);
  const bf16_t* YSB = (const bf16_t*)(p.ws + O_YSB);
  const int lane = ltid() & 63, w = ltid() >> 6, c0 = lane * 8;
  float gng[8], gnb[8], kaw[8], rkw[8];
#pragma unroll
  for (int j = 0; j < 8; ++j) {
    gng[j] = p.rwkv_gn_g[l * 512 + c0 + j]; gnb[j] = p.rwkv_gn_b[l * 512 + c0 + j];
    kaw[j] = p.rwkv_ka[l * 512 + c0 + j]; rkw[j] = p.rwkv_rk[l * 512 + c0 + j];
  }
  const int stride = gridDim.x * 8;
  int row = blockIdx.x * 8 + w;
  u32x4 q_ysf, q_ysb, q_r, q_k, q_v, q_af, q_ab, q_g;
  auto gl = [&](int rw) {
    q_ysf = *(const u32x4*)(YSF + (size_t)rw * 512 + c0); q_ysb = *(const u32x4*)(YSB + (size_t)rw * 512 + c0);
    q_r = *(const u32x4*)(ZRS + (size_t)rw * 1536 + c0); q_k = *(const u32x4*)(ZRS + (size_t)rw * 1536 + 512 + c0);
    q_v = *(const u32x4*)(ZRS + (size_t)rw * 1536 + 1024 + c0);
    q_af = *(const u32x4*)(AF + (size_t)rw * 512 + c0); q_ab = *(const u32x4*)(AB + (size_t)rw * 512 + c0);
    q_g = *(const u32x4*)(G + (size_t)rw * 512 + c0);
  };
  if (row < nrows) gl(row);
  for (; row < nrows; row += stride) {
    float ysf[8], ysb[8], r[8], k[8], v[8], af[8], ab[8], g[8];
    unpack8(q_ysf, ysf); unpack8(q_ysb, ysb); unpack8(q_r, r); unpack8(q_k, k); unpack8(q_v, v);
    unpack8(q_af, af); unpack8(q_ab, ab); unpack8(q_g, g);
    if (row + stride < nrows) gl(row + stride);
    float ys[8], s1 = 0.f, bp = 0.f;
#pragma unroll
    for (int j = 0; j < 8; ++j) {
      ys[j] = ysf[j] + ysb[j]; s1 += ys[j];
      bp += r[j] * k[j] * rkw[j] * (2.f + (af[j] + ab[j] - 2.f) * kaw[j]);
    }
    const float mu = red8(s1) * (1.f / 64.f);
    const float bon = red8(bp);
    float s2 = 0.f;
#pragma unroll
    for (int j = 0; j < 8; ++j) { ys[j] -= mu; s2 += ys[j] * ys[j]; }
    const float rs = rsqrtf(red8(s2) * (1.f / 64.f) + 64e-5f);
    float o[8];
#pragma unroll
    for (int j = 0; j < 8; ++j) o[j] = (ys[j] * rs * gng[j] + gnb[j] + bon * v[j]) * g[j];
    u32x4 ov;
    ov[0] = pk2(o[0], o[1]); ov[1] = pk2(o[2], o[3]); ov[2] = pk2(o[4], o[5]); ov[3] = pk2(o[6], o[7]);
    *(u32x4*)(YSF + (size_t)row * 512 + c0) = ov;
  }
}

struct EpiGate {
  static constexpr bool PERM = true, AFTER_DRAIN = false;
  char* ws;
  DEV void operator()(const f32x4 (&acc)[2][2][4][2], const pg8::Unit& u, int wr, int wc, int fr, int fq) const {
    const int b = u.pn >> 2, pn = u.pn & 3;
    bf16_t* G = (bf16_t*)(ws + (b == 0 ? O_G1 : (b == 1 ? O_G2 : O_G3)));
    const int row0 = u.pm * 256 + wr * 64 + fr, col0 = pn * 256 + wc * 32 + 8 * fq;
#pragma unroll
    for (int ai = 0; ai < 2; ++ai)
#pragma unroll
      for (int m = 0; m < 4; ++m) {
        const int row = row0 + ai * 128 + m * 16;
#pragma unroll
        for (int bj = 0; bj < 2; ++bj) {
          const f32x4 a0 = acc[ai][bj][m][0], a1 = acc[ai][bj][m][1];
          u32x4 o;
          o[0] = pk2(sigmoidf_(a0[0]), sigmoidf_(a0[1])); o[1] = pk2(sigmoidf_(a0[2]), sigmoidf_(a0[3]));
          o[2] = pk2(sigmoidf_(a1[0]), sigmoidf_(a1[1])); o[3] = pk2(sigmoidf_(a1[2]), sigmoidf_(a1[3]));
          *(u32x4*)(G + (size_t)row * DM + col0 + bj * 128) = o;
        }
      }
  }
};
DEV void gate_phase(const Params& p, int nrows, char* smem) {
  EpiGate E;
  E.ws = p.ws;
  pg8::Gemm g;
  g.A = (const bf16_t*)(p.ws + O_HM); g.Bt = (const bf16_t*)(p.ws + O_WB + W_WIN) + (size_t)NZP * 1024; g.M = nrows; g.N = 3072; g.K = 1024;
  pg8::StaticOrder S;
  S.init(g.M, g.N, (int)gridDim.x, (int)blockIdx.x);
  __syncthreads();
  pg8::gemm_phase<EpiGate, pg8::StaticOrder>((PG8_LAS unsigned char*)smem, g, S, E);
  __syncthreads();
}
struct MergeOrder {
  pg8::StaticOrder base;
  DEV bool next(int i, pg8::Unit& u) const {
    const int j = i / 3, b = i - 3 * j;
    pg8::Unit t;
    if (!base.next(j, t)) return false;
    u.pm = t.pm + 136 * (b == 0 ? 11 : (b == 1 ? 12 : 6));
    u.pn = t.pn + 4 * b;
    return true;
  }
  DEV void a_ready(const pg8::Unit&) const {}
  DEV void done(const pg8::Unit&) const {}
};
struct EpiMerge {
  static constexpr bool PERM = true, AFTER_DRAIN = false;
  char* ws;
  DEV void operator()(const f32x4 (&acc)[2][2][4][2], const pg8::Unit& u, int wr, int wc, int fr, int fq) const {
    const int b = u.pn >> 2, pn = u.pn & 3, pm = u.pm - 136 * (b == 0 ? 11 : (b == 1 ? 12 : 6));
    const bf16_t* G = (const bf16_t*)(ws + (b == 0 ? O_G1 : (b == 1 ? O_G2 : O_G3)));
    bf16_t* M = (bf16_t*)(ws + O_M);
    const int row0 = pm * 256 + wr * 64 + fr, col0 = pn * 256 + wc * 32 + 8 * fq;
#pragma unroll
    for (int ai = 0; ai < 2; ++ai)
#pragma unroll
      for (int m = 0; m < 4; ++m) {
        const int row = row0 + ai * 128 + m * 16;
#pragma unroll
        for (int bj = 0; bj < 2; ++bj) {
          const size_t off = (size_t)row * DM + col0 + bj * 128;
          const u32x4 gv = *(const u32x4*)(G + off);
          u32x4 mv = {0u, 0u, 0u, 0u};
          if (b > 0) mv = *(const u32x4*)(M + off);
          const f32x4 a0 = acc[ai][bj][m][0], a1 = acc[ai][bj][m][1];
          u32x4 o;
          o[0] = pk2(lo_bf(mv[0]) + lo_bf(gv[0]) * a0[0], hi_bf(mv[0]) + hi_bf(gv[0]) * a0[1]);
          o[1] = pk2(lo_bf(mv[1]) + lo_bf(gv[1]) * a0[2], hi_bf(mv[1]) + hi_bf(gv[1]) * a0[3]);
          o[2] = pk2(lo_bf(mv[2]) + lo_bf(gv[2]) * a1[0], hi_bf(mv[2]) + hi_bf(gv[2]) * a1[1]);
          o[3] = pk2(lo_bf(mv[3]) + lo_bf(gv[3]) * a1[2], hi_bf(mv[3]) + hi_bf(gv[3]) * a1[3]);
          *(u32x4*)(M + off) = o;
        }
      }
  }
};
DEV void merge_phase(const Params& p, int nrows, char* smem) {
  EpiMerge E;
  E.ws = p.ws;
  pg8::Gemm g;
  g.A = (const bf16_t*)p.ws; g.Bt = (const bf16_t*)(p.ws + O_WB + W_PCV); g.M = nrows; g.N = 1024; g.K = 512;
  MergeOrder S;
  S.base.init(g.M, g.N, (int)gridDim.x, (int)blockIdx.x);
  __syncthreads();
  pg8::gemm_phase<EpiMerge, MergeOrder>((PG8_LAS unsigned char*)smem, g, S, E);
  __syncthreads();
}

struct EpiResid {
  static constexpr bool PERM = false, AFTER_DRAIN = false;
  float* out; float* xc; const float* mod; bool store;
  DEV void operator()(const f32x4 (&acc)[2][2][4][2], const pg8::Unit& u, int wr, int wc, int fr, int fq) const {
    const int row0 = u.pm * 256 + wr * 64 + fr, col0 = u.pn * 256 + wc * 32 + 4 * fq;
#pragma unroll
    for (int ai = 0; ai < 2; ++ai)
#pragma unroll
      for (int m = 0; m < 4; ++m) {
        const int row = row0 + ai * 128 + m * 16;
        float* xr = row < T_LAT ? out + (size_t)row * DM : xc + (size_t)(row - T_LAT) * DM;
        const float* gt = mod + (size_t)modrow(row) * 6144;
#pragma unroll
        for (int bj = 0; bj < 2; ++bj)
#pragma unroll
          for (int n = 0; n < 2; ++n) {
            const int c = col0 + bj * 128 + n * 16;
            const f32x4 g4 = *(const f32x4*)(gt + c);
            f32x4 xv = *(f32x4*)(xr + c);
            xv += g4 * acc[ai][bj][m][n];
            if (store) *(f32x4*)(xr + c) = xv;
          }
      }
  }
};
DEV void resid_gemm_phase(const Params& p, int l, const bf16_t* A, int K, const bf16_t* Wt, int goff, int nrows, char* smem, bool store = true) {
  EpiResid E;
  E.store = store;
  E.out = p.out; E.xc = (float*)(p.ws + O_XC); E.mod = (const float*)(p.ws + O_MOD) + (size_t)l * 9 * 6144 + goff;
  pg8::Gemm g;
  g.A = A; g.Bt = Wt; g.M = nrows; g.N = 1024; g.K = K;
  pg8::StaticOrder S;
  S.init(g.M, g.N, (int)gridDim.x, (int)blockIdx.x);
  __syncthreads();
  pg8::gemm_phase<EpiResid, pg8::StaticOrder>((PG8_LAS unsigned char*)smem, g, S, E);
  __syncthreads();
}

struct EpiMlp1 {
  static constexpr bool PERM = true, AFTER_DRAIN = false;
  bf16_t* HID;
  DEV void operator()(const f32x4 (&acc)[2][2][4][2], const pg8::Unit& u, int wr, int wc, int fr, int fq) const {
    const int row0 = u.pm * 256 + wr * 64 + fr, col0 = u.pn * 256 + wc * 32 + 8 * fq;
#pragma unroll
    for (int ai = 0; ai < 2; ++ai)
#pragma unroll
      for (int m = 0; m < 4; ++m) {
        const int row = row0 + ai * 128 + m * 16;
#pragma unroll
        for (int bj = 0; bj < 2; ++bj) {
          float v[8];
#pragma unroll
          for (int j = 0; j < 4; ++j) {
            const float r0 = fmaxf(acc[ai][bj][m][0][j], 0.f), r1 = fmaxf(acc[ai][bj][m][1][j], 0.f);
            v[j] = r0 * r0; v[4 + j] = r1 * r1;
          }
          u32x4 o;
          o[0] = pk2(v[0], v[1]); o[1] = pk2(v[2], v[3]); o[2] = pk2(v[4], v[5]); o[3] = pk2(v[6], v[7]);
          *(u32x4*)(HID + (size_t)row * 4096 + col0 + bj * 128) = o;
        }
      }
  }
};
DEV void mlp1_phase(const Params& p, int nrows, char* smem) {
  EpiMlp1 E;
  E.HID = (bf16_t*)(p.ws + O_HID);
  pg8::Gemm g;
  g.A = (const bf16_t*)(p.ws + O_HM); g.Bt = (const bf16_t*)(p.ws + O_WB + W_W1); g.M = nrows; g.N = 4096; g.K = 1024;
  pg8::StaticOrder S;
  S.init(g.M, g.N, (int)gridDim.x, (int)blockIdx.x);
  __syncthreads();
  pg8::gemm_phase<EpiMlp1, pg8::StaticOrder>((PG8_LAS unsigned char*)smem, g, S, E);
  __syncthreads();
}

DEV void final_phase(const Params& p) {
  const int lane = ltid() & 63, w = ltid() >> 6;
  const int stride = gridDim.x * 8;
  f32x4 g[4];
#pragma unroll
  for (int i = 0; i < 4; ++i) g[i] = *(const f32x4*)(p.final_g + i * 256 + lane * 4);
  int row = blockIdx.x * 8 + w;
  f32x4 nv[4];
  if (row < T_LAT) {
#pragma unroll
    for (int i = 0; i < 4; ++i) nv[i] = *(const f32x4*)(p.out + (size_t)row * DM + i * 256 + lane * 4);
  }
  for (; row < T_LAT; row += stride) {
    float* xr = p.out + (size_t)row * DM;
    f32x4 v[4];
#pragma unroll
    for (int i = 0; i < 4; ++i) v[i] = nv[i];
    if (row + stride < T_LAT) {
#pragma unroll
      for (int i = 0; i < 4; ++i) nv[i] = *(const f32x4*)(p.out + (size_t)(row + stride) * DM + i * 256 + lane * 4);
    }
    float ss = 0.f;
#pragma unroll
    for (int i = 0; i < 4; ++i) ss += v[i][0] * v[i][0] + v[i][1] * v[i][1] + v[i][2] * v[i][2] + v[i][3] * v[i][3];
    const float rs = rsqrtf(wsum(ss) * (1.f / 1024.f) + 1e-6f);
#pragma unroll
    for (int i = 0; i < 4; ++i) *(f32x4*)(xr + i * 256 + lane * 4) = v[i] * rs * g[i];
  }
}

constexpr int N_PHASES = 26;
__global__ void __launch_bounds__(512) fwd_megakernel(Params p, int ph_lo, int ph_hi) {
  extern __shared__ __attribute__((aligned(16))) char smem[];
  cg::grid_group grid = cg::this_grid();
  volatile XLAS unsigned* st = (volatile XLAS unsigned*)(smem + 139264);
  if (threadIdx.x == 0) { st[0] = 0u; st[1] = 0u; st[2] = 0u; st[3] = 0u; }
  __syncthreads();
  const XcdBarrier xb = xcd_barrier_post((unsigned*)(p.ws + O_BAR), st);
  if (ph_hi > 1000) grid.sync();
  for (int ph = ph_lo; ph < ph_hi; ++ph) {
    if (ph == 0) {
      cvt_phase(p, 0, smem);
      mod_phase(p, smem);
    } else if (ph == N_PHASES - 1) {
      final_phase(p);
    } else {
      const int l = (ph - 1) / 12, sp = (ph - 1) % 12;
      const int nrows = (l == 1) ? T_LAT : T_ALL;
      switch (sp) {
        case 0:
          if (l > 0) cvt_phase(p, l, smem);
          norm_phase(p, l, 0, (bf16_t*)(p.ws + O_H0), l == 0);
          break;
        case 1: gemm_in_phase(p, smem); break;
        case 2: branch_phase(p, l, smem); break;
        case 3:
          lora64_phase(p, l, smem);
          lora_phase(p, l, smem, true);
          break;
        case 4: scan_phase(p, l, smem); break;
        case 5:
          post_phase(p, l, nrows);
          norm_phase(p, l, 0, (bf16_t*)(p.ws + O_HM), false, nrows);
          break;
        case 6: gate_phase(p, nrows, smem); break;
        case 7: merge_phase(p, nrows, smem); break;
        case 8: resid_gemm_phase(p, l, (const bf16_t*)(p.ws + O_M), 1024, (const bf16_t*)(p.ws + O_WB + W_WOUT), 2048, nrows, smem); break;
        case 9: norm_phase(p, l, 1, (bf16_t*)(p.ws + O_HM), false, nrows); break;
        case 10: mlp1_phase(p, nrows, smem); break;
        case 11: resid_gemm_phase(p, l, (const bf16_t*)(p.ws + O_HID), 4096, (const bf16_t*)(p.ws + O_WB + W_W2), 5120, nrows, smem); break;
      }
    }
    if (ph + 1 < ph_hi) xcd_barrier(xb);
  }
}

extern "C" void kernel_launch(void* const* d_in, const int* in_sizes, int n_in, void* d_out, int out_size, void* d_ws,
                              size_t ws_size, hipStream_t stream) {
  Params p{};
  const float** pp = (const float**)&p;
  for (int i = 0; i < 36; ++i) pp[i] = (const float*)d_in[i];
  p.out = (float*)d_out;
  p.ws = (char*)d_ws;
  static int grid_blocks = 0;
  if (!grid_blocks) {
    hipFuncSetAttribute((const void*)fwd_megakernel, hipFuncAttributeMaxDynamicSharedMemorySize, LDS_BYTES);
    int dev = 0, cus = 0, per_cu = 0;
    hipGetDevice(&dev);
    hipDeviceGetAttribute(&cus, hipDeviceAttributeMultiprocessorCount, dev);
    hipOccupancyMaxActiveBlocksPerMultiprocessor(&per_cu, fwd_megakernel, 512, LDS_BYTES);
    if (per_cu < 1) per_cu = 1;
    grid_blocks = cus * per_cu;
    grid_blocks &= ~7;
  }
  if (ws_size < WS_NEED) fprintf(stderr, "workspace too small: %zu < %zu\n", ws_size, (size_t)WS_NEED);
#ifndef MULTI_LAUNCH
#define MULTI_LAUNCH 0
#endif
#if MULTI_LAUNCH
  for (int ph = 0; ph < N_PHASES; ++ph)
    hipLaunchKernelGGL(fwd_megakernel, dim3(grid_blocks), dim3(512), LDS_BYTES, stream, p, ph, ph + 1);
#else
  hipMemsetAsync((char*)d_ws + O_BAR, 0, 16384, stream);
  int lo = 0, hi = N_PHASES;
  void* args[] = {&p, &lo, &hi};
  hipError_t e = hipLaunchCooperativeKernel((const void*)fwd_megakernel, dim3(grid_blocks), dim3(512), args, LDS_BYTES, stream);
  if (e != hipSuccess) fprintf(stderr, "cooperative launch failed: %s (grid %d)\n", hipGetErrorString(e), grid_blocks);
#endif
}
```

```cpp
#include <hip/hip_runtime.h>
#include <hip/hip_cooperative_groups.h>
#include <cstdio>
namespace cg = cooperative_groups;

typedef unsigned short bf16_t;
typedef short bf16x8 __attribute__((ext_vector_type(8)));
typedef float f32x4 __attribute__((ext_vector_type(4)));
typedef float f32x16 __attribute__((ext_vector_type(16)));
typedef unsigned u32x4 __attribute__((ext_vector_type(4)));
#define DEV __device__ __forceinline__
#define PROBE 0

constexpr int T_LAT = 32768, T_ALL = 34816, DM = 1024, DIN = 7552, NZ = 4480, NZP = 4608, DINT = 7680;
constexpr int SEQ = 4096, CTXL = 256, TK = 4352;
constexpr size_t U = 35651584ull;
constexpr size_t O_ZU = 0, O_ZK = U, O_VT = 2 * U, O_ZRW = 3 * U, O_ZRS = 7 * U, O_LIN = 10 * U, O_YCV = 11 * U, O_ZQ = 12 * U;
constexpr size_t O_H0 = 7 * U;
constexpr size_t O_EF = 0, O_EB = 3 * U, O_AF = 4 * U, O_AB = 5 * U, O_G = 2 * U, O_YSF = 6 * U, O_YSB = 10 * U;
constexpr size_t O_HM = 0, O_M = 0, O_HID = 3 * U;
constexpr size_t O_G1 = 3 * U, O_G2 = 7 * U, O_G3 = 9 * U;
constexpr size_t O_WB = 13 * U;
constexpr size_t W_WIN = 0, W_PCV = W_WIN + (size_t)DINT * 1024 * 2, W_PAT = W_PCV + 1048576, W_PRW = W_PAT + 1048576,
                 W_WOUT = W_PRW + 1048576, W_W1 = W_WOUT + 2097152, W_W2 = W_W1 + 8388608, W_LW2 = W_W2 + 8388608,
                 W_LA2 = W_LW2 + 131072, W_LG2 = W_LA2 + 131072, W_END = W_LG2 + 131072;
constexpr size_t O_XC = O_WB + W_END;
constexpr size_t O_MOD = O_XC + 8388608;
constexpr size_t O_BAR = O_MOD + 2 * 9 * 6144 * 4;
constexpr size_t O_GIN = O_BAR + 16384;
constexpr size_t WS_NEED = O_GIN + (size_t)T_ALL * 128 * 2;

constexpr int LDS_BYTES = 139264 + 16;

struct Params {
  const float *x, *c, *ctx, *c_ctx, *mod_w, *mod_b, *norm1_g, *norm2_g, *w_in, *conv_dw_w, *conv_dw_b, *conv_ln_g,
      *conv_ln_b, *p_conv, *att_lq1, *att_lk1, *att_lq2, *att_lk2, *att_subln_g, *p_att, *rwkv_shift, *rwkv_w0, *rwkv_w2,
      *rwkv_a0, *rwkv_a2, *rwkv_g2, *rwkv_kk, *rwkv_ka, *rwkv_rk, *rwkv_gn_g, *rwkv_gn_b, *p_rwkv, *w_out, *mlp_w1,
      *mlp_w2, *final_g;
  float* out;
  char* ws;
};

DEV int ltid() { int t = threadIdx.x; asm volatile("" : "+v"(t)); return t; }
DEV float bf2f(bf16_t h) { return __uint_as_float(((unsigned)h) << 16); }
typedef float f32x2_t __attribute__((ext_vector_type(2)));
typedef __bf16 bf16x2_t __attribute__((ext_vector_type(2)));
DEV unsigned pk2(float lo, float hi) {
  const f32x2_t v = {lo, hi};
  return __builtin_bit_cast(unsigned, __builtin_convertvector(v, bf16x2_t));
}
DEV bf16_t f2bf(float f) { return (bf16_t)(pk2(f, 0.f) & 0xffffu); }
DEV float lo_bf(unsigned u) { return __uint_as_float(u << 16); }
DEV float hi_bf(unsigned u) { return __uint_as_float(u & 0xffff0000u); }
template <int C> DEV float dppf(float v) {
  return __int_as_float(__builtin_amdgcn_update_dpp(0, __float_as_int(v), C, 0xF, 0xF, true));
}
DEV float xor32_sum(float v) {
  const auto r = __builtin_amdgcn_permlane32_swap(__float_as_uint(v), __float_as_uint(v), false, false);
  return __uint_as_float(r[0]) + __uint_as_float(r[1]);
}
DEV float xor32_max(float v) {
  const auto r = __builtin_amdgcn_permlane32_swap(__float_as_uint(v), __float_as_uint(v), false, false);
  return fmaxf(__uint_as_float(r[0]), __uint_as_float(r[1]));
}
DEV float xor16_sum(float v) {
  const auto r = __builtin_amdgcn_permlane16_swap(__float_as_uint(v), __float_as_uint(v), false, false);
  return __uint_as_float(r[0]) + __uint_as_float(r[1]);
}
DEV float wsum(float v) {
  v += dppf<0xB1>(v);
  v += dppf<0x4E>(v);
  v += dppf<0x141>(v);
  v += dppf<0x140>(v);
  v = xor16_sum(v);
  return xor32_sum(v);
}
DEV float sigmoidf_(float x) { return 1.f / (1.f + __expf(-x)); }
DEV float red16(float v) {
  v += dppf<0xB1>(v);
  v += dppf<0x4E>(v);
  v += dppf<0x141>(v);
  v += dppf<0x140>(v);
  return v;
}
DEV int vblock() { const int per = gridDim.x >> 3; return (blockIdx.x & 7) * per + (blockIdx.x >> 3); }
DEV float* xrow(const Params& p, int row) {
  return row < T_LAT ? p.out + (size_t)row * DM : (float*)(p.ws + O_XC) + (size_t)(row - T_LAT) * DM;
}
DEV int modrow(int row) { return row < T_LAT ? (row >> 12) : 8; }

#define XB_TMO      128
#define XB_XCNT(j)  (256  + 64 * (j))
#define XB_XSUB(j)  (1280 + 64 * (j))
#define XB_XGEN(j)  (2304 + 64 * (j))
#define XB_TOP      3328
#define XB_TOPGEN   3392
#define XCD_BAR_WORDS 3456
#define XB_SPIN_CAP (1u << 18)
#define XLAS __attribute__((address_space(3)))

__device__ __forceinline__ unsigned xb_ld(unsigned* p)              { return __hip_atomic_load(p, __ATOMIC_RELAXED, __HIP_MEMORY_SCOPE_AGENT); }
__device__ __forceinline__ unsigned xb_add(unsigned* p, unsigned v) { return __hip_atomic_fetch_add(p, v, __ATOMIC_RELAXED, __HIP_MEMORY_SCOPE_AGENT); }
__device__ __forceinline__ unsigned xb_xcc_id() { return (unsigned)__builtin_amdgcn_s_getreg((3 << 11) | 20) & 0xFu; }
#define XB_SPIN(cond, bar) do { unsigned _sp = 0; while (cond) { __builtin_amdgcn_s_sleep(1); \
    if ((++_sp & 255u) == 0u) { if (xb_ld(&(bar)[XB_TMO])) break; if (_sp > XB_SPIN_CAP) { atomicAdd(&(bar)[XB_TMO], 1u); break; } } } } while (0)

struct XcdBarrier {
    unsigned* bar; unsigned x;
    volatile XLAS unsigned* st;
};

__device__ __forceinline__ XcdBarrier xcd_barrier_post(unsigned* bar, volatile XLAS unsigned* st) {
    XcdBarrier b; b.bar = bar; b.x = xb_xcc_id(); b.st = st;
    if (threadIdx.x == 0) (void)xb_add(&bar[XB_XCNT(b.x)], 1u);
    return b;
}
__device__ __forceinline__ void xcd_barrier_complete(unsigned* bar, unsigned x, unsigned& nloc, unsigned& nx) {
    const unsigned G = gridDim.x * gridDim.y * gridDim.z;
    unsigned sum, cnt, mine, sp = 0u;
    for (;;) {
        sum = 0u; cnt = 0u; mine = 0u;
#pragma unroll
        for (unsigned j = 0; j < 16; ++j) { const unsigned c = xb_ld(&bar[XB_XCNT(j)]); sum += c; cnt += (c > 0u) ? 1u : 0u; mine = (j == x) ? c : mine; }
        if (sum == G) break;
        __builtin_amdgcn_s_sleep(1);
        if ((++sp & 255u) == 0u) { if (xb_ld(&bar[XB_TMO])) break; if (sp > XB_SPIN_CAP) { atomicAdd(&bar[XB_TMO], 1u); break; } }
    }
    nloc = mine > 0u ? mine : 1u; nx = cnt > 0u ? cnt : 1u;
}

__device__ __forceinline__ void xcd_barrier(const XcdBarrier& b) {
    asm volatile("s_waitcnt vmcnt(0)" ::: "memory");
    __syncthreads();
    if (threadIdx.x == 0) {
        unsigned* bar = b.bar;
        __builtin_amdgcn_s_waitcnt(0);
        unsigned nloc = b.st[0], nx = b.st[1];
        if (nloc == 0u) { xcd_barrier_complete(bar, b.x, nloc, nx); b.st[0] = nloc; b.st[1] = nx; }
        const unsigned old = xb_add(&bar[XB_XSUB(b.x)], 1u);
        const unsigned gen = old / nloc;
        if (old + 1u == (gen + 1u) * nloc) {
            __builtin_amdgcn_fence(__ATOMIC_RELEASE, "agent");
            asm volatile("s_waitcnt vmcnt(0)" ::: "memory");
            const unsigned og = xb_add(&bar[XB_TOP], 1u);
            const unsigned tg = og / nx;
            if (og + 1u == (tg + 1u) * nx) xb_add(&bar[XB_TOPGEN], 1u);
            else XB_SPIN(xb_ld(&bar[XB_TOPGEN]) == tg, bar);
            __builtin_amdgcn_fence(__ATOMIC_ACQUIRE, "agent");
            xb_add(&bar[XB_XGEN(b.x)], 1u);
            asm volatile("s_waitcnt vmcnt(0)" ::: "memory");
        } else {
            XB_SPIN(xb_ld(&bar[XB_XGEN(b.x)]) == gen, bar);
            __builtin_amdgcn_fence(__ATOMIC_ACQUIRE, "agent");
            asm volatile("s_waitcnt vmcnt(0)" ::: "memory");
        }
    }
    __syncthreads();
}

namespace pg8 {
#define PG8_LAS __attribute__((address_space(3)))
constexpr int BM = 256, BK = 64, HALF = 128, HTB = HALF * BK * 2, STAGE_BYTES = 8 * HTB, NXCD = 8, WGM = 4;
__host__ __device__ __forceinline__ int lds_byte(int r, int c) { const int st = (r >> 4) * 2 + (c >> 5), rr = r & 15, cc = c & 31, ob = rr * 64 + cc * 2; return st * 1024 + (ob ^ (((ob >> 9) & 1) << 5)); }
__host__ __device__ __forceinline__ void stage_rc(int b, int& R, int& C) { const int st = b / 1024, sb = b % 1024, swz = sb ^ (((sb >> 9) & 1) << 5); R = (st >> 1) * 16 + swz / 64; C = (st & 1) * 32 + (swz % 64) / 2; }
__host__ __device__ __forceinline__ int perm32(int rho) { const int n = rho >> 4, i = rho & 15; return 8 * (i >> 2) + 4 * n + (i & 3); }
struct Unit { int pm, pn; };
struct Gemm { const bf16_t* A; const bf16_t* Bt; int M, N, K; };
struct StaticOrder {
    int nM, nN, nwg, G, c;
    __host__ __device__ void init(int M, int N, int G_, int c_) { nM = M / BM; nN = N / BM; nwg = nM * nN; G = G_; c = c_; }
    __host__ __device__ bool next(int i, Unit& u) const {
        const long L = (long)i * G + c; if (L >= nwg) return false;
        int wgid = (int)L; { const int q = nwg / NXCD, r = nwg % NXCD, xcd = wgid % NXCD, off = wgid / NXCD; wgid = (xcd < r ? xcd * (q + 1) : r * (q + 1) + (xcd - r) * q) + off; }
        const int nig = WGM * nN, gid = wgid / nig, fm = gid * WGM, gsz = (nM - fm) < WGM ? (nM - fm) : WGM;
        u.pm = fm + ((wgid % nig) % gsz); u.pn = (wgid % nig) / gsz; return true;
    }
    __device__ __forceinline__ void a_ready(const Unit&) const {}
    __device__ __forceinline__ void done(const Unit&) const {}
};

template <class Epi, class Sched>
__device__ __forceinline__ void gemm_phase(PG8_LAS unsigned char* lds, const Gemm g, const Sched& S, const Epi& E) {
    const int tid = ltid(), wid = __builtin_amdgcn_readfirstlane(tid >> 6), lane = tid & 63, wr = wid >> 2, wc = wid & 3, fr = lane & 15, fq = lane >> 4;
    const int K = g.K, nt = K / BK;
    unsigned voffA[2], voffB[2];
#pragma unroll
    for (int i = 0; i < 2; ++i) { int R, C; stage_rc(tid * 16 + i * 8192, R, C); const int Rb = Epi::PERM ? ((R & ~31) + perm32(R & 31)) : R;
        voffA[i] = (unsigned)(R * K + C) * 2u; voffB[i] = (unsigned)(Rb * K + C) * 2u; }
    const size_t kstep = (size_t)(BK * 2);
    const size_t hstep = (size_t)HALF * K * 2;
    const size_t tstep = 2 * hstep;
    const unsigned ldsw = (unsigned)wid * 1024u;
    const int aoff = lds_byte(wr * 64 + fr, fq * 8), boff = lds_byte(wc * 32 + fr, fq * 8);
#define PG8_SA(b, h) (((b) * 2 + (h)) * HTB)
#define PG8_SB(b, h) ((4 + (b) * 2 + (h)) * HTB)
#define PG8_STAGE(bufoff, gbase, voff) do { _Pragma("unroll") for (int _i = 0; _i < 2; ++_i) \
        __builtin_amdgcn_global_load_lds((const unsigned*)((const char*)(gbase) + (voff)[_i]), (PG8_LAS unsigned*)(lds + (bufoff) + ldsw + _i * 8192), 16, 0, 0); } while (0)
#define PG8_LDA(dst, b, h) do { _Pragma("unroll") for (int m = 0; m < 4; ++m) _Pragma("unroll") for (int k = 0; k < 2; ++k) dst[m][k] = *(const PG8_LAS bf16x8*)(lds + PG8_SA(b, h) + aoff + m * 2048 + k * 1024); } while (0)
#define PG8_LDB(dst, b, h) do { _Pragma("unroll") for (int n = 0; n < 2; ++n) _Pragma("unroll") for (int k = 0; k < 2; ++k) dst[n][k] = *(const PG8_LAS bf16x8*)(lds + PG8_SB(b, h) + boff + n * 2048 + k * 1024); } while (0)
#define PG8_MMA(ai, bj, At, Bt) do { __builtin_amdgcn_s_setprio(1); _Pragma("unroll") for (int m = 0; m < 4; ++m) _Pragma("unroll") for (int n = 0; n < 2; ++n) _Pragma("unroll") for (int k = 0; k < 2; ++k) \
        acc[ai][bj][m][n] = __builtin_amdgcn_mfma_f32_16x16x32_bf16(Bt[n][k], At[m][k], acc[ai][bj][m][n], 0, 0, 0); __builtin_amdgcn_s_setprio(0); } while (0)
#define PG8_WAIT_V(n) asm volatile("s_waitcnt vmcnt(" #n ")" ::: "memory")
#define PG8_WAIT_L(n) asm volatile("s_waitcnt lgkmcnt(" #n ")" ::: "memory")
#define PG8_BAR __builtin_amdgcn_s_barrier()
#define PG8_SCHED __builtin_amdgcn_sched_barrier(0)
    Unit cur, nxt; int ui = 0;
    if (!S.next(0, cur)) return;
    f32x4 acc[2][2][4][2];
#pragma unroll
    for (int a = 0; a < 2; ++a)
#pragma unroll
        for (int b = 0; b < 2; ++b)
#pragma unroll
            for (int m = 0; m < 4; ++m)
#pragma unroll
                for (int n = 0; n < 2; ++n) acc[a][b][m][n] = (f32x4){0.f, 0.f, 0.f, 0.f};
    bf16x8 At[4][2], B0[2][2], B1[2][2];
    const char* cA = (const char*)g.A + (size_t)cur.pm * tstep; const char* cB = (const char*)g.Bt + (size_t)cur.pn * tstep;
    S.a_ready(cur);
    PG8_STAGE(PG8_SB(0, 0), cB, voffB); PG8_STAGE(PG8_SA(0, 0), cA, voffA); PG8_STAGE(PG8_SB(0, 1), cB + hstep, voffB); PG8_STAGE(PG8_SA(0, 1), cA + hstep, voffA);
    if (wr == 1) PG8_BAR;
    PG8_WAIT_V(4); PG8_BAR;
    PG8_STAGE(PG8_SB(1, 0), cB + kstep, voffB); PG8_STAGE(PG8_SA(1, 0), cA + kstep, voffA); PG8_STAGE(PG8_SB(1, 1), cB + hstep + kstep, voffB);
    PG8_WAIT_V(6); PG8_BAR;
    for (;;) {
        const bool has_next = S.next(ui + 1, nxt);
        const char* nA = has_next ? (const char*)g.A + (size_t)nxt.pm * tstep : cA; const char* nB = has_next ? (const char*)g.Bt + (size_t)nxt.pn * tstep : cB;
        for (int t = 0; t < nt; t += 2) {
            const bool last = (t == nt - 2);
            const char* a1 = cA + (size_t)(t + 1) * kstep;
            const char* a2 = last ? nA : cA + (size_t)(t + 2) * kstep; const char* b2 = last ? nB : cB + (size_t)(t + 2) * kstep;
            const char* a3 = a2 + kstep; const char* b3 = b2 + kstep;
            if (last && has_next) S.a_ready(nxt);
            PG8_LDB(B0, 0, 0); PG8_SCHED; PG8_LDA(At, 0, 0); PG8_STAGE(PG8_SA(1, 1), a1 + hstep, voffA);
            PG8_WAIT_L(8); PG8_BAR; PG8_WAIT_L(0); PG8_MMA(0, 0, At, B0); PG8_BAR; PG8_SCHED;
            PG8_LDB(B1, 0, 1); PG8_STAGE(PG8_SB(0, 0), b2, voffB);
            PG8_BAR; PG8_WAIT_L(0); PG8_MMA(0, 1, At, B1); PG8_BAR;
            PG8_LDA(At, 0, 1); PG8_STAGE(PG8_SA(0, 0), a2, voffA);
            PG8_BAR; PG8_WAIT_L(0); PG8_MMA(1, 0, At, B0); PG8_BAR; PG8_SCHED;
            PG8_STAGE(PG8_SB(0, 1), b2 + hstep, voffB);
            PG8_WAIT_V(6); PG8_BAR; PG8_MMA(1, 1, At, B1); PG8_BAR;
            PG8_LDB(B0, 1, 0); PG8_SCHED; PG8_LDA(At, 1, 0); PG8_STAGE(PG8_SA(0, 1), a2 + hstep, voffA);
            PG8_WAIT_L(8); PG8_BAR; PG8_WAIT_L(0); PG8_MMA(0, 0, At, B0); PG8_BAR; PG8_SCHED;
            PG8_LDB(B1, 1, 1); PG8_STAGE(PG8_SB(1, 0), b3, voffB);
            PG8_BAR; PG8_WAIT_L(0); PG8_MMA(0, 1, At, B1); PG8_BAR;
            PG8_LDA(At, 1, 1); PG8_STAGE(PG8_SA(1, 0), a3, voffA);
            PG8_BAR; PG8_WAIT_L(0); PG8_MMA(1, 0, At, B0); PG8_BAR; PG8_SCHED;
            PG8_STAGE(PG8_SB(1, 1), b3 + hstep, voffB);
            PG8_WAIT_V(6); PG8_BAR; PG8_MMA(1, 1, At, B1); PG8_BAR;
        }
        if constexpr (!Epi::AFTER_DRAIN) { E(acc, cur, wr, wc, fr, fq); S.done(cur); }
        if (!has_next) break;
#pragma unroll
        for (int a = 0; a < 2; ++a)
#pragma unroll
            for (int b = 0; b < 2; ++b)
#pragma unroll
                for (int m = 0; m < 4; ++m)
#pragma unroll
                    for (int n = 0; n < 2; ++n) acc[a][b][m][n] = (f32x4){0.f, 0.f, 0.f, 0.f};
        cur = nxt; cA = nA; cB = nB; ++ui;
    }
    PG8_WAIT_V(0);
    if (wr == 0) PG8_BAR;
    PG8_BAR;
    if constexpr (Epi::AFTER_DRAIN) { E.fused(acc, cur, wr, wc, fr, fq, lds, wid, lane); S.done(cur); }
#undef PG8_SA
#undef PG8_SB
#undef PG8_STAGE
#undef PG8_LDA
#undef PG8_LDB
#undef PG8_MMA
#undef PG8_WAIT_V
#undef PG8_WAIT_L
#undef PG8_BAR
#undef PG8_SCHED
}

}

constexpr int SROW = 144;
constexpr int A_ST = 256 * SROW, B_ST = 128 * SROW, ST_BYTES = A_ST + B_ST;

DEV void gemm_kloop(f32x4 (&acc)[4][4], const bf16_t* __restrict__ A, int lda, const bf16_t* __restrict__ Bt, int ldb,
                    int K, char* smem) {
  const int tid = ltid(), lane = tid & 63, w = tid >> 6, wm = w >> 1, wn = w & 1;
  const int fr = lane & 15, fq = lane >> 4;
  const int lrow = tid >> 3, lch = tid & 7;
  const bf16_t* ga = A + (size_t)lrow * lda + lch * 8;
  const bf16_t* gb = Bt + (size_t)lrow * ldb + lch * 8;
  u32x4 ra[4], rb[2];
#pragma unroll
  for (int i = 0; i < 4; ++i) ra[i] = *(const u32x4*)(ga + (size_t)(64 * i) * lda);
#pragma unroll
  for (int i = 0; i < 2; ++i) rb[i] = *(const u32x4*)(gb + (size_t)(64 * i) * ldb);
  char* swa = smem + lrow * SROW + lch * 16;
  char* swb = swa + A_ST;
  __syncthreads();
#pragma unroll
  for (int i = 0; i < 4; ++i) *(u32x4*)(swa + i * 64 * SROW) = ra[i];
#pragma unroll
  for (int i = 0; i < 2; ++i) *(u32x4*)(swb + i * 64 * SROW) = rb[i];
  __syncthreads();
  const int nk = K >> 6;
  const char* sra = smem + (wm * 64 + fr) * SROW + fq * 16;
  const char* srb = smem + A_ST + (wn * 64 + fr) * SROW + fq * 16;
  for (int kt = 0; kt < nk; ++kt) {
    const int cur = kt & 1;
    if (kt + 1 < nk) {
#pragma unroll
      for (int i = 0; i < 4; ++i) ra[i] = *(const u32x4*)(ga + (size_t)(64 * i) * lda + (kt + 1) * 64);
#pragma unroll
      for (int i = 0; i < 2; ++i) rb[i] = *(const u32x4*)(gb + (size_t)(64 * i) * ldb + (kt + 1) * 64);
    }
#pragma unroll
    for (int ks = 0; ks < 2; ++ks) {
      bf16x8 af[4], bfr[4];
#pragma unroll
      for (int mi = 0; mi < 4; ++mi) af[mi] = *(const bf16x8*)(sra + cur * ST_BYTES + mi * 16 * SROW + ks * 64);
#pragma unroll
      for (int ni = 0; ni < 4; ++ni) bfr[ni] = *(const bf16x8*)(srb + cur * ST_BYTES + ni * 16 * SROW + ks * 64);
#pragma unroll
      for (int mi = 0; mi < 4; ++mi)
#pragma unroll
        for (int ni = 0; ni < 4; ++ni)
          acc[mi][ni] = __builtin_amdgcn_mfma_f32_16x16x32_bf16(bfr[ni], af[mi], acc[mi][ni], 0, 0, 0);
    }
    if (kt + 1 < nk) {
      const int nx = cur ^ 1;
#pragma unroll
      for (int i = 0; i < 4; ++i) *(u32x4*)(swa + nx * ST_BYTES + i * 64 * SROW) = ra[i];
#pragma unroll
      for (int i = 0; i < 2; ++i) *(u32x4*)(swb + nx * ST_BYTES + i * 64 * SROW) = rb[i];
    }
    __syncthreads();
  }
}
DEV void zero_acc(f32x4 (&acc)[4][4]) {
#pragma unroll
  for (int a = 0; a < 4; ++a)
#pragma unroll
    for (int b = 0; b < 4; ++b) acc[a][b] = (f32x4){0.f, 0.f, 0.f, 0.f};
}
DEV void tile_pm_pn(int L, int nN, int& pm, int& pn) {
  const int g = L / (4 * nN), wi = L % (4 * nN);
  pm = g * 4 + (wi & 3);
  pn = wi >> 2;
}

DEV int conv_srccol(int n) {
  const int tile = n >> 8, w = n & 255;
  return w < 128 ? tile * 128 + w : 512 + tile * 128 + (w - 128);
}
DEV void cvt_job(const float* __restrict__ src, int K, int N, int ldsrc, bf16_t* __restrict__ dst, int nperm, int& tbase, char* smem) {
  float* lds = (float*)smem;
  const int nkt = K >> 6, nnt = N >> 6, cnt = nkt * nnt;
  const int G = gridDim.x;
  const int first = (int)((blockIdx.x + G - (tbase % G)) % G);
  const int tid = ltid();
  for (int t = first; t < cnt; t += G) {
    const int kt = t % nkt, nt = t / nkt;
    const int ty = tid >> 4, tx = tid & 15;
    const int n = nt * 64 + tx * 4;
    const int sc = (n < nperm) ? conv_srccol(n) : n;
#pragma unroll
    for (int i = 0; i < 2; ++i) {
      const int k = ty + 32 * i;
      const float4 v = *(const float4*)(src + (size_t)(kt * 64 + k) * ldsrc + sc);
      float* d = lds + k * 65 + tx * 4;
      d[0] = v.x; d[1] = v.y; d[2] = v.z; d[3] = v.w;
    }
    __syncthreads();
    {
      const int nn = tid >> 3, kc = tid & 7;
      float v[8];
#pragma unroll
      for (int j = 0; j < 8; ++j) v[j] = lds[(kc * 8 + j) * 65 + nn];
      uint4 o;
      o.x = pk2(v[0], v[1]); o.y = pk2(v[2], v[3]); o.z = pk2(v[4], v[5]); o.w = pk2(v[6], v[7]);
      *(uint4*)(dst + (size_t)(nt * 64 + nn) * K + kt * 64 + kc * 8) = o;
    }
    __syncthreads();
  }
  tbase += cnt;
}
DEV void cvt_phase(const Params& p, int l, char* smem) {
  char* wb = p.ws + O_WB;
  int tb = 0;
  const float* win = p.w_in + (size_t)l * 1024 * DIN;
  cvt_job(win, 1024, NZ, DIN, (bf16_t*)(wb + W_WIN), 1024, tb, smem);
  cvt_job(win + NZ, 1024, 3072, DIN, (bf16_t*)(wb + W_WIN) + (size_t)NZP * 1024, 0, tb, smem);
  cvt_job(p.mlp_w1 + (size_t)l * 1024 * 4096, 1024, 4096, 4096, (bf16_t*)(wb + W_W1), 0, tb, smem);
  cvt_job(p.mlp_w2 + (size_t)l * 4096 * 1024, 4096, 1024, 1024, (bf16_t*)(wb + W_W2), 0, tb, smem);
  cvt_job(p.w_out + (size_t)l * 1024 * 1024, 1024, 1024, 1024, (bf16_t*)(wb + W_WOUT), 0, tb, smem);
  cvt_job(p.p_conv + (size_t)l * 512 * 1024, 512, 1024, 1024, (bf16_t*)(wb + W_PCV), 0, tb, smem);
  cvt_job(p.p_att + (size_t)l * 512 * 1024, 512, 1024, 1024, (bf16_t*)(wb + W_PAT), 0, tb, smem);
  cvt_job(p.p_rwkv + (size_t)l * 512 * 1024, 512, 1024, 1024, (bf16_t*)(wb + W_PRW), 0, tb, smem);
  for (int d = 0; d < 2; ++d) {
    cvt_job(p.rwkv_w2 + (size_t)(l * 2 + d) * 64 * 512, 64, 512, 512, (bf16_t*)(wb + W_LW2) + d * 512 * 64, 0, tb, smem);
    cvt_job(p.rwkv_a2 + (size_t)(l * 2 + d) * 64 * 512, 64, 512, 512, (bf16_t*)(wb + W_LA2) + d * 512 * 64, 0, tb, smem);
  }
  cvt_job(p.rwkv_g2 + (size_t)l * 128 * 512, 128, 512, 512, (bf16_t*)(wb + W_LG2), 0, tb, smem);
}

DEV void mod_phase(const Params& p, char* smem) {
  float* sc = (float*)smem;
  float* red = sc + 9 * 1024;
  float* MOD = (float*)(p.ws + O_MOD);
  const int tid = ltid();
  if ((int)blockIdx.x >= 192) return;
  for (int i = tid; i < 9 * 1024; i += 512) {
    const int r = i >> 10, k = i & 1023;
    const float v = r < 8 ? p.c[r * 1024 + k] : p.c_ctx[k];
    sc[i] = v / (1.f + __expf(-v));
  }
  __syncthreads();
  for (int tile = blockIdx.x; tile < 192; tile += gridDim.x) {
    const int l = tile / 96, n0 = (tile % 96) * 64;
    const int kq = tid >> 6, col = tid & 63;
    float acc[9];
#pragma unroll
    for (int r = 0; r < 9; ++r) acc[r] = 0.f;
    const float* wp = p.mod_w + ((size_t)l * 1024 + kq * 128) * 6144 + n0 + col;
#pragma unroll 32
    for (int k = 0; k < 128; ++k) {
      const float wv = wp[(size_t)k * 6144];
#pragma unroll
      for (int r = 0; r < 9; ++r) acc[r] += sc[r * 1024 + kq * 128 + k] * wv;
    }
#pragma unroll
    for (int r = 0; r < 9; ++r) red[(kq * 9 + r) * 64 + col] = acc[r];
    __syncthreads();
    for (int idx = tid; idx < 576; idx += 512) {
      const int r = idx >> 6, cc = idx & 63;
      float s = p.mod_b[l * 6144 + n0 + cc];
#pragma unroll
      for (int q = 0; q < 8; ++q) s += red[(q * 9 + r) * 64 + cc];
      MOD[(size_t)(l * 9 + r) * 6144 + n0 + cc] = s;
    }
    __syncthreads();
  }
}

DEV void norm_phase(const Params& p, int l, int which, bf16_t* __restrict__ Hd, bool first, int nrows = T_ALL) {
  const float* g = (which ? p.norm2_g : p.norm1_g) + l * 1024;
  const float* MOD = (const float*)(p.ws + O_MOD);
  const int lane = ltid() & 63, w = ltid() >> 6;
  const int stride = gridDim.x * 8;
  f32x4 gg[4];
#pragma unroll
  for (int i = 0; i < 4; ++i) gg[i] = *(const f32x4*)(g + i * 256 + lane * 4);
  auto srcp = [&](int row) -> const float* {
    if (first) return row < T_LAT ? p.x + (size_t)row * DM : p.ctx + (size_t)(row - T_LAT) * DM;
    return xrow(p, row);
  };
  int row = blockIdx.x * 8 + w;
  f32x4 nv[4];
  if (row < nrows) {
    const float* s = srcp(row);
#pragma unroll
    for (int i = 0; i < 4; ++i) nv[i] = *(const f32x4*)(s + i * 256 + lane * 4);
  }
  for (; row < nrows; row += stride) {
    f32x4 v[4];
#pragma unroll
    for (int i = 0; i < 4; ++i) v[i] = nv[i];
    if (row + stride < nrows) {
      const float* s = srcp(row + stride);
#pragma unroll
      for (int i = 0; i < 4; ++i) nv[i] = *(const f32x4*)(s + i * 256 + lane * 4);
    }
    const float* md = MOD + (size_t)(l * 9 + modrow(row)) * 6144 + which * 3072;
    f32x4 sh[4], scl[4];
#pragma unroll
    for (int i = 0; i < 4; ++i) { sh[i] = *(const f32x4*)(md + i * 256 + lane * 4); scl[i] = *(const f32x4*)(md + 1024 + i * 256 + lane * 4); }
    float ss = 0.f;
#pragma unroll
    for (int i = 0; i < 4; ++i) ss += v[i][0] * v[i][0] + v[i][1] * v[i][1] + v[i][2] * v[i][2] + v[i][3] * v[i][3];
    if (first) {
      float* xr = xrow(p, row);
#pragma unroll
      for (int i = 0; i < 4; ++i) *(f32x4*)(xr + i * 256 + lane * 4) = v[i];
    }
    const float rs = rsqrtf(wsum(ss) * (1.f / 1024.f) + 1e-6f);
#pragma unroll
    for (int i = 0; i < 4; ++i) {
      const int c = i * 256 + lane * 4;
      const f32x4 h = v[i] * rs * gg[i] * (scl[i] + 1.f) + sh[i];
      uint2 o;
      o.x = pk2(h[0], h[1]); o.y = pk2(h[2], h[3]);
      *(uint2*)(Hd + (size_t)row * DM + c) = o;
    }
  }
}

DEV void rope2(float a, float b, float ang, float& o0, float& o1) {
  const float cs = __cosf(ang), sn = __sinf(ang);
  o0 = a * cs - b * sn;
  o1 = a * sn + b * cs;
}
struct EpiIn {
  static constexpr bool PERM = true, AFTER_DRAIN = false;
  bf16_t *ZU, *ZQ, *ZK, *VT, *ZRW;
  DEV void operator()(const f32x4 (&acc)[2][2][4][2], const pg8::Unit& u, int wr, int wc, int fr, int fq) const {
    const int row0 = u.pm * 256 + wr * 64 + fr, cl = wc * 32 + 8 * fq, pn = u.pn;
    if (pn < 4) {
#pragma unroll
      for (int ai = 0; ai < 2; ++ai)
#pragma unroll
        for (int m = 0; m < 4; ++m) {
          const int row = row0 + ai * 128 + m * 16;
          const f32x4 a0 = acc[ai][0][m][0], a1 = acc[ai][0][m][1], b0 = acc[ai][1][m][0], b1 = acc[ai][1][m][1];
          u32x4 o;
          o[0] = pk2(a0[0] * sigmoidf_(b0[0]), a0[1] * sigmoidf_(b0[1]));
          o[1] = pk2(a0[2] * sigmoidf_(b0[2]), a0[3] * sigmoidf_(b0[3]));
          o[2] = pk2(a1[0] * sigmoidf_(b1[0]), a1[1] * sigmoidf_(b1[1]));
          o[3] = pk2(a1[2] * sigmoidf_(b1[2]), a1[3] * sigmoidf_(b1[3]));
          *(u32x4*)(ZU + (size_t)row * 512 + pn * 128 + cl) = o;
        }
    } else if (pn < 8) {
      const bool isq = pn < 6;
      bf16_t* Z = isq ? ZQ : ZK;
      const float qs = isq ? 0.125f * 1.4426950408889634f : 1.f;
      const int cbase = (pn - (isq ? 4 : 6)) * 256 + cl;
#pragma unroll
      for (int ai = 0; ai < 2; ++ai)
#pragma unroll
        for (int m = 0; m < 4; ++m) {
          const int row = row0 + ai * 128 + m * 16;
#pragma unroll
          for (int bj = 0; bj < 2; ++bj) {
            const int c = cbase + bj * 128;
            float v[8];
#pragma unroll
            for (int j = 0; j < 4; ++j) { v[j] = acc[ai][bj][m][0][j]; v[4 + j] = acc[ai][bj][m][1][j]; }
            if (row < T_LAT) {
              const int t = row & 4095, d = c & 63, p0 = d >> 1;
              const float pos = (float)((p0 < 16) ? (t >> 6) : (t & 63));
              const int fi = p0 & 15;
#pragma unroll
              for (int q = 0; q < 4; ++q) {
                const float fr_ = exp2f(-(float)(fi + q) * 0.8304820237218406f);
                float o0, o1;
                rope2(v[2 * q], v[2 * q + 1], pos * fr_, o0, o1);
                v[2 * q] = o0; v[2 * q + 1] = o1;
              }
            }
            u32x4 o;
            o[0] = pk2(v[0] * qs, v[1] * qs); o[1] = pk2(v[2] * qs, v[3] * qs);
            o[2] = pk2(v[4] * qs, v[5] * qs); o[3] = pk2(v[6] * qs, v[7] * qs);
            *(u32x4*)(Z + (size_t)row * 512 + c) = o;
          }
        }
    } else if (pn < 10) {
#pragma unroll
      for (int ai = 0; ai < 2; ++ai)
#pragma unroll
        for (int m = 0; m < 4; ++m) {
          const int row = row0 + ai * 128 + m * 16;
          int b, kidx;
          if (row < T_LAT) { b = row >> 12; kidx = 256 + (row & 4095); } else { b = (row - T_LAT) >> 8; kidx = (row - T_LAT) & 255; }
#pragma unroll
          for (int bj = 0; bj < 2; ++bj) {
            const int head = (pn - 8) * 2 + bj;
            bf16_t* dst = VT + ((size_t)((b * 4 + head) * 128 + cl)) * TK + kidx;
#pragma unroll
            for (int j = 0; j < 4; ++j) {
              dst[(size_t)j * TK] = f2bf(acc[ai][bj][m][0][j]);
              dst[(size_t)(4 + j) * TK] = f2bf(acc[ai][bj][m][1][j]);
            }
          }
        }
    } else {
#pragma unroll
      for (int ai = 0; ai < 2; ++ai)
#pragma unroll
        for (int m = 0; m < 4; ++m) {
          const int row = row0 + ai * 128 + m * 16;
#pragma unroll
          for (int bj = 0; bj < 2; ++bj) {
            const int c = (pn - 10) * 256 + bj * 128 + cl;
            if (c < 1920) {
              u32x4 o;
              o[0] = pk2(acc[ai][bj][m][0][0], acc[ai][bj][m][0][1]); o[1] = pk2(acc[ai][bj][m][0][2], acc[ai][bj][m][0][3]);
              o[2] = pk2(acc[ai][bj][m][1][0], acc[ai][bj][m][1][1]); o[3] = pk2(acc[ai][bj][m][1][2], acc[ai][bj][m][1][3]);
              *(u32x4*)(ZRW + (size_t)row * 1920 + c) = o;
            }
          }
        }
    }
  }
};
DEV void gemm_in_phase(const Params& p, char* smem) {
  EpiIn E;
  E.ZU = (bf16_t*)(p.ws + O_ZU); E.ZQ = (bf16_t*)(p.ws + O_ZQ); E.ZK = (bf16_t*)(p.ws + O_ZK);
  E.VT = (bf16_t*)(p.ws + O_VT); E.ZRW = (bf16_t*)(p.ws + O_ZRW);
  pg8::Gemm g;
  g.A = (const bf16_t*)(p.ws + O_H0); g.Bt = (const bf16_t*)(p.ws + O_WB + W_WIN); g.M = T_ALL; g.N = NZP; g.K = 1024;
  pg8::StaticOrder S;
  S.init(g.M, g.N, (int)gridDim.x, (int)blockIdx.x);
  __syncthreads();
  pg8::gemm_phase<EpiIn, pg8::StaticOrder>((PG8_LAS unsigned char*)smem, g, S, E);
  __syncthreads();
}

constexpr int KROW = 272, VROW = 144, ATT_ST = 64 * KROW + 128 * VROW;
constexpr int ATT2_ST = 2 * 128 * KROW;
DEV int key_of_slot(int x) { return (x & 0x13) | ((x & 8) >> 1) | ((x & 4) << 1); }

DEV void attn_tile(const Params& p, int l, int tile, char* smem, bool do_store = true) {
  bf16_t* ZQ = (bf16_t*)(p.ws + O_ZQ);
  const bf16_t* ZK = (const bf16_t*)(p.ws + O_ZK);
  const bf16_t* VT = (const bf16_t*)(p.ws + O_VT);
  int b, head, q0, nkeys, qbase;
  if (tile < 1024) { b = tile >> 7; head = (tile >> 5) & 3; q0 = (tile & 31) * 128; nkeys = TK; qbase = b * SEQ; }
  else { const int tt = tile - 1024; b = tt >> 3; head = (tt >> 1) & 3; q0 = (tt & 1) * 128; nkeys = CTXL; qbase = T_LAT + b * CTXL; }
  const int tid = ltid(), lane = tid & 63, w = tid >> 6, ql = lane & 31, hh = lane >> 5, map = w >> 2, qg = w & 3;
  const int qrow = qbase + q0 + qg * 32 + ql;
  const float lam_init = l == 0 ? 0.2f : 0.35550907f;
  float lam;
  {
    const float a1 = p.att_lq1[l * 64 + lane] * p.att_lk1[l * 64 + lane];
    const float a2 = p.att_lq2[l * 64 + lane] * p.att_lk2[l * 64 + lane];
    lam = __expf(wsum(a1)) - __expf(wsum(a2)) + lam_init;
  }
  bf16x8 qf[4];
#pragma unroll
  for (int s = 0; s < 4; ++s) qf[s] = *(const bf16x8*)(ZQ + (size_t)qrow * 512 + head * 128 + map * 64 + s * 16 + hh * 8);
  f32x16 o[4];
#pragma unroll
  for (int dt = 0; dt < 4; ++dt)
#pragma unroll
    for (int e = 0; e < 16; ++e) o[dt][e] = 0.f;
  float m = -1e30f, lsum = 0.f;
  const int kr0 = tid >> 4, kch = tid & 15;
  const int vr0 = tid >> 4, vch = tid & 15;
  const bf16_t* vtb = VT + ((size_t)((b * 4 + head) * 128)) * TK;
  u32x4 kreg[4], vreg[4];
  auto gload = [&](int kt) {
    const int k0 = kt * 128;
#pragma unroll
    for (int i = 0; i < 4; ++i) {
      const int kidx = k0 + kr0 + 32 * i;
      const int krow = kidx < CTXL ? T_LAT + b * CTXL + kidx : b * SEQ + kidx - CTXL;
      kreg[i] = *(const u32x4*)(ZK + (size_t)krow * 512 + head * 128 + kch * 8);
      vreg[i] = *(const u32x4*)(vtb + (size_t)(vr0 + 32 * i) * TK + k0 + vch * 8);
    }
  };
  auto lstore = [&](int st) {
    char* Ks = smem + st * ATT2_ST;
    char* Vs = Ks + 128 * KROW;
#pragma unroll
    for (int i = 0; i < 4; ++i) {
      *(u32x4*)(Ks + (kr0 + 32 * i) * KROW + kch * 16) = kreg[i];
      *(u32x4*)(Vs + (vr0 + 32 * i) * KROW + vch * 16) = vreg[i];
    }
  };
  const int nkt = nkeys >> 7;
  gload(0);
  __syncthreads();
  lstore(0);
  __syncthreads();
  const int kos = key_of_slot(ql);
  for (int kt = 0; kt < nkt; ++kt) {
    const int cur = kt & 1;
    if (kt + 1 < nkt) gload(kt + 1);
    const char* Ks = smem + cur * ATT2_ST;
    const char* Vs = Ks + 128 * KROW;
#pragma unroll
    for (int h2 = 0; h2 < 2; ++h2) {
    const char* kp = Ks + (h2 * 64 + kos) * KROW + (map * 64 + hh * 8) * 2;
    const char* vp = Vs + ql * KROW + hh * 16 + h2 * 128;
    bf16x8 kf0[4], kf1[4];
#pragma unroll
    for (int ks = 0; ks < 4; ++ks) { kf0[ks] = *(const bf16x8*)(kp + ks * 32); kf1[ks] = *(const bf16x8*)(kp + 32 * KROW + ks * 32); }
    f32x16 s0, s1;
#pragma unroll
    for (int e = 0; e < 16; ++e) { s0[e] = 0.f; s1[e] = 0.f; }
#pragma unroll
    for (int ks = 0; ks < 4; ++ks) s0 = __builtin_amdgcn_mfma_f32_32x32x16_bf16(kf0[ks], qf[ks], s0, 0, 0, 0);
#pragma unroll
    for (int ks = 0; ks < 4; ++ks) s1 = __builtin_amdgcn_mfma_f32_32x32x16_bf16(kf1[ks], qf[ks], s1, 0, 0, 0);
    bf16x8 vf[8];
#pragma unroll
    for (int dt = 0; dt < 4; ++dt)
#pragma unroll
      for (int k2 = 0; k2 < 2; ++k2) vf[dt * 2 + k2] = *(const bf16x8*)(vp + dt * 32 * KROW + (k2 * 16) * 2);
    float mx = fmaxf(s0[0], s1[0]);
#pragma unroll
    for (int e = 1; e < 16; ++e) mx = fmaxf(mx, fmaxf(s0[e], s1[e]));
    mx = xor32_max(mx);
    const float mnew = (mx > m + 8.f) ? mx : m;
    if (__any(mnew > m)) {
      const float alpha = __builtin_amdgcn_exp2f(m - mnew);
      lsum *= alpha;
#pragma unroll
      for (int dt = 0; dt < 4; ++dt)
#pragma unroll
        for (int e = 0; e < 16; ++e) o[dt][e] *= alpha;
    }
    m = mnew;
    bf16x8 pb0[2], pb1[2];
    {
      float pe[16];
#pragma unroll
      for (int e = 0; e < 16; ++e) { pe[e] = __builtin_amdgcn_exp2f(s0[e] - m); lsum += pe[e]; }
#pragma unroll
      for (int k2 = 0; k2 < 2; ++k2) {
        u32x4 u;
        u[0] = pk2(pe[8 * k2 + 0], pe[8 * k2 + 1]); u[1] = pk2(pe[8 * k2 + 2], pe[8 * k2 + 3]);
        u[2] = pk2(pe[8 * k2 + 4], pe[8 * k2 + 5]); u[3] = pk2(pe[8 * k2 + 6], pe[8 * k2 + 7]);
        pb0[k2] = __builtin_bit_cast(bf16x8, u);
      }
    }
#pragma unroll
    for (int dt = 0; dt < 4; ++dt)
#pragma unroll
      for (int k2 = 0; k2 < 2; ++k2) o[dt] = __builtin_amdgcn_mfma_f32_32x32x16_bf16(vf[dt * 2 + k2], pb0[k2], o[dt], 0, 0, 0);
#pragma unroll
    for (int dt = 0; dt < 4; ++dt)
#pragma unroll
      for (int k2 = 0; k2 < 2; ++k2) vf[dt * 2 + k2] = *(const bf16x8*)(vp + dt * 32 * KROW + (32 + k2 * 16) * 2);
    {
      float pe[16];
#pragma unroll
      for (int e = 0; e < 16; ++e) { pe[e] = __builtin_amdgcn_exp2f(s1[e] - m); lsum += pe[e]; }
#pragma unroll
      for (int k2 = 0; k2 < 2; ++k2) {
        u32x4 u;
        u[0] = pk2(pe[8 * k2 + 0], pe[8 * k2 + 1]); u[1] = pk2(pe[8 * k2 + 2], pe[8 * k2 + 3]);
        u[2] = pk2(pe[8 * k2 + 4], pe[8 * k2 + 5]); u[3] = pk2(pe[8 * k2 + 6], pe[8 * k2 + 7]);
        pb1[k2] = __builtin_bit_cast(bf16x8, u);
      }
    }
#pragma unroll
    for (int dt = 0; dt < 4; ++dt)
#pragma unroll
      for (int k2 = 0; k2 < 2; ++k2) o[dt] = __builtin_amdgcn_mfma_f32_32x32x16_bf16(vf[dt * 2 + k2], pb1[k2], o[dt], 0, 0, 0);
    }
    if (kt + 1 < nkt) lstore(cur ^ 1);
    __syncthreads();
  }
  const float ltot = xor32_sum(lsum);
  float* ex = (float*)smem;
  if (map == 1) {
    const float c2 = lam / ltot;
#pragma unroll
    for (int dt = 0; dt < 4; ++dt)
#pragma unroll
      for (int e = 0; e < 16; ++e) {
        const int dv = dt * 32 + 8 * (e >> 2) + 4 * hh + (e & 3);
        ex[(qg * 128 + dv) * 32 + ql] = o[dt][e] * c2;
      }
  }
  __syncthreads();
  if (map == 0 && do_store) {
    const float c1 = 1.f / ltot;
    float ss = 0.f;
#pragma unroll
    for (int dt = 0; dt < 4; ++dt)
#pragma unroll
      for (int e = 0; e < 16; ++e) {
        const int dv = dt * 32 + 8 * (e >> 2) + 4 * hh + (e & 3);
        const float v = o[dt][e] * c1 - ex[(qg * 128 + dv) * 32 + ql];
        o[dt][e] = v;
        ss += v * v;
      }
    ss = xor32_sum(ss);
    const float rs = rsqrtf(ss * (1.f / 128.f) + 1e-5f) * (1.f - lam_init);
    const float* sg = p.att_subln_g + l * 128;
#pragma unroll
    for (int dt = 0; dt < 4; ++dt)
#pragma unroll
      for (int i = 0; i < 4; ++i) {
        const int dv = dt * 32 + 8 * i + 4 * hh;
        const float4 g4 = *(const float4*)(sg + dv);
        uint2 u;
        u.x = pk2(o[dt][4 * i + 0] * rs * g4.x, o[dt][4 * i + 1] * rs * g4.y);
        u.y = pk2(o[dt][4 * i + 2] * rs * g4.z, o[dt][4 * i + 3] * rs * g4.w);
        *(uint2*)(ZQ + (size_t)qrow * 512 + head * 128 + dv) = u;
      }
  }
  __syncthreads();
}

DEV void conv_tile(const Params& p, int l, int tile, char* smem) {
  const bf16_t* ZU = (const bf16_t*)(p.ws + O_ZU);
  bf16_t* YCV = (bf16_t*)(p.ws + O_YCV);
  const int r0 = tile * 64;
  int s_lo, s_hi;
  if (r0 < T_LAT) { s_lo = r0 & ~4095; s_hi = s_lo + SEQ; } else { s_lo = T_LAT + ((r0 - T_LAT) & ~255); s_hi = s_lo + CTXL; }
  const int tid = ltid(), lane = tid & 63, w = tid >> 6, c0 = lane * 8;
  const int t0 = r0 + w * 8;
  const float* wp = p.conv_dw_w + (size_t)l * 31 * 512 + c0;
  float acc[8][8];
  {
    const f32x4 b0 = *(const f32x4*)(p.conv_dw_b + l * 512 + c0), b1 = *(const f32x4*)(p.conv_dw_b + l * 512 + c0 + 4);
#pragma unroll
    for (int t = 0; t < 8; ++t)
#pragma unroll
      for (int j = 0; j < 4; ++j) { acc[t][j] = b0[j]; acc[t][4 + j] = b1[j]; }
  }
  f32x4 wk[8][2];
#pragma unroll
  for (int q = 0; q < 8; ++q) { wk[q][0] = (f32x4){0.f, 0.f, 0.f, 0.f}; wk[q][1] = (f32x4){0.f, 0.f, 0.f, 0.f}; }
#pragma unroll 4
  for (int s = 0; s < 40; ++s) {
    const int rr = t0 - 15 + s;
    u32x4 uv = {0u, 0u, 0u, 0u};
    if (rr >= s_lo && rr < s_hi) uv = *(const u32x4*)(ZU + (size_t)rr * 512 + c0);
    float u[8];
#pragma unroll
    for (int q = 0; q < 4; ++q) { u[2 * q] = lo_bf(uv[q]); u[2 * q + 1] = hi_bf(uv[q]); }
#pragma unroll
    for (int q = 7; q > 0; --q) { wk[q][0] = wk[q - 1][0]; wk[q][1] = wk[q - 1][1]; }
    wk[0][0] = (f32x4){0.f, 0.f, 0.f, 0.f}; wk[0][1] = (f32x4){0.f, 0.f, 0.f, 0.f};
    if (s <= 30) { wk[0][0] = *(const f32x4*)(wp + s * 512); wk[0][1] = *(const f32x4*)(wp + s * 512 + 4); }
#pragma unroll
    for (int t = 0; t < 8; ++t) {
#pragma unroll
      for (int j = 0; j < 4; ++j) { acc[t][j] += wk[t][0][j] * u[j]; acc[t][4 + j] += wk[t][1][j] * u[4 + j]; }
    }
  }
  const f32x4 g0 = *(const f32x4*)(p.conv_ln_g + l * 512 + c0), g1 = *(const f32x4*)(p.conv_ln_g + l * 512 + c0 + 4);
  const f32x4 e0 = *(const f32x4*)(p.conv_ln_b + l * 512 + c0), e1 = *(const f32x4*)(p.conv_ln_b + l * 512 + c0 + 4);
#pragma unroll
  for (int t = 0; t < 8; ++t) {
    float s1 = 0.f;
#pragma unroll
    for (int j = 0; j < 8; ++j) s1 += acc[t][j];
    const float mu = wsum(s1) * (1.f / 512.f);
    float s2 = 0.f;
#pragma unroll
    for (int j = 0; j < 8; ++j) { acc[t][j] -= mu; s2 += acc[t][j] * acc[t][j]; }
    const float rs = rsqrtf(wsum(s2) * (1.f / 512.f) + 1e-5f);
    float y[8];
#pragma unroll
    for (int j = 0; j < 4; ++j) {
      const float z0 = acc[t][j] * rs * g0[j] + e0[j], z1 = acc[t][4 + j] * rs * g1[j] + e1[j];
      y[j] = z0 * sigmoidf_(z0); y[4 + j] = z1 * sigmoidf_(z1);
    }
    u32x4 o;
    o[0] = pk2(y[0], y[1]); o[1] = pk2(y[2], y[3]); o[2] = pk2(y[4], y[5]); o[3] = pk2(y[6], y[7]);
    *(u32x4*)(YCV + (size_t)(t0 + t) * 512 + c0) = o;
  }
}

DEV void shift_tile(const Params& p, int l, int tile) {
  const bf16_t* ZRW = (const bf16_t*)(p.ws + O_ZRW);
  bf16_t* ZRS = (bf16_t*)(p.ws + O_ZRS);
  const int r0 = tile * 32;
  int s_lo, s_hi;
  if (r0 < T_LAT) { s_lo = r0 & ~4095; s_hi = s_lo + SEQ; } else { s_lo = T_LAT + ((r0 - T_LAT) & ~255); s_hi = s_lo + CTXL; }
  const int tid = ltid();
  if (tid >= 480) return;
  const int half = tid >= 240 ? 1 : 0, ch = tid - half * 240, col = ch * 8;
  const int rb = r0 + half * 16;
  u32x4 rows[18];
#pragma unroll
  for (int i = 0; i < 18; ++i) {
    const int rr = rb - 1 + i;
    rows[i] = (u32x4){0u, 0u, 0u, 0u};
    if (rr >= s_lo && rr < s_hi) rows[i] = *(const u32x4*)(ZRW + (size_t)rr * 1920 + col);
  }
  const float* sw = p.rwkv_shift + (size_t)l * 3 * 1920 + col;
  float w0[8], w1[8], w2[8];
#pragma unroll
  for (int j = 0; j < 8; ++j) { w0[j] = sw[j]; w1[j] = sw[1920 + j]; w2[j] = sw[3840 + j]; }
  const int act = (col >= 1536 && col < 1664) ? 1 : (col >= 1792 ? 2 : 0);
#pragma unroll
  for (int i = 0; i < 16; ++i) {
    const int row = rb + i;
    const u32x4 pv = rows[i], cu = rows[i + 1], nx = rows[i + 2];
    float y[8];
#pragma unroll
    for (int q = 0; q < 4; ++q) {
      y[2 * q] = w0[2 * q] * lo_bf(pv[q]) + w1[2 * q] * lo_bf(cu[q]) + w2[2 * q] * lo_bf(nx[q]);
      y[2 * q + 1] = w0[2 * q + 1] * hi_bf(pv[q]) + w1[2 * q + 1] * hi_bf(cu[q]) + w2[2 * q + 1] * hi_bf(nx[q]);
    }
    if (act == 1) {
#pragma unroll
      for (int j = 0; j < 8; ++j) y[j] = 1.f - 2.f / (1.f + __expf(2.f * y[j]));
    } else if (act == 2) {
#pragma unroll
      for (int j = 0; j < 8; ++j) y[j] = sigmoidf_(y[j]);
    }
    u32x4 o;
    o[0] = pk2(y[0], y[1]); o[1] = pk2(y[2], y[3]); o[2] = pk2(y[4], y[5]); o[3] = pk2(y[6], y[7]);
    if (col < 1536) *(u32x4*)(ZRS + (size_t)row * 1536 + col) = o;
    else if (col < 1792) *(u32x4*)((bf16_t*)(p.ws + O_LIN) + (size_t)row * 256 + (col - 1536)) = o;
    else *(u32x4*)((bf16_t*)(p.ws + O_GIN) + (size_t)row * 128 + (col - 1792)) = o;
  }
}

DEV void branch_phase(const Params& p, int l, char* smem) {
  const bool last = (l == 1);
  for (int L = vblock(); L < 1088 + 544 + 1088; L += gridDim.x) {
    if (L < 1088) { if (!(last && L >= 1024)) attn_tile(p, l, L, smem); }
    else if (L < 1632) { if (!(last && L - 1088 >= 512)) conv_tile(p, l, L - 1088, smem); }
    else shift_tile(p, l, L - 1632);
  }
}

DEV void lora_phase(const Params& p, int l, char* smem, bool gjob) {
  const bf16_t* LIN = (const bf16_t*)(p.ws + O_LIN);
  const int lane = ltid() & 63, w = ltid() >> 6, wm = w >> 1, wn = w & 1, fr = lane & 15, fq = lane >> 4;
  const int ntile = gjob ? 544 : 4 * 544;
  for (int L = vblock(); L < ntile; L += gridDim.x) {
    const int job = gjob ? 4 : L / 544, t = L - (gjob ? 0 : job * 544), pm = t >> 2, pn = t & 3;
    const int row0 = pm * 256, col0 = pn * 128;
    const bf16_t* A;
    const bf16_t* Bt;
    bf16_t* O;
    int K = 64, lda = 256;
    const float* bias = nullptr;
    if (job == 0) { A = LIN; Bt = (const bf16_t*)(p.ws + O_WB + W_LW2); O = (bf16_t*)(p.ws + O_EF); bias = p.rwkv_w0 + (l * 2 + 0) * 512; }
    else if (job == 1) { A = LIN + 64; Bt = (const bf16_t*)(p.ws + O_WB + W_LW2) + 512 * 64; O = (bf16_t*)(p.ws + O_EB); bias = p.rwkv_w0 + (l * 2 + 1) * 512; }
    else if (job == 2) { A = LIN + 128; Bt = (const bf16_t*)(p.ws + O_WB + W_LA2); O = (bf16_t*)(p.ws + O_AF); bias = p.rwkv_a0 + (l * 2 + 0) * 512; }
    else if (job == 3) { A = LIN + 192; Bt = (const bf16_t*)(p.ws + O_WB + W_LA2) + 512 * 64; O = (bf16_t*)(p.ws + O_AB); bias = p.rwkv_a0 + (l * 2 + 1) * 512; }
    else { A = (const bf16_t*)(p.ws + O_GIN); Bt = (const bf16_t*)(p.ws + O_WB + W_LG2); O = (bf16_t*)(p.ws + O_G); K = 128; lda = 128; }
    f32x4 acc[4][4];
    zero_acc(acc);
    gemm_kloop(acc, A + (size_t)row0 * lda, lda, Bt + (size_t)col0 * K, K, K, smem);
#pragma unroll
    for (int mi = 0; mi < 4; ++mi) {
      const int row = row0 + wm * 64 + mi * 16 + fr;
#pragma unroll
      for (int ni = 0; ni < 4; ++ni) {
        const int c = col0 + wn * 64 + ni * 16 + fq * 4;
        float v[4];
#pragma unroll
        for (int j = 0; j < 4; ++j) {
          float z = acc[mi][ni][j];
          if (job < 4) z = sigmoidf_(z + bias[c + j]);
          if (job < 2) z *= 0.6065306597126334f;
          v[j] = z;
        }
        uint2 o;
        o.x = pk2(v[0], v[1]); o.y = pk2(v[2], v[3]);
        *(uint2*)(O + (size_t)row * 512 + c) = o;
      }
    }
  }
}

DEV void lora64_phase(const Params& p, int l, char* smem) {
  const bf16_t* LIN = (const bf16_t*)(p.ws + O_LIN);
  const int tid = ltid(), lane = tid & 63, w = tid >> 6, wm = w >> 1, wn = w & 1, fr = lane & 15, fq = lane >> 4;
  const int lrow = tid >> 3, lch = tid & 7;
  u32x4 ra[4], rb[2];
  auto issue = [&](int L) {
    const int job = L / 544, t = L - job * 544, pm = t >> 2, pn = t & 3;
    const bf16_t* A = LIN + job * 64 + (size_t)(pm * 256 + lrow) * 256 + lch * 8;
    const bf16_t* Bt = (const bf16_t*)(p.ws + O_WB + ((job & 2) ? W_LA2 : W_LW2)) + (job & 1) * 512 * 64 + (size_t)(pn * 128 + lrow) * 64 + lch * 8;
#pragma unroll
    for (int i = 0; i < 4; ++i) ra[i] = *(const u32x4*)(A + (size_t)(64 * i) * 256);
#pragma unroll
    for (int i = 0; i < 2; ++i) rb[i] = *(const u32x4*)(Bt + (size_t)(64 * i) * 64);
  };
  char* swa = smem + lrow * SROW + lch * 16;
  char* swb = swa + A_ST;
  const char* sra = smem + (wm * 64 + fr) * SROW + fq * 16;
  const char* srb = smem + A_ST + (wn * 64 + fr) * SROW + fq * 16;
  int L = vblock();
  if (L < 4 * 544) issue(L);
  for (; L < 4 * 544; L += gridDim.x) {
    const int job = L / 544, t = L - job * 544, pm = t >> 2, pn = t & 3;
    const int row0 = pm * 256, col0 = pn * 128;
    __syncthreads();
#pragma unroll
    for (int i = 0; i < 4; ++i) *(u32x4*)(swa + i * 64 * SROW) = ra[i];
#pragma unroll
    for (int i = 0; i < 2; ++i) *(u32x4*)(swb + i * 64 * SROW) = rb[i];
    __syncthreads();
    if (L + (int)gridDim.x < 4 * 544) issue(L + gridDim.x);
    f32x4 acc[4][4];
    zero_acc(acc);
#pragma unroll
    for (int ks = 0; ks < 2; ++ks) {
      bf16x8 af[4], bfr[4];
#pragma unroll
      for (int mi = 0; mi < 4; ++mi) af[mi] = *(const bf16x8*)(sra + mi * 16 * SROW + ks * 64);
#pragma unroll
      for (int ni = 0; ni < 4; ++ni) bfr[ni] = *(const bf16x8*)(srb + ni * 16 * SROW + ks * 64);
#pragma unroll
      for (int mi = 0; mi < 4; ++mi)
#pragma unroll
        for (int ni = 0; ni < 4; ++ni) acc[mi][ni] = __builtin_amdgcn_mfma_f32_16x16x32_bf16(bfr[ni], af[mi], acc[mi][ni], 0, 0, 0);
    }
    bf16_t* O = (bf16_t*)(p.ws + (job == 0 ? O_EF : (job == 1 ? O_EB : (job == 2 ? O_AF : O_AB))));
    const float* bias = ((job & 2) ? p.rwkv_a0 : p.rwkv_w0) + (l * 2 + (job & 1)) * 512;
    const float sc = job < 2 ? 0.6065306597126334f : 1.f;
#pragma unroll
    for (int mi = 0; mi < 4; ++mi) {
      const int row = row0 + wm * 64 + mi * 16 + fr;
#pragma unroll
      for (int ni = 0; ni < 4; ++ni) {
        const int c = col0 + wn * 64 + ni * 16 + fq * 4;
        const f32x4 z = acc[mi][ni] + *(const f32x4*)(bias + c);
        uint2 o;
        o.x = pk2(sc * sigmoidf_(z[0]), sc * sigmoidf_(z[1])); o.y = pk2(sc * sigmoidf_(z[2]), sc * sigmoidf_(z[3]));
        *(uint2*)(O + (size_t)row * 512 + c) = o;
      }
    }
  }
  __syncthreads();
}

DEV int scan_row(int step, int dir, int b) {
  if (step < CTXL) { const int t = dir ? (CTXL - 1 - step) : step; return T_LAT + b * CTXL + t; }
  const int s2 = step - CTXL;
  const int t = dir ? (SEQ - 1 - s2) : s2;
  return b * SEQ + t;
}
DEV float red8(float v) {
  v += dppf<0xB1>(v);
  v += dppf<0x4E>(v);
  v += dppf<0x141>(v);
  return v;
}
struct ScanOps { f32x4 nkk0, nkk1, w0, w1, kka0, kka1, kd0, kd1, r0, r1; float v; };
DEV void scan_tile(const Params& p, int l, int tile, char* smem) {
  const int half = tile & 1, dir = (tile >> 1) & 1, h = (tile >> 2) & 7, b = tile >> 5;
  float* arr = (float*)smem;
  float* ybuf = arr + 2 * 32 * 384;
  const bf16_t* ZRS = (const bf16_t*)(p.ws + O_ZRS);
  const bf16_t* E = (const bf16_t*)(p.ws + (dir ? O_EB : O_EF));
  const bf16_t* Aa = (const bf16_t*)(p.ws + (dir ? O_AB : O_AF));
  bf16_t* YS = (bf16_t*)(p.ws + (dir ? O_YSB : O_YSF));
  const int tid = ltid(), lane = tid & 63;
  const int w = __builtin_amdgcn_readfirstlane(tid >> 6);
  const int col = h * 64 + lane;
  const float kkp = p.rwkv_kk[l * 512 + col], kap = p.rwkv_ka[l * 512 + col];
  auto produce = [&](int ch, int buf, int pw, int npw) {
#pragma unroll
    for (int i0 = 0; i0 < 32; i0 += 4 * npw) {
      bf16_t rr[4], rk[4], rv[4], re[4], ra[4];
#pragma unroll
      for (int i = 0; i < 4; ++i) {
        const int R = scan_row(ch * 32 + i0 + pw + npw * i, dir, b);
        rr[i] = ZRS[(size_t)R * 1536 + col];
        rk[i] = ZRS[(size_t)R * 1536 + 512 + col];
        rv[i] = ZRS[(size_t)R * 1536 + 1024 + col];
        re[i] = E[(size_t)R * 512 + col];
        ra[i] = Aa[(size_t)R * 512 + col];
      }
#pragma unroll
      for (int i = 0; i < 4; ++i) {
        const int sl = i0 + pw + npw * i;
        const float r = bf2f(rr[i]), k = bf2f(rk[i]), v = bf2f(rv[i]), e = bf2f(re[i]), a = bf2f(ra[i]);
        const float kkv = k * kkp;
        const float inv = rsqrtf(fmaxf(wsum(kkv * kkv), 1e-24f));
        const float kk = kkv * inv;
        float* d = arr + (buf * 32 + sl) * 384 + lane;
        d[0] = -kk;
        d[64] = __expf(-e);
        d[128] = kk * a;
        d[192] = k * (1.f + (a - 1.f) * kap);
        d[256] = r;
        d[320] = v;
      }
    }
  };
  auto flush = [&](int ch, int buf, int t256) {
#pragma unroll
    for (int q = 0; q < 2; ++q) {
      const int idx = t256 + 256 * q, sl = idx >> 4, rp = (idx & 15) * 2;
      const int R = scan_row(ch * 32 + sl, dir, b);
      const float* yb = ybuf + buf * 1024 + sl * 32 + rp;
      *(unsigned*)(YS + (size_t)R * 512 + h * 64 + half * 32 + rp) = pk2(yb[0], yb[1]);
    }
  };
  __syncthreads();
  produce(0, 0, w, 8);
  __syncthreads();
  f32x4 S0 = {0.f, 0.f, 0.f, 0.f}, S1 = {0.f, 0.f, 0.f, 0.f};
  const int r8 = lane >> 3, cg = lane & 7;
  for (int ch = 0; ch < 136; ++ch) {
    const int buf = ch & 1;
    if (w < 4) {
      const float* cb = arr + buf * 32 * 384;
      const int vo = 320 + half * 32 + w * 8 + r8;
      float* yw = ybuf + buf * 1024 + cg * 32 + w * 8 + r8;
      auto ldops = [&](ScanOps& o, int sl) {
        const f32x4* b4 = (const f32x4*)(cb + sl * 384);
        o.nkk0 = b4[cg * 2]; o.nkk1 = b4[cg * 2 + 1];
        o.w0 = b4[16 + cg * 2]; o.w1 = b4[16 + cg * 2 + 1];
        o.kka0 = b4[32 + cg * 2]; o.kka1 = b4[32 + cg * 2 + 1];
        o.kd0 = b4[48 + cg * 2]; o.kd1 = b4[48 + cg * 2 + 1];
        o.r0 = b4[64 + cg * 2]; o.r1 = b4[64 + cg * 2 + 1];
        o.v = cb[sl * 384 + vo];
      };
      float ykeep = 0.f;
      auto step = [&](const ScanOps& o, int sl) {
        const f32x4 sA = S0 * o.nkk0 + S1 * o.nkk1;
        const float sa = red8((sA[0] + sA[1]) + (sA[2] + sA[3]));
        S0 = S0 * o.w0 + (o.kka0 * sa + o.kd0 * o.v);
        S1 = S1 * o.w1 + (o.kka1 * sa + o.kd1 * o.v);
        const f32x4 yA = S0 * o.r0 + S1 * o.r1;
        const float y = red8((yA[0] + yA[1]) + (yA[2] + yA[3]));
        ykeep = (cg == (sl & 7)) ? y : ykeep;
      };
      ScanOps oa, ob;
      ldops(oa, 0);
#pragma unroll
      for (int s8 = 0; s8 < 32; s8 += 8) {
#pragma unroll
        for (int q = 0; q < 8; q += 2) {
          ldops(ob, s8 + q + 1);
          step(oa, s8 + q);
          ldops(oa, (s8 + q + 2) & 31);
          step(ob, s8 + q + 1);
        }
        yw[s8 * 32] = ykeep;
      }
    } else {
      const int pw = w - 4;
      if (ch > 0) flush(ch - 1, buf ^ 1, tid - 256);
      if (ch + 1 < 136) produce(ch + 1, buf ^ 1, pw, 4);
    }
    __syncthreads();
  }
  if (w >= 4) flush(135, 1, tid - 256);
  __syncthreads();
}
DEV void scan_phase(const Params& p, int l, char* smem) {
  for (int L = blockIdx.x; L < 256; L += gridDim.x) scan_tile(p, l, L, smem);
}

DEV void unpack8(const u32x4 u, float (&f)[8]) {
#pragma unroll
  for (int q = 0; q < 4; ++q) { f[2 * q] = lo_bf(u[q]); f[2 * q + 1] = hi_bf(u[q]); }
}
DEV void post_phase(const Params& p, int l, int nrows) {
  const bf16_t* ZRS = (const bf16_t*)(p.ws + O_ZRS);
  const bf16_t* AF = (const bf16_t*)(p.ws + O_AF);
  const bf16_t* AB = (const bf16_t*)(p.ws + O_AB);
  const bf16_t* G = (const bf16_t*)(p.ws + O_G);
  bf16_t* YSF = (bf16_t*)(p.ws + O_YSF);
  const bf16_t* YSB = (const bf16_t*)(p.ws + O_YSB);
  const int lane = ltid() & 63, w = ltid() >> 6, c0 = lane * 8;
  float gng[8], gnb[8], kaw[8], rkw[8];
#pragma unroll
  for (int j = 0; j < 8; ++j) {
    gng[j] = p.rwkv_gn_g[l * 512 + c0 + j]; gnb[j] = p.rwkv_gn_b[l * 512 + c0 + j];
    kaw[j] = p.rwkv_ka[l * 512 + c0 + j]; rkw[j] = p.rwkv_rk[l * 512 + c0 + j];
  }
  const int stride = gridDim.x * 8;
  int row = blockIdx.x * 8 + w;
  u32x4 q_ysf, q_ysb, q_r, q_k, q_v, q_af, q_ab, q_g;
  auto gl = [&](int rw) {
    q_ysf = *(const u32x4*)(YSF + (size_t)rw * 512 + c0); q_ysb = *(const u32x4*)(YSB + (size_t)rw * 512 + c0);
    q_r = *(const u32x4*)(ZRS + (size_t)rw * 1536 + c0); q_k = *(const u32x4*)(ZRS + (size_t)rw * 1536 + 512 + c0);
    q_v = *(const u32x4*)(ZRS + (size_t)rw * 1536 + 1024 + c0);
    q_af = *(const u32x4*)(AF + (size_t)rw * 512 + c0); q_ab = *(const u32x4*)(AB + (size_t)rw * 512 + c0);
    q_g = *(const u32x4*)(G + (size_t)rw * 512 + c0);
  };
  if (row < nrows) gl(row);
  for (; row < nrows; row += stride) {
    float ysf[8], ysb[8], r[8], k[8], v[8], af[8], ab[8], g[8];
    unpack8(q_ysf, ysf); unpack8(q_ysb, ysb); unpack8(q_r, r); unpack8(q_k, k); unpack8(q_v, v);
    unpack8(q_af, af); unpack8(q_ab, ab); unpack8(q_g, g);
    if (row + stride < nrows) gl(row + stride);
    float ys[8], s1 = 0.f, bp = 0.f;
#pragma unroll
    for (int j = 0; j < 8; ++j) {
      ys[j] = ysf[j] + ysb[j]; s1 += ys[j];
      bp += r[j] * k[j] * rkw[j] * (2.f + (af[j] + ab[j] - 2.f) * kaw[j]);
    }
    const float mu = red8(s1) * (1.f / 64.f);
    const float bon = red8(bp);
    float s2 = 0.f;
#pragma unroll
    for (int j = 0; j < 8; ++j) { ys[j] -= mu; s2 += ys[j] * ys[j]; }
    const float rs = rsqrtf(red8(s2) * (1.f / 64.f) + 64e-5f);
    float o[8];
#pragma unroll
    for (int j = 0; j < 8; ++j) o[j] = (ys[j] * rs * gng[j] + gnb[j] + bon * v[j]) * g[j];
    u32x4 ov;
    ov[0] = pk2(o[0], o[1]); ov[1] = pk2(o[2], o[3]); ov[2] = pk2(o[4], o[5]); ov[3] = pk2(o[6], o[7]);
    *(u32x4*)(YSF + (size_t)row * 512 + c0) = ov;
  }
}

struct EpiGate {
  static constexpr bool PERM = true, AFTER_DRAIN = false;
  char* ws;
  DEV void operator()(const f32x4 (&acc)[2][2][4][2], const pg8::Unit& u, int wr, int wc, int fr, int fq) const {
    const int b = u.pn >> 2, pn = u.pn & 3;
    bf16_t* G = (bf16_t*)(ws + (b == 0 ? O_G1 : (b == 1 ? O_G2 : O_G3)));
    const int row0 = u.pm * 256 + wr * 64 + fr, col0 = pn * 256 + wc * 32 + 8 * fq;
#pragma unroll
    for (int ai = 0; ai < 2; ++ai)
#pragma unroll
      for (int m = 0; m < 4; ++m) {
        const int row = row0 + ai * 128 + m * 16;
#pragma unroll
        for (int bj = 0; bj < 2; ++bj) {
          const f32x4 a0 = acc[ai][bj][m][0], a1 = acc[ai][bj][m][1];
          u32x4 o;
          o[0] = pk2(sigmoidf_(a0[0]), sigmoidf_(a0[1])); o[1] = pk2(sigmoidf_(a0[2]), sigmoidf_(a0[3]));
          o[2] = pk2(sigmoidf_(a1[0]), sigmoidf_(a1[1])); o[3] = pk2(sigmoidf_(a1[2]), sigmoidf_(a1[3]));
          *(u32x4*)(G + (size_t)row * DM + col0 + bj * 128) = o;
        }
      }
  }
};
DEV void gate_phase(const Params& p, int nrows, char* smem) {
  EpiGate E;
  E.ws = p.ws;
  pg8::Gemm g;
  g.A = (const bf16_t*)(p.ws + O_HM); g.Bt = (const bf16_t*)(p.ws + O_WB + W_WIN) + (size_t)NZP * 1024; g.M = nrows; g.N = 3072; g.K = 1024;
  pg8::StaticOrder S;
  S.init(g.M, g.N, (int)gridDim.x, (int)blockIdx.x);
  __syncthreads();
  pg8::gemm_phase<EpiGate, pg8::StaticOrder>((PG8_LAS unsigned char*)smem, g, S, E);
  __syncthreads();
}
struct MergeOrder {
  pg8::StaticOrder base;
  DEV bool next(int i, pg8::Unit& u) const {
    const int j = i / 3, b = i - 3 * j;
    pg8::Unit t;
    if (!base.next(j, t)) return false;
    u.pm = t.pm + 136 * (b == 0 ? 11 : (b == 1 ? 12 : 6));
    u.pn = t.pn + 4 * b;
    return true;
  }
  DEV void a_ready(const pg8::Unit&) const {}
  DEV void done(const pg8::Unit&) const {}
};
struct EpiMerge {
  static constexpr bool PERM = true, AFTER_DRAIN = false;
  char* ws;
  DEV void operator()(const f32x4 (&acc)[2][2][4][2], const pg8::Unit& u, int wr, int wc, int fr, int fq) const {
    const int b = u.pn >> 2, pn = u.pn & 3, pm = u.pm - 136 * (b == 0 ? 11 : (b == 1 ? 12 : 6));
    const bf16_t* G = (const bf16_t*)(ws + (b == 0 ? O_G1 : (b == 1 ? O_G2 : O_G3)));
    bf16_t* M = (bf16_t*)(ws + O_M);
    const int row0 = pm * 256 + wr * 64 + fr, col0 = pn * 256 + wc * 32 + 8 * fq;
#pragma unroll
    for (int ai = 0; ai < 2; ++ai)
#pragma unroll
      for (int m = 0; m < 4; ++m) {
        const int row = row0 + ai * 128 + m * 16;
#pragma unroll
        for (int bj = 0; bj < 2; ++bj) {
          const size_t off = (size_t)row * DM + col0 + bj * 128;
          const u32x4 gv = *(const u32x4*)(G + off);
          u32x4 mv = {0u, 0u, 0u, 0u};
          if (b > 0) mv = *(const u32x4*)(M + off);
          const f32x4 a0 = acc[ai][bj][m][0], a1 = acc[ai][bj][m][1];
          u32x4 o;
          o[0] = pk2(lo_bf(mv[0]) + lo_bf(gv[0]) * a0[0], hi_bf(mv[0]) + hi_bf(gv[0]) * a0[1]);
          o[1] = pk2(lo_bf(mv[1]) + lo_bf(gv[1]) * a0[2], hi_bf(mv[1]) + hi_bf(gv[1]) * a0[3]);
          o[2] = pk2(lo_bf(mv[2]) + lo_bf(gv[2]) * a1[0], hi_bf(mv[2]) + hi_bf(gv[2]) * a1[1]);
          o[3] = pk2(lo_bf(mv[3]) + lo_bf(gv[3]) * a1[2], hi_bf(mv[3]) + hi_bf(gv[3]) * a1[3]);
          *(u32x4*)(M + off) = o;
        }
      }
  }
};
DEV void merge_phase(const Params& p, int nrows, char* smem) {
  EpiMerge E;
  E.ws = p.ws;
  pg8::Gemm g;
  g.A = (const bf16_t*)p.ws; g.Bt = (const bf16_t*)(p.ws + O_WB + W_PCV); g.M = nrows; g.N = 1024; g.K = 512;
  MergeOrder S;
  S.base.init(g.M, g.N, (int)gridDim.x, (int)blockIdx.x);
  __syncthreads();
  pg8::gemm_phase<EpiMerge, MergeOrder>((PG8_LAS unsigned char*)smem, g, S, E);
  __syncthreads();
}

struct EpiResid {
  static constexpr bool PERM = false, AFTER_DRAIN = false;
  float* out; float* xc; const float* mod; bool store;
  DEV void operator()(const f32x4 (&acc)[2][2][4][2], const pg8::Unit& u, int wr, int wc, int fr, int fq) const {
    const int row0 = u.pm * 256 + wr * 64 + fr, col0 = u.pn * 256 + wc * 32 + 4 * fq;
#pragma unroll
    for (int ai = 0; ai < 2; ++ai)
#pragma unroll
      for (int m = 0; m < 4; ++m) {
        const int row = row0 + ai * 128 + m * 16;
        float* xr = row < T_LAT ? out + (size_t)row * DM : xc + (size_t)(row - T_LAT) * DM;
        const float* gt = mod + (size_t)modrow(row) * 6144;
#pragma unroll
        for (int bj = 0; bj < 2; ++bj)
#pragma unroll
          for (int n = 0; n < 2; ++n) {
            const int c = col0 + bj * 128 + n * 16;
            const f32x4 g4 = *(const f32x4*)(gt + c);
            f32x4 xv = *(f32x4*)(xr + c);
            xv += g4 * acc[ai][bj][m][n];
            if (store) *(f32x4*)(xr + c) = xv;
          }
      }
  }
};
DEV void resid_gemm_phase(const Params& p, int l, const bf16_t* A, int K, const bf16_t* Wt, int goff, int nrows, char* smem, bool store = true) {
  EpiResid E;
  E.store = store;
  E.out = p.out; E.xc = (float*)(p.ws + O_XC); E.mod = (const float*)(p.ws + O_MOD) + (size_t)l * 9 * 6144 + goff;
  pg8::Gemm g;
  g.A = A; g.Bt = Wt; g.M = nrows; g.N = 1024; g.K = K;
  pg8::StaticOrder S;
  S.init(g.M, g.N, (int)gridDim.x, (int)blockIdx.x);
  __syncthreads();
  pg8::gemm_phase<EpiResid, pg8::StaticOrder>((PG8_LAS unsigned char*)smem, g, S, E);
  __syncthreads();
}

struct EpiMlp1 {
  static constexpr bool PERM = true, AFTER_DRAIN = false;
  bf16_t* HID;
  DEV void operator()(const f32x4 (&acc)[2][2][4][2], const pg8::Unit& u, int wr, int wc, int fr, int fq) const {
    const int row0 = u.pm * 256 + wr * 64 + fr, col0 = u.pn * 256 + wc * 32 + 8 * fq;
#pragma unroll
    for (int ai = 0; ai < 2; ++ai)
#pragma unroll
      for (int m = 0; m < 4; ++m) {
        const int row = row0 + ai * 128 + m * 16;
#pragma unroll
        for (int bj = 0; bj < 2; ++bj) {
          float v[8];
#pragma unroll
          for (int j = 0; j < 4; ++j) {
            const float r0 = fmaxf(acc[ai][bj][m][0][j], 0.f), r1 = fmaxf(acc[ai][bj][m][1][j], 0.f);
            v[j] = r0 * r0; v[4 + j] = r1 * r1;
          }
          u32x4 o;
          o[0] = pk2(v[0], v[1]); o[1] = pk2(v[2], v[3]); o[2] = pk2(v[4], v[5]); o[3] = pk2(v[6], v[7]);
          *(u32x4*)(HID + (size_t)row * 4096 + col0 + bj * 128) = o;
        }
      }
  }
};
DEV void mlp1_phase(const Params& p, int nrows, char* smem) {
  EpiMlp1 E;
  E.HID = (bf16_t*)(p.ws + O_HID);
  pg8::Gemm g;
  g.A = (const bf16_t*)(p.ws + O_HM); g.Bt = (const bf16_t*)(p.ws + O_WB + W_W1); g.M = nrows; g.N = 4096; g.K = 1024;
  pg8::StaticOrder S;
  S.init(g.M, g.N, (int)gridDim.x, (int)blockIdx.x);
  __syncthreads();
  pg8::gemm_phase<EpiMlp1, pg8::StaticOrder>((PG8_LAS unsigned char*)smem, g, S, E);
  __syncthreads();
}

DEV void final_phase(const Params& p) {
  const int lane = ltid() & 63, w = ltid() >> 6;
  const int stride = gridDim.x * 8;
  f32x4 g[4];
#pragma unroll
  for (int i = 0; i < 4; ++i) g[i] = *(const f32x4*)(p.final_g + i * 256 + lane * 4);
  int row = blockIdx.x * 8 + w;
  f32x4 nv[4];
  if (row < T_LAT) {
#pragma unroll
    for (int i = 0; i < 4; ++i) nv[i] = *(const f32x4*)(p.out + (size_t)row * DM + i * 256 + lane * 4);
  }
  for (; row < T_LAT; row += stride) {
    float* xr = p.out + (size_t)row * DM;
    f32x4 v[4];
#pragma unroll
    for (int i = 0; i < 4; ++i) v[i] = nv[i];
    if (row + stride < T_LAT) {
#pragma unroll
      for (int i = 0; i < 4; ++i) nv[i] = *(const f32x4*)(p.out + (size_t)(row + stride) * DM + i * 256 + lane * 4);
    }
    float ss = 0.f;
#pragma unroll
    for (int i = 0; i < 4; ++i) ss += v[i][0] * v[i][0] + v[i][1] * v[i][1] + v[i][2] * v[i][2] + v[i][3] * v[i][3];
    const float rs = rsqrtf(wsum(ss) * (1.f / 1024.f) + 1e-6f);
#pragma unroll
    for (int i = 0; i < 4; ++i) *(f32x4*)(xr + i * 256 + lane * 4) = v[i] * rs * g[i];
  }
}

constexpr int N_PHASES = 26;
__global__ void __launch_bounds__(512) fwd_megakernel(Params p, int ph_lo, int ph_hi) {
  extern __shared__ __attribute__((aligned(16))) char smem[];
  cg::grid_group grid = cg::this_grid();
  volatile XLAS unsigned* st = (volatile XLAS unsigned*)(smem + 139264);
  if (threadIdx.x == 0) { st[0] = 0u; st[1] = 0u; st[2] = 0u; st[3] = 0u; }
  __syncthreads();
  const XcdBarrier xb = xcd_barrier_post((unsigned*)(p.ws + O_BAR), st);
  if (ph_hi > 1000) grid.sync();
  for (int ph = ph_lo; ph < ph_hi; ++ph) {
    if (ph == 0) {
      cvt_phase(p, 0, smem);
      mod_phase(p, smem);
    } else if (ph == N_PHASES - 1) {
      final_phase(p);
    } else {
      const int l = (ph - 1) / 12, sp = (ph - 1) % 12;
      const int nrows = (l == 1) ? T_LAT : T_ALL;
      switch (sp) {
        case 0:
          if (l > 0) cvt_phase(p, l, smem);
          norm_phase(p, l, 0, (bf16_t*)(p.ws + O_H0), l == 0);
          break;
        case 1: gemm_in_phase(p, smem); break;
        case 2: branch_phase(p, l, smem); break;
        case 3:
          lora64_phase(p, l, smem);
          lora_phase(p, l, smem, true);
          break;
        case 4: scan_phase(p, l, smem); break;
        case 5:
          post_phase(p, l, nrows);
          norm_phase(p, l, 0, (bf16_t*)(p.ws + O_HM), false, nrows);
          break;
        case 6: gate_phase(p, nrows, smem); break;
        case 7: merge_phase(p, nrows, smem); break;
        case 8: resid_gemm_phase(p, l, (const bf16_t*)(p.ws + O_M), 1024, (const bf16_t*)(p.ws + O_WB + W_WOUT), 2048, nrows, smem); break;
        case 9: norm_phase(p, l, 1, (bf16_t*)(p.ws + O_HM), false, nrows); break;
        case 10: mlp1_phase(p, nrows, smem); break;
        case 11: resid_gemm_phase(p, l, (const bf16_t*)(p.ws + O_HID), 4096, (const bf16_t*)(p.ws + O_WB + W_W2), 5120, nrows, smem); break;
      }
    }
    if (ph + 1 < ph_hi) xcd_barrier(xb);
  }
}

extern "C" void kernel_launch(void* const* d_in, const int* in_sizes, int n_in, void* d_out, int out_size, void* d_ws,
                              size_t ws_size, hipStream_t stream) {
  Params p{};
  const float** pp = (const float**)&p;
  for (int i = 0; i < 36; ++i) pp[i] = (const float*)d_in[i];
  p.out = (float*)d_out;
  p.ws = (char*)d_ws;
  static int grid_blocks = 0;
  if (!grid_blocks) {
    hipFuncSetAttribute((const void*)fwd_megakernel, hipFuncAttributeMaxDynamicSharedMemorySize, LDS_BYTES);
    int dev = 0, cus = 0, per_cu = 0;
    hipGetDevice(&dev);
    hipDeviceGetAttribute(&cus, hipDeviceAttributeMultiprocessorCount, dev);
    hipOccupancyMaxActiveBlocksPerMultiprocessor(&per_cu, fwd_megakernel, 512, LDS_BYTES);
    if (per_cu < 1) per_cu = 1;
    grid_blocks = cus * per_cu;
    grid_blocks &= ~7;
  }
  if (ws_size < WS_NEED) fprintf(stderr, "workspace too small: %zu < %zu\n", ws_size, (size_t)WS_NEED);
#ifndef MULTI_LAUNCH
#define MULTI_LAUNCH 0
#endif
#if MULTI_LAUNCH
  for (int ph = 0; ph < N_PHASES; ++ph)
    hipLaunchKernelGGL(fwd_megakernel, dim3(grid_blocks), dim3(512), LDS_BYTES, stream, p, ph, ph + 1);
#else
  hipMemsetAsync((char*)d_ws + O_BAR, 0, 16384, stream);
  int lo = 0, hi = N_PHASES;
  void* args[] = {&p, &lo, &hi};
  hipError_t e = hipLaunchCooperativeKernel((const void*)fwd_megakernel, dim3(grid_blocks), dim3(512), args, LDS_BYTES, stream);
  if (e != hipSuccess) fprintf(stderr, "cooperative launch failed: %s (grid %d)\n", hipGetErrorString(e), grid_blocks);
#endif
}
```

```cpp
#include <hip/hip_runtime.h>
#include <hip/hip_cooperative_groups.h>
#include <cstdio>
namespace cg = cooperative_groups;

typedef unsigned short bf16_t;
typedef short bf16x8 __attribute__((ext_vector_type(8)));
typedef float f32x4 __attribute__((ext_vector_type(4)));
typedef float f32x16 __attribute__((ext_vector_type(16)));
typedef unsigned u32x4 __attribute__((ext_vector_type(4)));
#define DEV __device__ __forceinline__
#define PROBE 0

constexpr int T_LAT = 32768, T_ALL = 34816, DM = 1024, DIN = 7552, NZ = 4480, NZP = 4608, DINT = 7680;
constexpr int SEQ = 4096, CTXL = 256, TK = 4352;
constexpr size_t U = 35651584ull;
constexpr size_t O_ZU = 0, O_ZK = U, O_VT = 2 * U, O_ZRW = 3 * U, O_ZRS = 7 * U, O_LIN = 10 * U, O_YCV = 11 * U, O_ZQ = 12 * U;
constexpr size_t O_H0 = 7 * U;
constexpr size_t O_EF = 0, O_EB = 3 * U, O_AF = 4 * U, O_AB = 5 * U, O_G = 2 * U, O_YSF = 6 * U, O_YSB = 10 * U;
constexpr size_t O_HM = 0, O_M = 0, O_HID = 3 * U;
constexpr size_t O_G1 = 3 * U, O_G2 = 7 * U, O_G3 = 9 * U;
constexpr size_t O_WB = 13 * U;
constexpr size_t W_WIN = 0, W_PCV = W_WIN + (size_t)DINT * 1024 * 2, W_PAT = W_PCV + 1048576, W_PRW = W_PAT + 1048576,
                 W_WOUT = W_PRW + 1048576, W_W1 = W_WOUT + 2097152, W_W2 = W_W1 + 8388608, W_LW2 = W_W2 + 8388608,
                 W_LA2 = W_LW2 + 131072, W_LG2 = W_LA2 + 131072, W_END = W_LG2 + 131072;
constexpr size_t O_XC = O_WB + W_END;
constexpr size_t O_MOD = O_XC + 8388608;
constexpr size_t O_BAR = O_MOD + 2 * 9 * 6144 * 4;
constexpr size_t O_GIN = O_BAR + 16384;
constexpr size_t WS_NEED = O_GIN + (size_t)T_ALL * 128 * 2;

constexpr int LDS_BYTES = 139264 + 16;

struct Params {
  const float *x, *c, *ctx, *c_ctx, *mod_w, *mod_b, *norm1_g, *norm2_g, *w_in, *conv_dw_w, *conv_dw_b, *conv_ln_g,
      *conv_ln_b, *p_conv, *att_lq1, *att_lk1, *att_lq2, *att_lk2, *att_subln_g, *p_att, *rwkv_shift, *rwkv_w0, *rwkv_w2,
      *rwkv_a0, *rwkv_a2, *rwkv_g2, *rwkv_kk, *rwkv_ka, *rwkv_rk, *rwkv_gn_g, *rwkv_gn_b, *p_rwkv, *w_out, *mlp_w1,
      *mlp_w2, *final_g;
  float* out;
  char* ws;
};

DEV int ltid() { int t = threadIdx.x; asm volatile("" : "+v"(t)); return t; }
DEV float bf2f(bf16_t h) { return __uint_as_float(((unsigned)h) << 16); }
typedef float f32x2_t __attribute__((ext_vector_type(2)));
typedef __bf16 bf16x2_t __attribute__((ext_vector_type(2)));
DEV unsigned pk2(float lo, float hi) {
  const f32x2_t v = {lo, hi};
  return __builtin_bit_cast(unsigned, __builtin_convertvector(v, bf16x2_t));
}
DEV bf16_t f2bf(float f) { return (bf16_t)(pk2(f, 0.f) & 0xffffu); }
DEV float lo_bf(unsigned u) { return __uint_as_float(u << 16); }
DEV float hi_bf(unsigned u) { return __uint_as_float(u & 0xffff0000u); }
template <int C> DEV float dppf(float v) {
  return __int_as_float(__builtin_amdgcn_update_dpp(0, __float_as_int(v), C, 0xF, 0xF, true));
}
DEV float xor32_sum(float v) {
  const auto r = __builtin_amdgcn_permlane32_swap(__float_as_uint(v), __float_as_uint(v), false, false);
  return __uint_as_float(r[0]) + __uint_as_float(r[1]);
}
DEV float xor32_max(float v) {
  const auto r = __builtin_amdgcn_permlane32_swap(__float_as_uint(v), __float_as_uint(v), false, false);
  return fmaxf(__uint_as_float(r[0]), __uint_as_float(r[1]));
}
DEV float xor16_sum(float v) {
  const auto r = __builtin_amdgcn_permlane16_swap(__float_as_uint(v), __float_as_uint(v), false, false);
  return __uint_as_float(r[0]) + __uint_as_float(r[1]);
}
DEV float wsum(float v) {
  v += dppf<0xB1>(v);
  v += dppf<0x4E>(v);
  v += dppf<0x141>(v);
  v += dppf<0x140>(v);
  v = xor16_sum(v);
  return xor32_sum(v);
}
DEV float sigmoidf_(float x) { return 1.f / (1.f + __expf(-x)); }
DEV float red16(float v) {
  v += dppf<0xB1>(v);
  v += dppf<0x4E>(v);
  v += dppf<0x141>(v);
  v += dppf<0x140>(v);
  return v;
}
DEV int vblock() { const int per = gridDim.x >> 3; return (blockIdx.x & 7) * per + (blockIdx.x >> 3); }
DEV float* xrow(const Params& p, int row) {
  return row < T_LAT ? p.out + (size_t)row * DM : (float*)(p.ws + O_XC) + (size_t)(row - T_LAT) * DM;
}
DEV int modrow(int row) { return row < T_LAT ? (row >> 12) : 8; }

#define XB_TMO      128
#define XB_XCNT(j)  (256  + 64 * (j))
#define XB_XSUB(j)  (1280 + 64 * (j))
#define XB_XGEN(j)  (2304 + 64 * (j))
#define XB_TOP      3328
#define XB_TOPGEN   3392
#define XCD_BAR_WORDS 3456
#define XB_SPIN_CAP (1u << 18)
#define XLAS __attribute__((address_space(3)))

__device__ __forceinline__ unsigned xb_ld(unsigned* p)              { return __hip_atomic_load(p, __ATOMIC_RELAXED, __HIP_MEMORY_SCOPE_AGENT); }
__device__ __forceinline__ unsigned xb_add(unsigned* p, unsigned v) { return __hip_atomic_fetch_add(p, v, __ATOMIC_RELAXED, __HIP_MEMORY_SCOPE_AGENT); }
__device__ __forceinline__ unsigned xb_xcc_id() { return (unsigned)__builtin_amdgcn_s_getreg((3 << 11) | 20) & 0xFu; }
#define XB_SPIN(cond, bar) do { unsigned _sp = 0; while (cond) { __builtin_amdgcn_s_sleep(1); \
    if ((++_sp & 255u) == 0u) { if (xb_ld(&(bar)[XB_TMO])) break; if (_sp > XB_SPIN_CAP) { atomicAdd(&(bar)[XB_TMO], 1u); break; } } } } while (0)

struct XcdBarrier {
    unsigned* bar; unsigned x;
    volatile XLAS unsigned* st;
};

__device__ __forceinline__ XcdBarrier xcd_barrier_post(unsigned* bar, volatile XLAS unsigned* st) {
    XcdBarrier b; b.bar = bar; b.x = xb_xcc_id(); b.st = st;
    if (threadIdx.x == 0) (void)xb_add(&bar[XB_XCNT(b.x)], 1u);
    return b;
}
__device__ __forceinline__ void xcd_barrier_complete(unsigned* bar, unsigned x, unsigned& nloc, unsigned& nx) {
    const unsigned G = gridDim.x * gridDim.y * gridDim.z;
    unsigned sum, cnt, mine, sp = 0u;
    for (;;) {
        sum = 0u; cnt = 0u; mine = 0u;
#pragma unroll
        for (unsigned j = 0; j < 16; ++j) { const unsigned c = xb_ld(&bar[XB_XCNT(j)]); sum += c; cnt += (c > 0u) ? 1u : 0u; mine = (j == x) ? c : mine; }
        if (sum == G) break;
        __builtin_amdgcn_s_sleep(1);
        if ((++sp & 255u) == 0u) { if (xb_ld(&bar[XB_TMO])) break; if (sp > XB_SPIN_CAP) { atomicAdd(&bar[XB_TMO], 1u); break; } }
    }
    nloc = mine > 0u ? mine : 1u; nx = cnt > 0u ? cnt : 1u;
}

__device__ __forceinline__ void xcd_barrier(const XcdBarrier& b) {
    asm volatile("s_waitcnt vmcnt(0)" ::: "memory");
    __syncthreads();
    if (threadIdx.x == 0) {
        unsigned* bar = b.bar;
        __builtin_amdgcn_s_waitcnt(0);
        unsigned nloc = b.st[0], nx = b.st[1];
        if (nloc == 0u) { xcd_barrier_complete(bar, b.x, nloc, nx); b.st[0] = nloc; b.st[1] = nx; }
        const unsigned old = xb_add(&bar[XB_XSUB(b.x)], 1u);
        const unsigned gen = old / nloc;
        if (old + 1u == (gen + 1u) * nloc) {
            __builtin_amdgcn_fence(__ATOMIC_RELEASE, "agent");
            asm volatile("s_waitcnt vmcnt(0)" ::: "memory");
            const unsigned og = xb_add(&bar[XB_TOP], 1u);
            const unsigned tg = og / nx;
            if (og + 1u == (tg + 1u) * nx) xb_add(&bar[XB_TOPGEN], 1u);
            else XB_SPIN(xb_ld(&bar[XB_TOPGEN]) == tg, bar);
            __builtin_amdgcn_fence(__ATOMIC_ACQUIRE, "agent");
            xb_add(&bar[XB_XGEN(b.x)], 1u);
            asm volatile("s_waitcnt vmcnt(0)" ::: "memory");
        } else {
            XB_SPIN(xb_ld(&bar[XB_XGEN(b.x)]) == gen, bar);
            __builtin_amdgcn_fence(__ATOMIC_ACQUIRE, "agent");
            asm volatile("s_waitcnt vmcnt(0)" ::: "memory");
        }
    }
    __syncthreads();
}

namespace pg8 {
#define PG8_LAS __attribute__((address_space(3)))
constexpr int BM = 256, BK = 64, HALF = 128, HTB = HALF * BK * 2, STAGE_BYTES = 8 * HTB, NXCD = 8, WGM = 4;
__host__ __device__ __forceinline__ int lds_byte(int r, int c) { const int st = (r >> 4) * 2 + (c >> 5), rr = r & 15, cc = c & 31, ob = rr * 64 + cc * 2; return st * 1024 + (ob ^ (((ob >> 9) & 1) << 5)); }
__host__ __device__ __forceinline__ void stage_rc(int b, int& R, int& C) { const int st = b / 1024, sb = b % 1024, swz = sb ^ (((sb >> 9) & 1) << 5); R = (st >> 1) * 16 + swz / 64; C = (st & 1) * 32 + (swz % 64) / 2; }
__host__ __device__ __forceinline__ int perm32(int rho) { const int n = rho >> 4, i = rho & 15; return 8 * (i >> 2) + 4 * n + (i & 3); }
struct Unit { int pm, pn; };
struct Gemm { const bf16_t* A; const bf16_t* Bt; int M, N, K; };
struct StaticOrder {
    int nM, nN, nwg, G, c;
    __host__ __device__ void init(int M, int N, int G_, int c_) { nM = M / BM; nN = N / BM; nwg = nM * nN; G = G_; c = c_; }
    __host__ __device__ bool next(int i, Unit& u) const {
        const long L = (long)i * G + c; if (L >= nwg) return false;
        int wgid = (int)L; { const int q = nwg / NXCD, r = nwg % NXCD, xcd = wgid % NXCD, off = wgid / NXCD; wgid = (xcd < r ? xcd * (q + 1) : r * (q + 1) + (xcd - r) * q) + off; }
        const int nig = WGM * nN, gid = wgid / nig, fm = gid * WGM, gsz = (nM - fm) < WGM ? (nM - fm) : WGM;
        u.pm = fm + ((wgid % nig) % gsz); u.pn = (wgid % nig) / gsz; return true;
    }
    __device__ __forceinline__ void a_ready(const Unit&) const {}
    __device__ __forceinline__ void done(const Unit&) const {}
};

template <class Epi, class Sched>
__device__ __forceinline__ void gemm_phase(PG8_LAS unsigned char* lds, const Gemm g, const Sched& S, const Epi& E) {
    const int tid = ltid(), wid = __builtin_amdgcn_readfirstlane(tid >> 6), lane = tid & 63, wr = wid >> 2, wc = wid & 3, fr = lane & 15, fq = lane >> 4;
    const int K = g.K, nt = K / BK;
    unsigned voffA[2], voffB[2];
#pragma unroll
    for (int i = 0; i < 2; ++i) { int R, C; stage_rc(tid * 16 + i * 8192, R, C); const int Rb = Epi::PERM ? ((R & ~31) + perm32(R & 31)) : R;
        voffA[i] = (unsigned)(R * K + C) * 2u; voffB[i] = (unsigned)(Rb * K + C) * 2u; }
    const size_t kstep = (size_t)(BK * 2);
    const size_t hstep = (size_t)HALF * K * 2;
    const size_t tstep = 2 * hstep;
    const unsigned ldsw = (unsigned)wid * 1024u;
    const int aoff = lds_byte(wr * 64 + fr, fq * 8), boff = lds_byte(wc * 32 + fr, fq * 8);
#define PG8_SA(b, h) (((b) * 2 + (h)) * HTB)
#define PG8_SB(b, h) ((4 + (b) * 2 + (h)) * HTB)
#define PG8_STAGE(bufoff, gbase, voff) do { _Pragma("unroll") for (int _i = 0; _i < 2; ++_i) \
        __builtin_amdgcn_global_load_lds((const unsigned*)((const char*)(gbase) + (voff)[_i]), (PG8_LAS unsigned*)(lds + (bufoff) + ldsw + _i * 8192), 16, 0, 0); } while (0)
#define PG8_LDA(dst, b, h) do { _Pragma("unroll") for (int m = 0; m < 4; ++m) _Pragma("unroll") for (int k = 0; k < 2; ++k) dst[m][k] = *(const PG8_LAS bf16x8*)(lds + PG8_SA(b, h) + aoff + m * 2048 + k * 1024); } while (0)
#define PG8_LDB(dst, b, h) do { _Pragma("unroll") for (int n = 0; n < 2; ++n) _Pragma("unroll") for (int k = 0; k < 2; ++k) dst[n][k] = *(const PG8_LAS bf16x8*)(lds + PG8_SB(b, h) + boff + n * 2048 + k * 1024); } while (0)
#define PG8_MMA(ai, bj, At, Bt) do { __builtin_amdgcn_s_setprio(1); _Pragma("unroll") for (int m = 0; m < 4; ++m) _Pragma("unroll") for (int n = 0; n < 2; ++n) _Pragma("unroll") for (int k = 0; k < 2; ++k) \
        acc[ai][bj][m][n] = __builtin_amdgcn_mfma_f32_16x16x32_bf16(Bt[n][k], At[m][k], acc[ai][bj][m][n], 0, 0, 0); __builtin_amdgcn_s_setprio(0); } while (0)
#define PG8_WAIT_V(n) asm volatile("s_waitcnt vmcnt(" #n ")" ::: "memory")
#define PG8_WAIT_L(n) asm volatile("s_waitcnt lgkmcnt(" #n ")" ::: "memory")
#define PG8_BAR __builtin_amdgcn_s_barrier()
#define PG8_SCHED __builtin_amdgcn_sched_barrier(0)
    Unit cur, nxt; int ui = 0;
    if (!S.next(0, cur)) return;
    f32x4 acc[2][2][4][2];
#pragma unroll
    for (int a = 0; a < 2; ++a)
#pragma unroll
        for (int b = 0; b < 2; ++b)
#pragma unroll
            for (int m = 0; m < 4; ++m)
#pragma unroll
                for (int n = 0; n < 2; ++n) acc[a][b][m][n] = (f32x4){0.f, 0.f, 0.f, 0.f};
    bf16x8 At[4][2], B0[2][2], B1[2][2];
    const char* cA = (const char*)g.A + (size_t)cur.pm * tstep; const char* cB = (const char*)g.Bt + (size_t)cur.pn * tstep;
    S.a_ready(cur);
    PG8_STAGE(PG8_SB(0, 0), cB, voffB); PG8_STAGE(PG8_SA(0, 0), cA, voffA); PG8_STAGE(PG8_SB(0, 1), cB + hstep, voffB); PG8_STAGE(PG8_SA(0, 1), cA + hstep, voffA);
    if (wr == 1) PG8_BAR;
    PG8_WAIT_V(4); PG8_BAR;
    PG8_STAGE(PG8_SB(1, 0), cB + kstep, voffB); PG8_STAGE(PG8_SA(1, 0), cA + kstep, voffA); PG8_STAGE(PG8_SB(1, 1), cB + hstep + kstep, voffB);
    PG8_WAIT_V(6); PG8_BAR;
    for (;;) {
        const bool has_next = S.next(ui + 1, nxt);
        const char* nA = has_next ? (const char*)g.A + (size_t)nxt.pm * tstep : cA; const char* nB = has_next ? (const char*)g.Bt + (size_t)nxt.pn * tstep : cB;
        for (int t = 0; t < nt; t += 2) {
            const bool last = (t == nt - 2);
            const char* a1 = cA + (size_t)(t + 1) * kstep;
            const char* a2 = last ? nA : cA + (size_t)(t + 2) * kstep; const char* b2 = last ? nB : cB + (size_t)(t + 2) * kstep;
            const char* a3 = a2 + kstep; const char* b3 = b2 + kstep;
            if (last && has_next) S.a_ready(nxt);
            PG8_LDB(B0, 0, 0); PG8_SCHED; PG8_LDA(At, 0, 0); PG8_STAGE(PG8_SA(1, 1), a1 + hstep, voffA);
            PG8_WAIT_L(8); PG8_BAR; PG8_WAIT_L(0); PG8_MMA(0, 0, At, B0); PG8_BAR; PG8_SCHED;
            PG8_LDB(B1, 0, 1); PG8_STAGE(PG8_SB(0, 0), b2, voffB);
            PG8_BAR; PG8_WAIT_L(0); PG8_MMA(0, 1, At, B1); PG8_BAR;
            PG8_LDA(At, 0, 1); PG8_STAGE(PG8_SA(0, 0), a2, voffA);
            PG8_BAR; PG8_WAIT_L(0); PG8_MMA(1, 0, At, B0); PG8_BAR; PG8_SCHED;
            PG8_STAGE(PG8_SB(0, 1), b2 + hstep, voffB);
            PG8_WAIT_V(6); PG8_BAR; PG8_MMA(1, 1, At, B1); PG8_BAR;
            PG8_LDB(B0, 1, 0); PG8_SCHED; PG8_LDA(At, 1, 0); PG8_STAGE(PG8_SA(0, 1), a2 + hstep, voffA);
            PG8_WAIT_L(8); PG8_BAR; PG8_WAIT_L(0); PG8_MMA(0, 0, At, B0); PG8_BAR; PG8_SCHED;
            PG8_LDB(B1, 1, 1); PG8_STAGE(PG8_SB(1, 0), b3, voffB);
            PG8_BAR; PG8_WAIT_L(0); PG8_MMA(0, 1, At, B1); PG8_BAR;
            PG8_LDA(At, 1, 1); PG8_STAGE(PG8_SA(1, 0), a3, voffA);
            PG8_BAR; PG8_WAIT_L(0); PG8_MMA(1, 0, At, B0); PG8_BAR; PG8_SCHED;
            PG8_STAGE(PG8_SB(1, 1), b3 + hstep, voffB);
            PG8_WAIT_V(6); PG8_BAR; PG8_MMA(1, 1, At, B1); PG8_BAR;
        }
        if constexpr (!Epi::AFTER_DRAIN) { E(acc, cur, wr, wc, fr, fq); S.done(cur); }
        if (!has_next) break;
#pragma unroll
        for (int a = 0; a < 2; ++a)
#pragma unroll
            for (int b = 0; b < 2; ++b)
#pragma unroll
                for (int m = 0; m < 4; ++m)
#pragma unroll
                    for (int n = 0; n < 2; ++n) acc[a][b][m][n] = (f32x4){0.f, 0.f, 0.f, 0.f};
        cur = nxt; cA = nA; cB = nB; ++ui;
    }
    PG8_WAIT_V(0);
    if (wr == 0) PG8_BAR;
    PG8_BAR;
    if constexpr (Epi::AFTER_DRAIN) { E.fused(acc, cur, wr, wc, fr, fq, lds, wid, lane); S.done(cur); }
#undef PG8_SA
#undef PG8_SB
#undef PG8_STAGE
#undef PG8_LDA
#undef PG8_LDB
#undef PG8_MMA
#undef PG8_WAIT_V
#undef PG8_WAIT_L
#undef PG8_BAR
#undef PG8_SCHED
}

}

constexpr int SROW = 144;
constexpr int A_ST = 256 * SROW, B_ST = 128 * SROW, ST_BYTES = A_ST + B_ST;

DEV void gemm_kloop(f32x4 (&acc)[4][4], const bf16_t* __restrict__ A, int lda, const bf16_t* __restrict__ Bt, int ldb,
                    int K, char* smem) {
  const int tid = ltid(), lane = tid & 63, w = tid >> 6, wm = w >> 1, wn = w & 1;
  const int fr = lane & 15, fq = lane >> 4;
  const int lrow = tid >> 3, lch = tid & 7;
  const bf16_t* ga = A + (size_t)lrow * lda + lch * 8;
  const bf16_t* gb = Bt + (size_t)lrow * ldb + lch * 8;
  u32x4 ra[4], rb[2];
#pragma unroll
  for (int i = 0; i < 4; ++i) ra[i] = *(const u32x4*)(ga + (size_t)(64 * i) * lda);
#pragma unroll
  for (int i = 0; i < 2; ++i) rb[i] = *(const u32x4*)(gb + (size_t)(64 * i) * ldb);
  char* swa = smem + lrow * SROW + lch * 16;
  char* swb = swa + A_ST;
  __syncthreads();
#pragma unroll
  for (int i = 0; i < 4; ++i) *(u32x4*)(swa + i * 64 * SROW) = ra[i];
#pragma unroll
  for (int i = 0; i < 2; ++i) *(u32x4*)(swb + i * 64 * SROW) = rb[i];
  __syncthreads();
  const int nk = K >> 6;
  const char* sra = smem + (wm * 64 + fr) * SROW + fq * 16;
  const char* srb = smem + A_ST + (wn * 64 + fr) * SROW + fq * 16;
  for (int kt = 0; kt < nk; ++kt) {
    const int cur = kt & 1;
    if (kt + 1 < nk) {
#pragma unroll
      for (int i = 0; i < 4; ++i) ra[i] = *(const u32x4*)(ga + (size_t)(64 * i) * lda + (kt + 1) * 64);
#pragma unroll
      for (int i = 0; i < 2; ++i) rb[i] = *(const u32x4*)(gb + (size_t)(64 * i) * ldb + (kt + 1) * 64);
    }
#pragma unroll
    for (int ks = 0; ks < 2; ++ks) {
      bf16x8 af[4], bfr[4];
#pragma unroll
      for (int mi = 0; mi < 4; ++mi) af[mi] = *(const bf16x8*)(sra + cur * ST_BYTES + mi * 16 * SROW + ks * 64);
#pragma unroll
      for (int ni = 0; ni < 4; ++ni) bfr[ni] = *(const bf16x8*)(srb + cur * ST_BYTES + ni * 16 * SROW + ks * 64);
#pragma unroll
      for (int mi = 0; mi < 4; ++mi)
#pragma unroll
        for (int ni = 0; ni < 4; ++ni)
          acc[mi][ni] = __builtin_amdgcn_mfma_f32_16x16x32_bf16(bfr[ni], af[mi], acc[mi][ni], 0, 0, 0);
    }
    if (kt + 1 < nk) {
      const int nx = cur ^ 1;
#pragma unroll
      for (int i = 0; i < 4; ++i) *(u32x4*)(swa + nx * ST_BYTES + i * 64 * SROW) = ra[i];
#pragma unroll
      for (int i = 0; i < 2; ++i) *(u32x4*)(swb + nx * ST_BYTES + i * 64 * SROW) = rb[i];
    }
    __syncthreads();
  }
}
DEV void zero_acc(f32x4 (&acc)[4][4]) {
#pragma unroll
  for (int a = 0; a < 4; ++a)
#pragma unroll
    for (int b = 0; b < 4; ++b) acc[a][b] = (f32x4){0.f, 0.f, 0.f, 0.f};
}
DEV void tile_pm_pn(int L, int nN, int& pm, int& pn) {
  const int g = L / (4 * nN), wi = L % (4 * nN);
  pm = g * 4 + (wi & 3);
  pn = wi >> 2;
}

DEV int conv_srccol(int n) {
  const int tile = n >> 8, w = n & 255;
  return w < 128 ? tile * 128 + w : 512 + tile * 128 + (w - 128);
}
DEV void cvt_job(const float* __restrict__ src, int K, int N, int ldsrc, bf16_t* __restrict__ dst, int nperm, int& tbase, char* smem) {
  float* lds = (float*)smem;
  const int nkt = K >> 6, nnt = N >> 6, cnt = nkt * nnt;
  const int G = gridDim.x;
  const int first = (int)((blockIdx.x + G - (tbase % G)) % G);
  const int tid = ltid();
  for (int t = first; t < cnt; t += G) {
    const int kt = t % nkt, nt = t / nkt;
    const int ty = tid >> 4, tx = tid & 15;
    const int n = nt * 64 + tx * 4;
    const int sc = (n < nperm) ? conv_srccol(n) : n;
#pragma unroll
    for (int i = 0; i < 2; ++i) {
      const int k = ty + 32 * i;
      const float4 v = *(const float4*)(src + (size_t)(kt * 64 + k) * ldsrc + sc);
      float* d = lds + k * 65 + tx * 4;
      d[0] = v.x; d[1] = v.y; d[2] = v.z; d[3] = v.w;
    }
    __syncthreads();
    {
      const int nn = tid >> 3, kc = tid & 7;
      float v[8];
#pragma unroll
      for (int j = 0; j < 8; ++j) v[j] = lds[(kc * 8 + j) * 65 + nn];
      uint4 o;
      o.x = pk2(v[0], v[1]); o.y = pk2(v[2], v[3]); o.z = pk2(v[4], v[5]); o.w = pk2(v[6], v[7]);
      *(uint4*)(dst + (size_t)(nt * 64 + nn) * K + kt * 64 + kc * 8) = o;
    }
    __syncthreads();
  }
  tbase += cnt;
}
DEV void cvt_phase(const Params& p, int l, char* smem) {
  char* wb = p.ws + O_WB;
  int tb = 0;
  const float* win = p.w_in + (size_t)l * 1024 * DIN;
  cvt_job(win, 1024, NZ, DIN, (bf16_t*)(wb + W_WIN), 1024, tb, smem);
  cvt_job(win + NZ, 1024, 3072, DIN, (bf16_t*)(wb + W_WIN) + (size_t)NZP * 1024, 0, tb, smem);
  cvt_job(p.mlp_w1 + (size_t)l * 1024 * 4096, 1024, 4096, 4096, (bf16_t*)(wb + W_W1), 0, tb, smem);
  cvt_job(p.mlp_w2 + (size_t)l * 4096 * 1024, 4096, 1024, 1024, (bf16_t*)(wb + W_W2), 0, tb, smem);
  cvt_job(p.w_out + (size_t)l * 1024 * 1024, 1024, 1024, 1024, (bf16_t*)(wb + W_WOUT), 0, tb, smem);
  cvt_job(p.p_conv + (size_t)l * 512 * 1024, 512, 1024, 1024, (bf16_t*)(wb + W_PCV), 0, tb, smem);
  cvt_job(p.p_att + (size_t)l * 512 * 1024, 512, 1024, 1024, (bf16_t*)(wb + W_PAT), 0, tb, smem);
  cvt_job(p.p_rwkv + (size_t)l * 512 * 1024, 512, 1024, 1024, (bf16_t*)(wb + W_PRW), 0, tb, smem);
  for (int d = 0; d < 2; ++d) {
    cvt_job(p.rwkv_w2 + (size_t)(l * 2 + d) * 64 * 512, 64, 512, 512, (bf16_t*)(wb + W_LW2) + d * 512 * 64, 0, tb, smem);
    cvt_job(p.rwkv_a2 + (size_t)(l * 2 + d) * 64 * 512, 64, 512, 512, (bf16_t*)(wb + W_LA2) + d * 512 * 64, 0, tb, smem);
  }
  cvt_job(p.rwkv_g2 + (size_t)l * 128 * 512, 128, 512, 512, (bf16_t*)(wb + W_LG2), 0, tb, smem);
}

DEV void mod_phase(const Params& p, char* smem) {
  float* sc = (float*)smem;
  float* red = sc + 9 * 1024;
  float* MOD = (float*)(p.ws + O_MOD);
  const int tid = ltid();
  if ((int)blockIdx.x >= 192) return;
  for (int i = tid; i < 9 * 1024; i += 512) {
    const int r = i >> 10, k = i & 1023;
    const float v = r < 8 ? p.c[r * 1024 + k] : p.c_ctx[k];
    sc[i] = v / (1.f + __expf(-v));
  }
  __syncthreads();
  for (int tile = blockIdx.x; tile < 192; tile += gridDim.x) {
    const int l = tile / 96, n0 = (tile % 96) * 64;
    const int kq = tid >> 6, col = tid & 63;
    float acc[9];
#pragma unroll
    for (int r = 0; r < 9; ++r) acc[r] = 0.f;
    const float* wp = p.mod_w + ((size_t)l * 1024 + kq * 128) * 6144 + n0 + col;
#pragma unroll 32
    for (int k = 0; k < 128; ++k) {
      const float wv = wp[(size_t)k * 6144];
#pragma unroll
      for (int r = 0; r < 9; ++r) acc[r] += sc[r * 1024 + kq * 128 + k] * wv;
    }
#pragma unroll
    for (int r = 0; r < 9; ++r) red[(kq * 9 + r) * 64 + col] = acc[r];
    __syncthreads();
    for (int idx = tid; idx < 576; idx += 512) {
      const int r = idx >> 6, cc = idx & 63;
      float s = p.mod_b[l * 6144 + n0 + cc];
#pragma unroll
      for (int q = 0; q < 8; ++q) s += red[(q * 9 + r) * 64 + cc];
      MOD[(size_t)(l * 9 + r) * 6144 + n0 + cc] = s;
    }
    __syncthreads();
  }
}

DEV void norm_phase(const Params& p, int l, int which, bf16_t* __restrict__ Hd, bool first, int nrows = T_ALL) {
  const float* g = (which ? p.norm2_g : p.norm1_g) + l * 1024;
  const float* MOD = (const float*)(p.ws + O_MOD);
  const int lane = ltid() & 63, w = ltid() >> 6;
  const int stride = gridDim.x * 8;
  f32x4 gg[4];
#pragma unroll
  for (int i = 0; i < 4; ++i) gg[i] = *(const f32x4*)(g + i * 256 + lane * 4);
  auto srcp = [&](int row) -> const float* {
    if (first) return row < T_LAT ? p.x + (size_t)row * DM : p.ctx + (size_t)(row - T_LAT) * DM;
    return xrow(p, row);
  };
  int row = blockIdx.x * 8 + w;
  f32x4 nv[4];
  if (row < nrows) {
    const float* s = srcp(row);
#pragma unroll
    for (int i = 0; i < 4; ++i) nv[i] = *(const f32x4*)(s + i * 256 + lane * 4);
  }
  for (; row < nrows; row += stride) {
    f32x4 v[4];
#pragma unroll
    for (int i = 0; i < 4; ++i) v[i] = nv[i];
    if (row + stride < nrows) {
      const float* s = srcp(row + stride);
#pragma unroll
      for (int i = 0; i < 4; ++i) nv[i] = *(const f32x4*)(s + i * 256 + lane * 4);
    }
    const float* md = MOD + (size_t)(l * 9 + modrow(row)) * 6144 + which * 3072;
    f32x4 sh[4], scl[4];
#pragma unroll
    for (int i = 0; i < 4; ++i) { sh[i] = *(const f32x4*)(md + i * 256 + lane * 4); scl[i] = *(const f32x4*)(md + 1024 + i * 256 + lane * 4); }
    float ss = 0.f;
#pragma unroll
    for (int i = 0; i < 4; ++i) ss += v[i][0] * v[i][0] + v[i][1] * v[i][1] + v[i][2] * v[i][2] + v[i][3] * v[i][3];
    const float rs = rsqrtf(wsum(ss) * (1.f / 1024.f) + 1e-6f);
#pragma unroll
    for (int i = 0; i < 4; ++i) {
      const int c = i * 256 + lane * 4;
      const f32x4 h = v[i] * rs * gg[i] * (scl[i] + 1.f) + sh[i];
      uint2 o;
      o.x = pk2(h[0], h[1]); o.y = pk2(h[2], h[3]);
      *(uint2*)(Hd + (size_t)row * DM + c) = o;
    }
  }
}

DEV void rope2(float a, float b, float ang, float& o0, float& o1) {
  const float cs = __cosf(ang), sn = __sinf(ang);
  o0 = a * cs - b * sn;
  o1 = a * sn + b * cs;
}
struct EpiIn {
  static constexpr bool PERM = true, AFTER_DRAIN = false;
  bf16_t *ZU, *ZQ, *ZK, *VT, *ZRW;
  DEV void operator()(const f32x4 (&acc)[2][2][4][2], const pg8::Unit& u, int wr, int wc, int fr, int fq) const {
    const int row0 = u.pm * 256 + wr * 64 + fr, cl = wc * 32 + 8 * fq, pn = u.pn;
    if (pn < 4) {
#pragma unroll
      for (int ai = 0; ai < 2; ++ai)
#pragma unroll
        for (int m = 0; m < 4; ++m) {
          const int row = row0 + ai * 128 + m * 16;
          const f32x4 a0 = acc[ai][0][m][0], a1 = acc[ai][0][m][1], b0 = acc[ai][1][m][0], b1 = acc[ai][1][m][1];
          u32x4 o;
          o[0] = pk2(a0[0] * sigmoidf_(b0[0]), a0[1] * sigmoidf_(b0[1]));
          o[1] = pk2(a0[2] * sigmoidf_(b0[2]), a0[3] * sigmoidf_(b0[3]));
          o[2] = pk2(a1[0] * sigmoidf_(b1[0]), a1[1] * sigmoidf_(b1[1]));
          o[3] = pk2(a1[2] * sigmoidf_(b1[2]), a1[3] * sigmoidf_(b1[3]));
          *(u32x4*)(ZU + (size_t)row * 512 + pn * 128 + cl) = o;
        }
    } else if (pn < 8) {
      const bool isq = pn < 6;
      bf16_t* Z = isq ? ZQ : ZK;
      const float qs = isq ? 0.125f * 1.4426950408889634f : 1.f;
      const int cbase = (pn - (isq ? 4 : 6)) * 256 + cl;
#pragma unroll
      for (int ai = 0; ai < 2; ++ai)
#pragma unroll
        for (int m = 0; m < 4; ++m) {
          const int row = row0 + ai * 128 + m * 16;
#pragma unroll
          for (int bj = 0; bj < 2; ++bj) {
            const int c = cbase + bj * 128;
            float v[8];
#pragma unroll
            for (int j = 0; j < 4; ++j) { v[j] = acc[ai][bj][m][0][j]; v[4 + j] = acc[ai][bj][m][1][j]; }
            if (row < T_LAT) {
              const int t = row & 4095, d = c & 63, p0 = d >> 1;
              const float pos = (float)((p0 < 16) ? (t >> 6) : (t & 63));
              const int fi = p0 & 15;
#pragma unroll
              for (int q = 0; q < 4; ++q) {
                const float fr_ = exp2f(-(float)(fi + q) * 0.8304820237218406f);
                float o0, o1;
                rope2(v[2 * q], v[2 * q + 1], pos * fr_, o0, o1);
                v[2 * q] = o0; v[2 * q + 1] = o1;
              }
            }
            u32x4 o;
            o[0] = pk2(v[0] * qs, v[1] * qs); o[1] = pk2(v[2] * qs, v[3] * qs);
            o[2] = pk2(v[4] * qs, v[5] * qs); o[3] = pk2(v[6] * qs, v[7] * qs);
            *(u32x4*)(Z + (size_t)row * 512 + c) = o;
          }
        }
    } else if (pn < 10) {
#pragma unroll
      for (int ai = 0; ai < 2; ++ai)
#pragma unroll
        for (int m = 0; m < 4; ++m) {
          const int row = row0 + ai * 128 + m * 16;
          int b, kidx;
          if (row < T_LAT) { b = row >> 12; kidx = 256 + (row & 4095); } else { b = (row - T_LAT) >> 8; kidx = (row - T_LAT) & 255; }
#pragma unroll
          for (int bj = 0; bj < 2; ++bj) {
            const int head = (pn - 8) * 2 + bj;
            bf16_t* dst = VT + ((size_t)((b * 4 + head) * 128 + cl)) * TK + kidx;
#pragma unroll
            for (int j = 0; j < 4; ++j) {
              dst[(size_t)j * TK] = f2bf(acc[ai][bj][m][0][j]);
              dst[(size_t)(4 + j) * TK] = f2bf(acc[ai][bj][m][1][j]);
            }
          }
        }
    } else {
#pragma unroll
      for (int ai = 0; ai < 2; ++ai)
#pragma unroll
        for (int m = 0; m < 4; ++m) {
          const int row = row0 + ai * 128 + m * 16;
#pragma unroll
          for (int bj = 0; bj < 2; ++bj) {
            const int c = (pn - 10) * 256 + bj * 128 + cl;
            if (c < 1920) {
              u32x4 o;
              o[0] = pk2(acc[ai][bj][m][0][0], acc[ai][bj][m][0][1]); o[1] = pk2(acc[ai][bj][m][0][2], acc[ai][bj][m][0][3]);
              o[2] = pk2(acc[ai][bj][m][1][0], acc[ai][bj][m][1][1]); o[3] = pk2(acc[ai][bj][m][1][2], acc[ai][bj][m][1][3]);
              *(u32x4*)(ZRW + (size_t)row * 1920 + c) = o;
            }
          }
        }
    }
  }
};
DEV void gemm_in_phase(const Params& p, char* smem) {
  EpiIn E;
  E.ZU = (bf16_t*)(p.ws + O_ZU); E.ZQ = (bf16_t*)(p.ws + O_ZQ); E.ZK = (bf16_t*)(p.ws + O_ZK);
  E.VT = (bf16_t*)(p.ws + O_VT); E.ZRW = (bf16_t*)(p.ws + O_ZRW);
  pg8::Gemm g;
  g.A = (const bf16_t*)(p.ws + O_H0); g.Bt = (const bf16_t*)(p.ws + O_WB + W_WIN); g.M = T_ALL; g.N = NZP; g.K = 1024;
  pg8::StaticOrder S;
  S.init(g.M, g.N, (int)gridDim.x, (int)blockIdx.x);
  __syncthreads();
  pg8::gemm_phase<EpiIn, pg8::StaticOrder>((PG8_LAS unsigned char*)smem, g, S, E);
  __syncthreads();
}

constexpr int KROW = 272, VROW = 144, ATT_ST = 64 * KROW + 128 * VROW;
constexpr int ATT2_ST = 2 * 128 * KROW;
DEV int key_of_slot(int x) { return (x & 0x13) | ((x & 8) >> 1) | ((x & 4) << 1); }

DEV void attn_tile(const Params& p, int l, int tile, char* smem, bool do_store = true) {
  bf16_t* ZQ = (bf16_t*)(p.ws + O_ZQ);
  const bf16_t* ZK = (const bf16_t*)(p.ws + O_ZK);
  const bf16_t* VT = (const bf16_t*)(p.ws + O_VT);
  int b, head, q0, nkeys, qbase;
  if (tile < 1024) { b = tile >> 7; head = (tile >> 5) & 3; q0 = (tile & 31) * 128; nkeys = TK; qbase = b * SEQ; }
  else { const int tt = tile - 1024; b = tt >> 3; head = (tt >> 1) & 3; q0 = (tt & 1) * 128; nkeys = CTXL; qbase = T_LAT + b * CTXL; }
  const int tid = ltid(), lane = tid & 63, w = tid >> 6, ql = lane & 31, hh = lane >> 5, map = w >> 2, qg = w & 3;
  const int qrow = qbase + q0 + qg * 32 + ql;
  const float lam_init = l == 0 ? 0.2f : 0.35550907f;
  float lam;
  {
    const float a1 = p.att_lq1[l * 64 + lane] * p.att_lk1[l * 64 + lane];
    const float a2 = p.att_lq2[l * 64 + lane] * p.att_lk2[l * 64 + lane];
    lam = __expf(wsum(a1)) - __expf(wsum(a2)) + lam_init;
  }
  bf16x8 qf[4];
#pragma unroll
  for (int s = 0; s < 4; ++s) qf[s] = *(const bf16x8*)(ZQ + (size_t)qrow * 512 + head * 128 + map * 64 + s * 16 + hh * 8);
  f32x16 o[4];
#pragma unroll
  for (int dt = 0; dt < 4; ++dt)
#pragma unroll
    for (int e = 0; e < 16; ++e) o[dt][e] = 0.f;
  float m = -1e30f, lsum = 0.f;
  const int kr0 = tid >> 4, kch = tid & 15;
  const int vr0 = tid >> 4, vch = tid & 15;
  const bf16_t* vtb = VT + ((size_t)((b * 4 + head) * 128)) * TK;
  u32x4 kreg[4], vreg[4];
  auto gload = [&](int kt) {
    const int k0 = kt * 128;
#pragma unroll
    for (int i = 0; i < 4; ++i) {
      const int kidx = k0 + kr0 + 32 * i;
      const int krow = kidx < CTXL ? T_LAT + b * CTXL + kidx : b * SEQ + kidx - CTXL;
      kreg[i] = *(const u32x4*)(ZK + (size_t)krow * 512 + head * 128 + kch * 8);
      vreg[i] = *(const u32x4*)(vtb + (size_t)(vr0 + 32 * i) * TK + k0 + vch * 8);
    }
  };
  auto lstore = [&](int st) {
    char* Ks = smem + st * ATT2_ST;
    char* Vs = Ks + 128 * KROW;
#pragma unroll
    for (int i = 0; i < 4; ++i) {
      *(u32x4*)(Ks + (kr0 + 32 * i) * KROW + kch * 16) = kreg[i];
      *(u32x4*)(Vs + (vr0 + 32 * i) * KROW + vch * 16) = vreg[i];
    }
  };
  const int nkt = nkeys >> 7;
  gload(0);
  __syncthreads();
  lstore(0);
  __syncthreads();
  const int kos = key_of_slot(ql);
  for (int kt = 0; kt < nkt; ++kt) {
    const int cur = kt & 1;
    if (kt + 1 < nkt) gload(kt + 1);
    const char* Ks = smem + cur * ATT2_ST;
    const char* Vs = Ks + 128 * KROW;
#pragma unroll
    for (int h2 = 0; h2 < 2; ++h2) {
    const char* kp = Ks + (h2 * 64 + kos) * KROW + (map * 64 + hh * 8) * 2;
    const char* vp = Vs + ql * KROW + hh * 16 + h2 * 128;
    bf16x8 kf0[4], kf1[4];
#pragma unroll
    for (int ks = 0; ks < 4; ++ks) { kf0[ks] = *(const bf16x8*)(kp + ks * 32); kf1[ks] = *(const bf16x8*)(kp + 32 * KROW + ks * 32); }
    f32x16 s0, s1;
#pragma unroll
    for (int e = 0; e < 16; ++e) { s0[e] = 0.f; s1[e] = 0.f; }
#pragma unroll
    for (int ks = 0; ks < 4; ++ks) s0 = __builtin_amdgcn_mfma_f32_32x32x16_bf16(kf0[ks], qf[ks], s0, 0, 0, 0);
#pragma unroll
    for (int ks = 0; ks < 4; ++ks) s1 = __builtin_amdgcn_mfma_f32_32x32x16_bf16(kf1[ks], qf[ks], s1, 0, 0, 0);
    bf16x8 vf[8];
#pragma unroll
    for (int dt = 0; dt < 4; ++dt)
#pragma unroll
      for (int k2 = 0; k2 < 2; ++k2) vf[dt * 2 + k2] = *(const bf16x8*)(vp + dt * 32 * KROW + (k2 * 16) * 2);
    float mx = fmaxf(s0[0], s1[0]);
#pragma unroll
    for (int e = 1; e < 16; ++e) mx = fmaxf(mx, fmaxf(s0[e], s1[e]));
    mx = xor32_max(mx);
    const float mnew = (mx > m + 8.f) ? mx : m;
    if (__any(mnew > m)) {
      const float alpha = __builtin_amdgcn_exp2f(m - mnew);
      lsum *= alpha;
#pragma unroll
      for (int dt = 0; dt < 4; ++dt)
#pragma unroll
        for (int e = 0; e < 16; ++e) o[dt][e] *= alpha;
    }
    m = mnew;
    bf16x8 pb0[2], pb1[2];
    {
      float pe[16];
#pragma unroll
      for (int e = 0; e < 16; ++e) { pe[e] = __builtin_amdgcn_exp2f(s0[e] - m); lsum += pe[e]; }
#pragma unroll
      for (int k2 = 0; k2 < 2; ++k2) {
        u32x4 u;
        u[0] = pk2(pe[8 * k2 + 0], pe[8 * k2 + 1]); u[1] = pk2(pe[8 * k2 + 2], pe[8 * k2 + 3]);
        u[2] = pk2(pe[8 * k2 + 4], pe[8 * k2 + 5]); u[3] = pk2(pe[8 * k2 + 6], pe[8 * k2 + 7]);
        pb0[k2] = __builtin_bit_cast(bf16x8, u);
      }
    }
#pragma unroll
    for (int dt = 0; dt < 4; ++dt)
#pragma unroll
      for (int k2 = 0; k2 < 2; ++k2) o[dt] = __builtin_amdgcn_mfma_f32_32x32x16_bf16(vf[dt * 2 + k2], pb0[k2], o[dt], 0, 0, 0);
#pragma unroll
    for (int dt = 0; dt < 4; ++dt)
#pragma unroll
      for (int k2 = 0; k2 < 2; ++k2) vf[dt * 2 + k2] = *(const bf16x8*)(vp + dt * 32 * KROW + (32 + k2 * 16) * 2);
    {
      float pe[16];
#pragma unroll
      for (int e = 0; e < 16; ++e) { pe[e] = __builtin_amdgcn_exp2f(s1[e] - m); lsum += pe[e]; }
#pragma unroll
      for (int k2 = 0; k2 < 2; ++k2) {
        u32x4 u;
        u[0] = pk2(pe[8 * k2 + 0], pe[8 * k2 + 1]); u[1] = pk2(pe[8 * k2 + 2], pe[8 * k2 + 3]);
        u[2] = pk2(pe[8 * k2 + 4], pe[8 * k2 + 5]); u[3] = pk2(pe[8 * k2 + 6], pe[8 * k2 + 7]);
        pb1[k2] = __builtin_bit_cast(bf16x8, u);
      }
    }
#pragma unroll
    for (int dt = 0; dt < 4; ++dt)
#pragma unroll
      for (int k2 = 0; k2 < 2; ++k2) o[dt] = __builtin_amdgcn_mfma_f32_32x32x16_bf16(vf[dt * 2 + k2], pb1[k2], o[dt], 0, 0, 0);
    }
    if (kt + 1 < nkt) lstore(cur ^ 1);
    __syncthreads();
  }
  const float ltot = xor32_sum(lsum);
  float* ex = (float*)smem;
  if (map == 1) {
    const float c2 = lam / ltot;
#pragma unroll
    for (int dt = 0; dt < 4; ++dt)
#pragma unroll
      for (int e = 0; e < 16; ++e) {
        const int dv = dt * 32 + 8 * (e >> 2) + 4 * hh + (e & 3);
        ex[(qg * 128 + dv) * 32 + ql] = o[dt][e] * c2;
      }
  }
  __syncthreads();
  if (map == 0 && do_store) {
    const float c1 = 1.f / ltot;
    float ss = 0.f;
#pragma unroll
    for (int dt = 0; dt < 4; ++dt)
#pragma unroll
      for (int e = 0; e < 16; ++e) {
        const int dv = dt * 32 + 8 * (e >> 2) + 4 * hh + (e & 3);
        const float v = o[dt][e] * c1 - ex[(qg * 128 + dv) * 32 + ql];
        o[dt][e] = v;
        ss += v * v;
      }
    ss = xor32_sum(ss);
    const float rs = rsqrtf(ss * (1.f / 128.f) + 1e-5f) * (1.f - lam_init);
    const float* sg = p.att_subln_g + l * 128;
#pragma unroll
    for (int dt = 0; dt < 4; ++dt)
#pragma unroll
      for (int i = 0; i < 4; ++i) {
        const int dv = dt * 32 + 8 * i + 4 * hh;
        const float4 g4 = *(const float4*)(sg + dv);
        uint2 u;
        u.x = pk2(o[dt][4 * i + 0] * rs * g4.x, o[dt][4 * i + 1] * rs * g4.y);
        u.y = pk2(o[dt][4 * i + 2] * rs * g4.z, o[dt][4 * i + 3] * rs * g4.w);
        *(uint2*)(ZQ + (size_t)qrow * 512 + head * 128 + dv) = u;
      }
  }
  __syncthreads();
}

DEV void conv_tile(const Params& p, int l, int tile, char* smem) {
  const bf16_t* ZU = (const bf16_t*)(p.ws + O_ZU);
  bf16_t* YCV = (bf16_t*)(p.ws + O_YCV);
  const int r0 = tile * 64;
  int s_lo, s_hi;
  if (r0 < T_LAT) { s_lo = r0 & ~4095; s_hi = s_lo + SEQ; } else { s_lo = T_LAT + ((r0 - T_LAT) & ~255); s_hi = s_lo + CTXL; }
  const int tid = ltid(), lane = tid & 63, w = tid >> 6, c0 = lane * 8;
  const int t0 = r0 + w * 8;
  const float* wp = p.conv_dw_w + (size_t)l * 31 * 512 + c0;
  float acc[8][8];
  {
    const f32x4 b0 = *(const f32x4*)(p.conv_dw_b + l * 512 + c0), b1 = *(const f32x4*)(p.conv_dw_b + l * 512 + c0 + 4);
#pragma unroll
    for (int t = 0; t < 8; ++t)
#pragma unroll
      for (int j = 0; j < 4; ++j) { acc[t][j] = b0[j]; acc[t][4 + j] = b1[j]; }
  }
  f32x4 wk[8][2];
#pragma unroll
  for (int q = 0; q < 8; ++q) { wk[q][0] = (f32x4){0.f, 0.f, 0.f, 0.f}; wk[q][1] = (f32x4){0.f, 0.f, 0.f, 0.f}; }
#pragma unroll 4
  for (int s = 0; s < 40; ++s) {
    const int rr = t0 - 15 + s;
    u32x4 uv = {0u, 0u, 0u, 0u};
    if (rr >= s_lo && rr < s_hi) uv = *(const u32x4*)(ZU + (size_t)rr * 512 + c0);
    float u[8];
#pragma unroll
    for (int q = 0; q < 4; ++q) { u[2 * q] = lo_bf(uv[q]); u[2 * q + 1] = hi_bf(uv[q]); }
#pragma unroll
    for (int q = 7; q > 0; --q) { wk[q][0] = wk[q - 1][0]; wk[q][1] = wk[q - 1][1]; }
    wk[0][0] = (f32x4){0.f, 0.f, 0.f, 0.f}; wk[0][1] = (f32x4){0.f, 0.f, 0.f, 0.f};
    if (s <= 30) { wk[0][0] = *(const f32x4*)(wp + s * 512); wk[0][1] = *(const f32x4*)(wp + s * 512 + 4); }
#pragma unroll
    for (int t = 0; t < 8; ++t) {
#pragma unroll
      for (int j = 0; j < 4; ++j) { acc[t][j] += wk[t][0][j] * u[j]; acc[t][4 + j] += wk[t][1][j] * u[4 + j]; }
    }
  }
  const f32x4 g0 = *(const f32x4*)(p.conv_ln_g + l * 512 + c0), g1 = *(const f32x4*)(p.conv_ln_g + l * 512 + c0 + 4);
  const f32x4 e0 = *(const f32x4*)(p.conv_ln_b + l * 512 + c0), e1 = *(const f32x4*)(p.conv_ln_b + l * 512 + c0 + 4);
#pragma unroll
  for (int t = 0; t < 8; ++t) {
    float s1 = 0.f;
#pragma unroll
    for (int j = 0; j < 8; ++j) s1 += acc[t][j];
    const float mu = wsum(s1) * (1.f / 512.f);
    float s2 = 0.f;
#pragma unroll
    for (int j = 0; j < 8; ++j) { acc[t][j] -= mu; s2 += acc[t][j] * acc[t][j]; }
    const float rs = rsqrtf(wsum(s2) * (1.f / 512.f) + 1e-5f);
    float y[8];
#pragma unroll
    for (int j = 0; j < 4; ++j) {
      const float z0 = acc[t][j] * rs * g0[j] + e0[j], z1 = acc[t][4 + j] * rs * g1[j] + e1[j];
      y[j] = z0 * sigmoidf_(z0); y[4 + j] = z1 * sigmoidf_(z1);
    }
    u32x4 o;
    o[0] = pk2(y[0], y[1]); o[1] = pk2(y[2], y[3]); o[2] = pk2(y[4], y[5]); o[3] = pk2(y[6], y[7]);
    *(u32x4*)(YCV + (size_t)(t0 + t) * 512 + c0) = o;
  }
}

DEV void shift_tile(const Params& p, int l, int tile) {
  const bf16_t* ZRW = (const bf16_t*)(p.ws + O_ZRW);
  bf16_t* ZRS = (bf16_t*)(p.ws + O_ZRS);
  const int r0 = tile * 32;
  int s_lo, s_hi;
  if (r0 < T_LAT) { s_lo = r0 & ~4095; s_hi = s_lo + SEQ; } else { s_lo = T_LAT + ((r0 - T_LAT) & ~255); s_hi = s_lo + CTXL; }
  const int tid = ltid();
  if (tid >= 480) return;
  const int half = tid >= 240 ? 1 : 0, ch = tid - half * 240, col = ch * 8;
  const int rb = r0 + half * 16;
  u32x4 rows[18];
#pragma unroll
  for (int i = 0; i < 18; ++i) {
    const int rr = rb - 1 + i;
    rows[i] = (u32x4){0u, 0u, 0u, 0u};
    if (rr >= s_lo && rr < s_hi) rows[i] = *(const u32x4*)(ZRW + (size_t)rr * 1920 + col);
  }
  const float* sw = p.rwkv_shift + (size_t)l * 3 * 1920 + col;
  float w0[8], w1[8], w2[8];
#pragma unroll
  for (int j = 0; j < 8; ++j) { w0[j] = sw[j]; w1[j] = sw[1920 + j]; w2[j] = sw[3840 + j]; }
  const int act = (col >= 1536 && col < 1664) ? 1 : (col >= 1792 ? 2 : 0);
#pragma unroll
  for (int i = 0; i < 16; ++i) {
    const int row = rb + i;
    const u32x4 pv = rows[i], cu = rows[i + 1], nx = rows[i + 2];
    float y[8];
#pragma unroll
    for (int q = 0; q < 4; ++q) {
      y[2 * q] = w0[2 * q] * lo_bf(pv[q]) + w1[2 * q] * lo_bf(cu[q]) + w2[2 * q] * lo_bf(nx[q]);
      y[2 * q + 1] = w0[2 * q + 1] * hi_bf(pv[q]) + w1[2 * q + 1] * hi_bf(cu[q]) + w2[2 * q + 1] * hi_bf(nx[q]);
    }
    if (act == 1) {
#pragma unroll
      for (int j = 0; j < 8; ++j) y[j] = 1.f - 2.f / (1.f + __expf(2.f * y[j]));
    } else if (act == 2) {
#pragma unroll
      for (int j = 0; j < 8; ++j) y[j] = sigmoidf_(y[j]);
    }
    u32x4 o;
    o[0] = pk2(y[0], y[1]); o[1] = pk2(y[2], y[3]); o[2] = pk2(y[4], y[5]); o[3] = pk2(y[6], y[7]);
    if (col < 1536) *(u32x4*)(ZRS + (size_t)row * 1536 + col) = o;
    else if (col < 1792) *(u32x4*)((bf16_t*)(p.ws + O_LIN) + (size_t)row * 256 + (col - 1536)) = o;
    else *(u32x4*)((bf16_t*)(p.ws + O_GIN) + (size_t)row * 128 + (col - 1792)) = o;
  }
}

DEV void branch_phase(const Params& p, int l, char* smem) {
  const bool last = (l == 1);
  for (int L = vblock(); L < 1088 + 544 + 1088; L += gridDim.x) {
    if (L < 1088) { if (!(last && L >= 1024)) attn_tile(p, l, L, smem); }
    else if (L < 1632) { if (!(last && L - 1088 >= 512)) conv_tile(p, l, L - 1088, smem); }
    else shift_tile(p, l, L - 1632);
  }
}

DEV void lora_phase(const Params& p, int l, char* smem, bool gjob) {
  const bf16_t* LIN = (const bf16_t*)(p.ws + O_LIN);
  const int lane = ltid() & 63, w = ltid() >> 6, wm = w >> 1, wn = w & 1, fr = lane & 15, fq = lane >> 4;
  const int ntile = gjob ? 544 : 4 * 544;
  for (int L = vblock(); L < ntile; L += gridDim.x) {
    const int job = gjob ? 4 : L / 544, t = L - (gjob ? 0 : job * 544), pm = t >> 2, pn = t & 3;
    const int row0 = pm * 256, col0 = pn * 128;
    const bf16_t* A;
    const bf16_t* Bt;
    bf16_t* O;
    int K = 64, lda = 256;
    const float* bias = nullptr;
    if (job == 0) { A = LIN; Bt = (const bf16_t*)(p.ws + O_WB + W_LW2); O = (bf16_t*)(p.ws + O_EF); bias = p.rwkv_w0 + (l * 2 + 0) * 512; }
    else if (job == 1) { A = LIN + 64; Bt = (const bf16_t*)(p.ws + O_WB + W_LW2) + 512 * 64; O = (bf16_t*)(p.ws + O_EB); bias = p.rwkv_w0 + (l * 2 + 1) * 512; }
    else if (job == 2) { A = LIN + 128; Bt = (const bf16_t*)(p.ws + O_WB + W_LA2); O = (bf16_t*)(p.ws + O_AF); bias = p.rwkv_a0 + (l * 2 + 0) * 512; }
    else if (job == 3) { A = LIN + 192; Bt = (const bf16_t*)(p.ws + O_WB + W_LA2) + 512 * 64; O = (bf16_t*)(p.ws + O_AB); bias = p.rwkv_a0 + (l * 2 + 1) * 512; }
    else { A = (const bf16_t*)(p.ws + O_GIN); Bt = (const bf16_t*)(p.ws + O_WB + W_LG2); O = (bf16_t*)(p.ws + O_G); K = 128; lda = 128; }
    f32x4 acc[4][4];
    zero_acc(acc);
    gemm_kloop(acc, A + (size_t)row0 * lda, lda, Bt + (size_t)col0 * K, K, K, smem);
#pragma unroll
    for (int mi = 0; mi < 4; ++mi) {
      const int row = row0 + wm * 64 + mi * 16 + fr;
#pragma unroll
      for (int ni = 0; ni < 4; ++ni) {
        const int c = col0 + wn * 64 + ni * 16 + fq * 4;
        float v[4];
#pragma unroll
        for (int j = 0; j < 4; ++j) {
          float z = acc[mi][ni][j];
          if (job < 4) z = sigmoidf_(z + bias[c + j]);
          if (job < 2) z *= 0.6065306597126334f;
          v[j] = z;
        }
        uint2 o;
        o.x = pk2(v[0], v[1]); o.y = pk2(v[2], v[3]);
        *(uint2*)(O + (size_t)row * 512 + c) = o;
      }
    }
  }
}

DEV void lora64_phase(const Params& p, int l, char* smem) {
  const bf16_t* LIN = (const bf16_t*)(p.ws + O_LIN);
  const int tid = ltid(), lane = tid & 63, w = tid >> 6, wm = w >> 1, wn = w & 1, fr = lane & 15, fq = lane >> 4;
  const int lrow = tid >> 3, lch = tid & 7;
  u32x4 ra[4], rb[2];
  auto issue = [&](int L) {
    const int job = L / 544, t = L - job * 544, pm = t >> 2, pn = t & 3;
    const bf16_t* A = LIN + job * 64 + (size_t)(pm * 256 + lrow) * 256 + lch * 8;
    const bf16_t* Bt = (const bf16_t*)(p.ws + O_WB + ((job & 2) ? W_LA2 : W_LW2)) + (job & 1) * 512 * 64 + (size_t)(pn * 128 + lrow) * 64 + lch * 8;
#pragma unroll
    for (int i = 0; i < 4; ++i) ra[i] = *(const u32x4*)(A + (size_t)(64 * i) * 256);
#pragma unroll
    for (int i = 0; i < 2; ++i) rb[i] = *(const u32x4*)(Bt + (size_t)(64 * i) * 64);
  };
  char* swa = smem + lrow * SROW + lch * 16;
  char* swb = swa + A_ST;
  const char* sra = smem + (wm * 64 + fr) * SROW + fq * 16;
  const char* srb = smem + A_ST + (wn * 64 + fr) * SROW + fq * 16;
  int L = vblock();
  if (L < 4 * 544) issue(L);
  for (; L < 4 * 544; L += gridDim.x) {
    const int job = L / 544, t = L - job * 544, pm = t >> 2, pn = t & 3;
    const int row0 = pm * 256, col0 = pn * 128;
    __syncthreads();
#pragma unroll
    for (int i = 0; i < 4; ++i) *(u32x4*)(swa + i * 64 * SROW) = ra[i];
#pragma unroll
    for (int i = 0; i < 2; ++i) *(u32x4*)(swb + i * 64 * SROW) = rb[i];
    __syncthreads();
    if (L + (int)gridDim.x < 4 * 544) issue(L + gridDim.x);
    f32x4 acc[4][4];
    zero_acc(acc);
#pragma unroll
    for (int ks = 0; ks < 2; ++ks) {
      bf16x8 af[4], bfr[4];
#pragma unroll
      for (int mi = 0; mi < 4; ++mi) af[mi] = *(const bf16x8*)(sra + mi * 16 * SROW + ks * 64);
#pragma unroll
      for (int ni = 0; ni < 4; ++ni) bfr[ni] = *(const bf16x8*)(srb + ni * 16 * SROW + ks * 64);
#pragma unroll
      for (int mi = 0; mi < 4; ++mi)
#pragma unroll
        for (int ni = 0; ni < 4; ++ni) acc[mi][ni] = __builtin_amdgcn_mfma_f32_16x16x32_bf16(bfr[ni], af[mi], acc[mi][ni], 0, 0, 0);
    }
    bf16_t* O = (bf16_t*)(p.ws + (job == 0 ? O_EF : (job == 1 ? O_EB : (job == 2 ? O_AF : O_AB))));
    const float* bias = ((job & 2) ? p.rwkv_a0 : p.rwkv_w0) + (l * 2 + (job & 1)) * 512;
    const float sc = job < 2 ? 0.6065306597126334f : 1.f;
#pragma unroll
    for (int mi = 0; mi < 4; ++mi) {
      const int row = row0 + wm * 64 + mi * 16 + fr;
#pragma unroll
      for (int ni = 0; ni < 4; ++ni) {
        const int c = col0 + wn * 64 + ni * 16 + fq * 4;
        const f32x4 z = acc[mi][ni] + *(const f32x4*)(bias + c);
        uint2 o;
        o.x = pk2(sc * sigmoidf_(z[0]), sc * sigmoidf_(z[1])); o.y = pk2(sc * sigmoidf_(z[2]), sc * sigmoidf_(z[3]));
        *(uint2*)(O + (size_t)row * 512 + c) = o;
      }
    }
  }
  __syncthreads();
}

DEV int scan_row(int step, int dir, int b) {
  if (step < CTXL) { const int t = dir ? (CTXL - 1 - step) : step; return T_LAT + b * CTXL + t; }
  const int s2 = step - CTXL;
  const int t = dir ? (SEQ - 1 - s2) : s2;
  return b * SEQ + t;
}
DEV float red8(float v) {
  v += dppf<0xB1>(v);
  v += dppf<0x4E>(v);
  v += dppf<0x141>(v);
  return v;
}
struct ScanOps { f32x4 nkk0, nkk1, w0, w1, kka0, kka1, kd0, kd1, r0, r1; float v; };
DEV void scan_tile(const Params& p, int l, int tile, char* smem) {
  const int half = tile & 1, dir = (tile >> 1) & 1, h = (tile >> 2) & 7, b = tile >> 5;
  float* arr = (float*)smem;
  float* ybuf = arr + 2 * 32 * 384;
  const bf16_t* ZRS = (const bf16_t*)(p.ws + O_ZRS);
  const bf16_t* E = (const bf16_t*)(p.ws + (dir ? O_EB : O_EF));
  const bf16_t* Aa = (const bf16_t*)(p.ws + (dir ? O_AB : O_AF));
  bf16_t* YS = (bf16_t*)(p.ws + (dir ? O_YSB : O_YSF));
  const int tid = ltid(), lane = tid & 63;
  const int w = __builtin_amdgcn_readfirstlane(tid >> 6);
  const int col = h * 64 + lane;
  const float kkp = p.rwkv_kk[l * 512 + col], kap = p.rwkv_ka[l * 512 + col];
  auto produce = [&](int ch, int buf, int pw, int npw) {
#pragma unroll
    for (int i0 = 0; i0 < 32; i0 += 4 * npw) {
      bf16_t rr[4], rk[4], rv[4], re[4], ra[4];
#pragma unroll
      for (int i = 0; i < 4; ++i) {
        const int R = scan_row(ch * 32 + i0 + pw + npw * i, dir, b);
        rr[i] = ZRS[(size_t)R * 1536 + col];
        rk[i] = ZRS[(size_t)R * 1536 + 512 + col];
        rv[i] = ZRS[(size_t)R * 1536 + 1024 + col];
        re[i] = E[(size_t)R * 512 + col];
        ra[i] = Aa[(size_t)R * 512 + col];
      }
#pragma unroll
      for (int i = 0; i < 4; ++i) {
        const int sl = i0 + pw + npw * i;
        const float r = bf2f(rr[i]), k = bf2f(rk[i]), v = bf2f(rv[i]), e = bf2f(re[i]), a = bf2f(ra[i]);
        const float kkv = k * kkp;
        const float inv = rsqrtf(fmaxf(wsum(kkv * kkv), 1e-24f));
        const float kk = kkv * inv;
        float* d = arr + (buf * 32 + sl) * 384 + lane;
        d[0] = -kk;
        d[64] = __expf(-e);
        d[128] = kk * a;
        d[192] = k * (1.f + (a - 1.f) * kap);
        d[256] = r;
        d[320] = v;
      }
    }
  };
  auto flush = [&](int ch, int buf, int t256) {
#pragma unroll
    for (int q = 0; q < 2; ++q) {
      const int idx = t256 + 256 * q, sl = idx >> 4, rp = (idx & 15) * 2;
      const int R = scan_row(ch * 32 + sl, dir, b);
      const float* yb = ybuf + buf * 1024 + sl * 32 + rp;
      *(unsigned*)(YS + (size_t)R * 512 + h * 64 + half * 32 + rp) = pk2(yb[0], yb[1]);
    }
  };
  __syncthreads();
  produce(0, 0, w, 8);
  __syncthreads();
  f32x4 S0 = {0.f, 0.f, 0.f, 0.f}, S1 = {0.f, 0.f, 0.f, 0.f};
  const int r8 = lane >> 3, cg = lane & 7;
  for (int ch = 0; ch < 136; ++ch) {
    const int buf = ch & 1;
    if (w < 4) {
      const float* cb = arr + buf * 32 * 384;
      const int vo = 320 + half * 32 + w * 8 + r8;
      float* yw = ybuf + buf * 1024 + cg * 32 + w * 8 + r8;
      auto ldops = [&](ScanOps& o, int sl) {
        const f32x4* b4 = (const f32x4*)(cb + sl * 384);
        o.nkk0 = b4[cg * 2]; o.nkk1 = b4[cg * 2 + 1];
        o.w0 = b4[16 + cg * 2]; o.w1 = b4[16 + cg * 2 + 1];
        o.kka0 = b4[32 + cg * 2]; o.kka1 = b4[32 + cg * 2 + 1];
        o.kd0 = b4[48 + cg * 2]; o.kd1 = b4[48 + cg * 2 + 1];
        o.r0 = b4[64 + cg * 2]; o.r1 = b4[64 + cg * 2 + 1];
        o.v = cb[sl * 384 + vo];
      };
      float ykeep = 0.f;
      auto step = [&](const ScanOps& o, int sl) {
        const f32x4 sA = S0 * o.nkk0 + S1 * o.nkk1;
        const float sa = red8((sA[0] + sA[1]) + (sA[2] + sA[3]));
        S0 = S0 * o.w0 + (o.kka0 * sa + o.kd0 * o.v);
        S1 = S1 * o.w1 + (o.kka1 * sa + o.kd1 * o.v);
        const f32x4 yA = S0 * o.r0 + S1 * o.r1;
        const float y = red8((yA[0] + yA[1]) + (yA[2] + yA[3]));
        ykeep = (cg == (sl & 7)) ? y : ykeep;
      };
      ScanOps oa, ob;
      ldops(oa, 0);
#pragma unroll
      for (int s8 = 0; s8 < 32; s8 += 8) {
#pragma unroll
        for (int q = 0; q < 8; q += 2) {
          ldops(ob, s8 + q + 1);
          step(oa, s8 + q);
          ldops(oa, (s8 + q + 2) & 31);
          step(ob, s8 + q + 1);
        }
        yw[s8 * 32] = ykeep;
      }
    } else {
      const int pw = w - 4;
      if (ch > 0) flush(ch - 1, buf ^ 1, tid - 256);
      if (ch + 1 < 136) produce(ch + 1, buf ^ 1, pw, 4);
    }
    __syncthreads();
  }
  if (w >= 4) flush(135, 1, tid - 256);
  __syncthreads();
}
DEV void scan_phase(const Params& p, int l, char* smem) {
  for (int L = blockIdx.x; L < 256; L += gridDim.x) scan_tile(p, l, L, smem);
}

DEV void unpack8(const u32x4 u, float (&f)[8]) {
#pragma unroll
  for (int q = 0; q < 4; ++q) { f[2 * q] = lo_bf(u[q]); f[2 * q + 1] = hi_bf(u[q]); }
}
DEV void post_phase(const Params& p, int l, int nrows) {
  const bf16_t* ZRS = (const bf16_t*)(p.ws + O_ZRS);
  const bf16_t* AF = (const bf16_t*)(p.ws + O_AF);
  const bf16_t* AB = (const bf16_t*)(p.ws + O_AB);
  const bf16_t* G = (const bf16_t*)(p.ws + O_G);
  bf16_t* YSF = (bf16_t*)(p.ws + O_YSF);
  const bf16_t* YSB = (const bf16_t*)(p.ws + O_YSB);
  const int lane = ltid() & 63, w = ltid() >> 6, c0 = lane * 8;
  float gng[8], gnb[8], kaw[8], rkw[8];
#pragma unroll
  for (int j = 0; j < 8; ++j) {
    gng[j] = p.rwkv_gn_g[l * 512 + c0 + j]; gnb[j] = p.rwkv_gn_b[l * 512 + c0 + j];
    kaw[j] = p.rwkv_ka[l * 512 + c0 + j]; rkw[j] = p.rwkv_rk[l * 512 + c0 + j];
  }
  const int stride = gridDim.x * 8;
  int row = blockIdx.x * 8 + w;
  u32x4 q_ysf, q_ysb, q_r, q_k, q_v, q_af, q_ab, q_g;
  auto gl = [&](int rw) {
    q_ysf = *(const u32x4*)(YSF + (size_t)rw * 512 + c0); q_ysb = *(const u32x4*)(YSB + (size_t)rw * 512 + c0);
    q_r = *(const u32x4*)(ZRS + (size_t)rw * 1536 + c0); q_k = *(const u32x4*)(ZRS + (size_t)rw * 1536 + 512 + c0);
    q_v = *(const u32x4*)(ZRS + (size_t)rw * 1536 + 1024 + c0);
    q_af = *(const u32x4*)(AF + (size_t)rw * 512 + c0); q_ab = *(const u32x4*)(AB + (size_t)rw * 512 + c0);
    q_g = *(const u32x4*)(G + (size_t)rw * 512 + c0);
  };
  if (row < nrows) gl(row);
  for (; row < nrows; row += stride) {
    float ysf[8], ysb[8], r[8], k[8], v[8], af[8], ab[8], g[8];
    unpack8(q_ysf, ysf); unpack8(q_ysb, ysb); unpack8(q_r, r); unpack8(q_k, k); unpack8(q_v, v);
    unpack8(q_af, af); unpack8(q_ab, ab); unpack8(q_g, g);
    if (row + stride < nrows) gl(row + stride);
    float ys[8], s1 = 0.f, bp = 0.f;
#pragma unroll
    for (int j = 0; j < 8; ++j) {
      ys[j] = ysf[j] + ysb[j]; s1 += ys[j];
      bp += r[j] * k[j] * rkw[j] * (2.f + (af[j] + ab[j] - 2.f) * kaw[j]);
    }
    const float mu = red8(s1) * (1.f / 64.f);
    const float bon = red8(bp);
    float s2 = 0.f;
#pragma unroll
    for (int j = 0; j < 8; ++j) { ys[j] -= mu; s2 += ys[j] * ys[j]; }
    const float rs = rsqrtf(red8(s2) * (1.f / 64.f) + 64e-5f);
    float o[8];
#pragma unroll
    for (int j = 0; j < 8; ++j) o[j] = (ys[j] * rs * gng[j] + gnb[j] + bon * v[j]) * g[j];
    u32x4 ov;
    ov[0] = pk2(o[0], o[1]); ov[1] = pk2(o[2], o[3]); ov[2] = pk2(o[4], o[5]); ov[3] = pk2(o[6], o[7]);
    *(u32x4*)(YSF + (size_t)row * 512 + c0) = ov;
  }
}

struct EpiGate {
  static constexpr bool PERM = true, AFTER_DRAIN = false;
  char* ws;
  DEV void operator()(const f32x4 (&acc)[2][2][4][2], const pg8::Unit& u, int wr, int wc, int fr, int fq) const {
    const int b = u.pn >> 2, pn = u.pn & 3;
    bf16_t* G = (bf16_t*)(ws + (b == 0 ? O_G1 : (b == 1 ? O_G2 : O_G3)));
    const int row0 = u.pm * 256 + wr * 64 + fr, col0 = pn * 256 + wc * 32 + 8 * fq;
#pragma unroll
    for (int ai = 0; ai < 2; ++ai)
#pragma unroll
      for (int m = 0; m < 4; ++m) {
        const int row = row0 + ai * 128 + m * 16;
#pragma unroll
        for (int bj = 0; bj < 2; ++bj) {
          const f32x4 a0 = acc[ai][bj][m][0], a1 = acc[ai][bj][m][1];
          u32x4 o;
          o[0] = pk2(sigmoidf_(a0[0]), sigmoidf_(a0[1])); o[1] = pk2(sigmoidf_(a0[2]), sigmoidf_(a0[3]));
          o[2] = pk2(sigmoidf_(a1[0]), sigmoidf_(a1[1])); o[3] = pk2(sigmoidf_(a1[2]), sigmoidf_(a1[3]));
          *(u32x4*)(G + (size_t)row * DM + col0 + bj * 128) = o;
        }
      }
  }
};
DEV void gate_phase(const Params& p, int nrows, char* smem) {
  EpiGate E;
  E.ws = p.ws;
  pg8::Gemm g;
  g.A = (const bf16_t*)(p.ws + O_HM); g.Bt = (const bf16_t*)(p.ws + O_WB + W_WIN) + (size_t)NZP * 1024; g.M = nrows; g.N = 3072; g.K = 1024;
  pg8::StaticOrder S;
  S.init(g.M, g.N, (int)gridDim.x, (int)blockIdx.x);
  __syncthreads();
  pg8::gemm_phase<EpiGate, pg8::StaticOrder>((PG8_LAS unsigned char*)smem, g, S, E);
  __syncthreads();
}
struct MergeOrder {
  pg8::StaticOrder base;
  DEV bool next(int i, pg8::Unit& u) const {
    const int j = i / 3, b = i - 3 * j;
    pg8::Unit t;
    if (!base.next(j, t)) return false;
    u.pm = t.pm + 136 * (b == 0 ? 11 : (b == 1 ? 12 : 6));
    u.pn = t.pn + 4 * b;
    return true;
  }
  DEV void a_ready(const pg8::Unit&) const {}
  DEV void done(const pg8::Unit&) const {}
};
struct EpiMerge {
  static constexpr bool PERM = true, AFTER_DRAIN = false;
  char* ws;
  DEV void operator()(const f32x4 (&acc)[2][2][4][2], const pg8::Unit& u, int wr, int wc, int fr, int fq) const {
    const int b = u.pn >> 2, pn = u.pn & 3, pm = u.pm - 136 * (b == 0 ? 11 : (b == 1 ? 12 : 6));
    const bf16_t* G = (const bf16_t*)(ws + (b == 0 ? O_G1 : (b == 1 ? O_G2 : O_G3)));
    bf16_t* M = (bf16_t*)(ws + O_M);
    const int row0 = pm * 256 + wr * 64 + fr, col0 = pn * 256 + wc * 32 + 8 * fq;
#pragma unroll
    for (int ai = 0; ai < 2; ++ai)
#pragma unroll
      for (int m = 0; m < 4; ++m) {
        const int row = row0 + ai * 128 + m * 16;
#pragma unroll
        for (int bj = 0; bj < 2; ++bj) {
          const size_t off = (size_t)row * DM + col0 + bj * 128;
          const u32x4 gv = *(const u32x4*)(G + off);
          u32x4 mv = {0u, 0u, 0u, 0u};
          if (b > 0) mv = *(const u32x4*)(M + off);
          const f32x4 a0 = acc[ai][bj][m][0], a1 = acc[ai][bj][m][1];
          u32x4 o;
          o[0] = pk2(lo_bf(mv[0]) + lo_bf(gv[0]) * a0[0], hi_bf(mv[0]) + hi_bf(gv[0]) * a0[1]);
          o[1] = pk2(lo_bf(mv[1]) + lo_bf(gv[1]) * a0[2], hi_bf(mv[1]) + hi_bf(gv[1]) * a0[3]);
          o[2] = pk2(lo_bf(mv[2]) + lo_bf(gv[2]) * a1[0], hi_bf(mv[2]) + hi_bf(gv[2]) * a1[1]);
          o[3] = pk2(lo_bf(mv[3]) + lo_bf(gv[3]) * a1[2], hi_bf(mv[3]) + hi_bf(gv[3]) * a1[3]);
          *(u32x4*)(M + off) = o;
        }
      }
  }
};
DEV void merge_phase(const Params& p, int nrows, char* smem) {
  EpiMerge E;
  E.ws = p.ws;
  pg8::Gemm g;
  g.A = (const bf16_t*)p.ws; g.Bt = (const bf16_t*)(p.ws + O_WB + W_PCV); g.M = nrows; g.N = 1024; g.K = 512;
  MergeOrder S;
  S.base.init(g.M, g.N, (int)gridDim.x, (int)blockIdx.x);
  __syncthreads();
  pg8::gemm_phase<EpiMerge, MergeOrder>((PG8_LAS unsigned char*)smem, g, S, E);
  __syncthreads();
}

struct EpiResid {
  static constexpr bool PERM = false, AFTER_DRAIN = false;
  float* out; float* xc; const float* rin_lat; const float* rin_ctx; const float* mod; bool store;
  DEV void operator()(const f32x4 (&acc)[2][2][4][2], const pg8::Unit& u, int wr, int wc, int fr, int fq) const {
    const int row0 = u.pm * 256 + wr * 64 + fr, col0 = u.pn * 256 + wc * 32 + 4 * fq;
#pragma unroll
    for (int ai = 0; ai < 2; ++ai)
#pragma unroll
      for (int m = 0; m < 4; ++m) {
        const int row = row0 + ai * 128 + m * 16;
        float* xr = row < T_LAT ? out + (size_t)row * DM : xc + (size_t)(row - T_LAT) * DM;
        const float* xi = row < T_LAT ? rin_lat + (size_t)row * DM : rin_ctx + (size_t)(row - T_LAT) * DM;
        const float* gt = mod + (size_t)modrow(row) * 6144;
#pragma unroll
        for (int bj = 0; bj < 2; ++bj)
#pragma unroll
          for (int n = 0; n < 2; ++n) {
            const int c = col0 + bj * 128 + n * 16;
            const f32x4 g4 = *(const f32x4*)(gt + c);
            f32x4 xv = *(const f32x4*)(xi + c);
            xv += g4 * acc[ai][bj][m][n];
            if (store) *(f32x4*)(xr + c) = xv;
          }
      }
  }
};
DEV void resid_gemm_phase(const Params& p, int l, const bf16_t* A, int K, const bf16_t* Wt, int goff, int nrows, char* smem, bool from_inputs = false) {
  EpiResid E;
  E.store = true;
  E.rin_lat = from_inputs ? p.x : p.out; E.rin_ctx = from_inputs ? p.ctx : (const float*)(p.ws + O_XC);
  E.out = p.out; E.xc = (float*)(p.ws + O_XC); E.mod = (const float*)(p.ws + O_MOD) + (size_t)l * 9 * 6144 + goff;
  pg8::Gemm g;
  g.A = A; g.Bt = Wt; g.M = nrows; g.N = 1024; g.K = K;
  pg8::StaticOrder S;
  S.init(g.M, g.N, (int)gridDim.x, (int)blockIdx.x);
  __syncthreads();
  pg8::gemm_phase<EpiResid, pg8::StaticOrder>((PG8_LAS unsigned char*)smem, g, S, E);
  __syncthreads();
}

struct EpiMlp1 {
  static constexpr bool PERM = true, AFTER_DRAIN = false;
  bf16_t* HID;
  DEV void operator()(const f32x4 (&acc)[2][2][4][2], const pg8::Unit& u, int wr, int wc, int fr, int fq) const {
    const int row0 = u.pm * 256 + wr * 64 + fr, col0 = u.pn * 256 + wc * 32 + 8 * fq;
#pragma unroll
    for (int ai = 0; ai < 2; ++ai)
#pragma unroll
      for (int m = 0; m < 4; ++m) {
        const int row = row0 + ai * 128 + m * 16;
#pragma unroll
        for (int bj = 0; bj < 2; ++bj) {
          float v[8];
#pragma unroll
          for (int j = 0; j < 4; ++j) {
            const float r0 = fmaxf(acc[ai][bj][m][0][j], 0.f), r1 = fmaxf(acc[ai][bj][m][1][j], 0.f);
            v[j] = r0 * r0; v[4 + j] = r1 * r1;
          }
          u32x4 o;
          o[0] = pk2(v[0], v[1]); o[1] = pk2(v[2], v[3]); o[2] = pk2(v[4], v[5]); o[3] = pk2(v[6], v[7]);
          *(u32x4*)(HID + (size_t)row * 4096 + col0 + bj * 128) = o;
        }
      }
  }
};
DEV void mlp1_phase(const Params& p, int nrows, char* smem) {
  EpiMlp1 E;
  E.HID = (bf16_t*)(p.ws + O_HID);
  pg8::Gemm g;
  g.A = (const bf16_t*)(p.ws + O_HM); g.Bt = (const bf16_t*)(p.ws + O_WB + W_W1); g.M = nrows; g.N = 4096; g.K = 1024;
  pg8::StaticOrder S;
  S.init(g.M, g.N, (int)gridDim.x, (int)blockIdx.x);
  __syncthreads();
  pg8::gemm_phase<EpiMlp1, pg8::StaticOrder>((PG8_LAS unsigned char*)smem, g, S, E);
  __syncthreads();
}

DEV void final_phase(const Params& p) {
  const int lane = ltid() & 63, w = ltid() >> 6;
  const int stride = gridDim.x * 8;
  f32x4 g[4];
#pragma unroll
  for (int i = 0; i < 4; ++i) g[i] = *(const f32x4*)(p.final_g + i * 256 + lane * 4);
  int row = blockIdx.x * 8 + w;
  f32x4 nv[4];
  if (row < T_LAT) {
#pragma unroll
    for (int i = 0; i < 4; ++i) nv[i] = *(const f32x4*)(p.out + (size_t)row * DM + i * 256 + lane * 4);
  }
  for (; row < T_LAT; row += stride) {
    float* xr = p.out + (size_t)row * DM;
    f32x4 v[4];
#pragma unroll
    for (int i = 0; i < 4; ++i) v[i] = nv[i];
    if (row + stride < T_LAT) {
#pragma unroll
      for (int i = 0; i < 4; ++i) nv[i] = *(const f32x4*)(p.out + (size_t)(row + stride) * DM + i * 256 + lane * 4);
    }
    float ss = 0.f;
#pragma unroll
    for (int i = 0; i < 4; ++i) ss += v[i][0] * v[i][0] + v[i][1] * v[i][1] + v[i][2] * v[i][2] + v[i][3] * v[i][3];
    const float rs = rsqrtf(wsum(ss) * (1.f / 1024.f) + 1e-6f);
#pragma unroll
    for (int i = 0; i < 4; ++i) *(f32x4*)(xr + i * 256 + lane * 4) = v[i] * rs * g[i];
  }
}

constexpr int N_PHASES = 26;
__global__ void __launch_bounds__(512) fwd_megakernel(Params p, int ph_lo, int ph_hi) {
  extern __shared__ __attribute__((aligned(16))) char smem[];
  cg::grid_group grid = cg::this_grid();
  volatile XLAS unsigned* st = (volatile XLAS unsigned*)(smem + 139264);
  if (threadIdx.x == 0) { st[0] = 0u; st[1] = 0u; st[2] = 0u; st[3] = 0u; }
  __syncthreads();
  const XcdBarrier xb = xcd_barrier_post((unsigned*)(p.ws + O_BAR), st);
  if (ph_hi > 1000) grid.sync();
  for (int ph = ph_lo; ph < ph_hi; ++ph) {
    if (ph == 0) {
      cvt_phase(p, 0, smem);
      mod_phase(p, smem);
    } else if (ph == N_PHASES - 1) {
      final_phase(p);
    } else {
      const int l = (ph - 1) / 12, sp = (ph - 1) % 12;
      const int nrows = (l == 1) ? T_LAT : T_ALL;
      switch (sp) {
        case 0:
          if (l > 0) cvt_phase(p, l, smem);
          norm_phase(p, l, 0, (bf16_t*)(p.ws + O_H0), l == 0);
          break;
        case 1: gemm_in_phase(p, smem); break;
        case 2: branch_phase(p, l, smem); break;
        case 3:
          lora64_phase(p, l, smem);
          lora_phase(p, l, smem, true);
          break;
        case 4: scan_phase(p, l, smem); break;
        case 5:
          post_phase(p, l, nrows);
          norm_phase(p, l, 0, (bf16_t*)(p.ws + O_HM), l == 0, nrows);
          break;
        case 6: gate_phase(p, nrows, smem); break;
        case 7: merge_phase(p, nrows, smem); break;
        case 8: resid_gemm_phase(p, l, (const bf16_t*)(p.ws + O_M), 1024, (const bf16_t*)(p.ws + O_WB + W_WOUT), 2048, nrows, smem, l == 0); break;
        case 9: norm_phase(p, l, 1, (bf16_t*)(p.ws + O_HM), false, nrows); break;
        case 10: mlp1_phase(p, nrows, smem); break;
        case 11: resid_gemm_phase(p, l, (const bf16_t*)(p.ws + O_HID), 4096, (const bf16_t*)(p.ws + O_WB + W_W2), 5120, nrows, smem); break;
      }
    }
    if (ph + 1 < ph_hi) xcd_barrier(xb);
  }
}

extern "C" void kernel_launch(void* const* d_in, const int* in_sizes, int n_in, void* d_out, int out_size, void* d_ws,
                              size_t ws_size, hipStream_t stream) {
  Params p{};
  const float** pp = (const float**)&p;
  for (int i = 0; i < 36; ++i) pp[i] = (const float*)d_in[i];
  p.out = (float*)d_out;
  p.ws = (char*)d_ws;
  static int grid_blocks = 0;
  if (!grid_blocks) {
    hipFuncSetAttribute((const void*)fwd_megakernel, hipFuncAttributeMaxDynamicSharedMemorySize, LDS_BYTES);
    int dev = 0, cus = 0, per_cu = 0;
    hipGetDevice(&dev);
    hipDeviceGetAttribute(&cus, hipDeviceAttributeMultiprocessorCount, dev);
    hipOccupancyMaxActiveBlocksPerMultiprocessor(&per_cu, fwd_megakernel, 512, LDS_BYTES);
    if (per_cu < 1) per_cu = 1;
    grid_blocks = cus * per_cu;
    grid_blocks &= ~7;
  }
  if (ws_size < WS_NEED) fprintf(stderr, "workspace too small: %zu < %zu\n", ws_size, (size_t)WS_NEED);
#ifndef MULTI_LAUNCH
#define MULTI_LAUNCH 0
#endif
#if MULTI_LAUNCH
  for (int ph = 0; ph < N_PHASES; ++ph)
    hipLaunchKernelGGL(fwd_megakernel, dim3(grid_blocks), dim3(512), LDS_BYTES, stream, p, ph, ph + 1);
#else
  hipMemsetAsync((char*)d_ws + O_BAR, 0, 16384, stream);
  int lo = 0, hi = N_PHASES;
  void* args[] = {&p, &lo, &hi};
  hipError_t e = hipLaunchCooperativeKernel((const void*)fwd_megakernel, dim3(grid_blocks), dim3(512), args, LDS_BYTES, stream);
  if (e != hipSuccess) fprintf(stderr, "cooperative launch failed: %s (grid %d)\n", hipGetErrorString(e), grid_blocks);
#endif
}
```

```cpp
#include <hip/hip_runtime.h>
#include <hip/hip_cooperative_groups.h>
#include <cstdio>
namespace cg = cooperative_groups;

typedef unsigned short bf16_t;
typedef short bf16x8 __attribute__((ext_vector_type(8)));
typedef float f32x4 __attribute__((ext_vector_type(4)));
typedef float f32x16 __attribute__((ext_vector_type(16)));
typedef unsigned u32x4 __attribute__((ext_vector_type(4)));
#define DEV __device__ __forceinline__
#define PROBE 0

constexpr int T_LAT = 32768, T_ALL = 34816, DM = 1024, DIN = 7552, NZ = 4480, NZP = 4608, DINT = 7680;
constexpr int SEQ = 4096, CTXL = 256, TK = 4352;
constexpr size_t U = 35651584ull;
constexpr size_t O_ZU = 0, O_ZK = U, O_VT = 2 * U, O_ZRW = 3 * U, O_ZRS = 7 * U, O_LIN = 10 * U, O_YCV = 11 * U, O_ZQ = 12 * U;
constexpr size_t O_H0 = 7 * U;
constexpr size_t O_EF = 0, O_EB = 3 * U, O_AF = 4 * U, O_AB = 5 * U, O_G = 2 * U, O_YSF = 6 * U, O_YSB = 10 * U;
constexpr size_t O_HM = 0, O_M = 0, O_HID = 3 * U;
constexpr size_t O_G1 = 3 * U, O_G2 = 7 * U, O_G3 = 9 * U;
constexpr size_t O_WB = 13 * U;
constexpr size_t W_WIN = 0, W_PCV = W_WIN + (size_t)DINT * 1024 * 2, W_PAT = W_PCV + 1048576, W_PRW = W_PAT + 1048576,
                 W_WOUT = W_PRW + 1048576, W_W1 = W_WOUT + 2097152, W_W2 = W_W1 + 8388608, W_LW2 = W_W2 + 8388608,
                 W_LA2 = W_LW2 + 131072, W_LG2 = W_LA2 + 131072, W_END = W_LG2 + 131072;
constexpr size_t O_XC = O_WB + W_END;
constexpr size_t O_MOD = O_XC + 8388608;
constexpr size_t O_BAR = O_MOD + 2 * 9 * 6144 * 4;
constexpr size_t O_GIN = O_BAR + 16384;
constexpr size_t WS_NEED = O_GIN + (size_t)T_ALL * 128 * 2;

constexpr int LDS_BYTES = 139264 + 16;

struct Params {
  const float *x, *c, *ctx, *c_ctx, *mod_w, *mod_b, *norm1_g, *norm2_g, *w_in, *conv_dw_w, *conv_dw_b, *conv_ln_g,
      *conv_ln_b, *p_conv, *att_lq1, *att_lk1, *att_lq2, *att_lk2, *att_subln_g, *p_att, *rwkv_shift, *rwkv_w0, *rwkv_w2,
      *rwkv_a0, *rwkv_a2, *rwkv_g2, *rwkv_kk, *rwkv_ka, *rwkv_rk, *rwkv_gn_g, *rwkv_gn_b, *p_rwkv, *w_out, *mlp_w1,
      *mlp_w2, *final_g;
  float* out;
  char* ws;
};

DEV int ltid() { int t = threadIdx.x; asm volatile("" : "+v"(t)); return t; }
DEV float bf2f(bf16_t h) { return __uint_as_float(((unsigned)h) << 16); }
typedef float f32x2_t __attribute__((ext_vector_type(2)));
typedef __bf16 bf16x2_t __attribute__((ext_vector_type(2)));
DEV unsigned pk2(float lo, float hi) {
  const f32x2_t v = {lo, hi};
  return __builtin_bit_cast(unsigned, __builtin_convertvector(v, bf16x2_t));
}
DEV bf16_t f2bf(float f) { return (bf16_t)(pk2(f, 0.f) & 0xffffu); }
DEV float lo_bf(unsigned u) { return __uint_as_float(u << 16); }
DEV float hi_bf(unsigned u) { return __uint_as_float(u & 0xffff0000u); }
template <int C> DEV float dppf(float v) {
  return __int_as_float(__builtin_amdgcn_update_dpp(0, __float_as_int(v), C, 0xF, 0xF, true));
}
DEV float xor32_sum(float v) {
  const auto r = __builtin_amdgcn_permlane32_swap(__float_as_uint(v), __float_as_uint(v), false, false);
  return __uint_as_float(r[0]) + __uint_as_float(r[1]);
}
DEV float xor32_max(float v) {
  const auto r = __builtin_amdgcn_permlane32_swap(__float_as_uint(v), __float_as_uint(v), false, false);
  return fmaxf(__uint_as_float(r[0]), __uint_as_float(r[1]));
}
DEV float xor16_sum(float v) {
  const auto r = __builtin_amdgcn_permlane16_swap(__float_as_uint(v), __float_as_uint(v), false, false);
  return __uint_as_float(r[0]) + __uint_as_float(r[1]);
}
DEV float wsum(float v) {
  v += dppf<0xB1>(v);
  v += dppf<0x4E>(v);
  v += dppf<0x141>(v);
  v += dppf<0x140>(v);
  v = xor16_sum(v);
  return xor32_sum(v);
}
DEV float sigmoidf_(float x) { return __builtin_amdgcn_rcpf(1.f + __expf(-x)); }
DEV float red16(float v) {
  v += dppf<0xB1>(v);
  v += dppf<0x4E>(v);
  v += dppf<0x141>(v);
  v += dppf<0x140>(v);
  return v;
}
DEV int vblock() { const int per = gridDim.x >> 3; return (blockIdx.x & 7) * per + (blockIdx.x >> 3); }
DEV float* xrow(const Params& p, int row) {
  return row < T_LAT ? p.out + (size_t)row * DM : (float*)(p.ws + O_XC) + (size_t)(row - T_LAT) * DM;
}
DEV int modrow(int row) { return row < T_LAT ? (row >> 12) : 8; }

#define XB_TMO      128
#define XB_XCNT(j)  (256  + 64 * (j))
#define XB_XSUB(j)  (1280 + 64 * (j))
#define XB_XGEN(j)  (2304 + 64 * (j))
#define XB_TOP      3328
#define XB_TOPGEN   3392
#define XCD_BAR_WORDS 3456
#define XB_SPIN_CAP (1u << 18)
#define XLAS __attribute__((address_space(3)))

__device__ __forceinline__ unsigned xb_ld(unsigned* p)              { return __hip_atomic_load(p, __ATOMIC_RELAXED, __HIP_MEMORY_SCOPE_AGENT); }
__device__ __forceinline__ unsigned xb_add(unsigned* p, unsigned v) { return __hip_atomic_fetch_add(p, v, __ATOMIC_RELAXED, __HIP_MEMORY_SCOPE_AGENT); }
__device__ __forceinline__ unsigned xb_xcc_id() { return (unsigned)__builtin_amdgcn_s_getreg((3 << 11) | 20) & 0xFu; }
#define XB_SPIN(cond, bar) do { unsigned _sp = 0; while (cond) { __builtin_amdgcn_s_sleep(1); \
    if ((++_sp & 255u) == 0u) { if (xb_ld(&(bar)[XB_TMO])) break; if (_sp > XB_SPIN_CAP) { atomicAdd(&(bar)[XB_TMO], 1u); break; } } } } while (0)

struct XcdBarrier {
    unsigned* bar; unsigned x;
    volatile XLAS unsigned* st;
};

__device__ __forceinline__ XcdBarrier xcd_barrier_post(unsigned* bar, volatile XLAS unsigned* st) {
    XcdBarrier b; b.bar = bar; b.x = xb_xcc_id(); b.st = st;
    if (threadIdx.x == 0) (void)xb_add(&bar[XB_XCNT(b.x)], 1u);
    return b;
}
__device__ __forceinline__ void xcd_barrier_complete(unsigned* bar, unsigned x, unsigned& nloc, unsigned& nx) {
    const unsigned G = gridDim.x * gridDim.y * gridDim.z;
    unsigned sum, cnt, mine, sp = 0u;
    for (;;) {
        sum = 0u; cnt = 0u; mine = 0u;
#pragma unroll
        for (unsigned j = 0; j < 16; ++j) { const unsigned c = xb_ld(&bar[XB_XCNT(j)]); sum += c; cnt += (c > 0u) ? 1u : 0u; mine = (j == x) ? c : mine; }
        if (sum == G) break;
        __builtin_amdgcn_s_sleep(1);
        if ((++sp & 255u) == 0u) { if (xb_ld(&bar[XB_TMO])) break; if (sp > XB_SPIN_CAP) { atomicAdd(&bar[XB_TMO], 1u); break; } }
    }
    nloc = mine > 0u ? mine : 1u; nx = cnt > 0u ? cnt : 1u;
}

__device__ __forceinline__ void xcd_barrier(const XcdBarrier& b) {
    asm volatile("s_waitcnt vmcnt(0)" ::: "memory");
    __syncthreads();
    if (threadIdx.x == 0) {
        unsigned* bar = b.bar;
        __builtin_amdgcn_s_waitcnt(0);
        unsigned nloc = b.st[0], nx = b.st[1];
        if (nloc == 0u) { xcd_barrier_complete(bar, b.x, nloc, nx); b.st[0] = nloc; b.st[1] = nx; }
        const unsigned old = xb_add(&bar[XB_XSUB(b.x)], 1u);
        const unsigned gen = old / nloc;
        if (old + 1u == (gen + 1u) * nloc) {
            __builtin_amdgcn_fence(__ATOMIC_RELEASE, "agent");
            asm volatile("s_waitcnt vmcnt(0)" ::: "memory");
            const unsigned og = xb_add(&bar[XB_TOP], 1u);
            const unsigned tg = og / nx;
            if (og + 1u == (tg + 1u) * nx) xb_add(&bar[XB_TOPGEN], 1u);
            else XB_SPIN(xb_ld(&bar[XB_TOPGEN]) == tg, bar);
            __builtin_amdgcn_fence(__ATOMIC_ACQUIRE, "agent");
            xb_add(&bar[XB_XGEN(b.x)], 1u);
            asm volatile("s_waitcnt vmcnt(0)" ::: "memory");
        } else {
            XB_SPIN(xb_ld(&bar[XB_XGEN(b.x)]) == gen, bar);
            __builtin_amdgcn_fence(__ATOMIC_ACQUIRE, "agent");
            asm volatile("s_waitcnt vmcnt(0)" ::: "memory");
        }
    }
    __syncthreads();
}

namespace pg8 {
#define PG8_LAS __attribute__((address_space(3)))
constexpr int BM = 256, BK = 64, HALF = 128, HTB = HALF * BK * 2, STAGE_BYTES = 8 * HTB, NXCD = 8, WGM = 4;
__host__ __device__ __forceinline__ int lds_byte(int r, int c) { const int st = (r >> 4) * 2 + (c >> 5), rr = r & 15, cc = c & 31, ob = rr * 64 + cc * 2; return st * 1024 + (ob ^ (((ob >> 9) & 1) << 5)); }
__host__ __device__ __forceinline__ void stage_rc(int b, int& R, int& C) { const int st = b / 1024, sb = b % 1024, swz = sb ^ (((sb >> 9) & 1) << 5); R = (st >> 1) * 16 + swz / 64; C = (st & 1) * 32 + (swz % 64) / 2; }
__host__ __device__ __forceinline__ int perm32(int rho) { const int n = rho >> 4, i = rho & 15; return 8 * (i >> 2) + 4 * n + (i & 3); }
struct Unit { int pm, pn; };
struct Gemm { const bf16_t* A; const bf16_t* Bt; int M, N, K; };
struct StaticOrder {
    int nM, nN, nwg, G, c;
    __host__ __device__ void init(int M, int N, int G_, int c_) { nM = M / BM; nN = N / BM; nwg = nM * nN; G = G_; c = c_; }
    __host__ __device__ bool next(int i, Unit& u) const {
        const long L = (long)i * G + c; if (L >= nwg) return false;
        int wgid = (int)L; { const int q = nwg / NXCD, r = nwg % NXCD, xcd = wgid % NXCD, off = wgid / NXCD; wgid = (xcd < r ? xcd * (q + 1) : r * (q + 1) + (xcd - r) * q) + off; }
        const int nig = WGM * nN, gid = wgid / nig, fm = gid * WGM, gsz = (nM - fm) < WGM ? (nM - fm) : WGM;
        u.pm = fm + ((wgid % nig) % gsz); u.pn = (wgid % nig) / gsz; return true;
    }
    __device__ __forceinline__ void a_ready(const Unit&) const {}
    __device__ __forceinline__ void done(const Unit&) const {}
};

template <class Epi, class Sched>
__device__ __forceinline__ void gemm_phase(PG8_LAS unsigned char* lds, const Gemm g, const Sched& S, const Epi& E) {
    const int tid = ltid(), wid = __builtin_amdgcn_readfirstlane(tid >> 6), lane = tid & 63, wr = wid >> 2, wc = wid & 3, fr = lane & 15, fq = lane >> 4;
    const int K = g.K, nt = K / BK;
    unsigned voffA[2], voffB[2];
#pragma unroll
    for (int i = 0; i < 2; ++i) { int R, C; stage_rc(tid * 16 + i * 8192, R, C); const int Rb = Epi::PERM ? ((R & ~31) + perm32(R & 31)) : R;
        voffA[i] = (unsigned)(R * K + C) * 2u; voffB[i] = (unsigned)(Rb * K + C) * 2u; }
    const size_t kstep = (size_t)(BK * 2);
    const size_t hstep = (size_t)HALF * K * 2;
    const size_t tstep = 2 * hstep;
    const unsigned ldsw = (unsigned)wid * 1024u;
    const int aoff = lds_byte(wr * 64 + fr, fq * 8), boff = lds_byte(wc * 32 + fr, fq * 8);
#define PG8_SA(b, h) (((b) * 2 + (h)) * HTB)
#define PG8_SB(b, h) ((4 + (b) * 2 + (h)) * HTB)
#define PG8_STAGE(bufoff, gbase, voff) do { _Pragma("unroll") for (int _i = 0; _i < 2; ++_i) \
        __builtin_amdgcn_global_load_lds((const unsigned*)((const char*)(gbase) + (voff)[_i]), (PG8_LAS unsigned*)(lds + (bufoff) + ldsw + _i * 8192), 16, 0, 0); } while (0)
#define PG8_LDA(dst, b, h) do { _Pragma("unroll") for (int m = 0; m < 4; ++m) _Pragma("unroll") for (int k = 0; k < 2; ++k) dst[m][k] = *(const PG8_LAS bf16x8*)(lds + PG8_SA(b, h) + aoff + m * 2048 + k * 1024); } while (0)
#define PG8_LDB(dst, b, h) do { _Pragma("unroll") for (int n = 0; n < 2; ++n) _Pragma("unroll") for (int k = 0; k < 2; ++k) dst[n][k] = *(const PG8_LAS bf16x8*)(lds + PG8_SB(b, h) + boff + n * 2048 + k * 1024); } while (0)
#define PG8_MMA(ai, bj, At, Bt) do { __builtin_amdgcn_s_setprio(1); _Pragma("unroll") for (int m = 0; m < 4; ++m) _Pragma("unroll") for (int n = 0; n < 2; ++n) _Pragma("unroll") for (int k = 0; k < 2; ++k) \
        acc[ai][bj][m][n] = __builtin_amdgcn_mfma_f32_16x16x32_bf16(Bt[n][k], At[m][k], acc[ai][bj][m][n], 0, 0, 0); __builtin_amdgcn_s_setprio(0); } while (0)
#define PG8_WAIT_V(n) asm volatile("s_waitcnt vmcnt(" #n ")" ::: "memory")
#define PG8_WAIT_L(n) asm volatile("s_waitcnt lgkmcnt(" #n ")" ::: "memory")
#define PG8_BAR __builtin_amdgcn_s_barrier()
#define PG8_SCHED __builtin_amdgcn_sched_barrier(0)
    Unit cur, nxt; int ui = 0;
    if (!S.next(0, cur)) return;
    f32x4 acc[2][2][4][2];
#pragma unroll
    for (int a = 0; a < 2; ++a)
#pragma unroll
        for (int b = 0; b < 2; ++b)
#pragma unroll
            for (int m = 0; m < 4; ++m)
#pragma unroll
                for (int n = 0; n < 2; ++n) acc[a][b][m][n] = (f32x4){0.f, 0.f, 0.f, 0.f};
    bf16x8 At[4][2], B0[2][2], B1[2][2];
    const char* cA = (const char*)g.A + (size_t)cur.pm * tstep; const char* cB = (const char*)g.Bt + (size_t)cur.pn * tstep;
    S.a_ready(cur);
    PG8_STAGE(PG8_SB(0, 0), cB, voffB); PG8_STAGE(PG8_SA(0, 0), cA, voffA); PG8_STAGE(PG8_SB(0, 1), cB + hstep, voffB); PG8_STAGE(PG8_SA(0, 1), cA + hstep, voffA);
    if (wr == 1) PG8_BAR;
    PG8_WAIT_V(4); PG8_BAR;
    PG8_STAGE(PG8_SB(1, 0), cB + kstep, voffB); PG8_STAGE(PG8_SA(1, 0), cA + kstep, voffA); PG8_STAGE(PG8_SB(1, 1), cB + hstep + kstep, voffB);
    PG8_WAIT_V(6); PG8_BAR;
    for (;;) {
        const bool has_next = S.next(ui + 1, nxt);
        const char* nA = has_next ? (const char*)g.A + (size_t)nxt.pm * tstep : cA; const char* nB = has_next ? (const char*)g.Bt + (size_t)nxt.pn * tstep : cB;
        for (int t = 0; t < nt; t += 2) {
            const bool last = (t == nt - 2);
            const char* a1 = cA + (size_t)(t + 1) * kstep;
            const char* a2 = last ? nA : cA + (size_t)(t + 2) * kstep; const char* b2 = last ? nB : cB + (size_t)(t + 2) * kstep;
            const char* a3 = a2 + kstep; const char* b3 = b2 + kstep;
            if (last && has_next) S.a_ready(nxt);
            PG8_LDB(B0, 0, 0); PG8_SCHED; PG8_LDA(At, 0, 0); PG8_STAGE(PG8_SA(1, 1), a1 + hstep, voffA);
            PG8_WAIT_L(8); PG8_BAR; PG8_WAIT_L(0); PG8_MMA(0, 0, At, B0); PG8_BAR; PG8_SCHED;
            PG8_LDB(B1, 0, 1); PG8_STAGE(PG8_SB(0, 0), b2, voffB);
            PG8_BAR; PG8_WAIT_L(0); PG8_MMA(0, 1, At, B1); PG8_BAR;
            PG8_LDA(At, 0, 1); PG8_STAGE(PG8_SA(0, 0), a2, voffA);
            PG8_BAR; PG8_WAIT_L(0); PG8_MMA(1, 0, At, B0); PG8_BAR; PG8_SCHED;
            PG8_STAGE(PG8_SB(0, 1), b2 + hstep, voffB);
            PG8_WAIT_V(6); PG8_BAR; PG8_MMA(1, 1, At, B1); PG8_BAR;
            PG8_LDB(B0, 1, 0); PG8_SCHED; PG8_LDA(At, 1, 0); PG8_STAGE(PG8_SA(0, 1), a2 + hstep, voffA);
            PG8_WAIT_L(8); PG8_BAR; PG8_WAIT_L(0); PG8_MMA(0, 0, At, B0); PG8_BAR; PG8_SCHED;
            PG8_LDB(B1, 1, 1); PG8_STAGE(PG8_SB(1, 0), b3, voffB);
            PG8_BAR; PG8_WAIT_L(0); PG8_MMA(0, 1, At, B1); PG8_BAR;
            PG8_LDA(At, 1, 1); PG8_STAGE(PG8_SA(1, 0), a3, voffA);
            PG8_BAR; PG8_WAIT_L(0); PG8_MMA(1, 0, At, B0); PG8_BAR; PG8_SCHED;
            PG8_STAGE(PG8_SB(1, 1), b3 + hstep, voffB);
            PG8_WAIT_V(6); PG8_BAR; PG8_MMA(1, 1, At, B1); PG8_BAR;
        }
        if constexpr (!Epi::AFTER_DRAIN) { E(acc, cur, wr, wc, fr, fq); S.done(cur); }
        if (!has_next) break;
#pragma unroll
        for (int a = 0; a < 2; ++a)
#pragma unroll
            for (int b = 0; b < 2; ++b)
#pragma unroll
                for (int m = 0; m < 4; ++m)
#pragma unroll
                    for (int n = 0; n < 2; ++n) acc[a][b][m][n] = (f32x4){0.f, 0.f, 0.f, 0.f};
        cur = nxt; cA = nA; cB = nB; ++ui;
    }
    PG8_WAIT_V(0);
    if (wr == 0) PG8_BAR;
    PG8_BAR;
    if constexpr (Epi::AFTER_DRAIN) { E.fused(acc, cur, wr, wc, fr, fq, lds, wid, lane); S.done(cur); }
#undef PG8_SA
#undef PG8_SB
#undef PG8_STAGE
#undef PG8_LDA
#undef PG8_LDB
#undef PG8_MMA
#undef PG8_WAIT_V
#undef PG8_WAIT_L
#undef PG8_BAR
#undef PG8_SCHED
}

}

constexpr int SROW = 144;
constexpr int A_ST = 256 * SROW, B_ST = 128 * SROW, ST_BYTES = A_ST + B_ST;

DEV void gemm_kloop(f32x4 (&acc)[4][4], const bf16_t* __restrict__ A, int lda, const bf16_t* __restrict__ Bt, int ldb,
                    int K, char* smem) {
  const int tid = ltid(), lane = tid & 63, w = tid >> 6, wm = w >> 1, wn = w & 1;
  const int fr = lane & 15, fq = lane >> 4;
  const int lrow = tid >> 3, lch = tid & 7;
  const bf16_t* ga = A + (size_t)lrow * lda + lch * 8;
  const bf16_t* gb = Bt + (size_t)lrow * ldb + lch * 8;
  u32x4 ra[4], rb[2];
#pragma unroll
  for (int i = 0; i < 4; ++i) ra[i] = *(const u32x4*)(ga + (size_t)(64 * i) * lda);
#pragma unroll
  for (int i = 0; i < 2; ++i) rb[i] = *(const u32x4*)(gb + (size_t)(64 * i) * ldb);
  char* swa = smem + lrow * SROW + lch * 16;
  char* swb = swa + A_ST;
  __syncthreads();
#pragma unroll
  for (int i = 0; i < 4; ++i) *(u32x4*)(swa + i * 64 * SROW) = ra[i];
#pragma unroll
  for (int i = 0; i < 2; ++i) *(u32x4*)(swb + i * 64 * SROW) = rb[i];
  __syncthreads();
  const int nk = K >> 6;
  const char* sra = smem + (wm * 64 + fr) * SROW + fq * 16;
  const char* srb = smem + A_ST + (wn * 64 + fr) * SROW + fq * 16;
  for (int kt = 0; kt < nk; ++kt) {
    const int cur = kt & 1;
    if (kt + 1 < nk) {
#pragma unroll
      for (int i = 0; i < 4; ++i) ra[i] = *(const u32x4*)(ga + (size_t)(64 * i) * lda + (kt + 1) * 64);
#pragma unroll
      for (int i = 0; i < 2; ++i) rb[i] = *(const u32x4*)(gb + (size_t)(64 * i) * ldb + (kt + 1) * 64);
    }
#pragma unroll
    for (int ks = 0; ks < 2; ++ks) {
      bf16x8 af[4], bfr[4];
#pragma unroll
      for (int mi = 0; mi < 4; ++mi) af[mi] = *(const bf16x8*)(sra + cur * ST_BYTES + mi * 16 * SROW + ks * 64);
#pragma unroll
      for (int ni = 0; ni < 4; ++ni) bfr[ni] = *(const bf16x8*)(srb + cur * ST_BYTES + ni * 16 * SROW + ks * 64);
#pragma unroll
      for (int mi = 0; mi < 4; ++mi)
#pragma unroll
        for (int ni = 0; ni < 4; ++ni)
          acc[mi][ni] = __builtin_amdgcn_mfma_f32_16x16x32_bf16(bfr[ni], af[mi], acc[mi][ni], 0, 0, 0);
    }
    if (kt + 1 < nk) {
      const int nx = cur ^ 1;
#pragma unroll
      for (int i = 0; i < 4; ++i) *(u32x4*)(swa + nx * ST_BYTES + i * 64 * SROW) = ra[i];
#pragma unroll
      for (int i = 0; i < 2; ++i) *(u32x4*)(swb + nx * ST_BYTES + i * 64 * SROW) = rb[i];
    }
    __syncthreads();
  }
}
DEV void zero_acc(f32x4 (&acc)[4][4]) {
#pragma unroll
  for (int a = 0; a < 4; ++a)
#pragma unroll
    for (int b = 0; b < 4; ++b) acc[a][b] = (f32x4){0.f, 0.f, 0.f, 0.f};
}
DEV void tile_pm_pn(int L, int nN, int& pm, int& pn) {
  const int g = L / (4 * nN), wi = L % (4 * nN);
  pm = g * 4 + (wi & 3);
  pn = wi >> 2;
}

DEV int conv_srccol(int n) {
  const int tile = n >> 8, w = n & 255;
  return w < 128 ? tile * 128 + w : 512 + tile * 128 + (w - 128);
}
DEV void cvt_job(const float* __restrict__ src, int K, int N, int ldsrc, bf16_t* __restrict__ dst, int nperm, int& tbase, char* smem) {
  float* lds = (float*)smem;
  const int nkt = K >> 6, nnt = N >> 6, cnt = nkt * nnt;
  const int G = gridDim.x;
  const int first = (int)((blockIdx.x + G - (tbase % G)) % G);
  const int tid = ltid();
  for (int t = first; t < cnt; t += G) {
    const int kt = t % nkt, nt = t / nkt;
    const int ty = tid >> 4, tx = tid & 15;
    const int n = nt * 64 + tx * 4;
    const int sc = (n < nperm) ? conv_srccol(n) : n;
#pragma unroll
    for (int i = 0; i < 2; ++i) {
      const int k = ty + 32 * i;
      const float4 v = *(const float4*)(src + (size_t)(kt * 64 + k) * ldsrc + sc);
      float* d = lds + k * 65 + tx * 4;
      d[0] = v.x; d[1] = v.y; d[2] = v.z; d[3] = v.w;
    }
    __syncthreads();
    {
      const int nn = tid >> 3, kc = tid & 7;
      float v[8];
#pragma unroll
      for (int j = 0; j < 8; ++j) v[j] = lds[(kc * 8 + j) * 65 + nn];
      uint4 o;
      o.x = pk2(v[0], v[1]); o.y = pk2(v[2], v[3]); o.z = pk2(v[4], v[5]); o.w = pk2(v[6], v[7]);
      *(uint4*)(dst + (size_t)(nt * 64 + nn) * K + kt * 64 + kc * 8) = o;
    }
    __syncthreads();
  }
  tbase += cnt;
}
DEV void cvt_phase(const Params& p, int l, char* smem) {
  char* wb = p.ws + O_WB;
  int tb = 0;
  const float* win = p.w_in + (size_t)l * 1024 * DIN;
  cvt_job(win, 1024, NZ, DIN, (bf16_t*)(wb + W_WIN), 1024, tb, smem);
  cvt_job(win + NZ, 1024, 3072, DIN, (bf16_t*)(wb + W_WIN) + (size_t)NZP * 1024, 0, tb, smem);
  cvt_job(p.mlp_w1 + (size_t)l * 1024 * 4096, 1024, 4096, 4096, (bf16_t*)(wb + W_W1), 0, tb, smem);
  cvt_job(p.mlp_w2 + (size_t)l * 4096 * 1024, 4096, 1024, 1024, (bf16_t*)(wb + W_W2), 0, tb, smem);
  cvt_job(p.w_out + (size_t)l * 1024 * 1024, 1024, 1024, 1024, (bf16_t*)(wb + W_WOUT), 0, tb, smem);
  cvt_job(p.p_conv + (size_t)l * 512 * 1024, 512, 1024, 1024, (bf16_t*)(wb + W_PCV), 0, tb, smem);
  cvt_job(p.p_att + (size_t)l * 512 * 1024, 512, 1024, 1024, (bf16_t*)(wb + W_PAT), 0, tb, smem);
  cvt_job(p.p_rwkv + (size_t)l * 512 * 1024, 512, 1024, 1024, (bf16_t*)(wb + W_PRW), 0, tb, smem);
  for (int d = 0; d < 2; ++d) {
    cvt_job(p.rwkv_w2 + (size_t)(l * 2 + d) * 64 * 512, 64, 512, 512, (bf16_t*)(wb + W_LW2) + d * 512 * 64, 0, tb, smem);
    cvt_job(p.rwkv_a2 + (size_t)(l * 2 + d) * 64 * 512, 64, 512, 512, (bf16_t*)(wb + W_LA2) + d * 512 * 64, 0, tb, smem);
  }
  cvt_job(p.rwkv_g2 + (size_t)l * 128 * 512, 128, 512, 512, (bf16_t*)(wb + W_LG2), 0, tb, smem);
}

DEV void mod_phase(const Params& p, char* smem) {
  float* sc = (float*)smem;
  float* red = sc + 9 * 1024;
  float* MOD = (float*)(p.ws + O_MOD);
  const int tid = ltid();
  if ((int)blockIdx.x >= 192) return;
  for (int i = tid; i < 9 * 1024; i += 512) {
    const int r = i >> 10, k = i & 1023;
    const float v = r < 8 ? p.c[r * 1024 + k] : p.c_ctx[k];
    sc[i] = v / (1.f + __expf(-v));
  }
  __syncthreads();
  for (int tile = blockIdx.x; tile < 192; tile += gridDim.x) {
    const int l = tile / 96, n0 = (tile % 96) * 64;
    const int kq = tid >> 6, col = tid & 63;
    float acc[9];
#pragma unroll
    for (int r = 0; r < 9; ++r) acc[r] = 0.f;
    const float* wp = p.mod_w + ((size_t)l * 1024 + kq * 128) * 6144 + n0 + col;
#pragma unroll 32
    for (int k = 0; k < 128; ++k) {
      const float wv = wp[(size_t)k * 6144];
#pragma unroll
      for (int r = 0; r < 9; ++r) acc[r] += sc[r * 1024 + kq * 128 + k] * wv;
    }
#pragma unroll
    for (int r = 0; r < 9; ++r) red[(kq * 9 + r) * 64 + col] = acc[r];
    __syncthreads();
    for (int idx = tid; idx < 576; idx += 512) {
      const int r = idx >> 6, cc = idx & 63;
      float s = p.mod_b[l * 6144 + n0 + cc];
#pragma unroll
      for (int q = 0; q < 8; ++q) s += red[(q * 9 + r) * 64 + cc];
      MOD[(size_t)(l * 9 + r) * 6144 + n0 + cc] = s;
    }
    __syncthreads();
  }
}

DEV void norm_phase(const Params& p, int l, int which, bf16_t* __restrict__ Hd, bool first, int nrows = T_ALL) {
  const float* g = (which ? p.norm2_g : p.norm1_g) + l * 1024;
  const float* MOD = (const float*)(p.ws + O_MOD);
  const int lane = ltid() & 63, w = ltid() >> 6;
  const int stride = gridDim.x * 8;
  f32x4 gg[4];
#pragma unroll
  for (int i = 0; i < 4; ++i) gg[i] = *(const f32x4*)(g + i * 256 + lane * 4);
  auto srcp = [&](int row) -> const float* {
    if (first) return row < T_LAT ? p.x + (size_t)row * DM : p.ctx + (size_t)(row - T_LAT) * DM;
    return xrow(p, row);
  };
  int row = blockIdx.x * 8 + w;
  f32x4 nv[4];
  if (row < nrows) {
    const float* s = srcp(row);
#pragma unroll
    for (int i = 0; i < 4; ++i) nv[i] = *(const f32x4*)(s + i * 256 + lane * 4);
  }
  for (; row < nrows; row += stride) {
    f32x4 v[4];
#pragma unroll
    for (int i = 0; i < 4; ++i) v[i] = nv[i];
    if (row + stride < nrows) {
      const float* s = srcp(row + stride);
#pragma unroll
      for (int i = 0; i < 4; ++i) nv[i] = *(const f32x4*)(s + i * 256 + lane * 4);
    }
    const float* md = MOD + (size_t)(l * 9 + modrow(row)) * 6144 + which * 3072;
    f32x4 sh[4], scl[4];
#pragma unroll
    for (int i = 0; i < 4; ++i) { sh[i] = *(const f32x4*)(md + i * 256 + lane * 4); scl[i] = *(const f32x4*)(md + 1024 + i * 256 + lane * 4); }
    float ss = 0.f;
#pragma unroll
    for (int i = 0; i < 4; ++i) ss += v[i][0] * v[i][0] + v[i][1] * v[i][1] + v[i][2] * v[i][2] + v[i][3] * v[i][3];
    const float rs = rsqrtf(wsum(ss) * (1.f / 1024.f) + 1e-6f);
#pragma unroll
    for (int i = 0; i < 4; ++i) {
      const int c = i * 256 + lane * 4;
      const f32x4 h = v[i] * rs * gg[i] * (scl[i] + 1.f) + sh[i];
      uint2 o;
      o.x = pk2(h[0], h[1]); o.y = pk2(h[2], h[3]);
      *(uint2*)(Hd + (size_t)row * DM + c) = o;
    }
  }
}

DEV void rope2(float a, float b, float ang, float& o0, float& o1) {
  const float cs = __cosf(ang), sn = __sinf(ang);
  o0 = a * cs - b * sn;
  o1 = a * sn + b * cs;
}
struct EpiIn {
  static constexpr bool PERM = true, AFTER_DRAIN = false;
  bf16_t *ZU, *ZQ, *ZK, *VT, *ZRW;
  DEV void operator()(const f32x4 (&acc)[2][2][4][2], const pg8::Unit& u, int wr, int wc, int fr, int fq) const {
    const int row0 = u.pm * 256 + wr * 64 + fr, cl = wc * 32 + 8 * fq, pn = u.pn;
    if (pn < 4) {
#pragma unroll
      for (int ai = 0; ai < 2; ++ai)
#pragma unroll
        for (int m = 0; m < 4; ++m) {
          const int row = row0 + ai * 128 + m * 16;
          const f32x4 a0 = acc[ai][0][m][0], a1 = acc[ai][0][m][1], b0 = acc[ai][1][m][0], b1 = acc[ai][1][m][1];
          u32x4 o;
          o[0] = pk2(a0[0] * sigmoidf_(b0[0]), a0[1] * sigmoidf_(b0[1]));
          o[1] = pk2(a0[2] * sigmoidf_(b0[2]), a0[3] * sigmoidf_(b0[3]));
          o[2] = pk2(a1[0] * sigmoidf_(b1[0]), a1[1] * sigmoidf_(b1[1]));
          o[3] = pk2(a1[2] * sigmoidf_(b1[2]), a1[3] * sigmoidf_(b1[3]));
          *(u32x4*)(ZU + (size_t)row * 512 + pn * 128 + cl) = o;
        }
    } else if (pn < 8) {
      const bool isq = pn < 6;
      bf16_t* Z = isq ? ZQ : ZK;
      const float qs = isq ? 0.125f * 1.4426950408889634f : 1.f;
      const int cbase = (pn - (isq ? 4 : 6)) * 256 + cl;
#pragma unroll
      for (int ai = 0; ai < 2; ++ai)
#pragma unroll
        for (int m = 0; m < 4; ++m) {
          const int row = row0 + ai * 128 + m * 16;
#pragma unroll
          for (int bj = 0; bj < 2; ++bj) {
            const int c = cbase + bj * 128;
            float v[8];
#pragma unroll
            for (int j = 0; j < 4; ++j) { v[j] = acc[ai][bj][m][0][j]; v[4 + j] = acc[ai][bj][m][1][j]; }
            if (row < T_LAT) {
              const int t = row & 4095, d = c & 63, p0 = d >> 1;
              const float pos = (float)((p0 < 16) ? (t >> 6) : (t & 63));
              const int fi = p0 & 15;
#pragma unroll
              for (int q = 0; q < 4; ++q) {
                const float fr_ = exp2f(-(float)(fi + q) * 0.8304820237218406f);
                float o0, o1;
                rope2(v[2 * q], v[2 * q + 1], pos * fr_, o0, o1);
                v[2 * q] = o0; v[2 * q + 1] = o1;
              }
            }
            u32x4 o;
            o[0] = pk2(v[0] * qs, v[1] * qs); o[1] = pk2(v[2] * qs, v[3] * qs);
            o[2] = pk2(v[4] * qs, v[5] * qs); o[3] = pk2(v[6] * qs, v[7] * qs);
            *(u32x4*)(Z + (size_t)row * 512 + c) = o;
          }
        }
    } else if (pn < 10) {
#pragma unroll
      for (int ai = 0; ai < 2; ++ai)
#pragma unroll
        for (int m = 0; m < 4; ++m) {
          const int row = row0 + ai * 128 + m * 16;
          int b, kidx;
          if (row < T_LAT) { b = row >> 12; kidx = 256 + (row & 4095); } else { b = (row - T_LAT) >> 8; kidx = (row - T_LAT) & 255; }
#pragma unroll
          for (int bj = 0; bj < 2; ++bj) {
            const int head = (pn - 8) * 2 + bj;
            bf16_t* dst = VT + ((size_t)((b * 4 + head) * 128 + cl)) * TK + kidx;
#pragma unroll
            for (int j = 0; j < 4; ++j) {
              dst[(size_t)j * TK] = f2bf(acc[ai][bj][m][0][j]);
              dst[(size_t)(4 + j) * TK] = f2bf(acc[ai][bj][m][1][j]);
            }
          }
        }
    } else {
#pragma unroll
      for (int ai = 0; ai < 2; ++ai)
#pragma unroll
        for (int m = 0; m < 4; ++m) {
          const int row = row0 + ai * 128 + m * 16;
#pragma unroll
          for (int bj = 0; bj < 2; ++bj) {
            const int c = (pn - 10) * 256 + bj * 128 + cl;
            if (c < 1920) {
              u32x4 o;
              o[0] = pk2(acc[ai][bj][m][0][0], acc[ai][bj][m][0][1]); o[1] = pk2(acc[ai][bj][m][0][2], acc[ai][bj][m][0][3]);
              o[2] = pk2(acc[ai][bj][m][1][0], acc[ai][bj][m][1][1]); o[3] = pk2(acc[ai][bj][m][1][2], acc[ai][bj][m][1][3]);
              *(u32x4*)(ZRW + (size_t)row * 1920 + c) = o;
            }
          }
        }
    }
  }
};
DEV void gemm_in_phase(const Params& p, char* smem) {
  EpiIn E;
  E.ZU = (bf16_t*)(p.ws + O_ZU); E.ZQ = (bf16_t*)(p.ws + O_ZQ); E.ZK = (bf16_t*)(p.ws + O_ZK);
  E.VT = (bf16_t*)(p.ws + O_VT); E.ZRW = (bf16_t*)(p.ws + O_ZRW);
  pg8::Gemm g;
  g.A = (const bf16_t*)(p.ws + O_H0); g.Bt = (const bf16_t*)(p.ws + O_WB + W_WIN); g.M = T_ALL; g.N = NZP; g.K = 1024;
  pg8::StaticOrder S;
  S.init(g.M, g.N, (int)gridDim.x, (int)blockIdx.x);
  __syncthreads();
  pg8::gemm_phase<EpiIn, pg8::StaticOrder>((PG8_LAS unsigned char*)smem, g, S, E);
  __syncthreads();
}

constexpr int KROW = 272, VROW = 144, ATT_ST = 64 * KROW + 128 * VROW;
constexpr int ATT2_ST = 2 * 128 * KROW;
DEV int key_of_slot(int x) { return (x & 0x13) | ((x & 8) >> 1) | ((x & 4) << 1); }

DEV void attn_tile(const Params& p, int l, int tile, char* smem, bool do_store = true) {
  bf16_t* ZQ = (bf16_t*)(p.ws + O_ZQ);
  const bf16_t* ZK = (const bf16_t*)(p.ws + O_ZK);
  const bf16_t* VT = (const bf16_t*)(p.ws + O_VT);
  int b, head, q0, nkeys, qbase;
  if (tile < 1024) { b = tile >> 7; head = (tile >> 5) & 3; q0 = (tile & 31) * 128; nkeys = TK; qbase = b * SEQ; }
  else { const int tt = tile - 1024; b = tt >> 3; head = (tt >> 1) & 3; q0 = (tt & 1) * 128; nkeys = CTXL; qbase = T_LAT + b * CTXL; }
  const int tid = ltid(), lane = tid & 63, w = tid >> 6, ql = lane & 31, hh = lane >> 5, map = w >> 2, qg = w & 3;
  const int qrow = qbase + q0 + qg * 32 + ql;
  const float lam_init = l == 0 ? 0.2f : 0.35550907f;
  float lam;
  {
    const float a1 = p.att_lq1[l * 64 + lane] * p.att_lk1[l * 64 + lane];
    const float a2 = p.att_lq2[l * 64 + lane] * p.att_lk2[l * 64 + lane];
    lam = __expf(wsum(a1)) - __expf(wsum(a2)) + lam_init;
  }
  bf16x8 qf[4];
#pragma unroll
  for (int s = 0; s < 4; ++s) qf[s] = *(const bf16x8*)(ZQ + (size_t)qrow * 512 + head * 128 + map * 64 + s * 16 + hh * 8);
  f32x16 o[4];
#pragma unroll
  for (int dt = 0; dt < 4; ++dt)
#pragma unroll
    for (int e = 0; e < 16; ++e) o[dt][e] = 0.f;
  float m = -1e30f, lsum = 0.f;
  const int kr0 = tid >> 4, kch = tid & 15;
  const int vr0 = tid >> 4, vch = tid & 15;
  const bf16_t* vtb = VT + ((size_t)((b * 4 + head) * 128)) * TK;
  u32x4 kreg[4], vreg[4];
  auto gload = [&](int kt) {
    const int k0 = kt * 128;
#pragma unroll
    for (int i = 0; i < 4; ++i) {
      const int kidx = k0 + kr0 + 32 * i;
      const int krow = kidx < CTXL ? T_LAT + b * CTXL + kidx : b * SEQ + kidx - CTXL;
      kreg[i] = *(const u32x4*)(ZK + (size_t)krow * 512 + head * 128 + kch * 8);
      vreg[i] = *(const u32x4*)(vtb + (size_t)(vr0 + 32 * i) * TK + k0 + vch * 8);
    }
  };
  auto lstore = [&](int st) {
    char* Ks = smem + st * ATT2_ST;
    char* Vs = Ks + 128 * KROW;
#pragma unroll
    for (int i = 0; i < 4; ++i) {
      *(u32x4*)(Ks + (kr0 + 32 * i) * KROW + kch * 16) = kreg[i];
      *(u32x4*)(Vs + (vr0 + 32 * i) * KROW + vch * 16) = vreg[i];
    }
  };
  const int nkt = nkeys >> 7;
  gload(0);
  __syncthreads();
  lstore(0);
  __syncthreads();
  const int kos = key_of_slot(ql);
  for (int kt = 0; kt < nkt; ++kt) {
    const int cur = kt & 1;
    if (kt + 1 < nkt) gload(kt + 1);
    const char* Ks = smem + cur * ATT2_ST;
    const char* Vs = Ks + 128 * KROW;
#pragma unroll
    for (int h2 = 0; h2 < 2; ++h2) {
    const char* kp = Ks + (h2 * 64 + kos) * KROW + (map * 64 + hh * 8) * 2;
    const char* vp = Vs + ql * KROW + hh * 16 + h2 * 128;
    bf16x8 kf0[4], kf1[4];
#pragma unroll
    for (int ks = 0; ks < 4; ++ks) { kf0[ks] = *(const bf16x8*)(kp + ks * 32); kf1[ks] = *(const bf16x8*)(kp + 32 * KROW + ks * 32); }
    f32x16 s0, s1;
#pragma unroll
    for (int e = 0; e < 16; ++e) { s0[e] = 0.f; s1[e] = 0.f; }
#pragma unroll
    for (int ks = 0; ks < 4; ++ks) s0 = __builtin_amdgcn_mfma_f32_32x32x16_bf16(kf0[ks], qf[ks], s0, 0, 0, 0);
#pragma unroll
    for (int ks = 0; ks < 4; ++ks) s1 = __builtin_amdgcn_mfma_f32_32x32x16_bf16(kf1[ks], qf[ks], s1, 0, 0, 0);
    bf16x8 vf[8];
#pragma unroll
    for (int dt = 0; dt < 4; ++dt)
#pragma unroll
      for (int k2 = 0; k2 < 2; ++k2) vf[dt * 2 + k2] = *(const bf16x8*)(vp + dt * 32 * KROW + (k2 * 16) * 2);
    float mx = fmaxf(s0[0], s1[0]);
#pragma unroll
    for (int e = 1; e < 16; ++e) mx = fmaxf(mx, fmaxf(s0[e], s1[e]));
    mx = xor32_max(mx);
    const float mnew = (mx > m + 8.f) ? mx : m;
    if (__any(mnew > m)) {
      const float alpha = __builtin_amdgcn_exp2f(m - mnew);
      lsum *= alpha;
#pragma unroll
      for (int dt = 0; dt < 4; ++dt)
#pragma unroll
        for (int e = 0; e < 16; ++e) o[dt][e] *= alpha;
    }
    m = mnew;
    bf16x8 pb0[2], pb1[2];
    {
      float pe[16];
#pragma unroll
      for (int e = 0; e < 16; ++e) { pe[e] = __builtin_amdgcn_exp2f(s0[e] - m); lsum += pe[e]; }
#pragma unroll
      for (int k2 = 0; k2 < 2; ++k2) {
        u32x4 u;
        u[0] = pk2(pe[8 * k2 + 0], pe[8 * k2 + 1]); u[1] = pk2(pe[8 * k2 + 2], pe[8 * k2 + 3]);
        u[2] = pk2(pe[8 * k2 + 4], pe[8 * k2 + 5]); u[3] = pk2(pe[8 * k2 + 6], pe[8 * k2 + 7]);
        pb0[k2] = __builtin_bit_cast(bf16x8, u);
      }
    }
#pragma unroll
    for (int dt = 0; dt < 4; ++dt)
#pragma unroll
      for (int k2 = 0; k2 < 2; ++k2) o[dt] = __builtin_amdgcn_mfma_f32_32x32x16_bf16(vf[dt * 2 + k2], pb0[k2], o[dt], 0, 0, 0);
#pragma unroll
    for (int dt = 0; dt < 4; ++dt)
#pragma unroll
      for (int k2 = 0; k2 < 2; ++k2) vf[dt * 2 + k2] = *(const bf16x8*)(vp + dt * 32 * KROW + (32 + k2 * 16) * 2);
    {
      float pe[16];
#pragma unroll
      for (int e = 0; e < 16; ++e) { pe[e] = __builtin_amdgcn_exp2f(s1[e] - m); lsum += pe[e]; }
#pragma unroll
      for (int k2 = 0; k2 < 2; ++k2) {
        u32x4 u;
        u[0] = pk2(pe[8 * k2 + 0], pe[8 * k2 + 1]); u[1] = pk2(pe[8 * k2 + 2], pe[8 * k2 + 3]);
        u[2] = pk2(pe[8 * k2 + 4], pe[8 * k2 + 5]); u[3] = pk2(pe[8 * k2 + 6], pe[8 * k2 + 7]);
        pb1[k2] = __builtin_bit_cast(bf16x8, u);
      }
    }
#pragma unroll
    for (int dt = 0; dt < 4; ++dt)
#pragma unroll
      for (int k2 = 0; k2 < 2; ++k2) o[dt] = __builtin_amdgcn_mfma_f32_32x32x16_bf16(vf[dt * 2 + k2], pb1[k2], o[dt], 0, 0, 0);
    }
    if (kt + 1 < nkt) lstore(cur ^ 1);
    __syncthreads();
  }
  const float ltot = xor32_sum(lsum);
  float* ex = (float*)smem;
  if (map == 1) {
    const float c2 = lam / ltot;
#pragma unroll
    for (int dt = 0; dt < 4; ++dt)
#pragma unroll
      for (int e = 0; e < 16; ++e) {
        const int dv = dt * 32 + 8 * (e >> 2) + 4 * hh + (e & 3);
        ex[(qg * 128 + dv) * 32 + ql] = o[dt][e] * c2;
      }
  }
  __syncthreads();
  if (map == 0 && do_store) {
    const float c1 = 1.f / ltot;
    float ss = 0.f;
#pragma unroll
    for (int dt = 0; dt < 4; ++dt)
#pragma unroll
      for (int e = 0; e < 16; ++e) {
        const int dv = dt * 32 + 8 * (e >> 2) + 4 * hh + (e & 3);
        const float v = o[dt][e] * c1 - ex[(qg * 128 + dv) * 32 + ql];
        o[dt][e] = v;
        ss += v * v;
      }
    ss = xor32_sum(ss);
    const float rs = rsqrtf(ss * (1.f / 128.f) + 1e-5f) * (1.f - lam_init);
    const float* sg = p.att_subln_g + l * 128;
#pragma unroll
    for (int dt = 0; dt < 4; ++dt)
#pragma unroll
      for (int i = 0; i < 4; ++i) {
        const int dv = dt * 32 + 8 * i + 4 * hh;
        const float4 g4 = *(const float4*)(sg + dv);
        uint2 u;
        u.x = pk2(o[dt][4 * i + 0] * rs * g4.x, o[dt][4 * i + 1] * rs * g4.y);
        u.y = pk2(o[dt][4 * i + 2] * rs * g4.z, o[dt][4 * i + 3] * rs * g4.w);
        *(uint2*)(ZQ + (size_t)qrow * 512 + head * 128 + dv) = u;
      }
  }
  __syncthreads();
}

DEV void conv_tile(const Params& p, int l, int tile, char* smem) {
  const bf16_t* ZU = (const bf16_t*)(p.ws + O_ZU);
  bf16_t* YCV = (bf16_t*)(p.ws + O_YCV);
  const int r0 = tile * 64;
  int s_lo, s_hi;
  if (r0 < T_LAT) { s_lo = r0 & ~4095; s_hi = s_lo + SEQ; } else { s_lo = T_LAT + ((r0 - T_LAT) & ~255); s_hi = s_lo + CTXL; }
  const int tid = ltid(), lane = tid & 63, w = tid >> 6, c0 = lane * 8;
  const int t0 = r0 + w * 8;
  const float* wp = p.conv_dw_w + (size_t)l * 31 * 512 + c0;
  float acc[8][8];
  {
    const f32x4 b0 = *(const f32x4*)(p.conv_dw_b + l * 512 + c0), b1 = *(const f32x4*)(p.conv_dw_b + l * 512 + c0 + 4);
#pragma unroll
    for (int t = 0; t < 8; ++t)
#pragma unroll
      for (int j = 0; j < 4; ++j) { acc[t][j] = b0[j]; acc[t][4 + j] = b1[j]; }
  }
  f32x4 wk[8][2];
#pragma unroll
  for (int q = 0; q < 8; ++q) { wk[q][0] = (f32x4){0.f, 0.f, 0.f, 0.f}; wk[q][1] = (f32x4){0.f, 0.f, 0.f, 0.f}; }
#pragma unroll 4
  for (int s = 0; s < 40; ++s) {
    const int rr = t0 - 15 + s;
    u32x4 uv = {0u, 0u, 0u, 0u};
    if (rr >= s_lo && rr < s_hi) uv = *(const u32x4*)(ZU + (size_t)rr * 512 + c0);
    float u[8];
#pragma unroll
    for (int q = 0; q < 4; ++q) { u[2 * q] = lo_bf(uv[q]); u[2 * q + 1] = hi_bf(uv[q]); }
#pragma unroll
    for (int q = 7; q > 0; --q) { wk[q][0] = wk[q - 1][0]; wk[q][1] = wk[q - 1][1]; }
    wk[0][0] = (f32x4){0.f, 0.f, 0.f, 0.f}; wk[0][1] = (f32x4){0.f, 0.f, 0.f, 0.f};
    if (s <= 30) { wk[0][0] = *(const f32x4*)(wp + s * 512); wk[0][1] = *(const f32x4*)(wp + s * 512 + 4); }
#pragma unroll
    for (int t = 0; t < 8; ++t) {
#pragma unroll
      for (int j = 0; j < 4; ++j) { acc[t][j] += wk[t][0][j] * u[j]; acc[t][4 + j] += wk[t][1][j] * u[4 + j]; }
    }
  }
  const f32x4 g0 = *(const f32x4*)(p.conv_ln_g + l * 512 + c0), g1 = *(const f32x4*)(p.conv_ln_g + l * 512 + c0 + 4);
  const f32x4 e0 = *(const f32x4*)(p.conv_ln_b + l * 512 + c0), e1 = *(const f32x4*)(p.conv_ln_b + l * 512 + c0 + 4);
#pragma unroll
  for (int t = 0; t < 8; ++t) {
    float s1 = 0.f;
#pragma unroll
    for (int j = 0; j < 8; ++j) s1 += acc[t][j];
    const float mu = wsum(s1) * (1.f / 512.f);
    float s2 = 0.f;
#pragma unroll
    for (int j = 0; j < 8; ++j) { acc[t][j] -= mu; s2 += acc[t][j] * acc[t][j]; }
    const float rs = rsqrtf(wsum(s2) * (1.f / 512.f) + 1e-5f);
    float y[8];
#pragma unroll
    for (int j = 0; j < 4; ++j) {
      const float z0 = acc[t][j] * rs * g0[j] + e0[j], z1 = acc[t][4 + j] * rs * g1[j] + e1[j];
      y[j] = z0 * sigmoidf_(z0); y[4 + j] = z1 * sigmoidf_(z1);
    }
    u32x4 o;
    o[0] = pk2(y[0], y[1]); o[1] = pk2(y[2], y[3]); o[2] = pk2(y[4], y[5]); o[3] = pk2(y[6], y[7]);
    *(u32x4*)(YCV + (size_t)(t0 + t) * 512 + c0) = o;
  }
}

DEV void shift_tile(const Params& p, int l, int tile) {
  const bf16_t* ZRW = (const bf16_t*)(p.ws + O_ZRW);
  bf16_t* ZRS = (bf16_t*)(p.ws + O_ZRS);
  const int r0 = tile * 32;
  int s_lo, s_hi;
  if (r0 < T_LAT) { s_lo = r0 & ~4095; s_hi = s_lo + SEQ; } else { s_lo = T_LAT + ((r0 - T_LAT) & ~255); s_hi = s_lo + CTXL; }
  const int tid = ltid();
  if (tid >= 480) return;
  const int half = tid >= 240 ? 1 : 0, ch = tid - half * 240, col = ch * 8;
  const int rb = r0 + half * 16;
  u32x4 rows[18];
#pragma unroll
  for (int i = 0; i < 18; ++i) {
    const int rr = rb - 1 + i;
    rows[i] = (u32x4){0u, 0u, 0u, 0u};
    if (rr >= s_lo && rr < s_hi) rows[i] = *(const u32x4*)(ZRW + (size_t)rr * 1920 + col);
  }
  const float* sw = p.rwkv_shift + (size_t)l * 3 * 1920 + col;
  float w0[8], w1[8], w2[8];
#pragma unroll
  for (int j = 0; j < 8; ++j) { w0[j] = sw[j]; w1[j] = sw[1920 + j]; w2[j] = sw[3840 + j]; }
  const int act = (col >= 1536 && col < 1664) ? 1 : (col >= 1792 ? 2 : 0);
#pragma unroll
  for (int i = 0; i < 16; ++i) {
    const int row = rb + i;
    const u32x4 pv = rows[i], cu = rows[i + 1], nx = rows[i + 2];
    float y[8];
#pragma unroll
    for (int q = 0; q < 4; ++q) {
      y[2 * q] = w0[2 * q] * lo_bf(pv[q]) + w1[2 * q] * lo_bf(cu[q]) + w2[2 * q] * lo_bf(nx[q]);
      y[2 * q + 1] = w0[2 * q + 1] * hi_bf(pv[q]) + w1[2 * q + 1] * hi_bf(cu[q]) + w2[2 * q + 1] * hi_bf(nx[q]);
    }
    if (act == 1) {
#pragma unroll
      for (int j = 0; j < 8; ++j) y[j] = 1.f - 2.f / (1.f + __expf(2.f * y[j]));
    } else if (act == 2) {
#pragma unroll
      for (int j = 0; j < 8; ++j) y[j] = sigmoidf_(y[j]);
    }
    u32x4 o;
    o[0] = pk2(y[0], y[1]); o[1] = pk2(y[2], y[3]); o[2] = pk2(y[4], y[5]); o[3] = pk2(y[6], y[7]);
    if (col < 1536) *(u32x4*)(ZRS + (size_t)row * 1536 + col) = o;
    else if (col < 1792) *(u32x4*)((bf16_t*)(p.ws + O_LIN) + (size_t)row * 256 + (col - 1536)) = o;
    else *(u32x4*)((bf16_t*)(p.ws + O_GIN) + (size_t)row * 128 + (col - 1792)) = o;
  }
}

DEV void branch_phase(const Params& p, int l, char* smem) {
  const bool last = (l == 1);
  for (int L = vblock(); L < 1088 + 544 + 1088; L += gridDim.x) {
    if (L < 1088) { if (!(last && L >= 1024)) attn_tile(p, l, L, smem); }
    else if (L < 1632) { if (!(last && L - 1088 >= 512)) conv_tile(p, l, L - 1088, smem); }
    else shift_tile(p, l, L - 1632);
  }
}

DEV void lora_phase(const Params& p, int l, char* smem, bool gjob) {
  const bf16_t* LIN = (const bf16_t*)(p.ws + O_LIN);
  const int lane = ltid() & 63, w = ltid() >> 6, wm = w >> 1, wn = w & 1, fr = lane & 15, fq = lane >> 4;
  const int ntile = gjob ? 544 : 4 * 544;
  for (int L = vblock(); L < ntile; L += gridDim.x) {
    const int job = gjob ? 4 : L / 544, t = L - (gjob ? 0 : job * 544), pm = t >> 2, pn = t & 3;
    const int row0 = pm * 256, col0 = pn * 128;
    const bf16_t* A;
    const bf16_t* Bt;
    bf16_t* O;
    int K = 64, lda = 256;
    const float* bias = nullptr;
    if (job == 0) { A = LIN; Bt = (const bf16_t*)(p.ws + O_WB + W_LW2); O = (bf16_t*)(p.ws + O_EF); bias = p.rwkv_w0 + (l * 2 + 0) * 512; }
    else if (job == 1) { A = LIN + 64; Bt = (const bf16_t*)(p.ws + O_WB + W_LW2) + 512 * 64; O = (bf16_t*)(p.ws + O_EB); bias = p.rwkv_w0 + (l * 2 + 1) * 512; }
    else if (job == 2) { A = LIN + 128; Bt = (const bf16_t*)(p.ws + O_WB + W_LA2); O = (bf16_t*)(p.ws + O_AF); bias = p.rwkv_a0 + (l * 2 + 0) * 512; }
    else if (job == 3) { A = LIN + 192; Bt = (const bf16_t*)(p.ws + O_WB + W_LA2) + 512 * 64; O = (bf16_t*)(p.ws + O_AB); bias = p.rwkv_a0 + (l * 2 + 1) * 512; }
    else { A = (const bf16_t*)(p.ws + O_GIN); Bt = (const bf16_t*)(p.ws + O_WB + W_LG2); O = (bf16_t*)(p.ws + O_G); K = 128; lda = 128; }
    f32x4 acc[4][4];
    zero_acc(acc);
    gemm_kloop(acc, A + (size_t)row0 * lda, lda, Bt + (size_t)col0 * K, K, K, smem);
#pragma unroll
    for (int mi = 0; mi < 4; ++mi) {
      const int row = row0 + wm * 64 + mi * 16 + fr;
#pragma unroll
      for (int ni = 0; ni < 4; ++ni) {
        const int c = col0 + wn * 64 + ni * 16 + fq * 4;
        float v[4];
#pragma unroll
        for (int j = 0; j < 4; ++j) {
          float z = acc[mi][ni][j];
          if (job < 4) z = sigmoidf_(z + bias[c + j]);
          if (job < 2) z *= 0.6065306597126334f;
          v[j] = z;
        }
        uint2 o;
        o.x = pk2(v[0], v[1]); o.y = pk2(v[2], v[3]);
        *(uint2*)(O + (size_t)row * 512 + c) = o;
      }
    }
  }
}

DEV void lora64_phase(const Params& p, int l, char* smem) {
  const bf16_t* LIN = (const bf16_t*)(p.ws + O_LIN);
  const int tid = ltid(), lane = tid & 63, w = tid >> 6, wm = w >> 1, wn = w & 1, fr = lane & 15, fq = lane >> 4;
  const int lrow = tid >> 3, lch = tid & 7;
  u32x4 ra[4], rb[2];
  auto issue = [&](int L) {
    const int job = L / 544, t = L - job * 544, pm = t >> 2, pn = t & 3;
    const bf16_t* A = LIN + job * 64 + (size_t)(pm * 256 + lrow) * 256 + lch * 8;
    const bf16_t* Bt = (const bf16_t*)(p.ws + O_WB + ((job & 2) ? W_LA2 : W_LW2)) + (job & 1) * 512 * 64 + (size_t)(pn * 128 + lrow) * 64 + lch * 8;
#pragma unroll
    for (int i = 0; i < 4; ++i) ra[i] = *(const u32x4*)(A + (size_t)(64 * i) * 256);
#pragma unroll
    for (int i = 0; i < 2; ++i) rb[i] = *(const u32x4*)(Bt + (size_t)(64 * i) * 64);
  };
  char* swa = smem + lrow * SROW + lch * 16;
  char* swb = swa + A_ST;
  const char* sra = smem + (wm * 64 + fr) * SROW + fq * 16;
  const char* srb = smem + A_ST + (wn * 64 + fr) * SROW + fq * 16;
  int L = vblock();
  if (L < 4 * 544) issue(L);
  for (; L < 4 * 544; L += gridDim.x) {
    const int job = L / 544, t = L - job * 544, pm = t >> 2, pn = t & 3;
    const int row0 = pm * 256, col0 = pn * 128;
    __syncthreads();
#pragma unroll
    for (int i = 0; i < 4; ++i) *(u32x4*)(swa + i * 64 * SROW) = ra[i];
#pragma unroll
    for (int i = 0; i < 2; ++i) *(u32x4*)(swb + i * 64 * SROW) = rb[i];
    __syncthreads();
    if (L + (int)gridDim.x < 4 * 544) issue(L + gridDim.x);
    f32x4 acc[4][4];
    zero_acc(acc);
#pragma unroll
    for (int ks = 0; ks < 2; ++ks) {
      bf16x8 af[4], bfr[4];
#pragma unroll
      for (int mi = 0; mi < 4; ++mi) af[mi] = *(const bf16x8*)(sra + mi * 16 * SROW + ks * 64);
#pragma unroll
      for (int ni = 0; ni < 4; ++ni) bfr[ni] = *(const bf16x8*)(srb + ni * 16 * SROW + ks * 64);
#pragma unroll
      for (int mi = 0; mi < 4; ++mi)
#pragma unroll
        for (int ni = 0; ni < 4; ++ni) acc[mi][ni] = __builtin_amdgcn_mfma_f32_16x16x32_bf16(bfr[ni], af[mi], acc[mi][ni], 0, 0, 0);
    }
    bf16_t* O = (bf16_t*)(p.ws + (job == 0 ? O_EF : (job == 1 ? O_EB : (job == 2 ? O_AF : O_AB))));
    const float* bias = ((job & 2) ? p.rwkv_a0 : p.rwkv_w0) + (l * 2 + (job & 1)) * 512;
    const float sc = job < 2 ? 0.6065306597126334f : 1.f;
#pragma unroll
    for (int mi = 0; mi < 4; ++mi) {
      const int row = row0 + wm * 64 + mi * 16 + fr;
#pragma unroll
      for (int ni = 0; ni < 4; ++ni) {
        const int c = col0 + wn * 64 + ni * 16 + fq * 4;
        const f32x4 z = acc[mi][ni] + *(const f32x4*)(bias + c);
        uint2 o;
        o.x = pk2(sc * sigmoidf_(z[0]), sc * sigmoidf_(z[1])); o.y = pk2(sc * sigmoidf_(z[2]), sc * sigmoidf_(z[3]));
        *(uint2*)(O + (size_t)row * 512 + c) = o;
      }
    }
  }
  __syncthreads();
}

DEV int scan_row(int step, int dir, int b) {
  if (step < CTXL) { const int t = dir ? (CTXL - 1 - step) : step; return T_LAT + b * CTXL + t; }
  const int s2 = step - CTXL;
  const int t = dir ? (SEQ - 1 - s2) : s2;
  return b * SEQ + t;
}
DEV float red8(float v) {
  v += dppf<0xB1>(v);
  v += dppf<0x4E>(v);
  v += dppf<0x141>(v);
  return v;
}
struct ScanOps { f32x4 nkk0, nkk1, w0, w1, kka0, kka1, kd0, kd1, r0, r1; float v; };
DEV void scan_tile(const Params& p, int l, int tile, char* smem) {
  const int half = tile & 1, dir = (tile >> 1) & 1, h = (tile >> 2) & 7, b = tile >> 5;
  float* arr = (float*)smem;
  float* ybuf = arr + 2 * 32 * 384;
  const bf16_t* ZRS = (const bf16_t*)(p.ws + O_ZRS);
  const bf16_t* E = (const bf16_t*)(p.ws + (dir ? O_EB : O_EF));
  const bf16_t* Aa = (const bf16_t*)(p.ws + (dir ? O_AB : O_AF));
  bf16_t* YS = (bf16_t*)(p.ws + (dir ? O_YSB : O_YSF));
  const int tid = ltid(), lane = tid & 63;
  const int w = __builtin_amdgcn_readfirstlane(tid >> 6);
  const int col = h * 64 + lane;
  const float kkp = p.rwkv_kk[l * 512 + col], kap = p.rwkv_ka[l * 512 + col];
  auto produce = [&](int ch, int buf, int pw, int npw) {
#pragma unroll
    for (int i0 = 0; i0 < 32; i0 += 4 * npw) {
      bf16_t rr[4], rk[4], rv[4], re[4], ra[4];
#pragma unroll
      for (int i = 0; i < 4; ++i) {
        const int R = scan_row(ch * 32 + i0 + pw + npw * i, dir, b);
        rr[i] = ZRS[(size_t)R * 1536 + col];
        rk[i] = ZRS[(size_t)R * 1536 + 512 + col];
        rv[i] = ZRS[(size_t)R * 1536 + 1024 + col];
        re[i] = E[(size_t)R * 512 + col];
        ra[i] = Aa[(size_t)R * 512 + col];
      }
#pragma unroll
      for (int i = 0; i < 4; ++i) {
        const int sl = i0 + pw + npw * i;
        const float r = bf2f(rr[i]), k = bf2f(rk[i]), v = bf2f(rv[i]), e = bf2f(re[i]), a = bf2f(ra[i]);
        const float kkv = k * kkp;
        const float inv = rsqrtf(fmaxf(wsum(kkv * kkv), 1e-24f));
        const float kk = kkv * inv;
        float* d = arr + (buf * 32 + sl) * 384 + lane;
        d[0] = -kk;
        d[64] = __expf(-e);
        d[128] = kk * a;
        d[192] = k * (1.f + (a - 1.f) * kap);
        d[256] = r;
        d[320] = v;
      }
    }
  };
  auto flush = [&](int ch, int buf, int t256) {
#pragma unroll
    for (int q = 0; q < 2; ++q) {
      const int idx = t256 + 256 * q, sl = idx >> 4, rp = (idx & 15) * 2;
      const int R = scan_row(ch * 32 + sl, dir, b);
      const float* yb = ybuf + buf * 1024 + sl * 32 + rp;
      *(unsigned*)(YS + (size_t)R * 512 + h * 64 + half * 32 + rp) = pk2(yb[0], yb[1]);
    }
  };
  __syncthreads();
  produce(0, 0, w, 8);
  __syncthreads();
  f32x4 S0 = {0.f, 0.f, 0.f, 0.f}, S1 = {0.f, 0.f, 0.f, 0.f};
  const int r8 = lane >> 3, cg = lane & 7;
  for (int ch = 0; ch < 136; ++ch) {
    const int buf = ch & 1;
    if (w < 4) {
      const float* cb = arr + buf * 32 * 384;
      const int vo = 320 + half * 32 + w * 8 + r8;
      float* yw = ybuf + buf * 1024 + cg * 32 + w * 8 + r8;
      auto ldops = [&](ScanOps& o, int sl) {
        const f32x4* b4 = (const f32x4*)(cb + sl * 384);
        o.nkk0 = b4[cg * 2]; o.nkk1 = b4[cg * 2 + 1];
        o.w0 = b4[16 + cg * 2]; o.w1 = b4[16 + cg * 2 + 1];
        o.kka0 = b4[32 + cg * 2]; o.kka1 = b4[32 + cg * 2 + 1];
        o.kd0 = b4[48 + cg * 2]; o.kd1 = b4[48 + cg * 2 + 1];
        o.r0 = b4[64 + cg * 2]; o.r1 = b4[64 + cg * 2 + 1];
        o.v = cb[sl * 384 + vo];
      };
      float ykeep = 0.f;
      auto step = [&](const ScanOps& o, int sl) {
        const f32x4 sA = S0 * o.nkk0 + S1 * o.nkk1;
        const float sa = red8((sA[0] + sA[1]) + (sA[2] + sA[3]));
        S0 = S0 * o.w0 + (o.kka0 * sa + o.kd0 * o.v);
        S1 = S1 * o.w1 + (o.kka1 * sa + o.kd1 * o.v);
        const f32x4 yA = S0 * o.r0 + S1 * o.r1;
        const float y = red8((yA[0] + yA[1]) + (yA[2] + yA[3]));
        ykeep = (cg == (sl & 7)) ? y : ykeep;
      };
      ScanOps oa, ob;
      ldops(oa, 0);
#pragma unroll
      for (int s8 = 0; s8 < 32; s8 += 8) {
#pragma unroll
        for (int q = 0; q < 8; q += 2) {
          ldops(ob, s8 + q + 1);
          step(oa, s8 + q);
          ldops(oa, (s8 + q + 2) & 31);
          step(ob, s8 + q + 1);
        }
        yw[s8 * 32] = ykeep;
      }
    } else {
      const int pw = w - 4;
      if (ch > 0) flush(ch - 1, buf ^ 1, tid - 256);
      if (ch + 1 < 136) produce(ch + 1, buf ^ 1, pw, 4);
    }
    __syncthreads();
  }
  if (w >= 4) flush(135, 1, tid - 256);
  __syncthreads();
}
DEV void scan_phase(const Params& p, int l, char* smem) {
  for (int L = blockIdx.x; L < 256; L += gridDim.x) scan_tile(p, l, L, smem);
}

DEV void unpack8(const u32x4 u, float (&f)[8]) {
#pragma unroll
  for (int q = 0; q < 4; ++q) { f[2 * q] = lo_bf(u[q]); f[2 * q + 1] = hi_bf(u[q]); }
}
DEV void post_phase(const Params& p, int l, int nrows) {
  const bf16_t* ZRS = (const bf16_t*)(p.ws + O_ZRS);
  const bf16_t* AF = (const bf16_t*)(p.ws + O_AF);
  const bf16_t* AB = (const bf16_t*)(p.ws + O_AB);
  const bf16_t* G = (const bf16_t*)(p.ws + O_G);
  bf16_t* YSF = (bf16_t*)(p.ws + O_YSF);
  const bf16_t* YSB = (const bf16_t*)(p.ws + O_YSB);
  const int lane = ltid() & 63, w = ltid() >> 6, c0 = lane * 8;
  float gng[8], gnb[8], kaw[8], rkw[8];
#pragma unroll
  for (int j = 0; j < 8; ++j) {
    gng[j] = p.rwkv_gn_g[l * 512 + c0 + j]; gnb[j] = p.rwkv_gn_b[l * 512 + c0 + j];
    kaw[j] = p.rwkv_ka[l * 512 + c0 + j]; rkw[j] = p.rwkv_rk[l * 512 + c0 + j];
  }
  const int stride = gridDim.x * 8;
  int row = blockIdx.x * 8 + w;
  u32x4 q_ysf, q_ysb, q_r, q_k, q_v, q_af, q_ab, q_g;
  auto gl = [&](int rw) {
    q_ysf = *(const u32x4*)(YSF + (size_t)rw * 512 + c0); q_ysb = *(const u32x4*)(YSB + (size_t)rw * 512 + c0);
    q_r = *(const u32x4*)(ZRS + (size_t)rw * 1536 + c0); q_k = *(const u32x4*)(ZRS + (size_t)rw * 1536 + 512 + c0);
    q_v = *(const u32x4*)(ZRS + (size_t)rw * 1536 + 1024 + c0);
    q_af = *(const u32x4*)(AF + (size_t)rw * 512 + c0); q_ab = *(const u32x4*)(AB + (size_t)rw * 512 + c0);
    q_g = *(const u32x4*)(G + (size_t)rw * 512 + c0);
  };
  if (row < nrows) gl(row);
  for (; row < nrows; row += stride) {
    float ysf[8], ysb[8], r[8], k[8], v[8], af[8], ab[8], g[8];
    unpack8(q_ysf, ysf); unpack8(q_ysb, ysb); unpack8(q_r, r); unpack8(q_k, k); unpack8(q_v, v);
    unpack8(q_af, af); unpack8(q_ab, ab); unpack8(q_g, g);
    if (row + stride < nrows) gl(row + stride);
    float ys[8], s1 = 0.f, bp = 0.f;
#pragma unroll
    for (int j = 0; j < 8; ++j) {
      ys[j] = ysf[j] + ysb[j]; s1 += ys[j];
      bp += r[j] * k[j] * rkw[j] * (2.f + (af[j] + ab[j] - 2.f) * kaw[j]);
    }
    const float mu = red8(s1) * (1.f / 64.f);
    const float bon = red8(bp);
    float s2 = 0.f;
#pragma unroll
    for (int j = 0; j < 8; ++j) { ys[j] -= mu; s2 += ys[j] * ys[j]; }
    const float rs = rsqrtf(red8(s2) * (1.f / 64.f) + 64e-5f);
    float o[8];
#pragma unroll
    for (int j = 0; j < 8; ++j) o[j] = (ys[j] * rs * gng[j] + gnb[j] + bon * v[j]) * g[j];
    u32x4 ov;
    ov[0] = pk2(o[0], o[1]); ov[1] = pk2(o[2], o[3]); ov[2] = pk2(o[4], o[5]); ov[3] = pk2(o[6], o[7]);
    *(u32x4*)(YSF + (size_t)row * 512 + c0) = ov;
  }
}

struct EpiGate {
  static constexpr bool PERM = true, AFTER_DRAIN = false;
  char* ws;
  DEV void operator()(const f32x4 (&acc)[2][2][4][2], const pg8::Unit& u, int wr, int wc, int fr, int fq) const {
    const int b = u.pn >> 2, pn = u.pn & 3;
    bf16_t* G = (bf16_t*)(ws + (b == 0 ? O_G1 : (b == 1 ? O_G2 : O_G3)));
    const int row0 = u.pm * 256 + wr * 64 + fr, col0 = pn * 256 + wc * 32 + 8 * fq;
#pragma unroll
    for (int ai = 0; ai < 2; ++ai)
#pragma unroll
      for (int m = 0; m < 4; ++m) {
        const int row = row0 + ai * 128 + m * 16;
#pragma unroll
        for (int bj = 0; bj < 2; ++bj) {
          const f32x4 a0 = acc[ai][bj][m][0], a1 = acc[ai][bj][m][1];
          u32x4 o;
          o[0] = pk2(sigmoidf_(a0[0]), sigmoidf_(a0[1])); o[1] = pk2(sigmoidf_(a0[2]), sigmoidf_(a0[3]));
          o[2] = pk2(sigmoidf_(a1[0]), sigmoidf_(a1[1])); o[3] = pk2(sigmoidf_(a1[2]), sigmoidf_(a1[3]));
          *(u32x4*)(G + (size_t)row * DM + col0 + bj * 128) = o;
        }
      }
  }
};
DEV void gate_phase(const Params& p, int nrows, char* smem) {
  EpiGate E;
  E.ws = p.ws;
  pg8::Gemm g;
  g.A = (const bf16_t*)(p.ws + O_HM); g.Bt = (const bf16_t*)(p.ws + O_WB + W_WIN) + (size_t)NZP * 1024; g.M = nrows; g.N = 3072; g.K = 1024;
  pg8::StaticOrder S;
  S.init(g.M, g.N, (int)gridDim.x, (int)blockIdx.x);
  __syncthreads();
  pg8::gemm_phase<EpiGate, pg8::StaticOrder>((PG8_LAS unsigned char*)smem, g, S, E);
  __syncthreads();
}
struct MergeOrder {
  pg8::StaticOrder base;
  DEV bool next(int i, pg8::Unit& u) const {
    const int j = i / 3, b = i - 3 * j;
    pg8::Unit t;
    if (!base.next(j, t)) return false;
    u.pm = t.pm + 136 * (b == 0 ? 11 : (b == 1 ? 12 : 6));
    u.pn = t.pn + 4 * b;
    return true;
  }
  DEV void a_ready(const pg8::Unit&) const {}
  DEV void done(const pg8::Unit&) const {}
};
struct EpiMerge {
  static constexpr bool PERM = true, AFTER_DRAIN = false;
  char* ws;
  DEV void operator()(const f32x4 (&acc)[2][2][4][2], const pg8::Unit& u, int wr, int wc, int fr, int fq) const {
    const int b = u.pn >> 2, pn = u.pn & 3, pm = u.pm - 136 * (b == 0 ? 11 : (b == 1 ? 12 : 6));
    const bf16_t* G = (const bf16_t*)(ws + (b == 0 ? O_G1 : (b == 1 ? O_G2 : O_G3)));
    bf16_t* M = (bf16_t*)(ws + O_M);
    const int row0 = pm * 256 + wr * 64 + fr, col0 = pn * 256 + wc * 32 + 8 * fq;
#pragma unroll
    for (int ai = 0; ai < 2; ++ai)
#pragma unroll
      for (int m = 0; m < 4; ++m) {
        const int row = row0 + ai * 128 + m * 16;
#pragma unroll
        for (int bj = 0; bj < 2; ++bj) {
          const size_t off = (size_t)row * DM + col0 + bj * 128;
          const u32x4 gv = *(const u32x4*)(G + off);
          u32x4 mv = {0u, 0u, 0u, 0u};
          if (b > 0) mv = *(const u32x4*)(M + off);
          const f32x4 a0 = acc[ai][bj][m][0], a1 = acc[ai][bj][m][1];
          u32x4 o;
          o[0] = pk2(lo_bf(mv[0]) + lo_bf(gv[0]) * a0[0], hi_bf(mv[0]) + hi_bf(gv[0]) * a0[1]);
          o[1] = pk2(lo_bf(mv[1]) + lo_bf(gv[1]) * a0[2], hi_bf(mv[1]) + hi_bf(gv[1]) * a0[3]);
          o[2] = pk2(lo_bf(mv[2]) + lo_bf(gv[2]) * a1[0], hi_bf(mv[2]) + hi_bf(gv[2]) * a1[1]);
          o[3] = pk2(lo_bf(mv[3]) + lo_bf(gv[3]) * a1[2], hi_bf(mv[3]) + hi_bf(gv[3]) * a1[3]);
          *(u32x4*)(M + off) = o;
        }
      }
  }
};
DEV void merge_phase(const Params& p, int nrows, char* smem) {
  EpiMerge E;
  E.ws = p.ws;
  pg8::Gemm g;
  g.A = (const bf16_t*)p.ws; g.Bt = (const bf16_t*)(p.ws + O_WB + W_PCV); g.M = nrows; g.N = 1024; g.K = 512;
  MergeOrder S;
  S.base.init(g.M, g.N, (int)gridDim.x, (int)blockIdx.x);
  __syncthreads();
  pg8::gemm_phase<EpiMerge, MergeOrder>((PG8_LAS unsigned char*)smem, g, S, E);
  __syncthreads();
}

struct EpiResid {
  static constexpr bool PERM = false, AFTER_DRAIN = false;
  float* out; float* xc; const float* rin_lat; const float* rin_ctx; const float* mod; bool store;
  DEV void operator()(const f32x4 (&acc)[2][2][4][2], const pg8::Unit& u, int wr, int wc, int fr, int fq) const {
    const int row0 = u.pm * 256 + wr * 64 + fr, col0 = u.pn * 256 + wc * 32 + 4 * fq;
#pragma unroll
    for (int ai = 0; ai < 2; ++ai)
#pragma unroll
      for (int m = 0; m < 4; ++m) {
        const int row = row0 + ai * 128 + m * 16;
        float* xr = row < T_LAT ? out + (size_t)row * DM : xc + (size_t)(row - T_LAT) * DM;
        const float* xi = row < T_LAT ? rin_lat + (size_t)row * DM : rin_ctx + (size_t)(row - T_LAT) * DM;
        const float* gt = mod + (size_t)modrow(row) * 6144;
#pragma unroll
        for (int bj = 0; bj < 2; ++bj)
#pragma unroll
          for (int n = 0; n < 2; ++n) {
            const int c = col0 + bj * 128 + n * 16;
            const f32x4 g4 = *(const f32x4*)(gt + c);
            f32x4 xv = *(const f32x4*)(xi + c);
            xv += g4 * acc[ai][bj][m][n];
            if (store) *(f32x4*)(xr + c) = xv;
          }
      }
  }
};
DEV void resid_gemm_phase(const Params& p, int l, const bf16_t* A, int K, const bf16_t* Wt, int goff, int nrows, char* smem, bool from_inputs = false) {
  EpiResid E;
  E.store = true;
  E.rin_lat = from_inputs ? p.x : p.out; E.rin_ctx = from_inputs ? p.ctx : (const float*)(p.ws + O_XC);
  E.out = p.out; E.xc = (float*)(p.ws + O_XC); E.mod = (const float*)(p.ws + O_MOD) + (size_t)l * 9 * 6144 + goff;
  pg8::Gemm g;
  g.A = A; g.Bt = Wt; g.M = nrows; g.N = 1024; g.K = K;
  pg8::StaticOrder S;
  S.init(g.M, g.N, (int)gridDim.x, (int)blockIdx.x);
  __syncthreads();
  pg8::gemm_phase<EpiResid, pg8::StaticOrder>((PG8_LAS unsigned char*)smem, g, S, E);
  __syncthreads();
}

struct EpiMlp1 {
  static constexpr bool PERM = true, AFTER_DRAIN = false;
  bf16_t* HID;
  DEV void operator()(const f32x4 (&acc)[2][2][4][2], const pg8::Unit& u, int wr, int wc, int fr, int fq) const {
    const int row0 = u.pm * 256 + wr * 64 + fr, col0 = u.pn * 256 + wc * 32 + 8 * fq;
#pragma unroll
    for (int ai = 0; ai < 2; ++ai)
#pragma unroll
      for (int m = 0; m < 4; ++m) {
        const int row = row0 + ai * 128 + m * 16;
#pragma unroll
        for (int bj = 0; bj < 2; ++bj) {
          float v[8];
#pragma unroll
          for (int j = 0; j < 4; ++j) {
            const float r0 = fmaxf(acc[ai][bj][m][0][j], 0.f), r1 = fmaxf(acc[ai][bj][m][1][j], 0.f);
            v[j] = r0 * r0; v[4 + j] = r1 * r1;
          }
          u32x4 o;
          o[0] = pk2(v[0], v[1]); o[1] = pk2(v[2], v[3]); o[2] = pk2(v[4], v[5]); o[3] = pk2(v[6], v[7]);
          *(u32x4*)(HID + (size_t)row * 4096 + col0 + bj * 128) = o;
        }
      }
  }
};
DEV void mlp1_phase(const Params& p, int nrows, char* smem) {
  EpiMlp1 E;
  E.HID = (bf16_t*)(p.ws + O_HID);
  pg8::Gemm g;
  g.A = (const bf16_t*)(p.ws + O_HM); g.Bt = (const bf16_t*)(p.ws + O_WB + W_W1); g.M = nrows; g.N = 4096; g.K = 1024;
  pg8::StaticOrder S;
  S.init(g.M, g.N, (int)gridDim.x, (int)blockIdx.x);
  __syncthreads();
  pg8::gemm_phase<EpiMlp1, pg8::StaticOrder>((PG8_LAS unsigned char*)smem, g, S, E);
  __syncthreads();
}

DEV void final_phase(const Params& p) {
  const int lane = ltid() & 63, w = ltid() >> 6;
  const int stride = gridDim.x * 8;
  f32x4 g[4];
#pragma unroll
  for (int i = 0; i < 4; ++i) g[i] = *(const f32x4*)(p.final_g + i * 256 + lane * 4);
  int row = blockIdx.x * 8 + w;
  f32x4 nv[4];
  if (row < T_LAT) {
#pragma unroll
    for (int i = 0; i < 4; ++i) nv[i] = *(const f32x4*)(p.out + (size_t)row * DM + i * 256 + lane * 4);
  }
  for (; row < T_LAT; row += stride) {
    float* xr = p.out + (size_t)row * DM;
    f32x4 v[4];
#pragma unroll
    for (int i = 0; i < 4; ++i) v[i] = nv[i];
    if (row + stride < T_LAT) {
#pragma unroll
      for (int i = 0; i < 4; ++i) nv[i] = *(const f32x4*)(p.out + (size_t)(row + stride) * DM + i * 256 + lane * 4);
    }
    float ss = 0.f;
#pragma unroll
    for (int i = 0; i < 4; ++i) ss += v[i][0] * v[i][0] + v[i][1] * v[i][1] + v[i][2] * v[i][2] + v[i][3] * v[i][3];
    const float rs = rsqrtf(wsum(ss) * (1.f / 1024.f) + 1e-6f);
#pragma unroll
    for (int i = 0; i < 4; ++i) *(f32x4*)(xr + i * 256 + lane * 4) = v[i] * rs * g[i];
  }
}

constexpr int N_PHASES = 26;
__global__ void __launch_bounds__(512) fwd_megakernel(Params p, int ph_lo, int ph_hi) {
  extern __shared__ __attribute__((aligned(16))) char smem[];
  cg::grid_group grid = cg::this_grid();
  volatile XLAS unsigned* st = (volatile XLAS unsigned*)(smem + 139264);
  if (threadIdx.x == 0) { st[0] = 0u; st[1] = 0u; st[2] = 0u; st[3] = 0u; }
  __syncthreads();
  const XcdBarrier xb = xcd_barrier_post((unsigned*)(p.ws + O_BAR), st);
  if (ph_hi > 1000) grid.sync();
  for (int ph = ph_lo; ph < ph_hi; ++ph) {
    if (ph == 0) {
      cvt_phase(p, 0, smem);
      mod_phase(p, smem);
    } else if (ph == N_PHASES - 1) {
      final_phase(p);
    } else {
      const int l = (ph - 1) / 12, sp = (ph - 1) % 12;
      const int nrows = (l == 1) ? T_LAT : T_ALL;
      switch (sp) {
        case 0:
          if (l > 0) cvt_phase(p, l, smem);
          norm_phase(p, l, 0, (bf16_t*)(p.ws + O_H0), l == 0);
          break;
        case 1: gemm_in_phase(p, smem); break;
        case 2: branch_phase(p, l, smem); break;
        case 3:
          lora64_phase(p, l, smem);
          lora_phase(p, l, smem, true);
          break;
        case 4: scan_phase(p, l, smem); break;
        case 5:
          post_phase(p, l, nrows);
          norm_phase(p, l, 0, (bf16_t*)(p.ws + O_HM), l == 0, nrows);
          break;
        case 6: gate_phase(p, nrows, smem); break;
        case 7: merge_phase(p, nrows, smem); break;
        case 8: resid_gemm_phase(p, l, (const bf16_t*)(p.ws + O_M), 1024, (const bf16_t*)(p.ws + O_WB + W_WOUT), 2048, nrows, smem, l == 0); break;
        case 9: norm_phase(p, l, 1, (bf16_t*)(p.ws + O_HM), false, nrows); break;
        case 10: mlp1_phase(p, nrows, smem); break;
        case 11: resid_gemm_phase(p, l, (const bf16_t*)(p.ws + O_HID), 4096, (const bf16_t*)(p.ws + O_WB + W_W2), 5120, nrows, smem); break;
      }
    }
    if (ph + 1 < ph_hi) xcd_barrier(xb);
  }
}

extern "C" void kernel_launch(void* const* d_in, const int* in_sizes, int n_in, void* d_out, int out_size, void* d_ws,
                              size_t ws_size, hipStream_t stream) {
  Params p{};
  const float** pp = (const float**)&p;
  for (int i = 0; i < 36; ++i) pp[i] = (const float*)d_in[i];
  p.out = (float*)d_out;
  p.ws = (char*)d_ws;
  static int grid_blocks = 0;
  if (!grid_blocks) {
    hipFuncSetAttribute((const void*)fwd_megakernel, hipFuncAttributeMaxDynamicSharedMemorySize, LDS_BYTES);
    int dev = 0, cus = 0, per_cu = 0;
    hipGetDevice(&dev);
    hipDeviceGetAttribute(&cus, hipDeviceAttributeMultiprocessorCount, dev);
    hipOccupancyMaxActiveBlocksPerMultiprocessor(&per_cu, fwd_megakernel, 512, LDS_BYTES);
    if (per_cu < 1) per_cu = 1;
    grid_blocks = cus * per_cu;
    grid_blocks &= ~7;
  }
  if (ws_size < WS_NEED) fprintf(stderr, "workspace too small: %zu < %zu\n", ws_size, (size_t)WS_NEED);
#ifndef MULTI_LAUNCH
#define MULTI_LAUNCH 0
#endif
#if MULTI_LAUNCH
  for (int ph = 0; ph < N_PHASES; ++ph)
    hipLaunchKernelGGL(fwd_megakernel, dim3(grid_blocks), dim3(512), LDS_BYTES, stream, p, ph, ph + 1);
#else
  hipMemsetAsync((char*)d_ws + O_BAR, 0, 16384, stream);
  int lo = 0, hi = N_PHASES;
  void* args[] = {&p, &lo, &hi};
  hipError_t e = hipLaunchCooperativeKernel((const void*)fwd_megakernel, dim3(grid_blocks), dim3(512), args, LDS_BYTES, stream);
  if (e != hipSuccess) fprintf(stderr, "cooperative launch failed: %s (grid %d)\n", hipGetErrorString(e), grid_blocks);
#endif
}
```

```cpp
#include <hip/hip_runtime.h>
#include <hip/hip_cooperative_groups.h>
#include <cstdio>
namespace cg = cooperative_groups;

typedef unsigned short bf16_t;
typedef short bf16x8 __attribute__((ext_vector_type(8)));
typedef float f32x4 __attribute__((ext_vector_type(4)));
typedef float f32x16 __attribute__((ext_vector_type(16)));
typedef unsigned u32x4 __attribute__((ext_vector_type(4)));
#define DEV __device__ __forceinline__
#define PROBE 0

constexpr int T_LAT = 32768, T_ALL = 34816, DM = 1024, DIN = 7552, NZ = 4480, NZP = 4608, DINT = 7680;
constexpr int SEQ = 4096, CTXL = 256, TK = 4352;
constexpr size_t U = 35651584ull;
constexpr size_t O_ZU = 0, O_ZK = U, O_VT = 2 * U, O_ZRW = 3 * U, O_ZRS = 7 * U, O_LIN = 10 * U, O_YCV = 11 * U, O_ZQ = 12 * U;
constexpr size_t O_H0 = 7 * U;
constexpr size_t O_EF = 0, O_EB = 3 * U, O_AF = 4 * U, O_AB = 5 * U, O_G = 2 * U, O_YSF = 6 * U, O_YSB = 10 * U;
constexpr size_t O_HM = 0, O_M = 0, O_HID = 3 * U;
constexpr size_t O_G1 = 3 * U, O_G2 = 7 * U, O_G3 = 9 * U;
constexpr size_t O_WB = 13 * U;
constexpr size_t W_WIN = 0, W_PCV = W_WIN + (size_t)DINT * 1024 * 2, W_PAT = W_PCV + 1048576, W_PRW = W_PAT + 1048576,
                 W_WOUT = W_PRW + 1048576, W_W1 = W_WOUT + 2097152, W_W2 = W_W1 + 8388608, W_LW2 = W_W2 + 8388608,
                 W_LA2 = W_LW2 + 131072, W_LG2 = W_LA2 + 131072, W_END = W_LG2 + 131072;
constexpr size_t O_XC = O_WB + W_END;
constexpr size_t O_MOD = O_XC + 8388608;
constexpr size_t O_BAR = O_MOD + 2 * 9 * 6144 * 4;
constexpr size_t O_GIN = O_BAR + 16384;
constexpr size_t WS_NEED = O_GIN + (size_t)T_ALL * 128 * 2;

constexpr int LDS_BYTES = 139264 + 16;

struct Params {
  const float *x, *c, *ctx, *c_ctx, *mod_w, *mod_b, *norm1_g, *norm2_g, *w_in, *conv_dw_w, *conv_dw_b, *conv_ln_g,
      *conv_ln_b, *p_conv, *att_lq1, *att_lk1, *att_lq2, *att_lk2, *att_subln_g, *p_att, *rwkv_shift, *rwkv_w0, *rwkv_w2,
      *rwkv_a0, *rwkv_a2, *rwkv_g2, *rwkv_kk, *rwkv_ka, *rwkv_rk, *rwkv_gn_g, *rwkv_gn_b, *p_rwkv, *w_out, *mlp_w1,
      *mlp_w2, *final_g;
  float* out;
  char* ws;
};

DEV int ltid() { int t = threadIdx.x; asm volatile("" : "+v"(t)); return t; }
DEV float bf2f(bf16_t h) { return __uint_as_float(((unsigned)h) << 16); }
typedef float f32x2_t __attribute__((ext_vector_type(2)));
typedef __bf16 bf16x2_t __attribute__((ext_vector_type(2)));
DEV unsigned pk2(float lo, float hi) {
  const f32x2_t v = {lo, hi};
  return __builtin_bit_cast(unsigned, __builtin_convertvector(v, bf16x2_t));
}
DEV bf16_t f2bf(float f) { return (bf16_t)(pk2(f, 0.f) & 0xffffu); }
DEV float lo_bf(unsigned u) { return __uint_as_float(u << 16); }
DEV float hi_bf(unsigned u) { return __uint_as_float(u & 0xffff0000u); }
template <int C> DEV float dppf(float v) {
  return __int_as_float(__builtin_amdgcn_update_dpp(0, __float_as_int(v), C, 0xF, 0xF, true));
}
DEV float xor32_sum(float v) {
  const auto r = __builtin_amdgcn_permlane32_swap(__float_as_uint(v), __float_as_uint(v), false, false);
  return __uint_as_float(r[0]) + __uint_as_float(r[1]);
}
DEV float xor32_max(float v) {
  const auto r = __builtin_amdgcn_permlane32_swap(__float_as_uint(v), __float_as_uint(v), false, false);
  return fmaxf(__uint_as_float(r[0]), __uint_as_float(r[1]));
}
DEV float xor16_sum(float v) {
  const auto r = __builtin_amdgcn_permlane16_swap(__float_as_uint(v), __float_as_uint(v), false, false);
  return __uint_as_float(r[0]) + __uint_as_float(r[1]);
}
DEV float wsum(float v) {
  v += dppf<0xB1>(v);
  v += dppf<0x4E>(v);
  v += dppf<0x141>(v);
  v += dppf<0x140>(v);
  v = xor16_sum(v);
  return xor32_sum(v);
}
DEV float sigmoidf_(float x) { return __builtin_amdgcn_rcpf(1.f + __expf(-x)); }
DEV float red16(float v) {
  v += dppf<0xB1>(v);
  v += dppf<0x4E>(v);
  v += dppf<0x141>(v);
  v += dppf<0x140>(v);
  return v;
}
DEV int vblock() { const int per = gridDim.x >> 3; return (blockIdx.x & 7) * per + (blockIdx.x >> 3); }
DEV float* xrow(const Params& p, int row) {
  return row < T_LAT ? p.out + (size_t)row * DM : (float*)(p.ws + O_XC) + (size_t)(row - T_LAT) * DM;
}
DEV int modrow(int row) { return row < T_LAT ? (row >> 12) : 8; }

#define XB_TMO      128
#define XB_XCNT(j)  (256  + 64 * (j))
#define XB_XSUB(j)  (1280 + 64 * (j))
#define XB_XGEN(j)  (2304 + 64 * (j))
#define XB_TOP      3328
#define XB_TOPGEN   3392
#define XCD_BAR_WORDS 3456
#define XB_SPIN_CAP (1u << 18)
#define XLAS __attribute__((address_space(3)))

__device__ __forceinline__ unsigned xb_ld(unsigned* p)              { return __hip_atomic_load(p, __ATOMIC_RELAXED, __HIP_MEMORY_SCOPE_AGENT); }
__device__ __forceinline__ unsigned xb_add(unsigned* p, unsigned v) { return __hip_atomic_fetch_add(p, v, __ATOMIC_RELAXED, __HIP_MEMORY_SCOPE_AGENT); }
__device__ __forceinline__ unsigned xb_xcc_id() { return (unsigned)__builtin_amdgcn_s_getreg((3 << 11) | 20) & 0xFu; }
#define XB_SPIN(cond, bar) do { unsigned _sp = 0; while (cond) { __builtin_amdgcn_s_sleep(1); \
    if ((++_sp & 255u) == 0u) { if (xb_ld(&(bar)[XB_TMO])) break; if (_sp > XB_SPIN_CAP) { atomicAdd(&(bar)[XB_TMO], 1u); break; } } } } while (0)

struct XcdBarrier {
    unsigned* bar; unsigned x;
    volatile XLAS unsigned* st;
};

__device__ __forceinline__ XcdBarrier xcd_barrier_post(unsigned* bar, volatile XLAS unsigned* st) {
    XcdBarrier b; b.bar = bar; b.x = xb_xcc_id(); b.st = st;
    if (threadIdx.x == 0) (void)xb_add(&bar[XB_XCNT(b.x)], 1u);
    return b;
}
__device__ __forceinline__ void xcd_barrier_complete(unsigned* bar, unsigned x, unsigned& nloc, unsigned& nx) {
    const unsigned G = gridDim.x * gridDim.y * gridDim.z;
    unsigned sum, cnt, mine, sp = 0u;
    for (;;) {
        sum = 0u; cnt = 0u; mine = 0u;
#pragma unroll
        for (unsigned j = 0; j < 16; ++j) { const unsigned c = xb_ld(&bar[XB_XCNT(j)]); sum += c; cnt += (c > 0u) ? 1u : 0u; mine = (j == x) ? c : mine; }
        if (sum == G) break;
        __builtin_amdgcn_s_sleep(1);
        if ((++sp & 255u) == 0u) { if (xb_ld(&bar[XB_TMO])) break; if (sp > XB_SPIN_CAP) { atomicAdd(&bar[XB_TMO], 1u); break; } }
    }
    nloc = mine > 0u ? mine : 1u; nx = cnt > 0u ? cnt : 1u;
}

__device__ __forceinline__ void xcd_barrier(const XcdBarrier& b) {
    asm volatile("s_waitcnt vmcnt(0)" ::: "memory");
    __syncthreads();
    if (threadIdx.x == 0) {
        unsigned* bar = b.bar;
        __builtin_amdgcn_s_waitcnt(0);
        unsigned nloc = b.st[0], nx = b.st[1];
        if (nloc == 0u) { xcd_barrier_complete(bar, b.x, nloc, nx); b.st[0] = nloc; b.st[1] = nx; }
        const unsigned old = xb_add(&bar[XB_XSUB(b.x)], 1u);
        const unsigned gen = old / nloc;
        if (old + 1u == (gen + 1u) * nloc) {
            __builtin_amdgcn_fence(__ATOMIC_RELEASE, "agent");
            asm volatile("s_waitcnt vmcnt(0)" ::: "memory");
            const unsigned og = xb_add(&bar[XB_TOP], 1u);
            const unsigned tg = og / nx;
            if (og + 1u == (tg + 1u) * nx) xb_add(&bar[XB_TOPGEN], 1u);
            else XB_SPIN(xb_ld(&bar[XB_TOPGEN]) == tg, bar);
            __builtin_amdgcn_fence(__ATOMIC_ACQUIRE, "agent");
            xb_add(&bar[XB_XGEN(b.x)], 1u);
            asm volatile("s_waitcnt vmcnt(0)" ::: "memory");
        } else {
            XB_SPIN(xb_ld(&bar[XB_XGEN(b.x)]) == gen, bar);
            __builtin_amdgcn_fence(__ATOMIC_ACQUIRE, "agent");
            asm volatile("s_waitcnt vmcnt(0)" ::: "memory");
        }
    }
    __syncthreads();
}

namespace pg8 {
#define PG8_LAS __attribute__((address_space(3)))
constexpr int BM = 256, BK = 64, HALF = 128, HTB = HALF * BK * 2, STAGE_BYTES = 8 * HTB, NXCD = 8, WGM = 4;
__host__ __device__ __forceinline__ int lds_byte(int r, int c) { const int st = (r >> 4) * 2 + (c >> 5), rr = r & 15, cc = c & 31, ob = rr * 64 + cc * 2; return st * 1024 + (ob ^ (((ob >> 9) & 1) << 5)); }
__host__ __device__ __forceinline__ void stage_rc(int b, int& R, int& C) { const int st = b / 1024, sb = b % 1024, swz = sb ^ (((sb >> 9) & 1) << 5); R = (st >> 1) * 16 + swz / 64; C = (st & 1) * 32 + (swz % 64) / 2; }
__host__ __device__ __forceinline__ int perm32(int rho) { const int n = rho >> 4, i = rho & 15; return 8 * (i >> 2) + 4 * n + (i & 3); }
struct Unit { int pm, pn; };
struct Gemm { const bf16_t* A; const bf16_t* Bt; int M, N, K; };
struct StaticOrder {
    int nM, nN, nwg, G, c;
    __host__ __device__ void init(int M, int N, int G_, int c_) { nM = M / BM; nN = N / BM; nwg = nM * nN; G = G_; c = c_; }
    __host__ __device__ bool next(int i, Unit& u) const {
        const long L = (long)i * G + c; if (L >= nwg) return false;
        int wgid = (int)L; { const int q = nwg / NXCD, r = nwg % NXCD, xcd = wgid % NXCD, off = wgid / NXCD; wgid = (xcd < r ? xcd * (q + 1) : r * (q + 1) + (xcd - r) * q) + off; }
        const int nig = WGM * nN, gid = wgid / nig, fm = gid * WGM, gsz = (nM - fm) < WGM ? (nM - fm) : WGM;
        u.pm = fm + ((wgid % nig) % gsz); u.pn = (wgid % nig) / gsz; return true;
    }
    __device__ __forceinline__ void a_ready(const Unit&) const {}
    __device__ __forceinline__ void done(const Unit&) const {}
};

template <class Epi, class Sched>
__device__ __forceinline__ void gemm_phase(PG8_LAS unsigned char* lds, const Gemm g, const Sched& S, const Epi& E) {
    const int tid = ltid(), wid = __builtin_amdgcn_readfirstlane(tid >> 6), lane = tid & 63, wr = wid >> 2, wc = wid & 3, fr = lane & 15, fq = lane >> 4;
    const int K = g.K, nt = K / BK;
    unsigned voffA[2], voffB[2];
#pragma unroll
    for (int i = 0; i < 2; ++i) { int R, C; stage_rc(tid * 16 + i * 8192, R, C); const int Rb = Epi::PERM ? ((R & ~31) + perm32(R & 31)) : R;
        voffA[i] = (unsigned)(R * K + C) * 2u; voffB[i] = (unsigned)(Rb * K + C) * 2u; }
    const size_t kstep = (size_t)(BK * 2);
    const size_t hstep = (size_t)HALF * K * 2;
    const size_t tstep = 2 * hstep;
    const unsigned ldsw = (unsigned)wid * 1024u;
    const int aoff = lds_byte(wr * 64 + fr, fq * 8), boff = lds_byte(wc * 32 + fr, fq * 8);
#define PG8_SA(b, h) (((b) * 2 + (h)) * HTB)
#define PG8_SB(b, h) ((4 + (b) * 2 + (h)) * HTB)
#define PG8_STAGE(bufoff, gbase, voff) do { _Pragma("unroll") for (int _i = 0; _i < 2; ++_i) \
        __builtin_amdgcn_global_load_lds((const unsigned*)((const char*)(gbase) + (voff)[_i]), (PG8_LAS unsigned*)(lds + (bufoff) + ldsw + _i * 8192), 16, 0, 0); } while (0)
#define PG8_LDA(dst, b, h) do { _Pragma("unroll") for (int m = 0; m < 4; ++m) _Pragma("unroll") for (int k = 0; k < 2; ++k) dst[m][k] = *(const PG8_LAS bf16x8*)(lds + PG8_SA(b, h) + aoff + m * 2048 + k * 1024); } while (0)
#define PG8_LDB(dst, b, h) do { _Pragma("unroll") for (int n = 0; n < 2; ++n) _Pragma("unroll") for (int k = 0; k < 2; ++k) dst[n][k] = *(const PG8_LAS bf16x8*)(lds + PG8_SB(b, h) + boff + n * 2048 + k * 1024); } while (0)
#define PG8_MMA(ai, bj, At, Bt) do { __builtin_amdgcn_s_setprio(1); _Pragma("unroll") for (int m = 0; m < 4; ++m) _Pragma("unroll") for (int n = 0; n < 2; ++n) _Pragma("unroll") for (int k = 0; k < 2; ++k) \
        acc[ai][bj][m][n] = __builtin_amdgcn_mfma_f32_16x16x32_bf16(Bt[n][k], At[m][k], acc[ai][bj][m][n], 0, 0, 0); __builtin_amdgcn_s_setprio(0); } while (0)
#define PG8_WAIT_V(n) asm volatile("s_waitcnt vmcnt(" #n ")" ::: "memory")
#define PG8_WAIT_L(n) asm volatile("s_waitcnt lgkmcnt(" #n ")" ::: "memory")
#define PG8_BAR __builtin_amdgcn_s_barrier()
#define PG8_SCHED __builtin_amdgcn_sched_barrier(0)
    Unit cur, nxt; int ui = 0;
    if (!S.next(0, cur)) return;
    f32x4 acc[2][2][4][2];
#pragma unroll
    for (int a = 0; a < 2; ++a)
#pragma unroll
        for (int b = 0; b < 2; ++b)
#pragma unroll
            for (int m = 0; m < 4; ++m)
#pragma unroll
                for (int n = 0; n < 2; ++n) acc[a][b][m][n] = (f32x4){0.f, 0.f, 0.f, 0.f};
    bf16x8 At[4][2], B0[2][2], B1[2][2];
    const char* cA = (const char*)g.A + (size_t)cur.pm * tstep; const char* cB = (const char*)g.Bt + (size_t)cur.pn * tstep;
    S.a_ready(cur);
    PG8_STAGE(PG8_SB(0, 0), cB, voffB); PG8_STAGE(PG8_SA(0, 0), cA, voffA); PG8_STAGE(PG8_SB(0, 1), cB + hstep, voffB); PG8_STAGE(PG8_SA(0, 1), cA + hstep, voffA);
    if (wr == 1) PG8_BAR;
    PG8_WAIT_V(4); PG8_BAR;
    PG8_STAGE(PG8_SB(1, 0), cB + kstep, voffB); PG8_STAGE(PG8_SA(1, 0), cA + kstep, voffA); PG8_STAGE(PG8_SB(1, 1), cB + hstep + kstep, voffB);
    PG8_WAIT_V(6); PG8_BAR;
    for (;;) {
        const bool has_next = S.next(ui + 1, nxt);
        const char* nA = has_next ? (const char*)g.A + (size_t)nxt.pm * tstep : cA; const char* nB = has_next ? (const char*)g.Bt + (size_t)nxt.pn * tstep : cB;
        for (int t = 0; t < nt; t += 2) {
            const bool last = (t == nt - 2);
            const char* a1 = cA + (size_t)(t + 1) * kstep;
            const char* a2 = last ? nA : cA + (size_t)(t + 2) * kstep; const char* b2 = last ? nB : cB + (size_t)(t + 2) * kstep;
            const char* a3 = a2 + kstep; const char* b3 = b2 + kstep;
            if (last && has_next) S.a_ready(nxt);
            PG8_LDB(B0, 0, 0); PG8_SCHED; PG8_LDA(At, 0, 0); PG8_STAGE(PG8_SA(1, 1), a1 + hstep, voffA);
            PG8_WAIT_L(8); PG8_BAR; PG8_WAIT_L(0); PG8_MMA(0, 0, At, B0); PG8_BAR; PG8_SCHED;
            PG8_LDB(B1, 0, 1); PG8_STAGE(PG8_SB(0, 0), b2, voffB);
            PG8_BAR; PG8_WAIT_L(0); PG8_MMA(0, 1, At, B1); PG8_BAR;
            PG8_LDA(At, 0, 1); PG8_STAGE(PG8_SA(0, 0), a2, voffA);
            PG8_BAR; PG8_WAIT_L(0); PG8_MMA(1, 0, At, B0); PG8_BAR; PG8_SCHED;
            PG8_STAGE(PG8_SB(0, 1), b2 + hstep, voffB);
            PG8_WAIT_V(6); PG8_BAR; PG8_MMA(1, 1, At, B1); PG8_BAR;
            PG8_LDB(B0, 1, 0); PG8_SCHED; PG8_LDA(At, 1, 0); PG8_STAGE(PG8_SA(0, 1), a2 + hstep, voffA);
            PG8_WAIT_L(8); PG8_BAR; PG8_WAIT_L(0); PG8_MMA(0, 0, At, B0); PG8_BAR; PG8_SCHED;
            PG8_LDB(B1, 1, 1); PG8_STAGE(PG8_SB(1, 0), b3, voffB);
            PG8_BAR; PG8_WAIT_L(0); PG8_MMA(0, 1, At, B1); PG8_BAR;
            PG8_LDA(At, 1, 1); PG8_STAGE(PG8_SA(1, 0), a3, voffA);
            PG8_BAR; PG8_WAIT_L(0); PG8_MMA(1, 0, At, B0); PG8_BAR; PG8_SCHED;
            PG8_STAGE(PG8_SB(1, 1), b3 + hstep, voffB);
            PG8_WAIT_V(6); PG8_BAR; PG8_MMA(1, 1, At, B1); PG8_BAR;
        }
        if constexpr (!Epi::AFTER_DRAIN) { E(acc, cur, wr, wc, fr, fq); S.done(cur); }
        if (!has_next) break;
#pragma unroll
        for (int a = 0; a < 2; ++a)
#pragma unroll
            for (int b = 0; b < 2; ++b)
#pragma unroll
                for (int m = 0; m < 4; ++m)
#pragma unroll
                    for (int n = 0; n < 2; ++n) acc[a][b][m][n] = (f32x4){0.f, 0.f, 0.f, 0.f};
        cur = nxt; cA = nA; cB = nB; ++ui;
    }
    PG8_WAIT_V(0);
    if (wr == 0) PG8_BAR;
    PG8_BAR;
    if constexpr (Epi::AFTER_DRAIN) { E.fused(acc, cur, wr, wc, fr, fq, lds, wid, lane); S.done(cur); }
#undef PG8_SA
#undef PG8_SB
#undef PG8_STAGE
#undef PG8_LDA
#undef PG8_LDB
#undef PG8_MMA
#undef PG8_WAIT_V
#undef PG8_WAIT_L
#undef PG8_BAR
#undef PG8_SCHED
}

}

constexpr int SROW = 144;
constexpr int A_ST = 256 * SROW, B_ST = 128 * SROW, ST_BYTES = A_ST + B_ST;

DEV void gemm_kloop(f32x4 (&acc)[4][4], const bf16_t* __restrict__ A, int lda, const bf16_t* __restrict__ Bt, int ldb,
                    int K, char* smem) {
  const int tid = ltid(), lane = tid & 63, w = tid >> 6, wm = w >> 1, wn = w & 1;
  const int fr = lane & 15, fq = lane >> 4;
  const int lrow = tid >> 3, lch = tid & 7;
  const bf16_t* ga = A + (size_t)lrow * lda + lch * 8;
  const bf16_t* gb = Bt + (size_t)lrow * ldb + lch * 8;
  u32x4 ra[4], rb[2];
#pragma unroll
  for (int i = 0; i < 4; ++i) ra[i] = *(const u32x4*)(ga + (size_t)(64 * i) * lda);
#pragma unroll
  for (int i = 0; i < 2; ++i) rb[i] = *(const u32x4*)(gb + (size_t)(64 * i) * ldb);
  char* swa = smem + lrow * SROW + lch * 16;
  char* swb = swa + A_ST;
  __syncthreads();
#pragma unroll
  for (int i = 0; i < 4; ++i) *(u32x4*)(swa + i * 64 * SROW) = ra[i];
#pragma unroll
  for (int i = 0; i < 2; ++i) *(u32x4*)(swb + i * 64 * SROW) = rb[i];
  __syncthreads();
  const int nk = K >> 6;
  const char* sra = smem + (wm * 64 + fr) * SROW + fq * 16;
  const char* srb = smem + A_ST + (wn * 64 + fr) * SROW + fq * 16;
  for (int kt = 0; kt < nk; ++kt) {
    const int cur = kt & 1;
    if (kt + 1 < nk) {
#pragma unroll
      for (int i = 0; i < 4; ++i) ra[i] = *(const u32x4*)(ga + (size_t)(64 * i) * lda + (kt + 1) * 64);
#pragma unroll
      for (int i = 0; i < 2; ++i) rb[i] = *(const u32x4*)(gb + (size_t)(64 * i) * ldb + (kt + 1) * 64);
    }
#pragma unroll
    for (int ks = 0; ks < 2; ++ks) {
      bf16x8 af[4], bfr[4];
#pragma unroll
      for (int mi = 0; mi < 4; ++mi) af[mi] = *(const bf16x8*)(sra + cur * ST_BYTES + mi * 16 * SROW + ks * 64);
#pragma unroll
      for (int ni = 0; ni < 4; ++ni) bfr[ni] = *(const bf16x8*)(srb + cur * ST_BYTES + ni * 16 * SROW + ks * 64);
#pragma unroll
      for (int mi = 0; mi < 4; ++mi)
#pragma unroll
        for (int ni = 0; ni < 4; ++ni)
          acc[mi][ni] = __builtin_amdgcn_mfma_f32_16x16x32_bf16(bfr[ni], af[mi], acc[mi][ni], 0, 0, 0);
    }
    if (kt + 1 < nk) {
      const int nx = cur ^ 1;
#pragma unroll
      for (int i = 0; i < 4; ++i) *(u32x4*)(swa + nx * ST_BYTES + i * 64 * SROW) = ra[i];
#pragma unroll
      for (int i = 0; i < 2; ++i) *(u32x4*)(swb + nx * ST_BYTES + i * 64 * SROW) = rb[i];
    }
    __syncthreads();
  }
}
DEV void zero_acc(f32x4 (&acc)[4][4]) {
#pragma unroll
  for (int a = 0; a < 4; ++a)
#pragma unroll
    for (int b = 0; b < 4; ++b) acc[a][b] = (f32x4){0.f, 0.f, 0.f, 0.f};
}
DEV void tile_pm_pn(int L, int nN, int& pm, int& pn) {
  const int g = L / (4 * nN), wi = L % (4 * nN);
  pm = g * 4 + (wi & 3);
  pn = wi >> 2;
}

DEV int conv_srccol(int n) {
  const int tile = n >> 8, w = n & 255;
  return w < 128 ? tile * 128 + w : 512 + tile * 128 + (w - 128);
}
DEV void cvt_job(const float* __restrict__ src, int K, int N, int ldsrc, bf16_t* __restrict__ dst, int nperm, int& tbase, char* smem) {
  float* lds = (float*)smem;
  const int nkt = K >> 6, nnt = N >> 6, cnt = nkt * nnt;
  const int G = gridDim.x;
  const int first = (int)((blockIdx.x + G - (tbase % G)) % G);
  const int tid = ltid();
  for (int t = first; t < cnt; t += G) {
    const int kt = t % nkt, nt = t / nkt;
    const int ty = tid >> 4, tx = tid & 15;
    const int n = nt * 64 + tx * 4;
    const int sc = (n < nperm) ? conv_srccol(n) : n;
#pragma unroll
    for (int i = 0; i < 2; ++i) {
      const int k = ty + 32 * i;
      const float4 v = *(const float4*)(src + (size_t)(kt * 64 + k) * ldsrc + sc);
      float* d = lds + k * 65 + tx * 4;
      d[0] = v.x; d[1] = v.y; d[2] = v.z; d[3] = v.w;
    }
    __syncthreads();
    {
      const int nn = tid >> 3, kc = tid & 7;
      float v[8];
#pragma unroll
      for (int j = 0; j < 8; ++j) v[j] = lds[(kc * 8 + j) * 65 + nn];
      uint4 o;
      o.x = pk2(v[0], v[1]); o.y = pk2(v[2], v[3]); o.z = pk2(v[4], v[5]); o.w = pk2(v[6], v[7]);
      *(uint4*)(dst + (size_t)(nt * 64 + nn) * K + kt * 64 + kc * 8) = o;
    }
    __syncthreads();
  }
  tbase += cnt;
}
DEV void cvt_phase(const Params& p, int l, char* smem) {
  char* wb = p.ws + O_WB;
  int tb = 0;
  const float* win = p.w_in + (size_t)l * 1024 * DIN;
  cvt_job(win, 1024, NZ, DIN, (bf16_t*)(wb + W_WIN), 1024, tb, smem);
  cvt_job(win + NZ, 1024, 3072, DIN, (bf16_t*)(wb + W_WIN) + (size_t)NZP * 1024, 0, tb, smem);
  cvt_job(p.mlp_w1 + (size_t)l * 1024 * 4096, 1024, 4096, 4096, (bf16_t*)(wb + W_W1), 0, tb, smem);
  cvt_job(p.mlp_w2 + (size_t)l * 4096 * 1024, 4096, 1024, 1024, (bf16_t*)(wb + W_W2), 0, tb, smem);
  cvt_job(p.w_out + (size_t)l * 1024 * 1024, 1024, 1024, 1024, (bf16_t*)(wb + W_WOUT), 0, tb, smem);
  cvt_job(p.p_conv + (size_t)l * 512 * 1024, 512, 1024, 1024, (bf16_t*)(wb + W_PCV), 0, tb, smem);
  cvt_job(p.p_att + (size_t)l * 512 * 1024, 512, 1024, 1024, (bf16_t*)(wb + W_PAT), 0, tb, smem);
  cvt_job(p.p_rwkv + (size_t)l * 512 * 1024, 512, 1024, 1024, (bf16_t*)(wb + W_PRW), 0, tb, smem);
  for (int d = 0; d < 2; ++d) {
    cvt_job(p.rwkv_w2 + (size_t)(l * 2 + d) * 64 * 512, 64, 512, 512, (bf16_t*)(wb + W_LW2) + d * 512 * 64, 0, tb, smem);
    cvt_job(p.rwkv_a2 + (size_t)(l * 2 + d) * 64 * 512, 64, 512, 512, (bf16_t*)(wb + W_LA2) + d * 512 * 64, 0, tb, smem);
  }
  cvt_job(p.rwkv_g2 + (size_t)l * 128 * 512, 128, 512, 512, (bf16_t*)(wb + W_LG2), 0, tb, smem);
}

DEV void mod_phase(const Params& p, char* smem) {
  float* sc = (float*)smem;
  float* red = sc + 9 * 1024;
  float* MOD = (float*)(p.ws + O_MOD);
  const int tid = ltid();
  if ((int)blockIdx.x >= 192) return;
  for (int i = tid; i < 9 * 1024; i += 512) {
    const int r = i >> 10, k = i & 1023;
    const float v = r < 8 ? p.c[r * 1024 + k] : p.c_ctx[k];
    sc[i] = v * __builtin_amdgcn_rcpf(1.f + __expf(-v));
  }
  __syncthreads();
  for (int tile = blockIdx.x; tile < 192; tile += gridDim.x) {
    const int l = tile / 96, n0 = (tile % 96) * 64;
    const int kq = tid >> 6, col = tid & 63;
    float acc[9];
#pragma unroll
    for (int r = 0; r < 9; ++r) acc[r] = 0.f;
    const float* wp = p.mod_w + ((size_t)l * 1024 + kq * 128) * 6144 + n0 + col;
#pragma unroll 32
    for (int k = 0; k < 128; ++k) {
      const float wv = wp[(size_t)k * 6144];
#pragma unroll
      for (int r = 0; r < 9; ++r) acc[r] += sc[r * 1024 + kq * 128 + k] * wv;
    }
#pragma unroll
    for (int r = 0; r < 9; ++r) red[(kq * 9 + r) * 64 + col] = acc[r];
    __syncthreads();
    for (int idx = tid; idx < 576; idx += 512) {
      const int r = idx >> 6, cc = idx & 63;
      float s = p.mod_b[l * 6144 + n0 + cc];
#pragma unroll
      for (int q = 0; q < 8; ++q) s += red[(q * 9 + r) * 64 + cc];
      MOD[(size_t)(l * 9 + r) * 6144 + n0 + cc] = s;
    }
    __syncthreads();
  }
}

DEV void norm_phase(const Params& p, int l, int which, bf16_t* __restrict__ Hd, bool first, int nrows = T_ALL) {
  const float* g = (which ? p.norm2_g : p.norm1_g) + l * 1024;
  const float* MOD = (const float*)(p.ws + O_MOD);
  const int lane = ltid() & 63, w = ltid() >> 6;
  const int stride = gridDim.x * 8;
  f32x4 gg[4];
#pragma unroll
  for (int i = 0; i < 4; ++i) gg[i] = *(const f32x4*)(g + i * 256 + lane * 4);
  auto srcp = [&](int row) -> const float* {
    if (first) return row < T_LAT ? p.x + (size_t)row * DM : p.ctx + (size_t)(row - T_LAT) * DM;
    return xrow(p, row);
  };
  int row = blockIdx.x * 8 + w;
  f32x4 nv[4];
  if (row < nrows) {
    const float* s = srcp(row);
#pragma unroll
    for (int i = 0; i < 4; ++i) nv[i] = *(const f32x4*)(s + i * 256 + lane * 4);
  }
  for (; row < nrows; row += stride) {
    f32x4 v[4];
#pragma unroll
    for (int i = 0; i < 4; ++i) v[i] = nv[i];
    if (row + stride < nrows) {
      const float* s = srcp(row + stride);
#pragma unroll
      for (int i = 0; i < 4; ++i) nv[i] = *(const f32x4*)(s + i * 256 + lane * 4);
    }
    const float* md = MOD + (size_t)(l * 9 + modrow(row)) * 6144 + which * 3072;
    f32x4 sh[4], scl[4];
#pragma unroll
    for (int i = 0; i < 4; ++i) { sh[i] = *(const f32x4*)(md + i * 256 + lane * 4); scl[i] = *(const f32x4*)(md + 1024 + i * 256 + lane * 4); }
    float ss = 0.f;
#pragma unroll
    for (int i = 0; i < 4; ++i) ss += v[i][0] * v[i][0] + v[i][1] * v[i][1] + v[i][2] * v[i][2] + v[i][3] * v[i][3];
    const float rs = __builtin_amdgcn_rsqf(wsum(ss) * (1.f / 1024.f) + 1e-6f);
#pragma unroll
    for (int i = 0; i < 4; ++i) {
      const int c = i * 256 + lane * 4;
      const f32x4 h = v[i] * rs * gg[i] * (scl[i] + 1.f) + sh[i];
      uint2 o;
      o.x = pk2(h[0], h[1]); o.y = pk2(h[2], h[3]);
      *(uint2*)(Hd + (size_t)row * DM + c) = o;
    }
  }
}

DEV void rope2(float a, float b, float ang, float& o0, float& o1) {
  const float cs = __cosf(ang), sn = __sinf(ang);
  o0 = a * cs - b * sn;
  o1 = a * sn + b * cs;
}
struct EpiIn {
  static constexpr bool PERM = true, AFTER_DRAIN = false;
  bf16_t *ZU, *ZQ, *ZK, *VT, *ZRW;
  DEV void operator()(const f32x4 (&acc)[2][2][4][2], const pg8::Unit& u, int wr, int wc, int fr, int fq) const {
    const int row0 = u.pm * 256 + wr * 64 + fr, cl = wc * 32 + 8 * fq, pn = u.pn;
    if (pn < 4) {
#pragma unroll
      for (int ai = 0; ai < 2; ++ai)
#pragma unroll
        for (int m = 0; m < 4; ++m) {
          const int row = row0 + ai * 128 + m * 16;
          const f32x4 a0 = acc[ai][0][m][0], a1 = acc[ai][0][m][1], b0 = acc[ai][1][m][0], b1 = acc[ai][1][m][1];
          u32x4 o;
          o[0] = pk2(a0[0] * sigmoidf_(b0[0]), a0[1] * sigmoidf_(b0[1]));
          o[1] = pk2(a0[2] * sigmoidf_(b0[2]), a0[3] * sigmoidf_(b0[3]));
          o[2] = pk2(a1[0] * sigmoidf_(b1[0]), a1[1] * sigmoidf_(b1[1]));
          o[3] = pk2(a1[2] * sigmoidf_(b1[2]), a1[3] * sigmoidf_(b1[3]));
          *(u32x4*)(ZU + (size_t)row * 512 + pn * 128 + cl) = o;
        }
    } else if (pn < 8) {
      const bool isq = pn < 6;
      bf16_t* Z = isq ? ZQ : ZK;
      const float qs = isq ? 0.125f * 1.4426950408889634f : 1.f;
      const int cbase = (pn - (isq ? 4 : 6)) * 256 + cl;
#pragma unroll
      for (int ai = 0; ai < 2; ++ai)
#pragma unroll
        for (int m = 0; m < 4; ++m) {
          const int row = row0 + ai * 128 + m * 16;
#pragma unroll
          for (int bj = 0; bj < 2; ++bj) {
            const int c = cbase + bj * 128;
            float v[8];
#pragma unroll
            for (int j = 0; j < 4; ++j) { v[j] = acc[ai][bj][m][0][j]; v[4 + j] = acc[ai][bj][m][1][j]; }
            if (row < T_LAT) {
              const int t = row & 4095, d = c & 63, p0 = d >> 1;
              const float pos = (float)((p0 < 16) ? (t >> 6) : (t & 63));
              const int fi = p0 & 15;
#pragma unroll
              for (int q = 0; q < 4; ++q) {
                const float fr_ = __builtin_amdgcn_exp2f(-(float)(fi + q) * 0.8304820237218406f);
                float o0, o1;
                rope2(v[2 * q], v[2 * q + 1], pos * fr_, o0, o1);
                v[2 * q] = o0; v[2 * q + 1] = o1;
              }
            }
            u32x4 o;
            o[0] = pk2(v[0] * qs, v[1] * qs); o[1] = pk2(v[2] * qs, v[3] * qs);
            o[2] = pk2(v[4] * qs, v[5] * qs); o[3] = pk2(v[6] * qs, v[7] * qs);
            *(u32x4*)(Z + (size_t)row * 512 + c) = o;
          }
        }
    } else if (pn < 10) {
#pragma unroll
      for (int ai = 0; ai < 2; ++ai)
#pragma unroll
        for (int m = 0; m < 4; ++m) {
          const int row = row0 + ai * 128 + m * 16;
          int b, kidx;
          if (row < T_LAT) { b = row >> 12; kidx = 256 + (row & 4095); } else { b = (row - T_LAT) >> 8; kidx = (row - T_LAT) & 255; }
#pragma unroll
          for (int bj = 0; bj < 2; ++bj) {
            const int head = (pn - 8) * 2 + bj;
            bf16_t* dst = VT + ((size_t)((b * 4 + head) * 128 + cl)) * TK + kidx;
#pragma unroll
            for (int j = 0; j < 4; ++j) {
              dst[(size_t)j * TK] = f2bf(acc[ai][bj][m][0][j]);
              dst[(size_t)(4 + j) * TK] = f2bf(acc[ai][bj][m][1][j]);
            }
          }
        }
    } else {
#pragma unroll
      for (int ai = 0; ai < 2; ++ai)
#pragma unroll
        for (int m = 0; m < 4; ++m) {
          const int row = row0 + ai * 128 + m * 16;
#pragma unroll
          for (int bj = 0; bj < 2; ++bj) {
            const int c = (pn - 10) * 256 + bj * 128 + cl;
            if (c < 1920) {
              u32x4 o;
              o[0] = pk2(acc[ai][bj][m][0][0], acc[ai][bj][m][0][1]); o[1] = pk2(acc[ai][bj][m][0][2], acc[ai][bj][m][0][3]);
              o[2] = pk2(acc[ai][bj][m][1][0], acc[ai][bj][m][1][1]); o[3] = pk2(acc[ai][bj][m][1][2], acc[ai][bj][m][1][3]);
              *(u32x4*)(ZRW + (size_t)row * 1920 + c) = o;
            }
          }
        }
    }
  }
};
DEV void gemm_in_phase(const Params& p, char* smem) {
  EpiIn E;
  E.ZU = (bf16_t*)(p.ws + O_ZU); E.ZQ = (bf16_t*)(p.ws + O_ZQ); E.ZK = (bf16_t*)(p.ws + O_ZK);
  E.VT = (bf16_t*)(p.ws + O_VT); E.ZRW = (bf16_t*)(p.ws + O_ZRW);
  pg8::Gemm g;
  g.A = (const bf16_t*)(p.ws + O_H0); g.Bt = (const bf16_t*)(p.ws + O_WB + W_WIN); g.M = T_ALL; g.N = NZP; g.K = 1024;
  pg8::StaticOrder S;
  S.init(g.M, g.N, (int)gridDim.x, (int)blockIdx.x);
  __syncthreads();
  pg8::gemm_phase<EpiIn, pg8::StaticOrder>((PG8_LAS unsigned char*)smem, g, S, E);
  __syncthreads();
}

constexpr int KROW = 272, VROW = 144, ATT_ST = 64 * KROW + 128 * VROW;
constexpr int ATT2_ST = 2 * 128 * KROW;
DEV int key_of_slot(int x) { return (x & 0x13) | ((x & 8) >> 1) | ((x & 4) << 1); }

DEV void attn_tile(const Params& p, int l, int tile, char* smem, bool do_store = true) {
  bf16_t* ZQ = (bf16_t*)(p.ws + O_ZQ);
  const bf16_t* ZK = (const bf16_t*)(p.ws + O_ZK);
  const bf16_t* VT = (const bf16_t*)(p.ws + O_VT);
  int b, head, q0, nkeys, qbase;
  if (tile < 1024) { b = tile >> 7; head = (tile >> 5) & 3; q0 = (tile & 31) * 128; nkeys = TK; qbase = b * SEQ; }
  else { const int tt = tile - 1024; b = tt >> 3; head = (tt >> 1) & 3; q0 = (tt & 1) * 128; nkeys = CTXL; qbase = T_LAT + b * CTXL; }
  const int tid = ltid(), lane = tid & 63, w = tid >> 6, ql = lane & 31, hh = lane >> 5, map = w >> 2, qg = w & 3;
  const int qrow = qbase + q0 + qg * 32 + ql;
  const float lam_init = l == 0 ? 0.2f : 0.35550907f;
  float lam;
  {
    const float a1 = p.att_lq1[l * 64 + lane] * p.att_lk1[l * 64 + lane];
    const float a2 = p.att_lq2[l * 64 + lane] * p.att_lk2[l * 64 + lane];
    lam = __expf(wsum(a1)) - __expf(wsum(a2)) + lam_init;
  }
  bf16x8 qf[4];
#pragma unroll
  for (int s = 0; s < 4; ++s) qf[s] = *(const bf16x8*)(ZQ + (size_t)qrow * 512 + head * 128 + map * 64 + s * 16 + hh * 8);
  f32x16 o[4];
#pragma unroll
  for (int dt = 0; dt < 4; ++dt)
#pragma unroll
    for (int e = 0; e < 16; ++e) o[dt][e] = 0.f;
  float m = -1e30f, lsum = 0.f;
  const int kr0 = tid >> 4, kch = tid & 15;
  const int vr0 = tid >> 4, vch = tid & 15;
  const bf16_t* vtb = VT + ((size_t)((b * 4 + head) * 128)) * TK;
  u32x4 kreg[4], vreg[4];
  auto gload = [&](int kt) {
    const int k0 = kt * 128;
#pragma unroll
    for (int i = 0; i < 4; ++i) {
      const int kidx = k0 + kr0 + 32 * i;
      const int krow = kidx < CTXL ? T_LAT + b * CTXL + kidx : b * SEQ + kidx - CTXL;
      kreg[i] = *(const u32x4*)(ZK + (size_t)krow * 512 + head * 128 + kch * 8);
      vreg[i] = *(const u32x4*)(vtb + (size_t)(vr0 + 32 * i) * TK + k0 + vch * 8);
    }
  };
  auto lstore = [&](int st) {
    char* Ks = smem + st * ATT2_ST;
    char* Vs = Ks + 128 * KROW;
#pragma unroll
    for (int i = 0; i < 4; ++i) {
      *(u32x4*)(Ks + (kr0 + 32 * i) * KROW + kch * 16) = kreg[i];
      *(u32x4*)(Vs + (vr0 + 32 * i) * KROW + vch * 16) = vreg[i];
    }
  };
  const int nkt = nkeys >> 7;
  gload(0);
  __syncthreads();
  lstore(0);
  __syncthreads();
  const int kos = key_of_slot(ql);
  for (int kt = 0; kt < nkt; ++kt) {
    const int cur = kt & 1;
    if (kt + 1 < nkt) gload(kt + 1);
    const char* Ks = smem + cur * ATT2_ST;
    const char* Vs = Ks + 128 * KROW;
#pragma unroll
    for (int h2 = 0; h2 < 2; ++h2) {
    const char* kp = Ks + (h2 * 64 + kos) * KROW + (map * 64 + hh * 8) * 2;
    const char* vp = Vs + ql * KROW + hh * 16 + h2 * 128;
    bf16x8 kf0[4], kf1[4];
#pragma unroll
    for (int ks = 0; ks < 4; ++ks) { kf0[ks] = *(const bf16x8*)(kp + ks * 32); kf1[ks] = *(const bf16x8*)(kp + 32 * KROW + ks * 32); }
    f32x16 s0, s1;
#pragma unroll
    for (int e = 0; e < 16; ++e) { s0[e] = 0.f; s1[e] = 0.f; }
#pragma unroll
    for (int ks = 0; ks < 4; ++ks) s0 = __builtin_amdgcn_mfma_f32_32x32x16_bf16(kf0[ks], qf[ks], s0, 0, 0, 0);
#pragma unroll
    for (int ks = 0; ks < 4; ++ks) s1 = __builtin_amdgcn_mfma_f32_32x32x16_bf16(kf1[ks], qf[ks], s1, 0, 0, 0);
    bf16x8 vf[8];
#pragma unroll
    for (int dt = 0; dt < 4; ++dt)
#pragma unroll
      for (int k2 = 0; k2 < 2; ++k2) vf[dt * 2 + k2] = *(const bf16x8*)(vp + dt * 32 * KROW + (k2 * 16) * 2);
    float mx = fmaxf(s0[0], s1[0]);
#pragma unroll
    for (int e = 1; e < 16; ++e) mx = fmaxf(mx, fmaxf(s0[e], s1[e]));
    mx = xor32_max(mx);
    const float mnew = (mx > m + 8.f) ? mx : m;
    if (__any(mnew > m)) {
      const float alpha = __builtin_amdgcn_exp2f(m - mnew);
      lsum *= alpha;
#pragma unroll
      for (int dt = 0; dt < 4; ++dt)
#pragma unroll
        for (int e = 0; e < 16; ++e) o[dt][e] *= alpha;
    }
    m = mnew;
    bf16x8 pb0[2], pb1[2];
    {
      float pe[16];
#pragma unroll
      for (int e = 0; e < 16; ++e) { pe[e] = __builtin_amdgcn_exp2f(s0[e] - m); lsum += pe[e]; }
#pragma unroll
      for (int k2 = 0; k2 < 2; ++k2) {
        u32x4 u;
        u[0] = pk2(pe[8 * k2 + 0], pe[8 * k2 + 1]); u[1] = pk2(pe[8 * k2 + 2], pe[8 * k2 + 3]);
        u[2] = pk2(pe[8 * k2 + 4], pe[8 * k2 + 5]); u[3] = pk2(pe[8 * k2 + 6], pe[8 * k2 + 7]);
        pb0[k2] = __builtin_bit_cast(bf16x8, u);
      }
    }
#pragma unroll
    for (int dt = 0; dt < 4; ++dt)
#pragma unroll
      for (int k2 = 0; k2 < 2; ++k2) o[dt] = __builtin_amdgcn_mfma_f32_32x32x16_bf16(vf[dt * 2 + k2], pb0[k2], o[dt], 0, 0, 0);
#pragma unroll
    for (int dt = 0; dt < 4; ++dt)
#pragma unroll
      for (int k2 = 0; k2 < 2; ++k2) vf[dt * 2 + k2] = *(const bf16x8*)(vp + dt * 32 * KROW + (32 + k2 * 16) * 2);
    {
      float pe[16];
#pragma unroll
      for (int e = 0; e < 16; ++e) { pe[e] = __builtin_amdgcn_exp2f(s1[e] - m); lsum += pe[e]; }
#pragma unroll
      for (int k2 = 0; k2 < 2; ++k2) {
        u32x4 u;
        u[0] = pk2(pe[8 * k2 + 0], pe[8 * k2 + 1]); u[1] = pk2(pe[8 * k2 + 2], pe[8 * k2 + 3]);
        u[2] = pk2(pe[8 * k2 + 4], pe[8 * k2 + 5]); u[3] = pk2(pe[8 * k2 + 6], pe[8 * k2 + 7]);
        pb1[k2] = __builtin_bit_cast(bf16x8, u);
      }
    }
#pragma unroll
    for (int dt = 0; dt < 4; ++dt)
#pragma unroll
      for (int k2 = 0; k2 < 2; ++k2) o[dt] = __builtin_amdgcn_mfma_f32_32x32x16_bf16(vf[dt * 2 + k2], pb1[k2], o[dt], 0, 0, 0);
    }
    if (kt + 1 < nkt) lstore(cur ^ 1);
    __syncthreads();
  }
  const float ltot = xor32_sum(lsum);
  float* ex = (float*)smem;
  if (map == 1) {
    const float c2 = lam / ltot;
#pragma unroll
    for (int dt = 0; dt < 4; ++dt)
#pragma unroll
      for (int e = 0; e < 16; ++e) {
        const int dv = dt * 32 + 8 * (e >> 2) + 4 * hh + (e & 3);
        ex[(qg * 128 + dv) * 32 + ql] = o[dt][e] * c2;
      }
  }
  __syncthreads();
  if (map == 0 && do_store) {
    const float c1 = 1.f / ltot;
    float ss = 0.f;
#pragma unroll
    for (int dt = 0; dt < 4; ++dt)
#pragma unroll
      for (int e = 0; e < 16; ++e) {
        const int dv = dt * 32 + 8 * (e >> 2) + 4 * hh + (e & 3);
        const float v = o[dt][e] * c1 - ex[(qg * 128 + dv) * 32 + ql];
        o[dt][e] = v;
        ss += v * v;
      }
    ss = xor32_sum(ss);
    const float rs = __builtin_amdgcn_rsqf(ss * (1.f / 128.f) + 1e-5f) * (1.f - lam_init);
    const float* sg = p.att_subln_g + l * 128;
#pragma unroll
    for (int dt = 0; dt < 4; ++dt)
#pragma unroll
      for (int i = 0; i < 4; ++i) {
        const int dv = dt * 32 + 8 * i + 4 * hh;
        const float4 g4 = *(const float4*)(sg + dv);
        uint2 u;
        u.x = pk2(o[dt][4 * i + 0] * rs * g4.x, o[dt][4 * i + 1] * rs * g4.y);
        u.y = pk2(o[dt][4 * i + 2] * rs * g4.z, o[dt][4 * i + 3] * rs * g4.w);
        *(uint2*)(ZQ + (size_t)qrow * 512 + head * 128 + dv) = u;
      }
  }
  __syncthreads();
}

DEV void conv_tile(const Params& p, int l, int tile, char* smem) {
  const bf16_t* ZU = (const bf16_t*)(p.ws + O_ZU);
  bf16_t* YCV = (bf16_t*)(p.ws + O_YCV);
  const int r0 = tile * 64;
  int s_lo, s_hi;
  if (r0 < T_LAT) { s_lo = r0 & ~4095; s_hi = s_lo + SEQ; } else { s_lo = T_LAT + ((r0 - T_LAT) & ~255); s_hi = s_lo + CTXL; }
  const int tid = ltid(), lane = tid & 63, w = tid >> 6, c0 = lane * 8;
  const int t0 = r0 + w * 8;
  const float* wp = p.conv_dw_w + (size_t)l * 31 * 512 + c0;
  float acc[8][8];
  {
    const f32x4 b0 = *(const f32x4*)(p.conv_dw_b + l * 512 + c0), b1 = *(const f32x4*)(p.conv_dw_b + l * 512 + c0 + 4);
#pragma unroll
    for (int t = 0; t < 8; ++t)
#pragma unroll
      for (int j = 0; j < 4; ++j) { acc[t][j] = b0[j]; acc[t][4 + j] = b1[j]; }
  }
  f32x4 wk[8][2];
#pragma unroll
  for (int q = 0; q < 8; ++q) { wk[q][0] = (f32x4){0.f, 0.f, 0.f, 0.f}; wk[q][1] = (f32x4){0.f, 0.f, 0.f, 0.f}; }
#pragma unroll 4
  for (int s = 0; s < 40; ++s) {
    const int rr = t0 - 15 + s;
    u32x4 uv = {0u, 0u, 0u, 0u};
    if (rr >= s_lo && rr < s_hi) uv = *(const u32x4*)(ZU + (size_t)rr * 512 + c0);
    float u[8];
#pragma unroll
    for (int q = 0; q < 4; ++q) { u[2 * q] = lo_bf(uv[q]); u[2 * q + 1] = hi_bf(uv[q]); }
#pragma unroll
    for (int q = 7; q > 0; --q) { wk[q][0] = wk[q - 1][0]; wk[q][1] = wk[q - 1][1]; }
    wk[0][0] = (f32x4){0.f, 0.f, 0.f, 0.f}; wk[0][1] = (f32x4){0.f, 0.f, 0.f, 0.f};
    if (s <= 30) { wk[0][0] = *(const f32x4*)(wp + s * 512); wk[0][1] = *(const f32x4*)(wp + s * 512 + 4); }
#pragma unroll
    for (int t = 0; t < 8; ++t) {
#pragma unroll
      for (int j = 0; j < 4; ++j) { acc[t][j] += wk[t][0][j] * u[j]; acc[t][4 + j] += wk[t][1][j] * u[4 + j]; }
    }
  }
  const f32x4 g0 = *(const f32x4*)(p.conv_ln_g + l * 512 + c0), g1 = *(const f32x4*)(p.conv_ln_g + l * 512 + c0 + 4);
  const f32x4 e0 = *(const f32x4*)(p.conv_ln_b + l * 512 + c0), e1 = *(const f32x4*)(p.conv_ln_b + l * 512 + c0 + 4);
#pragma unroll
  for (int t = 0; t < 8; ++t) {
    float s1 = 0.f;
#pragma unroll
    for (int j = 0; j < 8; ++j) s1 += acc[t][j];
    const float mu = wsum(s1) * (1.f / 512.f);
    float s2 = 0.f;
#pragma unroll
    for (int j = 0; j < 8; ++j) { acc[t][j] -= mu; s2 += acc[t][j] * acc[t][j]; }
    const float rs = __builtin_amdgcn_rsqf(wsum(s2) * (1.f / 512.f) + 1e-5f);
    float y[8];
#pragma unroll
    for (int j = 0; j < 4; ++j) {
      const float z0 = acc[t][j] * rs * g0[j] + e0[j], z1 = acc[t][4 + j] * rs * g1[j] + e1[j];
      y[j] = z0 * sigmoidf_(z0); y[4 + j] = z1 * sigmoidf_(z1);
    }
    u32x4 o;
    o[0] = pk2(y[0], y[1]); o[1] = pk2(y[2], y[3]); o[2] = pk2(y[4], y[5]); o[3] = pk2(y[6], y[7]);
    *(u32x4*)(YCV + (size_t)(t0 + t) * 512 + c0) = o;
  }
}

DEV void shift_tile(const Params& p, int l, int tile) {
  const bf16_t* ZRW = (const bf16_t*)(p.ws + O_ZRW);
  bf16_t* ZRS = (bf16_t*)(p.ws + O_ZRS);
  const int r0 = tile * 32;
  int s_lo, s_hi;
  if (r0 < T_LAT) { s_lo = r0 & ~4095; s_hi = s_lo + SEQ; } else { s_lo = T_LAT + ((r0 - T_LAT) & ~255); s_hi = s_lo + CTXL; }
  const int tid = ltid();
  if (tid >= 480) return;
  const int half = tid >= 240 ? 1 : 0, ch = tid - half * 240, col = ch * 8;
  const int rb = r0 + half * 16;
  u32x4 rows[18];
#pragma unroll
  for (int i = 0; i < 18; ++i) {
    const int rr = rb - 1 + i;
    rows[i] = (u32x4){0u, 0u, 0u, 0u};
    if (rr >= s_lo && rr < s_hi) rows[i] = *(const u32x4*)(ZRW + (size_t)rr * 1920 + col);
  }
  const float* sw = p.rwkv_shift + (size_t)l * 3 * 1920 + col;
  float w0[8], w1[8], w2[8];
#pragma unroll
  for (int j = 0; j < 8; ++j) { w0[j] = sw[j]; w1[j] = sw[1920 + j]; w2[j] = sw[3840 + j]; }
  const int act = (col >= 1536 && col < 1664) ? 1 : (col >= 1792 ? 2 : 0);
#pragma unroll
  for (int i = 0; i < 16; ++i) {
    const int row = rb + i;
    const u32x4 pv = rows[i], cu = rows[i + 1], nx = rows[i + 2];
    float y[8];
#pragma unroll
    for (int q = 0; q < 4; ++q) {
      y[2 * q] = w0[2 * q] * lo_bf(pv[q]) + w1[2 * q] * lo_bf(cu[q]) + w2[2 * q] * lo_bf(nx[q]);
      y[2 * q + 1] = w0[2 * q + 1] * hi_bf(pv[q]) + w1[2 * q + 1] * hi_bf(cu[q]) + w2[2 * q + 1] * hi_bf(nx[q]);
    }
    if (act == 1) {
#pragma unroll
      for (int j = 0; j < 8; ++j) y[j] = 1.f - 2.f * __builtin_amdgcn_rcpf(1.f + __expf(2.f * y[j]));
    } else if (act == 2) {
#pragma unroll
      for (int j = 0; j < 8; ++j) y[j] = sigmoidf_(y[j]);
    }
    u32x4 o;
    o[0] = pk2(y[0], y[1]); o[1] = pk2(y[2], y[3]); o[2] = pk2(y[4], y[5]); o[3] = pk2(y[6], y[7]);
    if (col < 1536) *(u32x4*)(ZRS + (size_t)row * 1536 + col) = o;
    else if (col < 1792) *(u32x4*)((bf16_t*)(p.ws + O_LIN) + (size_t)row * 256 + (col - 1536)) = o;
    else *(u32x4*)((bf16_t*)(p.ws + O_GIN) + (size_t)row * 128 + (col - 1792)) = o;
  }
}

DEV void branch_phase(const Params& p, int l, char* smem) {
  const bool last = (l == 1);
  for (int L = vblock(); L < 1088 + 544 + 1088; L += gridDim.x) {
    if (L < 1088) { if (!(last && L >= 1024)) attn_tile(p, l, L, smem); }
    else if (L < 1632) { if (!(last && L - 1088 >= 512)) conv_tile(p, l, L - 1088, smem); }
    else shift_tile(p, l, L - 1632);
  }
}

DEV void lora_phase(const Params& p, int l, char* smem, bool gjob) {
  const bf16_t* LIN = (const bf16_t*)(p.ws + O_LIN);
  const int lane = ltid() & 63, w = ltid() >> 6, wm = w >> 1, wn = w & 1, fr = lane & 15, fq = lane >> 4;
  const int ntile = gjob ? 544 : 4 * 544;
  for (int L = vblock(); L < ntile; L += gridDim.x) {
    const int job = gjob ? 4 : L / 544, t = L - (gjob ? 0 : job * 544), pm = t >> 2, pn = t & 3;
    const int row0 = pm * 256, col0 = pn * 128;
    const bf16_t* A;
    const bf16_t* Bt;
    bf16_t* O;
    int K = 64, lda = 256;
    const float* bias = nullptr;
    if (job == 0) { A = LIN; Bt = (const bf16_t*)(p.ws + O_WB + W_LW2); O = (bf16_t*)(p.ws + O_EF); bias = p.rwkv_w0 + (l * 2 + 0) * 512; }
    else if (job == 1) { A = LIN + 64; Bt = (const bf16_t*)(p.ws + O_WB + W_LW2) + 512 * 64; O = (bf16_t*)(p.ws + O_EB); bias = p.rwkv_w0 + (l * 2 + 1) * 512; }
    else if (job == 2) { A = LIN + 128; Bt = (const bf16_t*)(p.ws + O_WB + W_LA2); O = (bf16_t*)(p.ws + O_AF); bias = p.rwkv_a0 + (l * 2 + 0) * 512; }
    else if (job == 3) { A = LIN + 192; Bt = (const bf16_t*)(p.ws + O_WB + W_LA2) + 512 * 64; O = (bf16_t*)(p.ws + O_AB); bias = p.rwkv_a0 + (l * 2 + 1) * 512; }
    else { A = (const bf16_t*)(p.ws + O_GIN); Bt = (const bf16_t*)(p.ws + O_WB + W_LG2); O = (bf16_t*)(p.ws + O_G); K = 128; lda = 128; }
    f32x4 acc[4][4];
    zero_acc(acc);
    gemm_kloop(acc, A + (size_t)row0 * lda, lda, Bt + (size_t)col0 * K, K, K, smem);
#pragma unroll
    for (int mi = 0; mi < 4; ++mi) {
      const int row = row0 + wm * 64 + mi * 16 + fr;
#pragma unroll
      for (int ni = 0; ni < 4; ++ni) {
        const int c = col0 + wn * 64 + ni * 16 + fq * 4;
        float v[4];
#pragma unroll
        for (int j = 0; j < 4; ++j) {
          float z = acc[mi][ni][j];
          if (job < 4) z = sigmoidf_(z + bias[c + j]);
          if (job < 2) z *= 0.6065306597126334f;
          v[j] = z;
        }
        uint2 o;
        o.x = pk2(v[0], v[1]); o.y = pk2(v[2], v[3]);
        *(uint2*)(O + (size_t)row * 512 + c) = o;
      }
    }
  }
}

DEV void lora64_phase(const Params& p, int l, char* smem) {
  const bf16_t* LIN = (const bf16_t*)(p.ws + O_LIN);
  const int tid = ltid(), lane = tid & 63, w = tid >> 6, wm = w >> 1, wn = w & 1, fr = lane & 15, fq = lane >> 4;
  const int lrow = tid >> 3, lch = tid & 7;
  u32x4 ra[4], rb[2];
  auto issue = [&](int L) {
    const int job = L / 544, t = L - job * 544, pm = t >> 2, pn = t & 3;
    const bf16_t* A = LIN + job * 64 + (size_t)(pm * 256 + lrow) * 256 + lch * 8;
    const bf16_t* Bt = (const bf16_t*)(p.ws + O_WB + ((job & 2) ? W_LA2 : W_LW2)) + (job & 1) * 512 * 64 + (size_t)(pn * 128 + lrow) * 64 + lch * 8;
#pragma unroll
    for (int i = 0; i < 4; ++i) ra[i] = *(const u32x4*)(A + (size_t)(64 * i) * 256);
#pragma unroll
    for (int i = 0; i < 2; ++i) rb[i] = *(const u32x4*)(Bt + (size_t)(64 * i) * 64);
  };
  char* swa = smem + lrow * SROW + lch * 16;
  char* swb = swa + A_ST;
  const char* sra = smem + (wm * 64 + fr) * SROW + fq * 16;
  const char* srb = smem + A_ST + (wn * 64 + fr) * SROW + fq * 16;
  int L = vblock();
  if (L < 4 * 544) issue(L);
  for (; L < 4 * 544; L += gridDim.x) {
    const int job = L / 544, t = L - job * 544, pm = t >> 2, pn = t & 3;
    const int row0 = pm * 256, col0 = pn * 128;
    __syncthreads();
#pragma unroll
    for (int i = 0; i < 4; ++i) *(u32x4*)(swa + i * 64 * SROW) = ra[i];
#pragma unroll
    for (int i = 0; i < 2; ++i) *(u32x4*)(swb + i * 64 * SROW) = rb[i];
    __syncthreads();
    if (L + (int)gridDim.x < 4 * 544) issue(L + gridDim.x);
    f32x4 acc[4][4];
    zero_acc(acc);
#pragma unroll
    for (int ks = 0; ks < 2; ++ks) {
      bf16x8 af[4], bfr[4];
#pragma unroll
      for (int mi = 0; mi < 4; ++mi) af[mi] = *(const bf16x8*)(sra + mi * 16 * SROW + ks * 64);
#pragma unroll
      for (int ni = 0; ni < 4; ++ni) bfr[ni] = *(const bf16x8*)(srb + ni * 16 * SROW + ks * 64);
#pragma unroll
      for (int mi = 0; mi < 4; ++mi)
#pragma unroll
        for (int ni = 0; ni < 4; ++ni) acc[mi][ni] = __builtin_amdgcn_mfma_f32_16x16x32_bf16(bfr[ni], af[mi], acc[mi][ni], 0, 0, 0);
    }
    bf16_t* O = (bf16_t*)(p.ws + (job == 0 ? O_EF : (job == 1 ? O_EB : (job == 2 ? O_AF : O_AB))));
    const float* bias = ((job & 2) ? p.rwkv_a0 : p.rwkv_w0) + (l * 2 + (job & 1)) * 512;
    const float sc = job < 2 ? 0.6065306597126334f : 1.f;
#pragma unroll
    for (int mi = 0; mi < 4; ++mi) {
      const int row = row0 + wm * 64 + mi * 16 + fr;
#pragma unroll
      for (int ni = 0; ni < 4; ++ni) {
        const int c = col0 + wn * 64 + ni * 16 + fq * 4;
        const f32x4 z = acc[mi][ni] + *(const f32x4*)(bias + c);
        uint2 o;
        o.x = pk2(sc * sigmoidf_(z[0]), sc * sigmoidf_(z[1])); o.y = pk2(sc * sigmoidf_(z[2]), sc * sigmoidf_(z[3]));
        *(uint2*)(O + (size_t)row * 512 + c) = o;
      }
    }
  }
  __syncthreads();
}

DEV int scan_row(int step, int dir, int b) {
  if (step < CTXL) { const int t = dir ? (CTXL - 1 - step) : step; return T_LAT + b * CTXL + t; }
  const int s2 = step - CTXL;
  const int t = dir ? (SEQ - 1 - s2) : s2;
  return b * SEQ + t;
}
DEV float red8(float v) {
  v += dppf<0xB1>(v);
  v += dppf<0x4E>(v);
  v += dppf<0x141>(v);
  return v;
}
struct ScanOps { f32x4 nkk0, nkk1, w0, w1, kka0, kka1, kd0, kd1, r0, r1; float v; };
DEV void scan_tile(const Params& p, int l, int tile, char* smem) {
  const int half = tile & 1, dir = (tile >> 1) & 1, h = (tile >> 2) & 7, b = tile >> 5;
  float* arr = (float*)smem;
  float* ybuf = arr + 2 * 32 * 384;
  const bf16_t* ZRS = (const bf16_t*)(p.ws + O_ZRS);
  const bf16_t* E = (const bf16_t*)(p.ws + (dir ? O_EB : O_EF));
  const bf16_t* Aa = (const bf16_t*)(p.ws + (dir ? O_AB : O_AF));
  bf16_t* YS = (bf16_t*)(p.ws + (dir ? O_YSB : O_YSF));
  const int tid = ltid(), lane = tid & 63;
  const int w = __builtin_amdgcn_readfirstlane(tid >> 6);
  const int col = h * 64 + lane;
  const float kkp = p.rwkv_kk[l * 512 + col], kap = p.rwkv_ka[l * 512 + col];
  auto produce = [&](int ch, int buf, int pw, int npw) {
#pragma unroll
    for (int i0 = 0; i0 < 32; i0 += 4 * npw) {
      bf16_t rr[4], rk[4], rv[4], re[4], ra[4];
#pragma unroll
      for (int i = 0; i < 4; ++i) {
        const int R = scan_row(ch * 32 + i0 + pw + npw * i, dir, b);
        rr[i] = ZRS[(size_t)R * 1536 + col];
        rk[i] = ZRS[(size_t)R * 1536 + 512 + col];
        rv[i] = ZRS[(size_t)R * 1536 + 1024 + col];
        re[i] = E[(size_t)R * 512 + col];
        ra[i] = Aa[(size_t)R * 512 + col];
      }
#pragma unroll
      for (int i = 0; i < 4; ++i) {
        const int sl = i0 + pw + npw * i;
        const float r = bf2f(rr[i]), k = bf2f(rk[i]), v = bf2f(rv[i]), e = bf2f(re[i]), a = bf2f(ra[i]);
        const float kkv = k * kkp;
        const float inv = __builtin_amdgcn_rsqf(fmaxf(wsum(kkv * kkv), 1e-24f));
        const float kk = kkv * inv;
        float* d = arr + (buf * 32 + sl) * 384 + lane;
        d[0] = -kk;
        d[64] = __expf(-e);
        d[128] = kk * a;
        d[192] = k * (1.f + (a - 1.f) * kap);
        d[256] = r;
        d[320] = v;
      }
    }
  };
  auto flush = [&](int ch, int buf, int t256) {
#pragma unroll
    for (int q = 0; q < 2; ++q) {
      const int idx = t256 + 256 * q, sl = idx >> 4, rp = (idx & 15) * 2;
      const int R = scan_row(ch * 32 + sl, dir, b);
      const float* yb = ybuf + buf * 1024 + sl * 32 + rp;
      *(unsigned*)(YS + (size_t)R * 512 + h * 64 + half * 32 + rp) = pk2(yb[0], yb[1]);
    }
  };
  __syncthreads();
  produce(0, 0, w, 8);
  __syncthreads();
  f32x4 S0 = {0.f, 0.f, 0.f, 0.f}, S1 = {0.f, 0.f, 0.f, 0.f};
  const int r8 = lane >> 3, cg = lane & 7;
  for (int ch = 0; ch < 136; ++ch) {
    const int buf = ch & 1;
    if (w < 4) {
      const float* cb = arr + buf * 32 * 384;
      const int vo = 320 + half * 32 + w * 8 + r8;
      float* yw = ybuf + buf * 1024 + cg * 32 + w * 8 + r8;
      auto ldops = [&](ScanOps& o, int sl) {
        const f32x4* b4 = (const f32x4*)(cb + sl * 384);
        o.nkk0 = b4[cg * 2]; o.nkk1 = b4[cg * 2 + 1];
        o.w0 = b4[16 + cg * 2]; o.w1 = b4[16 + cg * 2 + 1];
        o.kka0 = b4[32 + cg * 2]; o.kka1 = b4[32 + cg * 2 + 1];
        o.kd0 = b4[48 + cg * 2]; o.kd1 = b4[48 + cg * 2 + 1];
        o.r0 = b4[64 + cg * 2]; o.r1 = b4[64 + cg * 2 + 1];
        o.v = cb[sl * 384 + vo];
      };
      float ykeep = 0.f;
      auto step = [&](const ScanOps& o, int sl) {
        const f32x4 sA = S0 * o.nkk0 + S1 * o.nkk1;
        const float sa = red8((sA[0] + sA[1]) + (sA[2] + sA[3]));
        S0 = S0 * o.w0 + (o.kka0 * sa + o.kd0 * o.v);
        S1 = S1 * o.w1 + (o.kka1 * sa + o.kd1 * o.v);
        const f32x4 yA = S0 * o.r0 + S1 * o.r1;
        const float y = red8((yA[0] + yA[1]) + (yA[2] + yA[3]));
        ykeep = (cg == (sl & 7)) ? y : ykeep;
      };
      ScanOps oa, ob;
      ldops(oa, 0);
#pragma unroll
      for (int s8 = 0; s8 < 32; s8 += 8) {
#pragma unroll
        for (int q = 0; q < 8; q += 2) {
          ldops(ob, s8 + q + 1);
          step(oa, s8 + q);
          ldops(oa, (s8 + q + 2) & 31);
          step(ob, s8 + q + 1);
        }
        yw[s8 * 32] = ykeep;
      }
    } else {
      const int pw = w - 4;
      if (ch > 0) flush(ch - 1, buf ^ 1, tid - 256);
      if (ch + 1 < 136) produce(ch + 1, buf ^ 1, pw, 4);
    }
    __syncthreads();
  }
  if (w >= 4) flush(135, 1, tid - 256);
  __syncthreads();
}
DEV void scan_phase(const Params& p, int l, char* smem) {
  for (int L = blockIdx.x; L < 256; L += gridDim.x) scan_tile(p, l, L, smem);
}

DEV void unpack8(const u32x4 u, float (&f)[8]) {
#pragma unroll
  for (int q = 0; q < 4; ++q) { f[2 * q] = lo_bf(u[q]); f[2 * q + 1] = hi_bf(u[q]); }
}
DEV void post_phase(const Params& p, int l, int nrows) {
  const bf16_t* ZRS = (const bf16_t*)(p.ws + O_ZRS);
  const bf16_t* AF = (const bf16_t*)(p.ws + O_AF);
  const bf16_t* AB = (const bf16_t*)(p.ws + O_AB);
  const bf16_t* G = (const bf16_t*)(p.ws + O_G);
  bf16_t* YSF = (bf16_t*)(p.ws + O_YSF);
  const bf16_t* YSB = (const bf16_t*)(p.ws + O_YSB);
  const int lane = ltid() & 63, w = ltid() >> 6, c0 = lane * 8;
  float gng[8], gnb[8], kaw[8], rkw[8];
#pragma unroll
  for (int j = 0; j < 8; ++j) {
    gng[j] = p.rwkv_gn_g[l * 512 + c0 + j]; gnb[j] = p.rwkv_gn_b[l * 512 + c0 + j];
    kaw[j] = p.rwkv_ka[l * 512 + c0 + j]; rkw[j] = p.rwkv_rk[l * 512 + c0 + j];
  }
  const int stride = gridDim.x * 8;
  int row = blockIdx.x * 8 + w;
  u32x4 q_ysf, q_ysb, q_r, q_k, q_v, q_af, q_ab, q_g;
  auto gl = [&](int rw) {
    q_ysf = *(const u32x4*)(YSF + (size_t)rw * 512 + c0); q_ysb = *(const u32x4*)(YSB + (size_t)rw * 512 + c0);
    q_r = *(const u32x4*)(ZRS + (size_t)rw * 1536 + c0); q_k = *(const u32x4*)(ZRS + (size_t)rw * 1536 + 512 + c0);
    q_v = *(const u32x4*)(ZRS + (size_t)rw * 1536 + 1024 + c0);
    q_af = *(const u32x4*)(AF + (size_t)rw * 512 + c0); q_ab = *(const u32x4*)(AB + (size_t)rw * 512 + c0);
    q_g = *(const u32x4*)(G + (size_t)rw * 512 + c0);
  };
  if (row < nrows) gl(row);
  for (; row < nrows; row += stride) {
    float ysf[8], ysb[8], r[8], k[8], v[8], af[8], ab[8], g[8];
    unpack8(q_ysf, ysf); unpack8(q_ysb, ysb); unpack8(q_r, r); unpack8(q_k, k); unpack8(q_v, v);
    unpack8(q_af, af); unpack8(q_ab, ab); unpack8(q_g, g);
    if (row + stride < nrows) gl(row + stride);
    float ys[8], s1 = 0.f, bp = 0.f;
#pragma unroll
    for (int j = 0; j < 8; ++j) {
      ys[j] = ysf[j] + ysb[j]; s1 += ys[j];
      bp += r[j] * k[j] * rkw[j] * (2.f + (af[j] + ab[j] - 2.f) * kaw[j]);
    }
    const float mu = red8(s1) * (1.f / 64.f);
    const float bon = red8(bp);
    float s2 = 0.f;
#pragma unroll
    for (int j = 0; j < 8; ++j) { ys[j] -= mu; s2 += ys[j] * ys[j]; }
    const float rs = __builtin_amdgcn_rsqf(red8(s2) * (1.f / 64.f) + 64e-5f);
    float o[8];
#pragma unroll
    for (int j = 0; j < 8; ++j) o[j] = (ys[j] * rs * gng[j] + gnb[j] + bon * v[j]) * g[j];
    u32x4 ov;
    ov[0] = pk2(o[0], o[1]); ov[1] = pk2(o[2], o[3]); ov[2] = pk2(o[4], o[5]); ov[3] = pk2(o[6], o[7]);
    *(u32x4*)(YSF + (size_t)row * 512 + c0) = ov;
  }
}

struct EpiGate {
  static constexpr bool PERM = true, AFTER_DRAIN = false;
  char* ws;
  DEV void operator()(const f32x4 (&acc)[2][2][4][2], const pg8::Unit& u, int wr, int wc, int fr, int fq) const {
    const int b = u.pn >> 2, pn = u.pn & 3;
    bf16_t* G = (bf16_t*)(ws + (b == 0 ? O_G1 : (b == 1 ? O_G2 : O_G3)));
    const int row0 = u.pm * 256 + wr * 64 + fr, col0 = pn * 256 + wc * 32 + 8 * fq;
#pragma unroll
    for (int ai = 0; ai < 2; ++ai)
#pragma unroll
      for (int m = 0; m < 4; ++m) {
        const int row = row0 + ai * 128 + m * 16;
#pragma unroll
        for (int bj = 0; bj < 2; ++bj) {
          const f32x4 a0 = acc[ai][bj][m][0], a1 = acc[ai][bj][m][1];
          u32x4 o;
          o[0] = pk2(sigmoidf_(a0[0]), sigmoidf_(a0[1])); o[1] = pk2(sigmoidf_(a0[2]), sigmoidf_(a0[3]));
          o[2] = pk2(sigmoidf_(a1[0]), sigmoidf_(a1[1])); o[3] = pk2(sigmoidf_(a1[2]), sigmoidf_(a1[3]));
          *(u32x4*)(G + (size_t)row * DM + col0 + bj * 128) = o;
        }
      }
  }
};
DEV void gate_phase(const Params& p, int nrows, char* smem) {
  EpiGate E;
  E.ws = p.ws;
  pg8::Gemm g;
  g.A = (const bf16_t*)(p.ws + O_HM); g.Bt = (const bf16_t*)(p.ws + O_WB + W_WIN) + (size_t)NZP * 1024; g.M = nrows; g.N = 3072; g.K = 1024;
  pg8::StaticOrder S;
  S.init(g.M, g.N, (int)gridDim.x, (int)blockIdx.x);
  __syncthreads();
  pg8::gemm_phase<EpiGate, pg8::StaticOrder>((PG8_LAS unsigned char*)smem, g, S, E);
  __syncthreads();
}
struct MergeOrder {
  pg8::StaticOrder base;
  DEV bool next(int i, pg8::Unit& u) const {
    const int j = i / 3, b = i - 3 * j;
    pg8::Unit t;
    if (!base.next(j, t)) return false;
    u.pm = t.pm + 136 * (b == 0 ? 11 : (b == 1 ? 12 : 6));
    u.pn = t.pn + 4 * b;
    return true;
  }
  DEV void a_ready(const pg8::Unit&) const {}
  DEV void done(const pg8::Unit&) const {}
};
struct EpiMerge {
  static constexpr bool PERM = true, AFTER_DRAIN = false;
  char* ws;
  DEV void operator()(const f32x4 (&acc)[2][2][4][2], const pg8::Unit& u, int wr, int wc, int fr, int fq) const {
    const int b = u.pn >> 2, pn = u.pn & 3, pm = u.pm - 136 * (b == 0 ? 11 : (b == 1 ? 12 : 6));
    const bf16_t* G = (const bf16_t*)(ws + (b == 0 ? O_G1 : (b == 1 ? O_G2 : O_G3)));
    bf16_t* M = (bf16_t*)(ws + O_M);
    const int row0 = pm * 256 + wr * 64 + fr, col0 = pn * 256 + wc * 32 + 8 * fq;
#pragma unroll
    for (int ai = 0; ai < 2; ++ai)
#pragma unroll
      for (int m = 0; m < 4; ++m) {
        const int row = row0 + ai * 128 + m * 16;
#pragma unroll
        for (int bj = 0; bj < 2; ++bj) {
          const size_t off = (size_t)row * DM + col0 + bj * 128;
          const u32x4 gv = *(const u32x4*)(G + off);
          u32x4 mv = {0u, 0u, 0u, 0u};
          if (b > 0) mv = *(const u32x4*)(M + off);
          const f32x4 a0 = acc[ai][bj][m][0], a1 = acc[ai][bj][m][1];
          u32x4 o;
          o[0] = pk2(lo_bf(mv[0]) + lo_bf(gv[0]) * a0[0], hi_bf(mv[0]) + hi_bf(gv[0]) * a0[1]);
          o[1] = pk2(lo_bf(mv[1]) + lo_bf(gv[1]) * a0[2], hi_bf(mv[1]) + hi_bf(gv[1]) * a0[3]);
          o[2] = pk2(lo_bf(mv[2]) + lo_bf(gv[2]) * a1[0], hi_bf(mv[2]) + hi_bf(gv[2]) * a1[1]);
          o[3] = pk2(lo_bf(mv[3]) + lo_bf(gv[3]) * a1[2], hi_bf(mv[3]) + hi_bf(gv[3]) * a1[3]);
          *(u32x4*)(M + off) = o;
        }
      }
  }
};
DEV void merge_phase(const Params& p, int nrows, char* smem) {
  EpiMerge E;
  E.ws = p.ws;
  pg8::Gemm g;
  g.A = (const bf16_t*)p.ws; g.Bt = (const bf16_t*)(p.ws + O_WB + W_PCV); g.M = nrows; g.N = 1024; g.K = 512;
  MergeOrder S;
  S.base.init(g.M, g.N, (int)gridDim.x, (int)blockIdx.x);
  __syncthreads();
  pg8::gemm_phase<EpiMerge, MergeOrder>((PG8_LAS unsigned char*)smem, g, S, E);
  __syncthreads();
}

struct EpiResid {
  static constexpr bool PERM = false, AFTER_DRAIN = false;
  float* out; float* xc; const float* rin_lat; const float* rin_ctx; const float* mod; bool store;
  DEV void operator()(const f32x4 (&acc)[2][2][4][2], const pg8::Unit& u, int wr, int wc, int fr, int fq) const {
    const int row0 = u.pm * 256 + wr * 64 + fr, col0 = u.pn * 256 + wc * 32 + 4 * fq;
#pragma unroll
    for (int ai = 0; ai < 2; ++ai)
#pragma unroll
      for (int m = 0; m < 4; ++m) {
        const int row = row0 + ai * 128 + m * 16;
        float* xr = row < T_LAT ? out + (size_t)row * DM : xc + (size_t)(row - T_LAT) * DM;
        const float* xi = row < T_LAT ? rin_lat + (size_t)row * DM : rin_ctx + (size_t)(row - T_LAT) * DM;
        const float* gt = mod + (size_t)modrow(row) * 6144;
#pragma unroll
        for (int bj = 0; bj < 2; ++bj)
#pragma unroll
          for (int n = 0; n < 2; ++n) {
            const int c = col0 + bj * 128 + n * 16;
            const f32x4 g4 = *(const f32x4*)(gt + c);
            f32x4 xv = *(const f32x4*)(xi + c);
            xv += g4 * acc[ai][bj][m][n];
            if (store) *(f32x4*)(xr + c) = xv;
          }
      }
  }
};
DEV void resid_gemm_phase(const Params& p, int l, const bf16_t* A, int K, const bf16_t* Wt, int goff, int nrows, char* smem, bool from_inputs = false) {
  EpiResid E;
  E.store = true;
  E.rin_lat = from_inputs ? p.x : p.out; E.rin_ctx = from_inputs ? p.ctx : (const float*)(p.ws + O_XC);
  E.out = p.out; E.xc = (float*)(p.ws + O_XC); E.mod = (const float*)(p.ws + O_MOD) + (size_t)l * 9 * 6144 + goff;
  pg8::Gemm g;
  g.A = A; g.Bt = Wt; g.M = nrows; g.N = 1024; g.K = K;
  pg8::StaticOrder S;
  S.init(g.M, g.N, (int)gridDim.x, (int)blockIdx.x);
  __syncthreads();
  pg8::gemm_phase<EpiResid, pg8::StaticOrder>((PG8_LAS unsigned char*)smem, g, S, E);
  __syncthreads();
}

struct EpiMlp1 {
  static constexpr bool PERM = true, AFTER_DRAIN = false;
  bf16_t* HID;
  DEV void operator()(const f32x4 (&acc)[2][2][4][2], const pg8::Unit& u, int wr, int wc, int fr, int fq) const {
    const int row0 = u.pm * 256 + wr * 64 + fr, col0 = u.pn * 256 + wc * 32 + 8 * fq;
#pragma unroll
    for (int ai = 0; ai < 2; ++ai)
#pragma unroll
      for (int m = 0; m < 4; ++m) {
        const int row = row0 + ai * 128 + m * 16;
#pragma unroll
        for (int bj = 0; bj < 2; ++bj) {
          float v[8];
#pragma unroll
          for (int j = 0; j < 4; ++j) {
            const float r0 = fmaxf(acc[ai][bj][m][0][j], 0.f), r1 = fmaxf(acc[ai][bj][m][1][j], 0.f);
            v[j] = r0 * r0; v[4 + j] = r1 * r1;
          }
          u32x4 o;
          o[0] = pk2(v[0], v[1]); o[1] = pk2(v[2], v[3]); o[2] = pk2(v[4], v[5]); o[3] = pk2(v[6], v[7]);
          *(u32x4*)(HID + (size_t)row * 4096 + col0 + bj * 128) = o;
        }
      }
  }
};
DEV void mlp1_phase(const Params& p, int nrows, char* smem) {
  EpiMlp1 E;
  E.HID = (bf16_t*)(p.ws + O_HID);
  pg8::Gemm g;
  g.A = (const bf16_t*)(p.ws + O_HM); g.Bt = (const bf16_t*)(p.ws + O_WB + W_W1); g.M = nrows; g.N = 4096; g.K = 1024;
  pg8::StaticOrder S;
  S.init(g.M, g.N, (int)gridDim.x, (int)blockIdx.x);
  __syncthreads();
  pg8::gemm_phase<EpiMlp1, pg8::StaticOrder>((PG8_LAS unsigned char*)smem, g, S, E);
  __syncthreads();
}

DEV void final_phase(const Params& p) {
  const int lane = ltid() & 63, w = ltid() >> 6;
  const int stride = gridDim.x * 8;
  f32x4 g[4];
#pragma unroll
  for (int i = 0; i < 4; ++i) g[i] = *(const f32x4*)(p.final_g + i * 256 + lane * 4);
  int row = blockIdx.x * 8 + w;
  f32x4 nv[4];
  if (row < T_LAT) {
#pragma unroll
    for (int i = 0; i < 4; ++i) nv[i] = *(const f32x4*)(p.out + (size_t)row * DM + i * 256 + lane * 4);
  }
  for (; row < T_LAT; row += stride) {
    float* xr = p.out + (size_t)row * DM;
    f32x4 v[4];
#pragma unroll
    for (int i = 0; i < 4; ++i) v[i] = nv[i];
    if (row + stride < T_LAT) {
#pragma unroll
      for (int i = 0; i < 4; ++i) nv[i] = *(const f32x4*)(p.out + (size_t)(row + stride) * DM + i * 256 + lane * 4);
    }
    float ss = 0.f;
#pragma unroll
    for (int i = 0; i < 4; ++i) ss += v[i][0] * v[i][0] + v[i][1] * v[i][1] + v[i][2] * v[i][2] + v[i][3] * v[i][3];
    const float rs = __builtin_amdgcn_rsqf(wsum(ss) * (1.f / 1024.f) + 1e-6f);
#pragma unroll
    for (int i = 0; i < 4; ++i) *(f32x4*)(xr + i * 256 + lane * 4) = v[i] * rs * g[i];
  }
}

constexpr int N_PHASES = 26;
__global__ void __launch_bounds__(512) fwd_megakernel(Params p, int ph_lo, int ph_hi) {
  extern __shared__ __attribute__((aligned(16))) char smem[];
  cg::grid_group grid = cg::this_grid();
  volatile XLAS unsigned* st = (volatile XLAS unsigned*)(smem + 139264);
  if (threadIdx.x == 0) { st[0] = 0u; st[1] = 0u; st[2] = 0u; st[3] = 0u; }
  __syncthreads();
  const XcdBarrier xb = xcd_barrier_post((unsigned*)(p.ws + O_BAR), st);
  if (ph_hi > 1000) grid.sync();
  for (int ph = ph_lo; ph < ph_hi; ++ph) {
    if (ph == 0) {
      cvt_phase(p, 0, smem);
      mod_phase(p, smem);
    } else if (ph == N_PHASES - 1) {
      final_phase(p);
    } else {
      const int l = (ph - 1) / 12, sp = (ph - 1) % 12;
      const int nrows = (l == 1) ? T_LAT : T_ALL;
      switch (sp) {
        case 0:
          if (l > 0) cvt_phase(p, l, smem);
          norm_phase(p, l, 0, (bf16_t*)(p.ws + O_H0), l == 0);
          break;
        case 1: gemm_in_phase(p, smem); break;
        case 2: branch_phase(p, l, smem); break;
        case 3:
          lora64_phase(p, l, smem);
          lora_phase(p, l, smem, true);
          break;
        case 4: scan_phase(p, l, smem); break;
        case 5:
          post_phase(p, l, nrows);
          norm_phase(p, l, 0, (bf16_t*)(p.ws + O_HM), l == 0, nrows);
          break;
        case 6: gate_phase(p, nrows, smem); break;
        case 7: merge_phase(p, nrows, smem); break;
        case 8: resid_gemm_phase(p, l, (const bf16_t*)(p.ws + O_M), 1024, (const bf16_t*)(p.ws + O_WB + W_WOUT), 2048, nrows, smem, l == 0); break;
        case 9: norm_phase(p, l, 1, (bf16_t*)(p.ws + O_HM), false, nrows); break;
        case 10: mlp1_phase(p, nrows, smem); break;
        case 11: resid_gemm_phase(p, l, (const bf16_t*)(p.ws + O_HID), 4096, (const bf16_t*)(p.ws + O_WB + W_W2), 5120, nrows, smem); break;
      }
    }
    if (ph + 1 < ph_hi) xcd_barrier(xb);
  }
}

extern "C" void kernel_launch(void* const* d_in, const int* in_sizes, int n_in, void* d_out, int out_size, void* d_ws,
                              size_t ws_size, hipStream_t stream) {
  Params p{};
  const float** pp = (const float**)&p;
  for (int i = 0; i < 36; ++i) pp[i] = (const float*)d_in[i];
  p.out = (float*)d_out;
  p.ws = (char*)d_ws;
  static int grid_blocks = 0;
  if (!grid_blocks) {
    hipFuncSetAttribute((const void*)fwd_megakernel, hipFuncAttributeMaxDynamicSharedMemorySize, LDS_BYTES);
    int dev = 0, cus = 0, per_cu = 0;
    hipGetDevice(&dev);
    hipDeviceGetAttribute(&cus, hipDeviceAttributeMultiprocessorCount, dev);
    hipOccupancyMaxActiveBlocksPerMultiprocessor(&per_cu, fwd_megakernel, 512, LDS_BYTES);
    if (per_cu < 1) per_cu = 1;
    grid_blocks = cus * per_cu;
    grid_blocks &= ~7;
  }
  if (ws_size < WS_NEED) fprintf(stderr, "workspace too small: %zu < %zu\n", ws_size, (size_t)WS_NEED);
#ifndef MULTI_LAUNCH
#define MULTI_LAUNCH 0
#endif
#if MULTI_LAUNCH
  for (int ph = 0; ph < N_PHASES; ++ph)
    hipLaunchKernelGGL(fwd_megakernel, dim3(grid_blocks), dim3(512), LDS_BYTES, stream, p, ph, ph + 1);
#else
  hipMemsetAsync((char*)d_ws + O_BAR, 0, 16384, stream);
  int lo = 0, hi = N_PHASES;
  void* args[] = {&p, &lo, &hi};
  hipError_t e = hipLaunchCooperativeKernel((const void*)fwd_megakernel, dim3(grid_blocks), dim3(512), args, LDS_BYTES, stream);
  if (e != hipSuccess) fprintf(stderr, "cooperative launch failed: %s (grid %d)\n", hipGetErrorString(e), grid_blocks);
#endif
}
```

```cpp
#include <hip/hip_runtime.h>
#include <hip/hip_cooperative_groups.h>
#include <cstdio>
namespace cg = cooperative_groups;

typedef unsigned short bf16_t;
typedef short bf16x8 __attribute__((ext_vector_type(8)));
typedef float f32x4 __attribute__((ext_vector_type(4)));
typedef float f32x16 __attribute__((ext_vector_type(16)));
typedef unsigned u32x4 __attribute__((ext_vector_type(4)));
#define DEV __device__ __forceinline__
#define PROBE 0

constexpr int T_LAT = 32768, T_ALL = 34816, DM = 1024, DIN = 7552, NZ = 4480, NZP = 4608, DINT = 7680;
constexpr int SEQ = 4096, CTXL = 256, TK = 4352;
constexpr size_t U = 35651584ull;
constexpr size_t O_ZU = 0, O_ZK = U, O_VT = 2 * U, O_ZRW = 3 * U, O_ZRS = 7 * U, O_LIN = 10 * U, O_YCV = 11 * U, O_ZQ = 12 * U;
constexpr size_t O_H0 = 7 * U;
constexpr size_t O_EF = 0, O_EB = 3 * U, O_AF = 4 * U, O_AB = 5 * U, O_G = 2 * U, O_YSF = 6 * U, O_YSB = 10 * U;
constexpr size_t O_HM = 0, O_M = 0, O_HID = 3 * U;
constexpr size_t O_G1 = 3 * U, O_G2 = 7 * U, O_G3 = 9 * U;
constexpr size_t O_WB = 13 * U;
constexpr size_t W_WIN = 0, W_PCV = W_WIN + (size_t)DINT * 1024 * 2, W_PAT = W_PCV + 1048576, W_PRW = W_PAT + 1048576,
                 W_WOUT = W_PRW + 1048576, W_W1 = W_WOUT + 2097152, W_W2 = W_W1 + 8388608, W_LW2 = W_W2 + 8388608,
                 W_LA2 = W_LW2 + 131072, W_LG2 = W_LA2 + 131072, W_END = W_LG2 + 131072;
constexpr size_t O_XC = O_WB + W_END;
constexpr size_t O_MOD = O_XC + 8388608;
constexpr size_t O_BAR = O_MOD + 2 * 9 * 6144 * 4;
constexpr size_t O_GIN = O_BAR + 16384;
constexpr size_t WS_NEED = O_GIN + (size_t)T_ALL * 128 * 2;

constexpr int LDS_BYTES = 139264 + 16;

struct Params {
  const float *x, *c, *ctx, *c_ctx, *mod_w, *mod_b, *norm1_g, *norm2_g, *w_in, *conv_dw_w, *conv_dw_b, *conv_ln_g,
      *conv_ln_b, *p_conv, *att_lq1, *att_lk1, *att_lq2, *att_lk2, *att_subln_g, *p_att, *rwkv_shift, *rwkv_w0, *rwkv_w2,
      *rwkv_a0, *rwkv_a2, *rwkv_g2, *rwkv_kk, *rwkv_ka, *rwkv_rk, *rwkv_gn_g, *rwkv_gn_b, *p_rwkv, *w_out, *mlp_w1,
      *mlp_w2, *final_g;
  float* out;
  char* ws;
};

DEV int ltid() { int t = threadIdx.x; asm volatile("" : "+v"(t)); return t; }
DEV float bf2f(bf16_t h) { return __uint_as_float(((unsigned)h) << 16); }
typedef float f32x2_t __attribute__((ext_vector_type(2)));
typedef __bf16 bf16x2_t __attribute__((ext_vector_type(2)));
DEV unsigned pk2(float lo, float hi) {
  const f32x2_t v = {lo, hi};
  return __builtin_bit_cast(unsigned, __builtin_convertvector(v, bf16x2_t));
}
DEV bf16_t f2bf(float f) { return (bf16_t)(pk2(f, 0.f) & 0xffffu); }
DEV float lo_bf(unsigned u) { return __uint_as_float(u << 16); }
DEV float hi_bf(unsigned u) { return __uint_as_float(u & 0xffff0000u); }
template <int C> DEV float dppf(float v) {
  return __int_as_float(__builtin_amdgcn_update_dpp(0, __float_as_int(v), C, 0xF, 0xF, true));
}
DEV float xor32_sum(float v) {
  const auto r = __builtin_amdgcn_permlane32_swap(__float_as_uint(v), __float_as_uint(v), false, false);
  return __uint_as_float(r[0]) + __uint_as_float(r[1]);
}
DEV float xor32_max(float v) {
  const auto r = __builtin_amdgcn_permlane32_swap(__float_as_uint(v), __float_as_uint(v), false, false);
  return fmaxf(__uint_as_float(r[0]), __uint_as_float(r[1]));
}
DEV float xor16_sum(float v) {
  const auto r = __builtin_amdgcn_permlane16_swap(__float_as_uint(v), __float_as_uint(v), false, false);
  return __uint_as_float(r[0]) + __uint_as_float(r[1]);
}
DEV float wsum(float v) {
  v += dppf<0xB1>(v);
  v += dppf<0x4E>(v);
  v += dppf<0x141>(v);
  v += dppf<0x140>(v);
  v = xor16_sum(v);
  return xor32_sum(v);
}
DEV float sigmoidf_(float x) { return __builtin_amdgcn_rcpf(1.f + __expf(-x)); }
DEV float red16(float v) {
  v += dppf<0xB1>(v);
  v += dppf<0x4E>(v);
  v += dppf<0x141>(v);
  v += dppf<0x140>(v);
  return v;
}
DEV int vblock() { const int per = gridDim.x >> 3; return (blockIdx.x & 7) * per + (blockIdx.x >> 3); }
DEV float* xrow(const Params& p, int row) {
  return row < T_LAT ? p.out + (size_t)row * DM : (float*)(p.ws + O_XC) + (size_t)(row - T_LAT) * DM;
}
DEV int modrow(int row) { return row < T_LAT ? (row >> 12) : 8; }

#define XB_TMO      128
#define XB_XCNT(j)  (256  + 64 * (j))
#define XB_XSUB(j)  (1280 + 64 * (j))
#define XB_XGEN(j)  (2304 + 64 * (j))
#define XB_TOP      3328
#define XB_TOPGEN   3392
#define XCD_BAR_WORDS 3456
#define XB_SPIN_CAP (1u << 18)
#define XLAS __attribute__((address_space(3)))

__device__ __forceinline__ unsigned xb_ld(unsigned* p)              { return __hip_atomic_load(p, __ATOMIC_RELAXED, __HIP_MEMORY_SCOPE_AGENT); }
__device__ __forceinline__ unsigned xb_add(unsigned* p, unsigned v) { return __hip_atomic_fetch_add(p, v, __ATOMIC_RELAXED, __HIP_MEMORY_SCOPE_AGENT); }
__device__ __forceinline__ unsigned xb_xcc_id() { return (unsigned)__builtin_amdgcn_s_getreg((3 << 11) | 20) & 0xFu; }
#define XB_SPIN(cond, bar) do { unsigned _sp = 0; while (cond) { __builtin_amdgcn_s_sleep(1); \
    if ((++_sp & 255u) == 0u) { if (xb_ld(&(bar)[XB_TMO])) break; if (_sp > XB_SPIN_CAP) { atomicAdd(&(bar)[XB_TMO], 1u); break; } } } } while (0)

struct XcdBarrier {
    unsigned* bar; unsigned x;
    volatile XLAS unsigned* st;
};

__device__ __forceinline__ XcdBarrier xcd_barrier_post(unsigned* bar, volatile XLAS unsigned* st) {
    XcdBarrier b; b.bar = bar; b.x = xb_xcc_id(); b.st = st;
    if (threadIdx.x == 0) (void)xb_add(&bar[XB_XCNT(b.x)], 1u);
    return b;
}
__device__ __forceinline__ void xcd_barrier_complete(unsigned* bar, unsigned x, unsigned& nloc, unsigned& nx) {
    const unsigned G = gridDim.x * gridDim.y * gridDim.z;
    unsigned sum, cnt, mine, sp = 0u;
    for (;;) {
        sum = 0u; cnt = 0u; mine = 0u;
#pragma unroll
        for (unsigned j = 0; j < 16; ++j) { const unsigned c = xb_ld(&bar[XB_XCNT(j)]); sum += c; cnt += (c > 0u) ? 1u : 0u; mine = (j == x) ? c : mine; }
        if (sum == G) break;
        __builtin_amdgcn_s_sleep(1);
        if ((++sp & 255u) == 0u) { if (xb_ld(&bar[XB_TMO])) break; if (sp > XB_SPIN_CAP) { atomicAdd(&bar[XB_TMO], 1u); break; } }
    }
    nloc = mine > 0u ? mine : 1u; nx = cnt > 0u ? cnt : 1u;
}

__device__ __forceinline__ void xcd_barrier(const XcdBarrier& b) {
    asm volatile("s_waitcnt vmcnt(0)" ::: "memory");
    __syncthreads();
    if (threadIdx.x == 0) {
        unsigned* bar = b.bar;
        __builtin_amdgcn_s_waitcnt(0);
        unsigned nloc = b.st[0], nx = b.st[1];
        if (nloc == 0u) { xcd_barrier_complete(bar, b.x, nloc, nx); b.st[0] = nloc; b.st[1] = nx; }
        const unsigned old = xb_add(&bar[XB_XSUB(b.x)], 1u);
        const unsigned gen = old / nloc;
        if (old + 1u == (gen + 1u) * nloc) {
            __builtin_amdgcn_fence(__ATOMIC_RELEASE, "agent");
            asm volatile("s_waitcnt vmcnt(0)" ::: "memory");
            const unsigned og = xb_add(&bar[XB_TOP], 1u);
            const unsigned tg = og / nx;
            if (og + 1u == (tg + 1u) * nx) xb_add(&bar[XB_TOPGEN], 1u);
            else XB_SPIN(xb_ld(&bar[XB_TOPGEN]) == tg, bar);
            __builtin_amdgcn_fence(__ATOMIC_ACQUIRE, "agent");
            xb_add(&bar[XB_XGEN(b.x)], 1u);
            asm volatile("s_waitcnt vmcnt(0)" ::: "memory");
        } else {
            XB_SPIN(xb_ld(&bar[XB_XGEN(b.x)]) == gen, bar);
            __builtin_amdgcn_fence(__ATOMIC_ACQUIRE, "agent");
            asm volatile("s_waitcnt vmcnt(0)" ::: "memory");
        }
    }
    __syncthreads();
}

namespace pg8 {
#define PG8_LAS __attribute__((address_space(3)))
constexpr int BM = 256, BK = 64, HALF = 128, HTB = HALF * BK * 2, STAGE_BYTES = 8 * HTB, NXCD = 8, WGM = 4;
__host__ __device__ __forceinline__ int lds_byte(int r, int c) { const int st = (r >> 4) * 2 + (c >> 5), rr = r & 15, cc = c & 31, ob = rr * 64 + cc * 2; return st * 1024 + (ob ^ (((ob >> 9) & 1) << 5)); }
__host__ __device__ __forceinline__ void stage_rc(int b, int& R, int& C) { const int st = b / 1024, sb = b % 1024, swz = sb ^ (((sb >> 9) & 1) << 5); R = (st >> 1) * 16 + swz / 64; C = (st & 1) * 32 + (swz % 64) / 2; }
__host__ __device__ __forceinline__ int perm32(int rho) { const int n = rho >> 4, i = rho & 15; return 8 * (i >> 2) + 4 * n + (i & 3); }
struct Unit { int pm, pn; };
struct Gemm { const bf16_t* A; const bf16_t* Bt; int M, N, K; };
struct StaticOrder {
    int nM, nN, nwg, G, c;
    __host__ __device__ void init(int M, int N, int G_, int c_) { nM = M / BM; nN = N / BM; nwg = nM * nN; G = G_; c = c_; }
    __host__ __device__ bool next(int i, Unit& u) const {
        const long L = (long)i * G + c; if (L >= nwg) return false;
        int wgid = (int)L; { const int q = nwg / NXCD, r = nwg % NXCD, xcd = wgid % NXCD, off = wgid / NXCD; wgid = (xcd < r ? xcd * (q + 1) : r * (q + 1) + (xcd - r) * q) + off; }
        const int nig = WGM * nN, gid = wgid / nig, fm = gid * WGM, gsz = (nM - fm) < WGM ? (nM - fm) : WGM;
        u.pm = fm + ((wgid % nig) % gsz); u.pn = (wgid % nig) / gsz; return true;
    }
    __device__ __forceinline__ void a_ready(const Unit&) const {}
    __device__ __forceinline__ void done(const Unit&) const {}
};

template <class Epi, class Sched>
__device__ __forceinline__ void gemm_phase(PG8_LAS unsigned char* lds, const Gemm g, const Sched& S, const Epi& E) {
    const int tid = ltid(), wid = __builtin_amdgcn_readfirstlane(tid >> 6), lane = tid & 63, wr = wid >> 2, wc = wid & 3, fr = lane & 15, fq = lane >> 4;
    const int K = g.K, nt = K / BK;
    unsigned voffA[2], voffB[2];
#pragma unroll
    for (int i = 0; i < 2; ++i) { int R, C; stage_rc(tid * 16 + i * 8192, R, C); const int Rb = Epi::PERM ? ((R & ~31) + perm32(R & 31)) : R;
        voffA[i] = (unsigned)(R * K + C) * 2u; voffB[i] = (unsigned)(Rb * K + C) * 2u; }
    const size_t kstep = (size_t)(BK * 2);
    const size_t hstep = (size_t)HALF * K * 2;
    const size_t tstep = 2 * hstep;
    const unsigned ldsw = (unsigned)wid * 1024u;
    const int aoff = lds_byte(wr * 64 + fr, fq * 8), boff = lds_byte(wc * 32 + fr, fq * 8);
#define PG8_SA(b, h) (((b) * 2 + (h)) * HTB)
#define PG8_SB(b, h) ((4 + (b) * 2 + (h)) * HTB)
#define PG8_STAGE(bufoff, gbase, voff) do { _Pragma("unroll") for (int _i = 0; _i < 2; ++_i) \
        __builtin_amdgcn_global_load_lds((const unsigned*)((const char*)(gbase) + (voff)[_i]), (PG8_LAS unsigned*)(lds + (bufoff) + ldsw + _i * 8192), 16, 0, 0); } while (0)
#define PG8_LDA(dst, b, h) do { _Pragma("unroll") for (int m = 0; m < 4; ++m) _Pragma("unroll") for (int k = 0; k < 2; ++k) dst[m][k] = *(const PG8_LAS bf16x8*)(lds + PG8_SA(b, h) + aoff + m * 2048 + k * 1024); } while (0)
#define PG8_LDB(dst, b, h) do { _Pragma("unroll") for (int n = 0; n < 2; ++n) _Pragma("unroll") for (int k = 0; k < 2; ++k) dst[n][k] = *(const PG8_LAS bf16x8*)(lds + PG8_SB(b, h) + boff + n * 2048 + k * 1024); } while (0)
#define PG8_MMA(ai, bj, At, Bt) do { __builtin_amdgcn_s_setprio(1); _Pragma("unroll") for (int m = 0; m < 4; ++m) _Pragma("unroll") for (int n = 0; n < 2; ++n) _Pragma("unroll") for (int k = 0; k < 2; ++k) \
        acc[ai][bj][m][n] = __builtin_amdgcn_mfma_f32_16x16x32_bf16(Bt[n][k], At[m][k], acc[ai][bj][m][n], 0, 0, 0); __builtin_amdgcn_s_setprio(0); } while (0)
#define PG8_WAIT_V(n) asm volatile("s_waitcnt vmcnt(" #n ")" ::: "memory")
#define PG8_WAIT_L(n) asm volatile("s_waitcnt lgkmcnt(" #n ")" ::: "memory")
#define PG8_BAR __builtin_amdgcn_s_barrier()
#define PG8_SCHED __builtin_amdgcn_sched_barrier(0)
    Unit cur, nxt; int ui = 0;
    if (!S.next(0, cur)) return;
    f32x4 acc[2][2][4][2];
#pragma unroll
    for (int a = 0; a < 2; ++a)
#pragma unroll
        for (int b = 0; b < 2; ++b)
#pragma unroll
            for (int m = 0; m < 4; ++m)
#pragma unroll
                for (int n = 0; n < 2; ++n) acc[a][b][m][n] = (f32x4){0.f, 0.f, 0.f, 0.f};
    bf16x8 At[4][2], B0[2][2], B1[2][2];
    const char* cA = (const char*)g.A + (size_t)cur.pm * tstep; const char* cB = (const char*)g.Bt + (size_t)cur.pn * tstep;
    S.a_ready(cur);
    PG8_STAGE(PG8_SB(0, 0), cB, voffB); PG8_STAGE(PG8_SA(0, 0), cA, voffA); PG8_STAGE(PG8_SB(0, 1), cB + hstep, voffB); PG8_STAGE(PG8_SA(0, 1), cA + hstep, voffA);
    if (wr == 1) PG8_BAR;
    PG8_WAIT_V(4); PG8_BAR;
    PG8_STAGE(PG8_SB(1, 0), cB + kstep, voffB); PG8_STAGE(PG8_SA(1, 0), cA + kstep, voffA); PG8_STAGE(PG8_SB(1, 1), cB + hstep + kstep, voffB);
    PG8_WAIT_V(6); PG8_BAR;
    for (;;) {
        const bool has_next = S.next(ui + 1, nxt);
        const char* nA = has_next ? (const char*)g.A + (size_t)nxt.pm * tstep : cA; const char* nB = has_next ? (const char*)g.Bt + (size_t)nxt.pn * tstep : cB;
        for (int t = 0; t < nt; t += 2) {
            const bool last = (t == nt - 2);
            const char* a1 = cA + (size_t)(t + 1) * kstep;
            const char* a2 = last ? nA : cA + (size_t)(t + 2) * kstep; const char* b2 = last ? nB : cB + (size_t)(t + 2) * kstep;
            const char* a3 = a2 + kstep; const char* b3 = b2 + kstep;
            if (last && has_next) S.a_ready(nxt);
            PG8_LDB(B0, 0, 0); PG8_SCHED; PG8_LDA(At, 0, 0); PG8_STAGE(PG8_SA(1, 1), a1 + hstep, voffA);
            PG8_WAIT_L(8); PG8_BAR; PG8_WAIT_L(0); PG8_MMA(0, 0, At, B0); PG8_BAR; PG8_SCHED;
            PG8_LDB(B1, 0, 1); PG8_STAGE(PG8_SB(0, 0), b2, voffB);
            PG8_BAR; PG8_WAIT_L(0); PG8_MMA(0, 1, At, B1); PG8_BAR;
            PG8_LDA(At, 0, 1); PG8_STAGE(PG8_SA(0, 0), a2, voffA);
            PG8_BAR; PG8_WAIT_L(0); PG8_MMA(1, 0, At, B0); PG8_BAR; PG8_SCHED;
            PG8_STAGE(PG8_SB(0, 1), b2 + hstep, voffB);
            PG8_WAIT_V(6); PG8_BAR; PG8_MMA(1, 1, At, B1); PG8_BAR;
            PG8_LDB(B0, 1, 0); PG8_SCHED; PG8_LDA(At, 1, 0); PG8_STAGE(PG8_SA(0, 1), a2 + hstep, voffA);
            PG8_WAIT_L(8); PG8_BAR; PG8_WAIT_L(0); PG8_MMA(0, 0, At, B0); PG8_BAR; PG8_SCHED;
            PG8_LDB(B1, 1, 1); PG8_STAGE(PG8_SB(1, 0), b3, voffB);
            PG8_BAR; PG8_WAIT_L(0); PG8_MMA(0, 1, At, B1); PG8_BAR;
            PG8_LDA(At, 1, 1); PG8_STAGE(PG8_SA(1, 0), a3, voffA);
            PG8_BAR; PG8_WAIT_L(0); PG8_MMA(1, 0, At, B0); PG8_BAR; PG8_SCHED;
            PG8_STAGE(PG8_SB(1, 1), b3 + hstep, voffB);
            PG8_WAIT_V(6); PG8_BAR; PG8_MMA(1, 1, At, B1); PG8_BAR;
        }
        if constexpr (!Epi::AFTER_DRAIN) { E(acc, cur, wr, wc, fr, fq); S.done(cur); }
        if (!has_next) break;
#pragma unroll
        for (int a = 0; a < 2; ++a)
#pragma unroll
            for (int b = 0; b < 2; ++b)
#pragma unroll
                for (int m = 0; m < 4; ++m)
#pragma unroll
                    for (int n = 0; n < 2; ++n) acc[a][b][m][n] = (f32x4){0.f, 0.f, 0.f, 0.f};
        cur = nxt; cA = nA; cB = nB; ++ui;
    }
    PG8_WAIT_V(0);
    if (wr == 0) PG8_BAR;
    PG8_BAR;
    if constexpr (Epi::AFTER_DRAIN) { E.fused(acc, cur, wr, wc, fr, fq, lds, wid, lane); S.done(cur); }
#undef PG8_SA
#undef PG8_SB
#undef PG8_STAGE
#undef PG8_LDA
#undef PG8_LDB
#undef PG8_MMA
#undef PG8_WAIT_V
#undef PG8_WAIT_L
#undef PG8_BAR
#undef PG8_SCHED
}

}

constexpr int SROW = 144;
constexpr int A_ST = 256 * SROW, B_ST = 128 * SROW, ST_BYTES = A_ST + B_ST;

DEV void gemm_kloop(f32x4 (&acc)[4][4], const bf16_t* __restrict__ A, int lda, const bf16_t* __restrict__ Bt, int ldb,
                    int K, char* smem) {
  const int tid = ltid(), lane = tid & 63, w = tid >> 6, wm = w >> 1, wn = w & 1;
  const int fr = lane & 15, fq = lane >> 4;
  const int lrow = tid >> 3, lch = tid & 7;
  const bf16_t* ga = A + (size_t)lrow * lda + lch * 8;
  const bf16_t* gb = Bt + (size_t)lrow * ldb + lch * 8;
  u32x4 ra[4], rb[2];
#pragma unroll
  for (int i = 0; i < 4; ++i) ra[i] = *(const u32x4*)(ga + (size_t)(64 * i) * lda);
#pragma unroll
  for (int i = 0; i < 2; ++i) rb[i] = *(const u32x4*)(gb + (size_t)(64 * i) * ldb);
  char* swa = smem + lrow * SROW + lch * 16;
  char* swb = swa + A_ST;
  __syncthreads();
#pragma unroll
  for (int i = 0; i < 4; ++i) *(u32x4*)(swa + i * 64 * SROW) = ra[i];
#pragma unroll
  for (int i = 0; i < 2; ++i) *(u32x4*)(swb + i * 64 * SROW) = rb[i];
  __syncthreads();
  const int nk = K >> 6;
  const char* sra = smem + (wm * 64 + fr) * SROW + fq * 16;
  const char* srb = smem + A_ST + (wn * 64 + fr) * SROW + fq * 16;
  for (int kt = 0; kt < nk; ++kt) {
    const int cur = kt & 1;
    if (kt + 1 < nk) {
#pragma unroll
      for (int i = 0; i < 4; ++i) ra[i] = *(const u32x4*)(ga + (size_t)(64 * i) * lda + (kt + 1) * 64);
#pragma unroll
      for (int i = 0; i < 2; ++i) rb[i] = *(const u32x4*)(gb + (size_t)(64 * i) * ldb + (kt + 1) * 64);
    }
#pragma unroll
    for (int ks = 0; ks < 2; ++ks) {
      bf16x8 af[4], bfr[4];
#pragma unroll
      for (int mi = 0; mi < 4; ++mi) af[mi] = *(const bf16x8*)(sra + cur * ST_BYTES + mi * 16 * SROW + ks * 64);
#pragma unroll
      for (int ni = 0; ni < 4; ++ni) bfr[ni] = *(const bf16x8*)(srb + cur * ST_BYTES + ni * 16 * SROW + ks * 64);
#pragma unroll
      for (int mi = 0; mi < 4; ++mi)
#pragma unroll
        for (int ni = 0; ni < 4; ++ni)
          acc[mi][ni] = __builtin_amdgcn_mfma_f32_16x16x32_bf16(bfr[ni], af[mi], acc[mi][ni], 0, 0, 0);
    }
    if (kt + 1 < nk) {
      const int nx = cur ^ 1;
#pragma unroll
      for (int i = 0; i < 4; ++i) *(u32x4*)(swa + nx * ST_BYTES + i * 64 * SROW) = ra[i];
#pragma unroll
      for (int i = 0; i < 2; ++i) *(u32x4*)(swb + nx * ST_BYTES + i * 64 * SROW) = rb[i];
    }
    __syncthreads();
  }
}
DEV void zero_acc(f32x4 (&acc)[4][4]) {
#pragma unroll
  for (int a = 0; a < 4; ++a)
#pragma unroll
    for (int b = 0; b < 4; ++b) acc[a][b] = (f32x4){0.f, 0.f, 0.f, 0.f};
}
DEV void tile_pm_pn(int L, int nN, int& pm, int& pn) {
  const int g = L / (4 * nN), wi = L % (4 * nN);
  pm = g * 4 + (wi & 3);
  pn = wi >> 2;
}

DEV int conv_srccol(int n) {
  const int tile = n >> 8, w = n & 255;
  return w < 128 ? tile * 128 + w : 512 + tile * 128 + (w - 128);
}
DEV void cvt_job(const float* __restrict__ src, int K, int N, int ldsrc, bf16_t* __restrict__ dst, int nperm, int& tbase, char* smem) {
  float* lds = (float*)smem;
  const int nkt = K >> 6, nnt = N >> 6, cnt = nkt * nnt;
  const int G = gridDim.x;
  const int first = (int)((blockIdx.x + G - (tbase % G)) % G);
  const int tid = ltid();
  for (int t = first; t < cnt; t += G) {
    const int kt = t % nkt, nt = t / nkt;
    const int ty = tid >> 4, tx = tid & 15;
    const int n = nt * 64 + tx * 4;
    const int sc = (n < nperm) ? conv_srccol(n) : n;
#pragma unroll
    for (int i = 0; i < 2; ++i) {
      const int k = ty + 32 * i;
      const float4 v = *(const float4*)(src + (size_t)(kt * 64 + k) * ldsrc + sc);
      float* d = lds + k * 65 + tx * 4;
      d[0] = v.x; d[1] = v.y; d[2] = v.z; d[3] = v.w;
    }
    __syncthreads();
    {
      const int nn = tid >> 3, kc = tid & 7;
      float v[8];
#pragma unroll
      for (int j = 0; j < 8; ++j) v[j] = lds[(kc * 8 + j) * 65 + nn];
      uint4 o;
      o.x = pk2(v[0], v[1]); o.y = pk2(v[2], v[3]); o.z = pk2(v[4], v[5]); o.w = pk2(v[6], v[7]);
      *(uint4*)(dst + (size_t)(nt * 64 + nn) * K + kt * 64 + kc * 8) = o;
    }
    __syncthreads();
  }
  tbase += cnt;
}
DEV void cvt_phase(const Params& p, int l, char* smem) {
  char* wb = p.ws + O_WB;
  int tb = 0;
  const float* win = p.w_in + (size_t)l * 1024 * DIN;
  cvt_job(win, 1024, NZ, DIN, (bf16_t*)(wb + W_WIN), 1024, tb, smem);
  cvt_job(win + NZ, 1024, 3072, DIN, (bf16_t*)(wb + W_WIN) + (size_t)NZP * 1024, 0, tb, smem);
  cvt_job(p.mlp_w1 + (size_t)l * 1024 * 4096, 1024, 4096, 4096, (bf16_t*)(wb + W_W1), 0, tb, smem);
  cvt_job(p.mlp_w2 + (size_t)l * 4096 * 1024, 4096, 1024, 1024, (bf16_t*)(wb + W_W2), 0, tb, smem);
  cvt_job(p.w_out + (size_t)l * 1024 * 1024, 1024, 1024, 1024, (bf16_t*)(wb + W_WOUT), 0, tb, smem);
  cvt_job(p.p_conv + (size_t)l * 512 * 1024, 512, 1024, 1024, (bf16_t*)(wb + W_PCV), 0, tb, smem);
  cvt_job(p.p_att + (size_t)l * 512 * 1024, 512, 1024, 1024, (bf16_t*)(wb + W_PAT), 0, tb, smem);
  cvt_job(p.p_rwkv + (size_t)l * 512 * 1024, 512, 1024, 1024, (bf16_t*)(wb + W_PRW), 0, tb, smem);
  for (int d = 0; d < 2; ++d) {
    cvt_job(p.rwkv_w2 + (size_t)(l * 2 + d) * 64 * 512, 64, 512, 512, (bf16_t*)(wb + W_LW2) + d * 512 * 64, 0, tb, smem);
    cvt_job(p.rwkv_a2 + (size_t)(l * 2 + d) * 64 * 512, 64, 512, 512, (bf16_t*)(wb + W_LA2) + d * 512 * 64, 0, tb, smem);
  }
  cvt_job(p.rwkv_g2 + (size_t)l * 128 * 512, 128, 512, 512, (bf16_t*)(wb + W_LG2), 0, tb, smem);
}

DEV void mod_phase(const Params& p, char* smem) {
  float* sc = (float*)smem;
  float* red = sc + 9 * 1024;
  float* MOD = (float*)(p.ws + O_MOD);
  const int tid = ltid();
  if ((int)blockIdx.x >= 192) return;
  for (int i = tid; i < 9 * 1024; i += 512) {
    const int r = i >> 10, k = i & 1023;
    const float v = r < 8 ? p.c[r * 1024 + k] : p.c_ctx[k];
    sc[i] = v * __builtin_amdgcn_rcpf(1.f + __expf(-v));
  }
  __syncthreads();
  for (int tile = blockIdx.x; tile < 192; tile += gridDim.x) {
    const int l = tile / 96, n0 = (tile % 96) * 64;
    const int kq = tid >> 6, col = tid & 63;
    float acc[9];
#pragma unroll
    for (int r = 0; r < 9; ++r) acc[r] = 0.f;
    const float* wp = p.mod_w + ((size_t)l * 1024 + kq * 128) * 6144 + n0 + col;
#pragma unroll 32
    for (int k = 0; k < 128; ++k) {
      const float wv = wp[(size_t)k * 6144];
#pragma unroll
      for (int r = 0; r < 9; ++r) acc[r] += sc[r * 1024 + kq * 128 + k] * wv;
    }
#pragma unroll
    for (int r = 0; r < 9; ++r) red[(kq * 9 + r) * 64 + col] = acc[r];
    __syncthreads();
    for (int idx = tid; idx < 576; idx += 512) {
      const int r = idx >> 6, cc = idx & 63;
      float s = p.mod_b[l * 6144 + n0 + cc];
#pragma unroll
      for (int q = 0; q < 8; ++q) s += red[(q * 9 + r) * 64 + cc];
      MOD[(size_t)(l * 9 + r) * 6144 + n0 + cc] = s;
    }
    __syncthreads();
  }
}

DEV void norm_phase(const Params& p, int l, int which, bf16_t* __restrict__ Hd, bool first, int nrows = T_ALL) {
  const float* g = (which ? p.norm2_g : p.norm1_g) + l * 1024;
  const float* MOD = (const float*)(p.ws + O_MOD);
  const int lane = ltid() & 63, w = ltid() >> 6;
  const int stride = gridDim.x * 8;
  f32x4 gg[4];
#pragma unroll
  for (int i = 0; i < 4; ++i) gg[i] = *(const f32x4*)(g + i * 256 + lane * 4);
  auto srcp = [&](int row) -> const float* {
    if (first) return row < T_LAT ? p.x + (size_t)row * DM : p.ctx + (size_t)(row - T_LAT) * DM;
    return xrow(p, row);
  };
  int row = blockIdx.x * 8 + w;
  f32x4 nv[4];
  if (row < nrows) {
    const float* s = srcp(row);
#pragma unroll
    for (int i = 0; i < 4; ++i) nv[i] = *(const f32x4*)(s + i * 256 + lane * 4);
  }
  for (; row < nrows; row += stride) {
    f32x4 v[4];
#pragma unroll
    for (int i = 0; i < 4; ++i) v[i] = nv[i];
    if (row + stride < nrows) {
      const float* s = srcp(row + stride);
#pragma unroll
      for (int i = 0; i < 4; ++i) nv[i] = *(const f32x4*)(s + i * 256 + lane * 4);
    }
    const float* md = MOD + (size_t)(l * 9 + modrow(row)) * 6144 + which * 3072;
    f32x4 sh[4], scl[4];
#pragma unroll
    for (int i = 0; i < 4; ++i) { sh[i] = *(const f32x4*)(md + i * 256 + lane * 4); scl[i] = *(const f32x4*)(md + 1024 + i * 256 + lane * 4); }
    float ss = 0.f;
#pragma unroll
    for (int i = 0; i < 4; ++i) ss += v[i][0] * v[i][0] + v[i][1] * v[i][1] + v[i][2] * v[i][2] + v[i][3] * v[i][3];
    const float rs = __builtin_amdgcn_rsqf(wsum(ss) * (1.f / 1024.f) + 1e-6f);
#pragma unroll
    for (int i = 0; i < 4; ++i) {
      const int c = i * 256 + lane * 4;
      const f32x4 h = v[i] * rs * gg[i] * (scl[i] + 1.f) + sh[i];
      uint2 o;
      o.x = pk2(h[0], h[1]); o.y = pk2(h[2], h[3]);
      *(uint2*)(Hd + (size_t)row * DM + c) = o;
    }
  }
}

DEV void rope2(float a, float b, float ang, float& o0, float& o1) {
  const float cs = __cosf(ang), sn = __sinf(ang);
  o0 = a * cs - b * sn;
  o1 = a * sn + b * cs;
}
struct EpiIn {
  static constexpr bool PERM = true, AFTER_DRAIN = false;
  bf16_t *ZU, *ZQ, *ZK, *VT, *ZRW;
  DEV void operator()(const f32x4 (&acc)[2][2][4][2], const pg8::Unit& u, int wr, int wc, int fr, int fq) const {
    const int row0 = u.pm * 256 + wr * 64 + fr, cl = wc * 32 + 8 * fq, pn = u.pn;
    if (pn < 4) {
#pragma unroll
      for (int ai = 0; ai < 2; ++ai)
#pragma unroll
        for (int m = 0; m < 4; ++m) {
          const int row = row0 + ai * 128 + m * 16;
          const f32x4 a0 = acc[ai][0][m][0], a1 = acc[ai][0][m][1], b0 = acc[ai][1][m][0], b1 = acc[ai][1][m][1];
          u32x4 o;
          o[0] = pk2(a0[0] * sigmoidf_(b0[0]), a0[1] * sigmoidf_(b0[1]));
          o[1] = pk2(a0[2] * sigmoidf_(b0[2]), a0[3] * sigmoidf_(b0[3]));
          o[2] = pk2(a1[0] * sigmoidf_(b1[0]), a1[1] * sigmoidf_(b1[1]));
          o[3] = pk2(a1[2] * sigmoidf_(b1[2]), a1[3] * sigmoidf_(b1[3]));
          *(u32x4*)(ZU + (size_t)row * 512 + pn * 128 + cl) = o;
        }
    } else if (pn < 8) {
      const bool isq = pn < 6;
      bf16_t* Z = isq ? ZQ : ZK;
      const float qs = isq ? 0.125f * 1.4426950408889634f : 1.f;
      const int cbase = (pn - (isq ? 4 : 6)) * 256 + cl;
#pragma unroll
      for (int ai = 0; ai < 2; ++ai)
#pragma unroll
        for (int m = 0; m < 4; ++m) {
          const int row = row0 + ai * 128 + m * 16;
#pragma unroll
          for (int bj = 0; bj < 2; ++bj) {
            const int c = cbase + bj * 128;
            float v[8];
#pragma unroll
            for (int j = 0; j < 4; ++j) { v[j] = acc[ai][bj][m][0][j]; v[4 + j] = acc[ai][bj][m][1][j]; }
            if (row < T_LAT) {
              const int t = row & 4095, d = c & 63, p0 = d >> 1;
              const float pos = (float)((p0 < 16) ? (t >> 6) : (t & 63));
              const int fi = p0 & 15;
#pragma unroll
              for (int q = 0; q < 4; ++q) {
                const float fr_ = __builtin_amdgcn_exp2f(-(float)(fi + q) * 0.8304820237218406f);
                float o0, o1;
                rope2(v[2 * q], v[2 * q + 1], pos * fr_, o0, o1);
                v[2 * q] = o0; v[2 * q + 1] = o1;
              }
            }
            u32x4 o;
            o[0] = pk2(v[0] * qs, v[1] * qs); o[1] = pk2(v[2] * qs, v[3] * qs);
            o[2] = pk2(v[4] * qs, v[5] * qs); o[3] = pk2(v[6] * qs, v[7] * qs);
            *(u32x4*)(Z + (size_t)row * 512 + c) = o;
          }
        }
    } else if (pn < 10) {
#pragma unroll
      for (int ai = 0; ai < 2; ++ai)
#pragma unroll
        for (int m = 0; m < 4; ++m) {
          const int row = row0 + ai * 128 + m * 16;
          int b, kidx;
          if (row < T_LAT) { b = row >> 12; kidx = 256 + (row & 4095); } else { b = (row - T_LAT) >> 8; kidx = (row - T_LAT) & 255; }
#pragma unroll
          for (int bj = 0; bj < 2; ++bj) {
            const int head = (pn - 8) * 2 + bj;
            bf16_t* dst = VT + ((size_t)((b * 4 + head) * 128 + cl)) * TK + kidx;
#pragma unroll
            for (int j = 0; j < 4; ++j) {
              dst[(size_t)j * TK] = f2bf(acc[ai][bj][m][0][j]);
              dst[(size_t)(4 + j) * TK] = f2bf(acc[ai][bj][m][1][j]);
            }
          }
        }
    } else {
#pragma unroll
      for (int ai = 0; ai < 2; ++ai)
#pragma unroll
        for (int m = 0; m < 4; ++m) {
          const int row = row0 + ai * 128 + m * 16;
#pragma unroll
          for (int bj = 0; bj < 2; ++bj) {
            const int c = (pn - 10) * 256 + bj * 128 + cl;
            if (c < 1920) {
              u32x4 o;
              o[0] = pk2(acc[ai][bj][m][0][0], acc[ai][bj][m][0][1]); o[1] = pk2(acc[ai][bj][m][0][2], acc[ai][bj][m][0][3]);
              o[2] = pk2(acc[ai][bj][m][1][0], acc[ai][bj][m][1][1]); o[3] = pk2(acc[ai][bj][m][1][2], acc[ai][bj][m][1][3]);
              *(u32x4*)(ZRW + (size_t)row * 1920 + c) = o;
            }
          }
        }
    }
  }
};
DEV void gemm_in_phase(const Params& p, char* smem) {
  EpiIn E;
  E.ZU = (bf16_t*)(p.ws + O_ZU); E.ZQ = (bf16_t*)(p.ws + O_ZQ); E.ZK = (bf16_t*)(p.ws + O_ZK);
  E.VT = (bf16_t*)(p.ws + O_VT); E.ZRW = (bf16_t*)(p.ws + O_ZRW);
  pg8::Gemm g;
  g.A = (const bf16_t*)(p.ws + O_H0); g.Bt = (const bf16_t*)(p.ws + O_WB + W_WIN); g.M = T_ALL; g.N = NZP; g.K = 1024;
  pg8::StaticOrder S;
  S.init(g.M, g.N, (int)gridDim.x, (int)blockIdx.x);
  __syncthreads();
  pg8::gemm_phase<EpiIn, pg8::StaticOrder>((PG8_LAS unsigned char*)smem, g, S, E);
  __syncthreads();
}

constexpr int KROW = 272, VROW = 144, ATT_ST = 64 * KROW + 128 * VROW;
constexpr int ATT2_ST = 2 * 128 * KROW;
DEV int key_of_slot(int x) { return (x & 0x13) | ((x & 8) >> 1) | ((x & 4) << 1); }

DEV void attn_tile(const Params& p, int l, int tile, char* smem, bool do_store = true) {
  bf16_t* ZQ = (bf16_t*)(p.ws + O_ZQ);
  const bf16_t* ZK = (const bf16_t*)(p.ws + O_ZK);
  const bf16_t* VT = (const bf16_t*)(p.ws + O_VT);
  int b, head, q0, nkeys, qbase;
  if (tile < 1024) { b = tile >> 7; head = (tile >> 5) & 3; q0 = (tile & 31) * 128; nkeys = TK; qbase = b * SEQ; }
  else { const int tt = tile - 1024; b = tt >> 3; head = (tt >> 1) & 3; q0 = (tt & 1) * 128; nkeys = CTXL; qbase = T_LAT + b * CTXL; }
  const int tid = ltid(), lane = tid & 63, w = tid >> 6, ql = lane & 31, hh = lane >> 5, map = w >> 2, qg = w & 3;
  const int qrow = qbase + q0 + qg * 32 + ql;
  const float lam_init = l == 0 ? 0.2f : 0.35550907f;
  float lam;
  {
    const float a1 = p.att_lq1[l * 64 + lane] * p.att_lk1[l * 64 + lane];
    const float a2 = p.att_lq2[l * 64 + lane] * p.att_lk2[l * 64 + lane];
    lam = __expf(wsum(a1)) - __expf(wsum(a2)) + lam_init;
  }
  bf16x8 qf[4];
#pragma unroll
  for (int s = 0; s < 4; ++s) qf[s] = *(const bf16x8*)(ZQ + (size_t)qrow * 512 + head * 128 + map * 64 + s * 16 + hh * 8);
  f32x16 o[4];
#pragma unroll
  for (int dt = 0; dt < 4; ++dt)
#pragma unroll
    for (int e = 0; e < 16; ++e) o[dt][e] = 0.f;
  float m = -1e30f, lsum = 0.f;
  const int kr0 = tid >> 4, kch = tid & 15;
  const int vr0 = tid >> 4, vch = tid & 15;
  const bf16_t* vtb = VT + ((size_t)((b * 4 + head) * 128)) * TK;
  u32x4 kreg[4], vreg[4];
  auto gload = [&](int kt) {
    const int k0 = kt * 128;
#pragma unroll
    for (int i = 0; i < 4; ++i) {
      const int kidx = k0 + kr0 + 32 * i;
      const int krow = kidx < CTXL ? T_LAT + b * CTXL + kidx : b * SEQ + kidx - CTXL;
      kreg[i] = *(const u32x4*)(ZK + (size_t)krow * 512 + head * 128 + kch * 8);
      vreg[i] = *(const u32x4*)(vtb + (size_t)(vr0 + 32 * i) * TK + k0 + vch * 8);
    }
  };
  auto lstore = [&](int st) {
    char* Ks = smem + st * ATT2_ST;
    char* Vs = Ks + 128 * KROW;
#pragma unroll
    for (int i = 0; i < 4; ++i) {
      *(u32x4*)(Ks + (kr0 + 32 * i) * KROW + kch * 16) = kreg[i];
      *(u32x4*)(Vs + (vr0 + 32 * i) * KROW + vch * 16) = vreg[i];
    }
  };
  const int nkt = nkeys >> 7;
  gload(0);
  __syncthreads();
  lstore(0);
  __syncthreads();
  const int kos = key_of_slot(ql);
  for (int kt = 0; kt < nkt; ++kt) {
    const int cur = kt & 1;
    if (kt + 1 < nkt) gload(kt + 1);
    const char* Ks = smem + cur * ATT2_ST;
    const char* Vs = Ks + 128 * KROW;
#pragma unroll
    for (int h2 = 0; h2 < 2; ++h2) {
    const char* kp = Ks + (h2 * 64 + kos) * KROW + (map * 64 + hh * 8) * 2;
    const char* vp = Vs + ql * KROW + hh * 16 + h2 * 128;
    bf16x8 kf0[4], kf1[4];
#pragma unroll
    for (int ks = 0; ks < 4; ++ks) { kf0[ks] = *(const bf16x8*)(kp + ks * 32); kf1[ks] = *(const bf16x8*)(kp + 32 * KROW + ks * 32); }
    f32x16 s0, s1;
#pragma unroll
    for (int e = 0; e < 16; ++e) { s0[e] = 0.f; s1[e] = 0.f; }
#pragma unroll
    for (int ks = 0; ks < 4; ++ks) s0 = __builtin_amdgcn_mfma_f32_32x32x16_bf16(kf0[ks], qf[ks], s0, 0, 0, 0);
#pragma unroll
    for (int ks = 0; ks < 4; ++ks) s1 = __builtin_amdgcn_mfma_f32_32x32x16_bf16(kf1[ks], qf[ks], s1, 0, 0, 0);
    bf16x8 vf[8];
#pragma unroll
    for (int dt = 0; dt < 4; ++dt)
#pragma unroll
      for (int k2 = 0; k2 < 2; ++k2) vf[dt * 2 + k2] = *(const bf16x8*)(vp + dt * 32 * KROW + (k2 * 16) * 2);
    float mx = fmaxf(s0[0], s1[0]);
#pragma unroll
    for (int e = 1; e < 16; ++e) mx = fmaxf(mx, fmaxf(s0[e], s1[e]));
    mx = xor32_max(mx);
    const float mnew = (mx > m + 8.f) ? mx : m;
    if (__any(mnew > m)) {
      const float alpha = __builtin_amdgcn_exp2f(m - mnew);
      lsum *= alpha;
#pragma unroll
      for (int dt = 0; dt < 4; ++dt)
#pragma unroll
        for (int e = 0; e < 16; ++e) o[dt][e] *= alpha;
    }
    m = mnew;
    bf16x8 pb0[2], pb1[2];
    {
      float pe[16];
#pragma unroll
      for (int e = 0; e < 16; ++e) { pe[e] = __builtin_amdgcn_exp2f(s0[e] - m); lsum += pe[e]; }
#pragma unroll
      for (int k2 = 0; k2 < 2; ++k2) {
        u32x4 u;
        u[0] = pk2(pe[8 * k2 + 0], pe[8 * k2 + 1]); u[1] = pk2(pe[8 * k2 + 2], pe[8 * k2 + 3]);
        u[2] = pk2(pe[8 * k2 + 4], pe[8 * k2 + 5]); u[3] = pk2(pe[8 * k2 + 6], pe[8 * k2 + 7]);
        pb0[k2] = __builtin_bit_cast(bf16x8, u);
      }
    }
#pragma unroll
    for (int dt = 0; dt < 4; ++dt)
#pragma unroll
      for (int k2 = 0; k2 < 2; ++k2) o[dt] = __builtin_amdgcn_mfma_f32_32x32x16_bf16(vf[dt * 2 + k2], pb0[k2], o[dt], 0, 0, 0);
#pragma unroll
    for (int dt = 0; dt < 4; ++dt)
#pragma unroll
      for (int k2 = 0; k2 < 2; ++k2) vf[dt * 2 + k2] = *(const bf16x8*)(vp + dt * 32 * KROW + (32 + k2 * 16) * 2);
    {
      float pe[16];
#pragma unroll
      for (int e = 0; e < 16; ++e) { pe[e] = __builtin_amdgcn_exp2f(s1[e] - m); lsum += pe[e]; }
#pragma unroll
      for (int k2 = 0; k2 < 2; ++k2) {
        u32x4 u;
        u[0] = pk2(pe[8 * k2 + 0], pe[8 * k2 + 1]); u[1] = pk2(pe[8 * k2 + 2], pe[8 * k2 + 3]);
        u[2] = pk2(pe[8 * k2 + 4], pe[8 * k2 + 5]); u[3] = pk2(pe[8 * k2 + 6], pe[8 * k2 + 7]);
        pb1[k2] = __builtin_bit_cast(bf16x8, u);
      }
    }
#pragma unroll
    for (int dt = 0; dt < 4; ++dt)
#pragma unroll
      for (int k2 = 0; k2 < 2; ++k2) o[dt] = __builtin_amdgcn_mfma_f32_32x32x16_bf16(vf[dt * 2 + k2], pb1[k2], o[dt], 0, 0, 0);
    }
    if (kt + 1 < nkt) lstore(cur ^ 1);
    __syncthreads();
  }
  const float ltot = xor32_sum(lsum);
  float* ex = (float*)smem;
  if (map == 1) {
    const float c2 = lam / ltot;
#pragma unroll
    for (int dt = 0; dt < 4; ++dt)
#pragma unroll
      for (int e = 0; e < 16; ++e) {
        const int dv = dt * 32 + 8 * (e >> 2) + 4 * hh + (e & 3);
        ex[(qg * 128 + dv) * 32 + ql] = o[dt][e] * c2;
      }
  }
  __syncthreads();
  if (map == 0 && do_store) {
    const float c1 = 1.f / ltot;
    float ss = 0.f;
#pragma unroll
    for (int dt = 0; dt < 4; ++dt)
#pragma unroll
      for (int e = 0; e < 16; ++e) {
        const int dv = dt * 32 + 8 * (e >> 2) + 4 * hh + (e & 3);
        const float v = o[dt][e] * c1 - ex[(qg * 128 + dv) * 32 + ql];
        o[dt][e] = v;
        ss += v * v;
      }
    ss = xor32_sum(ss);
    const float rs = __builtin_amdgcn_rsqf(ss * (1.f / 128.f) + 1e-5f) * (1.f - lam_init);
    const float* sg = p.att_subln_g + l * 128;
#pragma unroll
    for (int dt = 0; dt < 4; ++dt)
#pragma unroll
      for (int i = 0; i < 4; ++i) {
        const int dv = dt * 32 + 8 * i + 4 * hh;
        const float4 g4 = *(const float4*)(sg + dv);
        uint2 u;
        u.x = pk2(o[dt][4 * i + 0] * rs * g4.x, o[dt][4 * i + 1] * rs * g4.y);
        u.y = pk2(o[dt][4 * i + 2] * rs * g4.z, o[dt][4 * i + 3] * rs * g4.w);
        *(uint2*)(ZQ + (size_t)qrow * 512 + head * 128 + dv) = u;
      }
  }
  __syncthreads();
}

DEV void conv_tile(const Params& p, int l, int tile, char* smem) {
  const bf16_t* ZU = (const bf16_t*)(p.ws + O_ZU);
  bf16_t* YCV = (bf16_t*)(p.ws + O_YCV);
  const int r0 = tile * 64;
  int s_lo, s_hi;
  if (r0 < T_LAT) { s_lo = r0 & ~4095; s_hi = s_lo + SEQ; } else { s_lo = T_LAT + ((r0 - T_LAT) & ~255); s_hi = s_lo + CTXL; }
  const int tid = ltid(), lane = tid & 63, w = tid >> 6, c0 = lane * 8;
  const int t0 = r0 + w * 8;
  const float* wp = p.conv_dw_w + (size_t)l * 31 * 512 + c0;
  float acc[8][8];
  {
    const f32x4 b0 = *(const f32x4*)(p.conv_dw_b + l * 512 + c0), b1 = *(const f32x4*)(p.conv_dw_b + l * 512 + c0 + 4);
#pragma unroll
    for (int t = 0; t < 8; ++t)
#pragma unroll
      for (int j = 0; j < 4; ++j) { acc[t][j] = b0[j]; acc[t][4 + j] = b1[j]; }
  }
  f32x4 wk[8][2];
#pragma unroll
  for (int q = 0; q < 8; ++q) { wk[q][0] = (f32x4){0.f, 0.f, 0.f, 0.f}; wk[q][1] = (f32x4){0.f, 0.f, 0.f, 0.f}; }
#pragma unroll 4
  for (int s = 0; s < 40; ++s) {
    const int rr = t0 - 15 + s;
    u32x4 uv = {0u, 0u, 0u, 0u};
    if (rr >= s_lo && rr < s_hi) uv = *(const u32x4*)(ZU + (size_t)rr * 512 + c0);
    float u[8];
#pragma unroll
    for (int q = 0; q < 4; ++q) { u[2 * q] = lo_bf(uv[q]); u[2 * q + 1] = hi_bf(uv[q]); }
#pragma unroll
    for (int q = 7; q > 0; --q) { wk[q][0] = wk[q - 1][0]; wk[q][1] = wk[q - 1][1]; }
    wk[0][0] = (f32x4){0.f, 0.f, 0.f, 0.f}; wk[0][1] = (f32x4){0.f, 0.f, 0.f, 0.f};
    if (s <= 30) { wk[0][0] = *(const f32x4*)(wp + s * 512); wk[0][1] = *(const f32x4*)(wp + s * 512 + 4); }
#pragma unroll
    for (int t = 0; t < 8; ++t) {
#pragma unroll
      for (int j = 0; j < 4; ++j) { acc[t][j] += wk[t][0][j] * u[j]; acc[t][4 + j] += wk[t][1][j] * u[4 + j]; }
    }
  }
  const f32x4 g0 = *(const f32x4*)(p.conv_ln_g + l * 512 + c0), g1 = *(const f32x4*)(p.conv_ln_g + l * 512 + c0 + 4);
  const f32x4 e0 = *(const f32x4*)(p.conv_ln_b + l * 512 + c0), e1 = *(const f32x4*)(p.conv_ln_b + l * 512 + c0 + 4);
#pragma unroll
  for (int t = 0; t < 8; ++t) {
    float s1 = 0.f;
#pragma unroll
    for (int j = 0; j < 8; ++j) s1 += acc[t][j];
    const float mu = wsum(s1) * (1.f / 512.f);
    float s2 = 0.f;
#pragma unroll
    for (int j = 0; j < 8; ++j) { acc[t][j] -= mu; s2 += acc[t][j] * acc[t][j]; }
    const float rs = __builtin_amdgcn_rsqf(wsum(s2) * (1.f / 512.f) + 1e-5f);
    float y[8];
#pragma unroll
    for (int j = 0; j < 4; ++j) {
      const float z0 = acc[t][j] * rs * g0[j] + e0[j], z1 = acc[t][4 + j] * rs * g1[j] + e1[j];
      y[j] = z0 * sigmoidf_(z0); y[4 + j] = z1 * sigmoidf_(z1);
    }
    u32x4 o;
    o[0] = pk2(y[0], y[1]); o[1] = pk2(y[2], y[3]); o[2] = pk2(y[4], y[5]); o[3] = pk2(y[6], y[7]);
    *(u32x4*)(YCV + (size_t)(t0 + t) * 512 + c0) = o;
  }
}

DEV void shift_tile(const Params& p, int l, int tile) {
  const bf16_t* ZRW = (const bf16_t*)(p.ws + O_ZRW);
  bf16_t* ZRS = (bf16_t*)(p.ws + O_ZRS);
  const int r0 = tile * 32;
  int s_lo, s_hi;
  if (r0 < T_LAT) { s_lo = r0 & ~4095; s_hi = s_lo + SEQ; } else { s_lo = T_LAT + ((r0 - T_LAT) & ~255); s_hi = s_lo + CTXL; }
  const int tid = ltid();
  if (tid >= 480) return;
  const int half = tid >= 240 ? 1 : 0, ch = tid - half * 240, col = ch * 8;
  const int rb = r0 + half * 16;
  u32x4 rows[18];
#pragma unroll
  for (int i = 0; i < 18; ++i) {
    const int rr = rb - 1 + i;
    rows[i] = (u32x4){0u, 0u, 0u, 0u};
    if (rr >= s_lo && rr < s_hi) rows[i] = *(const u32x4*)(ZRW + (size_t)rr * 1920 + col);
  }
  const float* sw = p.rwkv_shift + (size_t)l * 3 * 1920 + col;
  float w0[8], w1[8], w2[8];
#pragma unroll
  for (int j = 0; j < 8; ++j) { w0[j] = sw[j]; w1[j] = sw[1920 + j]; w2[j] = sw[3840 + j]; }
  const int act = (col >= 1536 && col < 1664) ? 1 : (col >= 1792 ? 2 : 0);
#pragma unroll
  for (int i = 0; i < 16; ++i) {
    const int row = rb + i;
    const u32x4 pv = rows[i], cu = rows[i + 1], nx = rows[i + 2];
    float y[8];
#pragma unroll
    for (int q = 0; q < 4; ++q) {
      y[2 * q] = w0[2 * q] * lo_bf(pv[q]) + w1[2 * q] * lo_bf(cu[q]) + w2[2 * q] * lo_bf(nx[q]);
      y[2 * q + 1] = w0[2 * q + 1] * hi_bf(pv[q]) + w1[2 * q + 1] * hi_bf(cu[q]) + w2[2 * q + 1] * hi_bf(nx[q]);
    }
    if (act == 1) {
#pragma unroll
      for (int j = 0; j < 8; ++j) y[j] = 1.f - 2.f * __builtin_amdgcn_rcpf(1.f + __expf(2.f * y[j]));
    } else if (act == 2) {
#pragma unroll
      for (int j = 0; j < 8; ++j) y[j] = sigmoidf_(y[j]);
    }
    u32x4 o;
    o[0] = pk2(y[0], y[1]); o[1] = pk2(y[2], y[3]); o[2] = pk2(y[4], y[5]); o[3] = pk2(y[6], y[7]);
    if (col < 1536) *(u32x4*)(ZRS + (size_t)row * 1536 + col) = o;
    else if (col < 1792) *(u32x4*)((bf16_t*)(p.ws + O_LIN) + (size_t)row * 256 + (col - 1536)) = o;
    else *(u32x4*)((bf16_t*)(p.ws + O_GIN) + (size_t)row * 128 + (col - 1792)) = o;
  }
}

DEV void branch_phase(const Params& p, int l, char* smem) {
  const bool last = (l == 1);
  for (int L = vblock(); L < 1088 + 544 + 1088; L += gridDim.x) {
    if (L < 1088) { if (!(last && L >= 1024)) attn_tile(p, l, L, smem); }
    else if (L < 1632) { if (!(last && L - 1088 >= 512)) conv_tile(p, l, L - 1088, smem); }
    else shift_tile(p, l, L - 1632);
  }
}

DEV void lora_phase(const Params& p, int l, char* smem, bool gjob) {
  const bf16_t* LIN = (const bf16_t*)(p.ws + O_LIN);
  const int lane = ltid() & 63, w = ltid() >> 6, wm = w >> 1, wn = w & 1, fr = lane & 15, fq = lane >> 4;
  const int ntile = gjob ? 544 : 4 * 544;
  for (int L = vblock(); L < ntile; L += gridDim.x) {
    const int job = gjob ? 4 : L / 544, t = L - (gjob ? 0 : job * 544), pm = t >> 2, pn = t & 3;
    const int row0 = pm * 256, col0 = pn * 128;
    const bf16_t* A;
    const bf16_t* Bt;
    bf16_t* O;
    int K = 64, lda = 256;
    const float* bias = nullptr;
    if (job == 0) { A = LIN; Bt = (const bf16_t*)(p.ws + O_WB + W_LW2); O = (bf16_t*)(p.ws + O_EF); bias = p.rwkv_w0 + (l * 2 + 0) * 512; }
    else if (job == 1) { A = LIN + 64; Bt = (const bf16_t*)(p.ws + O_WB + W_LW2) + 512 * 64; O = (bf16_t*)(p.ws + O_EB); bias = p.rwkv_w0 + (l * 2 + 1) * 512; }
    else if (job == 2) { A = LIN + 128; Bt = (const bf16_t*)(p.ws + O_WB + W_LA2); O = (bf16_t*)(p.ws + O_AF); bias = p.rwkv_a0 + (l * 2 + 0) * 512; }
    else if (job == 3) { A = LIN + 192; Bt = (const bf16_t*)(p.ws + O_WB + W_LA2) + 512 * 64; O = (bf16_t*)(p.ws + O_AB); bias = p.rwkv_a0 + (l * 2 + 1) * 512; }
    else { A = (const bf16_t*)(p.ws + O_GIN); Bt = (const bf16_t*)(p.ws + O_WB + W_LG2); O = (bf16_t*)(p.ws + O_G); K = 128; lda = 128; }
    f32x4 acc[4][4];
    zero_acc(acc);
    gemm_kloop(acc, A + (size_t)row0 * lda, lda, Bt + (size_t)col0 * K, K, K, smem);
#pragma unroll
    for (int mi = 0; mi < 4; ++mi) {
      const int row = row0 + wm * 64 + mi * 16 + fr;
#pragma unroll
      for (int ni = 0; ni < 4; ++ni) {
        const int c = col0 + wn * 64 + ni * 16 + fq * 4;
        float v[4];
#pragma unroll
        for (int j = 0; j < 4; ++j) {
          float z = acc[mi][ni][j];
          if (job < 4) z = sigmoidf_(z + bias[c + j]);
          if (job < 2) z *= 0.6065306597126334f;
          v[j] = z;
        }
        uint2 o;
        o.x = pk2(v[0], v[1]); o.y = pk2(v[2], v[3]);
        *(uint2*)(O + (size_t)row * 512 + c) = o;
      }
    }
  }
}

DEV void lora64_phase(const Params& p, int l, char* smem) {
  const bf16_t* LIN = (const bf16_t*)(p.ws + O_LIN);
  const int tid = ltid(), lane = tid & 63, w = tid >> 6, wm = w >> 1, wn = w & 1, fr = lane & 15, fq = lane >> 4;
  const int lrow = tid >> 3, lch = tid & 7;
  u32x4 ra[4], rb[2];
  auto issue = [&](int L) {
    const int job = L / 544, t = L - job * 544, pm = t >> 2, pn = t & 3;
    const bf16_t* A = LIN + job * 64 + (size_t)(pm * 256 + lrow) * 256 + lch * 8;
    const bf16_t* Bt = (const bf16_t*)(p.ws + O_WB + ((job & 2) ? W_LA2 : W_LW2)) + (job & 1) * 512 * 64 + (size_t)(pn * 128 + lrow) * 64 + lch * 8;
#pragma unroll
    for (int i = 0; i < 4; ++i) ra[i] = *(const u32x4*)(A + (size_t)(64 * i) * 256);
#pragma unroll
    for (int i = 0; i < 2; ++i) rb[i] = *(const u32x4*)(Bt + (size_t)(64 * i) * 64);
  };
  char* swa = smem + lrow * SROW + lch * 16;
  char* swb = swa + A_ST;
  const char* sra = smem + (wm * 64 + fr) * SROW + fq * 16;
  const char* srb = smem + A_ST + (wn * 64 + fr) * SROW + fq * 16;
  int L = vblock();
  if (L < 4 * 544) issue(L);
  for (; L < 4 * 544; L += gridDim.x) {
    const int job = L / 544, t = L - job * 544, pm = t >> 2, pn = t & 3;
    const int row0 = pm * 256, col0 = pn * 128;
    __syncthreads();
#pragma unroll
    for (int i = 0; i < 4; ++i) *(u32x4*)(swa + i * 64 * SROW) = ra[i];
#pragma unroll
    for (int i = 0; i < 2; ++i) *(u32x4*)(swb + i * 64 * SROW) = rb[i];
    __syncthreads();
    if (L + (int)gridDim.x < 4 * 544) issue(L + gridDim.x);
    f32x4 acc[4][4];
    zero_acc(acc);
#pragma unroll
    for (int ks = 0; ks < 2; ++ks) {
      bf16x8 af[4], bfr[4];
#pragma unroll
      for (int mi = 0; mi < 4; ++mi) af[mi] = *(const bf16x8*)(sra + mi * 16 * SROW + ks * 64);
#pragma unroll
      for (int ni = 0; ni < 4; ++ni) bfr[ni] = *(const bf16x8*)(srb + ni * 16 * SROW + ks * 64);
#pragma unroll
      for (int mi = 0; mi < 4; ++mi)
#pragma unroll
        for (int ni = 0; ni < 4; ++ni) acc[mi][ni] = __builtin_amdgcn_mfma_f32_16x16x32_bf16(bfr[ni], af[mi], acc[mi][ni], 0, 0, 0);
    }
    bf16_t* O = (bf16_t*)(p.ws + (job == 0 ? O_EF : (job == 1 ? O_EB : (job == 2 ? O_AF : O_AB))));
    const float* bias = ((job & 2) ? p.rwkv_a0 : p.rwkv_w0) + (l * 2 + (job & 1)) * 512;
    const float sc = job < 2 ? 0.6065306597126334f : 1.f;
#pragma unroll
    for (int mi = 0; mi < 4; ++mi) {
      const int row = row0 + wm * 64 + mi * 16 + fr;
#pragma unroll
      for (int ni = 0; ni < 4; ++ni) {
        const int c = col0 + wn * 64 + ni * 16 + fq * 4;
        const f32x4 z = acc[mi][ni] + *(const f32x4*)(bias + c);
        uint2 o;
        o.x = pk2(sc * sigmoidf_(z[0]), sc * sigmoidf_(z[1])); o.y = pk2(sc * sigmoidf_(z[2]), sc * sigmoidf_(z[3]));
        *(uint2*)(O + (size_t)row * 512 + c) = o;
      }
    }
  }
  __syncthreads();
}

DEV int scan_row(int step, int dir, int b) {
  if (step < CTXL) { const int t = dir ? (CTXL - 1 - step) : step; return T_LAT + b * CTXL + t; }
  const int s2 = step - CTXL;
  const int t = dir ? (SEQ - 1 - s2) : s2;
  return b * SEQ + t;
}
DEV float red8(float v) {
  v += dppf<0xB1>(v);
  v += dppf<0x4E>(v);
  v += dppf<0x141>(v);
  return v;
}
struct ScanOps { f32x4 nkk0, nkk1, w0, w1, kka0, kka1, kd0, kd1, r0, r1; float v; };
DEV void scan_tile(const Params& p, int l, int tile, char* smem) {
  const int half = tile & 1, dir = (tile >> 1) & 1, h = (tile >> 2) & 7, b = tile >> 5;
  float* arr = (float*)smem;
  float* ybuf = arr + 2 * 32 * 384;
  const bf16_t* ZRS = (const bf16_t*)(p.ws + O_ZRS);
  const bf16_t* E = (const bf16_t*)(p.ws + (dir ? O_EB : O_EF));
  const bf16_t* Aa = (const bf16_t*)(p.ws + (dir ? O_AB : O_AF));
  bf16_t* YS = (bf16_t*)(p.ws + (dir ? O_YSB : O_YSF));
  const int tid = ltid(), lane = tid & 63;
  const int w = __builtin_amdgcn_readfirstlane(tid >> 6);
  const int col = h * 64 + lane;
  const float kkp = p.rwkv_kk[l * 512 + col], kap = p.rwkv_ka[l * 512 + col];
  auto produce = [&](int ch, int buf, int pw, int npw) {
#pragma unroll
    for (int i0 = 0; i0 < 32; i0 += 4 * npw) {
      bf16_t rr[4], rk[4], rv[4], re[4], ra[4];
#pragma unroll
      for (int i = 0; i < 4; ++i) {
        const int R = scan_row(ch * 32 + i0 + pw + npw * i, dir, b);
        rr[i] = ZRS[(size_t)R * 1536 + col];
        rk[i] = ZRS[(size_t)R * 1536 + 512 + col];
        rv[i] = ZRS[(size_t)R * 1536 + 1024 + col];
        re[i] = E[(size_t)R * 512 + col];
        ra[i] = Aa[(size_t)R * 512 + col];
      }
#pragma unroll
      for (int i = 0; i < 4; ++i) {
        const int sl = i0 + pw + npw * i;
        const float r = bf2f(rr[i]), k = bf2f(rk[i]), v = bf2f(rv[i]), e = bf2f(re[i]), a = bf2f(ra[i]);
        const float kkv = k * kkp;
        const float inv = __builtin_amdgcn_rsqf(fmaxf(wsum(kkv * kkv), 1e-24f));
        const float kk = kkv * inv;
        float* d = arr + (buf * 32 + sl) * 384 + lane;
        d[0] = -kk;
        d[64] = __expf(-e);
        d[128] = kk * a;
        d[192] = k * (1.f + (a - 1.f) * kap);
        d[256] = r;
        d[320] = v;
      }
    }
  };
  auto flush = [&](int ch, int buf, int t256) {
#pragma unroll
    for (int q = 0; q < 2; ++q) {
      const int idx = t256 + 256 * q, sl = idx >> 4, rp = (idx & 15) * 2;
      const int R = scan_row(ch * 32 + sl, dir, b);
      const float* yb = ybuf + buf * 1024 + sl * 32 + rp;
      *(unsigned*)(YS + (size_t)R * 512 + h * 64 + half * 32 + rp) = pk2(yb[0], yb[1]);
    }
  };
  __syncthreads();
  produce(0, 0, w, 8);
  __syncthreads();
  f32x4 S0 = {0.f, 0.f, 0.f, 0.f}, S1 = {0.f, 0.f, 0.f, 0.f};
  const int r8 = lane >> 3, cg = lane & 7;
  for (int ch = 0; ch < 136; ++ch) {
    const int buf = ch & 1;
    if (w < 4) {
      const float* cb = arr + buf * 32 * 384;
      const int vo = 320 + half * 32 + w * 8 + r8;
      float* yw = ybuf + buf * 1024 + cg * 32 + w * 8 + r8;
      auto ldops = [&](ScanOps& o, int sl) {
        const f32x4* b4 = (const f32x4*)(cb + sl * 384);
        o.nkk0 = b4[cg * 2]; o.nkk1 = b4[cg * 2 + 1];
        o.w0 = b4[16 + cg * 2]; o.w1 = b4[16 + cg * 2 + 1];
        o.kka0 = b4[32 + cg * 2]; o.kka1 = b4[32 + cg * 2 + 1];
        o.kd0 = b4[48 + cg * 2]; o.kd1 = b4[48 + cg * 2 + 1];
        o.r0 = b4[64 + cg * 2]; o.r1 = b4[64 + cg * 2 + 1];
        o.v = cb[sl * 384 + vo];
      };
      float ykeep = 0.f;
      auto step = [&](const ScanOps& o, int sl) {
        const f32x4 sA = S0 * o.nkk0 + S1 * o.nkk1;
        const float sa = red8((sA[0] + sA[1]) + (sA[2] + sA[3]));
        S0 = S0 * o.w0 + (o.kka0 * sa + o.kd0 * o.v);
        S1 = S1 * o.w1 + (o.kka1 * sa + o.kd1 * o.v);
        const f32x4 yA = S0 * o.r0 + S1 * o.r1;
        const float y = red8((yA[0] + yA[1]) + (yA[2] + yA[3]));
        ykeep = (cg == (sl & 7)) ? y : ykeep;
      };
      ScanOps oa, ob;
      ldops(oa, 0);
#pragma unroll
      for (int s8 = 0; s8 < 32; s8 += 8) {
#pragma unroll
        for (int q = 0; q < 8; q += 2) {
          ldops(ob, s8 + q + 1);
          step(oa, s8 + q);
          ldops(oa, (s8 + q + 2) & 31);
          step(ob, s8 + q + 1);
        }
        yw[s8 * 32] = ykeep;
      }
    } else {
      const int pw = w - 4;
      if (ch > 0) flush(ch - 1, buf ^ 1, tid - 256);
      if (ch + 1 < 136) produce(ch + 1, buf ^ 1, pw, 4);
    }
    __syncthreads();
  }
  if (w >= 4) flush(135, 1, tid - 256);
  __syncthreads();
}
DEV void scan_phase(const Params& p, int l, char* smem) {
  for (int L = blockIdx.x; L < 256; L += gridDim.x) scan_tile(p, l, L, smem);
}

DEV void unpack8(const u32x4 u, float (&f)[8]) {
#pragma unroll
  for (int q = 0; q < 4; ++q) { f[2 * q] = lo_bf(u[q]); f[2 * q + 1] = hi_bf(u[q]); }
}
DEV void post_phase(const Params& p, int l, int nrows) {
  const bf16_t* ZRS = (const bf16_t*)(p.ws + O_ZRS);
  const bf16_t* AF = (const bf16_t*)(p.ws + O_AF);
  const bf16_t* AB = (const bf16_t*)(p.ws + O_AB);
  const bf16_t* G = (const bf16_t*)(p.ws + O_G);
  bf16_t* YSF = (bf16_t*)(p.ws + O_YSF);
  const bf16_t* YSB = (const bf16_t*)(p.ws + O_YSB);
  const int lane = ltid() & 63, w = ltid() >> 6, c0 = lane * 8;
  float gng[8], gnb[8], kaw[8], rkw[8];
#pragma unroll
  for (int j = 0; j < 8; ++j) {
    gng[j] = p.rwkv_gn_g[l * 512 + c0 + j]; gnb[j] = p.rwkv_gn_b[l * 512 + c0 + j];
    kaw[j] = p.rwkv_ka[l * 512 + c0 + j]; rkw[j] = p.rwkv_rk[l * 512 + c0 + j];
  }
  const int stride = gridDim.x * 8;
  int row = blockIdx.x * 8 + w;
  u32x4 q_ysf, q_ysb, q_r, q_k, q_v, q_af, q_ab, q_g;
  auto gl = [&](int rw) {
    q_ysf = *(const u32x4*)(YSF + (size_t)rw * 512 + c0); q_ysb = *(const u32x4*)(YSB + (size_t)rw * 512 + c0);
    q_r = *(const u32x4*)(ZRS + (size_t)rw * 1536 + c0); q_k = *(const u32x4*)(ZRS + (size_t)rw * 1536 + 512 + c0);
    q_v = *(const u32x4*)(ZRS + (size_t)rw * 1536 + 1024 + c0);
    q_af = *(const u32x4*)(AF + (size_t)rw * 512 + c0); q_ab = *(const u32x4*)(AB + (size_t)rw * 512 + c0);
    q_g = *(const u32x4*)(G + (size_t)rw * 512 + c0);
  };
  if (row < nrows) gl(row);
  for (; row < nrows; row += stride) {
    float ysf[8], ysb[8], r[8], k[8], v[8], af[8], ab[8], g[8];
    unpack8(q_ysf, ysf); unpack8(q_ysb, ysb); unpack8(q_r, r); unpack8(q_k, k); unpack8(q_v, v);
    unpack8(q_af, af); unpack8(q_ab, ab); unpack8(q_g, g);
    if (row + stride < nrows) gl(row + stride);
    float ys[8], s1 = 0.f, bp = 0.f;
#pragma unroll
    for (int j = 0; j < 8; ++j) {
      ys[j] = ysf[j] + ysb[j]; s1 += ys[j];
      bp += r[j] * k[j] * rkw[j] * (2.f + (af[j] + ab[j] - 2.f) * kaw[j]);
    }
    const float mu = red8(s1) * (1.f / 64.f);
    const float bon = red8(bp);
    float s2 = 0.f;
#pragma unroll
    for (int j = 0; j < 8; ++j) { ys[j] -= mu; s2 += ys[j] * ys[j]; }
    const float rs = __builtin_amdgcn_rsqf(red8(s2) * (1.f / 64.f) + 64e-5f);
    float o[8];
#pragma unroll
    for (int j = 0; j < 8; ++j) o[j] = (ys[j] * rs * gng[j] + gnb[j] + bon * v[j]) * g[j];
    u32x4 ov;
    ov[0] = pk2(o[0], o[1]); ov[1] = pk2(o[2], o[3]); ov[2] = pk2(o[4], o[5]); ov[3] = pk2(o[6], o[7]);
    *(u32x4*)(YSF + (size_t)row * 512 + c0) = ov;
  }
}

struct EpiGate {
  static constexpr bool PERM = true, AFTER_DRAIN = false;
  char* ws;
  DEV void operator()(const f32x4 (&acc)[2][2][4][2], const pg8::Unit& u, int wr, int wc, int fr, int fq) const {
    const int b = u.pn >> 2, pn = u.pn & 3;
    bf16_t* G = (bf16_t*)(ws + (b == 0 ? O_G1 : (b == 1 ? O_G2 : O_G3)));
    const int row0 = u.pm * 256 + wr * 64 + fr, col0 = pn * 256 + wc * 32 + 8 * fq;
#pragma unroll
    for (int ai = 0; ai < 2; ++ai)
#pragma unroll
      for (int m = 0; m < 4; ++m) {
        const int row = row0 + ai * 128 + m * 16;
#pragma unroll
        for (int bj = 0; bj < 2; ++bj) {
          const f32x4 a0 = acc[ai][bj][m][0], a1 = acc[ai][bj][m][1];
          u32x4 o;
          o[0] = pk2(sigmoidf_(a0[0]), sigmoidf_(a0[1])); o[1] = pk2(sigmoidf_(a0[2]), sigmoidf_(a0[3]));
          o[2] = pk2(sigmoidf_(a1[0]), sigmoidf_(a1[1])); o[3] = pk2(sigmoidf_(a1[2]), sigmoidf_(a1[3]));
          *(u32x4*)(G + (size_t)row * DM + col0 + bj * 128) = o;
        }
      }
  }
};
DEV void gate_phase(const Params& p, int nrows, char* smem) {
  EpiGate E;
  E.ws = p.ws;
  pg8::Gemm g;
  g.A = (const bf16_t*)(p.ws + O_HM); g.Bt = (const bf16_t*)(p.ws + O_WB + W_WIN) + (size_t)NZP * 1024; g.M = nrows; g.N = 3072; g.K = 1024;
  pg8::StaticOrder S;
  S.init(g.M, g.N, (int)gridDim.x, (int)blockIdx.x);
  __syncthreads();
  pg8::gemm_phase<EpiGate, pg8::StaticOrder>((PG8_LAS unsigned char*)smem, g, S, E);
  __syncthreads();
}
struct MergeOrder {
  pg8::StaticOrder base;
  DEV bool next(int i, pg8::Unit& u) const {
    const int j = i / 3, b = i - 3 * j;
    pg8::Unit t;
    if (!base.next(j, t)) return false;
    u.pm = t.pm + 136 * (b == 0 ? 11 : (b == 1 ? 12 : 6));
    u.pn = t.pn + 4 * b;
    return true;
  }
  DEV void a_ready(const pg8::Unit&) const {}
  DEV void done(const pg8::Unit&) const {}
};
struct EpiMerge {
  static constexpr bool PERM = true, AFTER_DRAIN = false;
  char* ws;
  DEV void operator()(const f32x4 (&acc)[2][2][4][2], const pg8::Unit& u, int wr, int wc, int fr, int fq) const {
    const int b = u.pn >> 2, pn = u.pn & 3, pm = u.pm - 136 * (b == 0 ? 11 : (b == 1 ? 12 : 6));
    const bf16_t* G = (const bf16_t*)(ws + (b == 0 ? O_G1 : (b == 1 ? O_G2 : O_G3)));
    bf16_t* M = (bf16_t*)(ws + O_M);
    const int row0 = pm * 256 + wr * 64 + fr, col0 = pn * 256 + wc * 32 + 8 * fq;
#pragma unroll
    for (int ai = 0; ai < 2; ++ai) {
      u32x4 gv[4][2], mv[4][2];
#pragma unroll
      for (int m = 0; m < 4; ++m)
#pragma unroll
        for (int bj = 0; bj < 2; ++bj) {
          const size_t off = (size_t)(row0 + ai * 128 + m * 16) * DM + col0 + bj * 128;
          gv[m][bj] = *(const u32x4*)(G + off);
          mv[m][bj] = (u32x4){0u, 0u, 0u, 0u};
          if (b > 0) mv[m][bj] = *(const u32x4*)(M + off);
        }
#pragma unroll
      for (int m = 0; m < 4; ++m)
#pragma unroll
        for (int bj = 0; bj < 2; ++bj) {
          const size_t off = (size_t)(row0 + ai * 128 + m * 16) * DM + col0 + bj * 128;
          const f32x4 a0 = acc[ai][bj][m][0], a1 = acc[ai][bj][m][1];
          const u32x4 g4 = gv[m][bj], m4 = mv[m][bj];
          u32x4 o;
          o[0] = pk2(lo_bf(m4[0]) + lo_bf(g4[0]) * a0[0], hi_bf(m4[0]) + hi_bf(g4[0]) * a0[1]);
          o[1] = pk2(lo_bf(m4[1]) + lo_bf(g4[1]) * a0[2], hi_bf(m4[1]) + hi_bf(g4[1]) * a0[3]);
          o[2] = pk2(lo_bf(m4[2]) + lo_bf(g4[2]) * a1[0], hi_bf(m4[2]) + hi_bf(g4[2]) * a1[1]);
          o[3] = pk2(lo_bf(m4[3]) + lo_bf(g4[3]) * a1[2], hi_bf(m4[3]) + hi_bf(g4[3]) * a1[3]);
          *(u32x4*)(M + off) = o;
        }
    }
  }
};
DEV void merge_phase(const Params& p, int nrows, char* smem) {
  EpiMerge E;
  E.ws = p.ws;
  pg8::Gemm g;
  g.A = (const bf16_t*)p.ws; g.Bt = (const bf16_t*)(p.ws + O_WB + W_PCV); g.M = nrows; g.N = 1024; g.K = 512;
  MergeOrder S;
  S.base.init(g.M, g.N, (int)gridDim.x, (int)blockIdx.x);
  __syncthreads();
  pg8::gemm_phase<EpiMerge, MergeOrder>((PG8_LAS unsigned char*)smem, g, S, E);
  __syncthreads();
}

struct EpiResid {
  static constexpr bool PERM = false, AFTER_DRAIN = false;
  float* out; float* xc; const float* rin_lat; const float* rin_ctx; const float* mod; bool store;
  DEV void operator()(const f32x4 (&acc)[2][2][4][2], const pg8::Unit& u, int wr, int wc, int fr, int fq) const {
    const int row0 = u.pm * 256 + wr * 64 + fr, col0 = u.pn * 256 + wc * 32 + 4 * fq;
    const float* gt = mod + (size_t)modrow(row0) * 6144;
    f32x4 g4[2][2];
#pragma unroll
    for (int bj = 0; bj < 2; ++bj)
#pragma unroll
      for (int n = 0; n < 2; ++n) g4[bj][n] = *(const f32x4*)(gt + col0 + bj * 128 + n * 16);
#pragma unroll
    for (int ai = 0; ai < 2; ++ai) {
      f32x4 xv[4][2][2];
#pragma unroll
      for (int m = 0; m < 4; ++m) {
        const int row = row0 + ai * 128 + m * 16;
        const float* xi = row < T_LAT ? rin_lat + (size_t)row * DM : rin_ctx + (size_t)(row - T_LAT) * DM;
#pragma unroll
        for (int bj = 0; bj < 2; ++bj)
#pragma unroll
          for (int n = 0; n < 2; ++n) xv[m][bj][n] = *(const f32x4*)(xi + col0 + bj * 128 + n * 16);
      }
#pragma unroll
      for (int m = 0; m < 4; ++m) {
        const int row = row0 + ai * 128 + m * 16;
        float* xr = row < T_LAT ? out + (size_t)row * DM : xc + (size_t)(row - T_LAT) * DM;
#pragma unroll
        for (int bj = 0; bj < 2; ++bj)
#pragma unroll
          for (int n = 0; n < 2; ++n) {
            const f32x4 r = xv[m][bj][n] + g4[bj][n] * acc[ai][bj][m][n];
            if (store) *(f32x4*)(xr + col0 + bj * 128 + n * 16) = r;
          }
      }
    }
  }
};
DEV void resid_gemm_phase(const Params& p, int l, const bf16_t* A, int K, const bf16_t* Wt, int goff, int nrows, char* smem, bool from_inputs = false) {
  EpiResid E;
  E.store = true;
  E.rin_lat = from_inputs ? p.x : p.out; E.rin_ctx = from_inputs ? p.ctx : (const float*)(p.ws + O_XC);
  E.out = p.out; E.xc = (float*)(p.ws + O_XC); E.mod = (const float*)(p.ws + O_MOD) + (size_t)l * 9 * 6144 + goff;
  pg8::Gemm g;
  g.A = A; g.Bt = Wt; g.M = nrows; g.N = 1024; g.K = K;
  pg8::StaticOrder S;
  S.init(g.M, g.N, (int)gridDim.x, (int)blockIdx.x);
  __syncthreads();
  pg8::gemm_phase<EpiResid, pg8::StaticOrder>((PG8_LAS unsigned char*)smem, g, S, E);
  __syncthreads();
}

struct EpiMlp1 {
  static constexpr bool PERM = true, AFTER_DRAIN = false;
  bf16_t* HID;
  DEV void operator()(const f32x4 (&acc)[2][2][4][2], const pg8::Unit& u, int wr, int wc, int fr, int fq) const {
    const int row0 = u.pm * 256 + wr * 64 + fr, col0 = u.pn * 256 + wc * 32 + 8 * fq;
#pragma unroll
    for (int ai = 0; ai < 2; ++ai)
#pragma unroll
      for (int m = 0; m < 4; ++m) {
        const int row = row0 + ai * 128 + m * 16;
#pragma unroll
        for (int bj = 0; bj < 2; ++bj) {
          float v[8];
#pragma unroll
          for (int j = 0; j < 4; ++j) {
            const float r0 = fmaxf(acc[ai][bj][m][0][j], 0.f), r1 = fmaxf(acc[ai][bj][m][1][j], 0.f);
            v[j] = r0 * r0; v[4 + j] = r1 * r1;
          }
          u32x4 o;
          o[0] = pk2(v[0], v[1]); o[1] = pk2(v[2], v[3]); o[2] = pk2(v[4], v[5]); o[3] = pk2(v[6], v[7]);
          *(u32x4*)(HID + (size_t)row * 4096 + col0 + bj * 128) = o;
        }
      }
  }
};
DEV void mlp1_phase(const Params& p, int nrows, char* smem) {
  EpiMlp1 E;
  E.HID = (bf16_t*)(p.ws + O_HID);
  pg8::Gemm g;
  g.A = (const bf16_t*)(p.ws + O_HM); g.Bt = (const bf16_t*)(p.ws + O_WB + W_W1); g.M = nrows; g.N = 4096; g.K = 1024;
  pg8::StaticOrder S;
  S.init(g.M, g.N, (int)gridDim.x, (int)blockIdx.x);
  __syncthreads();
  pg8::gemm_phase<EpiMlp1, pg8::StaticOrder>((PG8_LAS unsigned char*)smem, g, S, E);
  __syncthreads();
}

DEV void final_phase(const Params& p) {
  const int lane = ltid() & 63, w = ltid() >> 6;
  const int stride = gridDim.x * 8;
  f32x4 g[4];
#pragma unroll
  for (int i = 0; i < 4; ++i) g[i] = *(const f32x4*)(p.final_g + i * 256 + lane * 4);
  int row = blockIdx.x * 8 + w;
  f32x4 nv[4];
  if (row < T_LAT) {
#pragma unroll
    for (int i = 0; i < 4; ++i) nv[i] = *(const f32x4*)(p.out + (size_t)row * DM + i * 256 + lane * 4);
  }
  for (; row < T_LAT; row += stride) {
    float* xr = p.out + (size_t)row * DM;
    f32x4 v[4];
#pragma unroll
    for (int i = 0; i < 4; ++i) v[i] = nv[i];
    if (row + stride < T_LAT) {
#pragma unroll
      for (int i = 0; i < 4; ++i) nv[i] = *(const f32x4*)(p.out + (size_t)(row + stride) * DM + i * 256 + lane * 4);
    }
    float ss = 0.f;
#pragma unroll
    for (int i = 0; i < 4; ++i) ss += v[i][0] * v[i][0] + v[i][1] * v[i][1] + v[i][2] * v[i][2] + v[i][3] * v[i][3];
    const float rs = __builtin_amdgcn_rsqf(wsum(ss) * (1.f / 1024.f) + 1e-6f);
#pragma unroll
    for (int i = 0; i < 4; ++i) *(f32x4*)(xr + i * 256 + lane * 4) = v[i] * rs * g[i];
  }
}

constexpr int N_PHASES = 26;
__global__ void __launch_bounds__(512) fwd_megakernel(Params p, int ph_lo, int ph_hi) {
  extern __shared__ __attribute__((aligned(16))) char smem[];
  cg::grid_group grid = cg::this_grid();
  volatile XLAS unsigned* st = (volatile XLAS unsigned*)(smem + 139264);
  if (threadIdx.x == 0) { st[0] = 0u; st[1] = 0u; st[2] = 0u; st[3] = 0u; }
  __syncthreads();
  const XcdBarrier xb = xcd_barrier_post((unsigned*)(p.ws + O_BAR), st);
  if (ph_hi > 1000) grid.sync();
  for (int ph = ph_lo; ph < ph_hi; ++ph) {
    if (ph == 0) {
      cvt_phase(p, 0, smem);
      mod_phase(p, smem);
    } else if (ph == N_PHASES - 1) {
      final_phase(p);
    } else {
      const int l = (ph - 1) / 12, sp = (ph - 1) % 12;
      const int nrows = (l == 1) ? T_LAT : T_ALL;
      switch (sp) {
        case 0:
          if (l > 0) cvt_phase(p, l, smem);
          norm_phase(p, l, 0, (bf16_t*)(p.ws + O_H0), l == 0);
          break;
        case 1: gemm_in_phase(p, smem); break;
        case 2: branch_phase(p, l, smem); break;
        case 3:
          lora64_phase(p, l, smem);
          lora_phase(p, l, smem, true);
          break;
        case 4: scan_phase(p, l, smem); break;
        case 5:
          post_phase(p, l, nrows);
          norm_phase(p, l, 0, (bf16_t*)(p.ws + O_HM), l == 0, nrows);
          break;
        case 6: gate_phase(p, nrows, smem); break;
        case 7: merge_phase(p, nrows, smem); break;
        case 8: resid_gemm_phase(p, l, (const bf16_t*)(p.ws + O_M), 1024, (const bf16_t*)(p.ws + O_WB + W_WOUT), 2048, nrows, smem, l == 0); break;
        case 9: norm_phase(p, l, 1, (bf16_t*)(p.ws + O_HM), false, nrows); break;
        case 10: mlp1_phase(p, nrows, smem); break;
        case 11: resid_gemm_phase(p, l, (const bf16_t*)(p.ws + O_HID), 4096, (const bf16_t*)(p.ws + O_WB + W_W2), 5120, nrows, smem); break;
      }
    }
    if (ph + 1 < ph_hi) xcd_barrier(xb);
  }
}

extern "C" void kernel_launch(void* const* d_in, const int* in_sizes, int n_in, void* d_out, int out_size, void* d_ws,
                              size_t ws_size, hipStream_t stream) {
  Params p{};
  const float** pp = (const float**)&p;
  for (int i = 0; i < 36; ++i) pp[i] = (const float*)d_in[i];
  p.out = (float*)d_out;
  p.ws = (char*)d_ws;
  static int grid_blocks = 0;
  if (!grid_blocks) {
    hipFuncSetAttribute((const void*)fwd_megakernel, hipFuncAttributeMaxDynamicSharedMemorySize, LDS_BYTES);
    int dev = 0, cus = 0, per_cu = 0;
    hipGetDevice(&dev);
    hipDeviceGetAttribute(&cus, hipDeviceAttributeMultiprocessorCount, dev);
    hipOccupancyMaxActiveBlocksPerMultiprocessor(&per_cu, fwd_megakernel, 512, LDS_BYTES);
    if (per_cu < 1) per_cu = 1;
    grid_blocks = cus * per_cu;
    grid_blocks &= ~7;
  }
  if (ws_size < WS_NEED) fprintf(stderr, "workspace too small: %zu < %zu\n", ws_size, (size_t)WS_NEED);
#ifndef MULTI_LAUNCH
#define MULTI_LAUNCH 0
#endif
#if MULTI_LAUNCH
  for (int ph = 0; ph < N_PHASES; ++ph)
    hipLaunchKernelGGL(fwd_megakernel, dim3(grid_blocks), dim3(512), LDS_BYTES, stream, p, ph, ph + 1);
#else
  hipMemsetAsync((char*)d_ws + O_BAR, 0, 16384, stream);
  int lo = 0, hi = N_PHASES;
  void* args[] = {&p, &lo, &hi};
  hipError_t e = hipLaunchCooperativeKernel((const void*)fwd_megakernel, dim3(grid_blocks), dim3(512), args, LDS_BYTES, stream);
  if (e != hipSuccess) fprintf(stderr, "cooperative launch failed: %s (grid %d)\n", hipGetErrorString(e), grid_blocks);
#endif
}
```

```cpp
#include <hip/hip_runtime.h>
#include <hip/hip_cooperative_groups.h>
#include <cstdio>
namespace cg = cooperative_groups;

typedef unsigned short bf16_t;
typedef short bf16x8 __attribute__((ext_vector_type(8)));
typedef float f32x4 __attribute__((ext_vector_type(4)));
typedef float f32x16 __attribute__((ext_vector_type(16)));
typedef unsigned u32x4 __attribute__((ext_vector_type(4)));
#define DEV __device__ __forceinline__
#define PROBE 0

constexpr int T_LAT = 32768, T_ALL = 34816, DM = 1024, DIN = 7552, NZ = 4480, NZP = 4608, DINT = 7680;
constexpr int SEQ = 4096, CTXL = 256, TK = 4352;
constexpr size_t U = 35651584ull;
constexpr size_t O_ZU = 0, O_ZK = U, O_VT = 2 * U, O_ZRW = 3 * U, O_ZRS = 7 * U, O_LIN = 10 * U, O_YCV = 11 * U, O_ZQ = 12 * U;
constexpr size_t O_H0 = 7 * U;
constexpr size_t O_EF = 0, O_EB = 3 * U, O_AF = 4 * U, O_AB = 5 * U, O_G = 2 * U, O_YSF = 6 * U, O_YSB = 10 * U;
constexpr size_t O_HM = 0, O_M = 0, O_HID = 3 * U;
constexpr size_t O_G1 = 3 * U, O_G2 = 7 * U, O_G3 = 9 * U;
constexpr size_t O_WB = 13 * U;
constexpr size_t W_WIN = 0, W_PCV = W_WIN + (size_t)DINT * 1024 * 2, W_PAT = W_PCV + 1048576, W_PRW = W_PAT + 1048576,
                 W_WOUT = W_PRW + 1048576, W_W1 = W_WOUT + 2097152, W_W2 = W_W1 + 8388608, W_LW2 = W_W2 + 8388608,
                 W_LA2 = W_LW2 + 131072, W_LG2 = W_LA2 + 131072, W_END = W_LG2 + 131072;
constexpr size_t O_XC = O_WB + W_END;
constexpr size_t O_MOD = O_XC + 8388608;
constexpr size_t O_BAR = O_MOD + 2 * 9 * 6144 * 4;
constexpr size_t O_GIN = O_BAR + 16384;
constexpr size_t WS_NEED = O_GIN + (size_t)T_ALL * 128 * 2;

constexpr int LDS_BYTES = 139264 + 16;

struct Params {
  const float *x, *c, *ctx, *c_ctx, *mod_w, *mod_b, *norm1_g, *norm2_g, *w_in, *conv_dw_w, *conv_dw_b, *conv_ln_g,
      *conv_ln_b, *p_conv, *att_lq1, *att_lk1, *att_lq2, *att_lk2, *att_subln_g, *p_att, *rwkv_shift, *rwkv_w0, *rwkv_w2,
      *rwkv_a0, *rwkv_a2, *rwkv_g2, *rwkv_kk, *rwkv_ka, *rwkv_rk, *rwkv_gn_g, *rwkv_gn_b, *p_rwkv, *w_out, *mlp_w1,
      *mlp_w2, *final_g;
  float* out;
  char* ws;
};

DEV int ltid() { int t = threadIdx.x; asm volatile("" : "+v"(t)); return t; }
DEV float bf2f(bf16_t h) { return __uint_as_float(((unsigned)h) << 16); }
typedef float f32x2_t __attribute__((ext_vector_type(2)));
typedef __bf16 bf16x2_t __attribute__((ext_vector_type(2)));
DEV unsigned pk2(float lo, float hi) {
  const f32x2_t v = {lo, hi};
  return __builtin_bit_cast(unsigned, __builtin_convertvector(v, bf16x2_t));
}
DEV bf16_t f2bf(float f) { return (bf16_t)(pk2(f, 0.f) & 0xffffu); }
DEV float lo_bf(unsigned u) { return __uint_as_float(u << 16); }
DEV float hi_bf(unsigned u) { return __uint_as_float(u & 0xffff0000u); }
template <int C> DEV float dppf(float v) {
  return __int_as_float(__builtin_amdgcn_update_dpp(0, __float_as_int(v), C, 0xF, 0xF, true));
}
DEV float xor32_sum(float v) {
  const auto r = __builtin_amdgcn_permlane32_swap(__float_as_uint(v), __float_as_uint(v), false, false);
  return __uint_as_float(r[0]) + __uint_as_float(r[1]);
}
DEV float xor32_max(float v) {
  const auto r = __builtin_amdgcn_permlane32_swap(__float_as_uint(v), __float_as_uint(v), false, false);
  return fmaxf(__uint_as_float(r[0]), __uint_as_float(r[1]));
}
DEV float xor16_sum(float v) {
  const auto r = __builtin_amdgcn_permlane16_swap(__float_as_uint(v), __float_as_uint(v), false, false);
  return __uint_as_float(r[0]) + __uint_as_float(r[1]);
}
DEV float wsum(float v) {
  v += dppf<0xB1>(v);
  v += dppf<0x4E>(v);
  v += dppf<0x141>(v);
  v += dppf<0x140>(v);
  v = xor16_sum(v);
  return xor32_sum(v);
}
DEV float sigmoidf_(float x) { return __builtin_amdgcn_rcpf(1.f + __expf(-x)); }
DEV float red16(float v) {
  v += dppf<0xB1>(v);
  v += dppf<0x4E>(v);
  v += dppf<0x141>(v);
  v += dppf<0x140>(v);
  return v;
}
DEV int vblock() { const int per = gridDim.x >> 3; return (blockIdx.x & 7) * per + (blockIdx.x >> 3); }
DEV float* xrow(const Params& p, int row) {
  return row < T_LAT ? p.out + (size_t)row * DM : (float*)(p.ws + O_XC) + (size_t)(row - T_LAT) * DM;
}
DEV int modrow(int row) { return row < T_LAT ? (row >> 12) : 8; }

#define XB_TMO      128
#define XB_XCNT(j)  (256  + 64 * (j))
#define XB_XSUB(j)  (1280 + 64 * (j))
#define XB_XGEN(j)  (2304 + 64 * (j))
#define XB_TOP      3328
#define XB_TOPGEN   3392
#define XCD_BAR_WORDS 3456
#define XB_SPIN_CAP (1u << 18)
#define XLAS __attribute__((address_space(3)))

__device__ __forceinline__ unsigned xb_ld(unsigned* p)              { return __hip_atomic_load(p, __ATOMIC_RELAXED, __HIP_MEMORY_SCOPE_AGENT); }
__device__ __forceinline__ unsigned xb_add(unsigned* p, unsigned v) { return __hip_atomic_fetch_add(p, v, __ATOMIC_RELAXED, __HIP_MEMORY_SCOPE_AGENT); }
__device__ __forceinline__ unsigned xb_xcc_id() { return (unsigned)__builtin_amdgcn_s_getreg((3 << 11) | 20) & 0xFu; }
#define XB_SPIN(cond, bar) do { unsigned _sp = 0; while (cond) { __builtin_amdgcn_s_sleep(1); \
    if ((++_sp & 255u) == 0u) { if (xb_ld(&(bar)[XB_TMO])) break; if (_sp > XB_SPIN_CAP) { atomicAdd(&(bar)[XB_TMO], 1u); break; } } } } while (0)

struct XcdBarrier {
    unsigned* bar; unsigned x;
    volatile XLAS unsigned* st;
};

__device__ __forceinline__ XcdBarrier xcd_barrier_post(unsigned* bar, volatile XLAS unsigned* st) {
    XcdBarrier b; b.bar = bar; b.x = xb_xcc_id(); b.st = st;
    if (threadIdx.x == 0) (void)xb_add(&bar[XB_XCNT(b.x)], 1u);
    return b;
}
__device__ __forceinline__ void xcd_barrier_complete(unsigned* bar, unsigned x, unsigned& nloc, unsigned& nx) {
    const unsigned G = gridDim.x * gridDim.y * gridDim.z;
    unsigned sum, cnt, mine, sp = 0u;
    for (;;) {
        sum = 0u; cnt = 0u; mine = 0u;
#pragma unroll
        for (unsigned j = 0; j < 16; ++j) { const unsigned c = xb_ld(&bar[XB_XCNT(j)]); sum += c; cnt += (c > 0u) ? 1u : 0u; mine = (j == x) ? c : mine; }
        if (sum == G) break;
        __builtin_amdgcn_s_sleep(1);
        if ((++sp & 255u) == 0u) { if (xb_ld(&bar[XB_TMO])) break; if (sp > XB_SPIN_CAP) { atomicAdd(&bar[XB_TMO], 1u); break; } }
    }
    nloc = mine > 0u ? mine : 1u; nx = cnt > 0u ? cnt : 1u;
}

__device__ __forceinline__ void xcd_barrier(const XcdBarrier& b) {
    asm volatile("s_waitcnt vmcnt(0)" ::: "memory");
    __syncthreads();
    if (threadIdx.x == 0) {
        unsigned* bar = b.bar;
        __builtin_amdgcn_s_waitcnt(0);
        unsigned nloc = b.st[0], nx = b.st[1];
        if (nloc == 0u) { xcd_barrier_complete(bar, b.x, nloc, nx); b.st[0] = nloc; b.st[1] = nx; }
        const unsigned old = xb_add(&bar[XB_XSUB(b.x)], 1u);
        const unsigned gen = old / nloc;
        if (old + 1u == (gen + 1u) * nloc) {
            __builtin_amdgcn_fence(__ATOMIC_RELEASE, "agent");
            asm volatile("s_waitcnt vmcnt(0)" ::: "memory");
            const unsigned og = xb_add(&bar[XB_TOP], 1u);
            const unsigned tg = og / nx;
            if (og + 1u == (tg + 1u) * nx) xb_add(&bar[XB_TOPGEN], 1u);
            else XB_SPIN(xb_ld(&bar[XB_TOPGEN]) == tg, bar);
            __builtin_amdgcn_fence(__ATOMIC_ACQUIRE, "agent");
            xb_add(&bar[XB_XGEN(b.x)], 1u);
            asm volatile("s_waitcnt vmcnt(0)" ::: "memory");
        } else {
            XB_SPIN(xb_ld(&bar[XB_XGEN(b.x)]) == gen, bar);
            __builtin_amdgcn_fence(__ATOMIC_ACQUIRE, "agent");
            asm volatile("s_waitcnt vmcnt(0)" ::: "memory");
        }
    }
    __syncthreads();
}

namespace pg8 {
#define PG8_LAS __attribute__((address_space(3)))
constexpr int BM = 256, BK = 64, HALF = 128, HTB = HALF * BK * 2, STAGE_BYTES = 8 * HTB, NXCD = 8, WGM = 4;
__host__ __device__ __forceinline__ int lds_byte(int r, int c) { const int st = (r >> 4) * 2 + (c >> 5), rr = r & 15, cc = c & 31, ob = rr * 64 + cc * 2; return st * 1024 + (ob ^ (((ob >> 9) & 1) << 5)); }
__host__ __device__ __forceinline__ void stage_rc(int b, int& R, int& C) { const int st = b / 1024, sb = b % 1024, swz = sb ^ (((sb >> 9) & 1) << 5); R = (st >> 1) * 16 + swz / 64; C = (st & 1) * 32 + (swz % 64) / 2; }
__host__ __device__ __forceinline__ int perm32(int rho) { const int n = rho >> 4, i = rho & 15; return 8 * (i >> 2) + 4 * n + (i & 3); }
struct Unit { int pm, pn; };
struct Gemm { const bf16_t* A; const bf16_t* Bt; int M, N, K; };
struct StaticOrder {
    int nM, nN, nwg, G, c;
    __host__ __device__ void init(int M, int N, int G_, int c_) { nM = M / BM; nN = N / BM; nwg = nM * nN; G = G_; c = c_; }
    __host__ __device__ bool next(int i, Unit& u) const {
        const long L = (long)i * G + c; if (L >= nwg) return false;
        int wgid = (int)L; { const int q = nwg / NXCD, r = nwg % NXCD, xcd = wgid % NXCD, off = wgid / NXCD; wgid = (xcd < r ? xcd * (q + 1) : r * (q + 1) + (xcd - r) * q) + off; }
        const int nig = WGM * nN, gid = wgid / nig, fm = gid * WGM, gsz = (nM - fm) < WGM ? (nM - fm) : WGM;
        u.pm = fm + ((wgid % nig) % gsz); u.pn = (wgid % nig) / gsz; return true;
    }
    __device__ __forceinline__ void a_ready(const Unit&) const {}
    __device__ __forceinline__ void done(const Unit&) const {}
};

template <class Epi, class Sched>
__device__ __forceinline__ void gemm_phase(PG8_LAS unsigned char* lds, const Gemm g, const Sched& S, const Epi& E) {
    const int tid = ltid(), wid = __builtin_amdgcn_readfirstlane(tid >> 6), lane = tid & 63, wr = wid >> 2, wc = wid & 3, fr = lane & 15, fq = lane >> 4;
    const int K = g.K, nt = K / BK;
    unsigned voffA[2], voffB[2];
#pragma unroll
    for (int i = 0; i < 2; ++i) { int R, C; stage_rc(tid * 16 + i * 8192, R, C); const int Rb = Epi::PERM ? ((R & ~31) + perm32(R & 31)) : R;
        voffA[i] = (unsigned)(R * K + C) * 2u; voffB[i] = (unsigned)(Rb * K + C) * 2u; }
    const size_t kstep = (size_t)(BK * 2);
    const size_t hstep = (size_t)HALF * K * 2;
    const size_t tstep = 2 * hstep;
    const unsigned ldsw = (unsigned)wid * 1024u;
    const int aoff = lds_byte(wr * 64 + fr, fq * 8), boff = lds_byte(wc * 32 + fr, fq * 8);
#define PG8_SA(b, h) (((b) * 2 + (h)) * HTB)
#define PG8_SB(b, h) ((4 + (b) * 2 + (h)) * HTB)
#define PG8_STAGE(bufoff, gbase, voff) do { _Pragma("unroll") for (int _i = 0; _i < 2; ++_i) \
        __builtin_amdgcn_global_load_lds((const unsigned*)((const char*)(gbase) + (voff)[_i]), (PG8_LAS unsigned*)(lds + (bufoff) + ldsw + _i * 8192), 16, 0, 0); } while (0)
#define PG8_LDA(dst, b, h) do { _Pragma("unroll") for (int m = 0; m < 4; ++m) _Pragma("unroll") for (int k = 0; k < 2; ++k) dst[m][k] = *(const PG8_LAS bf16x8*)(lds + PG8_SA(b, h) + aoff + m * 2048 + k * 1024); } while (0)
#define PG8_LDB(dst, b, h) do { _Pragma("unroll") for (int n = 0; n < 2; ++n) _Pragma("unroll") for (int k = 0; k < 2; ++k) dst[n][k] = *(const PG8_LAS bf16x8*)(lds + PG8_SB(b, h) + boff + n * 2048 + k * 1024); } while (0)
#define PG8_MMA(ai, bj, At, Bt) do { __builtin_amdgcn_s_setprio(1); _Pragma("unroll") for (int m = 0; m < 4; ++m) _Pragma("unroll") for (int n = 0; n < 2; ++n) _Pragma("unroll") for (int k = 0; k < 2; ++k) \
        acc[ai][bj][m][n] = __builtin_amdgcn_mfma_f32_16x16x32_bf16(Bt[n][k], At[m][k], acc[ai][bj][m][n], 0, 0, 0); __builtin_amdgcn_s_setprio(0); } while (0)
#define PG8_WAIT_V(n) asm volatile("s_waitcnt vmcnt(" #n ")" ::: "memory")
#define PG8_WAIT_L(n) asm volatile("s_waitcnt lgkmcnt(" #n ")" ::: "memory")
#define PG8_BAR __builtin_amdgcn_s_barrier()
#define PG8_SCHED __builtin_amdgcn_sched_barrier(0)
    Unit cur, nxt; int ui = 0;
    if (!S.next(0, cur)) return;
    f32x4 acc[2][2][4][2];
#pragma unroll
    for (int a = 0; a < 2; ++a)
#pragma unroll
        for (int b = 0; b < 2; ++b)
#pragma unroll
            for (int m = 0; m < 4; ++m)
#pragma unroll
                for (int n = 0; n < 2; ++n) acc[a][b][m][n] = (f32x4){0.f, 0.f, 0.f, 0.f};
    bf16x8 At[4][2], B0[2][2], B1[2][2];
    const char* cA = (const char*)g.A + (size_t)cur.pm * tstep; const char* cB = (const char*)g.Bt + (size_t)cur.pn * tstep;
    S.a_ready(cur);
    PG8_STAGE(PG8_SB(0, 0), cB, voffB); PG8_STAGE(PG8_SA(0, 0), cA, voffA); PG8_STAGE(PG8_SB(0, 1), cB + hstep, voffB); PG8_STAGE(PG8_SA(0, 1), cA + hstep, voffA);
    if (wr == 1) PG8_BAR;
    PG8_WAIT_V(4); PG8_BAR;
    PG8_STAGE(PG8_SB(1, 0), cB + kstep, voffB); PG8_STAGE(PG8_SA(1, 0), cA + kstep, voffA); PG8_STAGE(PG8_SB(1, 1), cB + hstep + kstep, voffB);
    PG8_WAIT_V(6); PG8_BAR;
    for (;;) {
        const bool has_next = S.next(ui + 1, nxt);
        const char* nA = has_next ? (const char*)g.A + (size_t)nxt.pm * tstep : cA; const char* nB = has_next ? (const char*)g.Bt + (size_t)nxt.pn * tstep : cB;
        for (int t = 0; t < nt; t += 2) {
            const bool last = (t == nt - 2);
            const char* a1 = cA + (size_t)(t + 1) * kstep;
            const char* a2 = last ? nA : cA + (size_t)(t + 2) * kstep; const char* b2 = last ? nB : cB + (size_t)(t + 2) * kstep;
            const char* a3 = a2 + kstep; const char* b3 = b2 + kstep;
            if (last && has_next) S.a_ready(nxt);
            PG8_LDB(B0, 0, 0); PG8_SCHED; PG8_LDA(At, 0, 0); PG8_STAGE(PG8_SA(1, 1), a1 + hstep, voffA);
            PG8_WAIT_L(8); PG8_BAR; PG8_WAIT_L(0); PG8_MMA(0, 0, At, B0); PG8_BAR; PG8_SCHED;
            PG8_LDB(B1, 0, 1); PG8_STAGE(PG8_SB(0, 0), b2, voffB);
            PG8_BAR; PG8_WAIT_L(0); PG8_MMA(0, 1, At, B1); PG8_BAR;
            PG8_LDA(At, 0, 1); PG8_STAGE(PG8_SA(0, 0), a2, voffA);
            PG8_BAR; PG8_WAIT_L(0); PG8_MMA(1, 0, At, B0); PG8_BAR; PG8_SCHED;
            PG8_STAGE(PG8_SB(0, 1), b2 + hstep, voffB);
            PG8_WAIT_V(6); PG8_BAR; PG8_MMA(1, 1, At, B1); PG8_BAR;
            PG8_LDB(B0, 1, 0); PG8_SCHED; PG8_LDA(At, 1, 0); PG8_STAGE(PG8_SA(0, 1), a2 + hstep, voffA);
            PG8_WAIT_L(8); PG8_BAR; PG8_WAIT_L(0); PG8_MMA(0, 0, At, B0); PG8_BAR; PG8_SCHED;
            PG8_LDB(B1, 1, 1); PG8_STAGE(PG8_SB(1, 0), b3, voffB);
            PG8_BAR; PG8_WAIT_L(0); PG8_MMA(0, 1, At, B1); PG8_BAR;
            PG8_LDA(At, 1, 1); PG8_STAGE(PG8_SA(1, 0), a3, voffA);
            PG8_BAR; PG8_WAIT_L(0); PG8_MMA(1, 0, At, B0); PG8_BAR; PG8_SCHED;
            PG8_STAGE(PG8_SB(1, 1), b3 + hstep, voffB);
            PG8_WAIT_V(6); PG8_BAR; PG8_MMA(1, 1, At, B1); PG8_BAR;
        }
        if constexpr (!Epi::AFTER_DRAIN) { E(acc, cur, wr, wc, fr, fq); S.done(cur); }
        if (!has_next) break;
#pragma unroll
        for (int a = 0; a < 2; ++a)
#pragma unroll
            for (int b = 0; b < 2; ++b)
#pragma unroll
                for (int m = 0; m < 4; ++m)
#pragma unroll
                    for (int n = 0; n < 2; ++n) acc[a][b][m][n] = (f32x4){0.f, 0.f, 0.f, 0.f};
        cur = nxt; cA = nA; cB = nB; ++ui;
    }
    PG8_WAIT_V(0);
    if (wr == 0) PG8_BAR;
    PG8_BAR;
    if constexpr (Epi::AFTER_DRAIN) { E.fused(acc, cur, wr, wc, fr, fq, lds, wid, lane); S.done(cur); }
#undef PG8_SA
#undef PG8_SB
#undef PG8_STAGE
#undef PG8_LDA
#undef PG8_LDB
#undef PG8_MMA
#undef PG8_WAIT_V
#undef PG8_WAIT_L
#undef PG8_BAR
#undef PG8_SCHED
}

}

constexpr int SROW = 144;
constexpr int A_ST = 256 * SROW, B_ST = 128 * SROW, ST_BYTES = A_ST + B_ST;

DEV void gemm_kloop(f32x4 (&acc)[4][4], const bf16_t* __restrict__ A, int lda, const bf16_t* __restrict__ Bt, int ldb,
                    int K, char* smem) {
  const int tid = ltid(), lane = tid & 63, w = tid >> 6, wm = w >> 1, wn = w & 1;
  const int fr = lane & 15, fq = lane >> 4;
  const int lrow = tid >> 3, lch = tid & 7;
  const bf16_t* ga = A + (size_t)lrow * lda + lch * 8;
  const bf16_t* gb = Bt + (size_t)lrow * ldb + lch * 8;
  u32x4 ra[4], rb[2];
#pragma unroll
  for (int i = 0; i < 4; ++i) ra[i] = *(const u32x4*)(ga + (size_t)(64 * i) * lda);
#pragma unroll
  for (int i = 0; i < 2; ++i) rb[i] = *(const u32x4*)(gb + (size_t)(64 * i) * ldb);
  char* swa = smem + lrow * SROW + lch * 16;
  char* swb = swa + A_ST;
  __syncthreads();
#pragma unroll
  for (int i = 0; i < 4; ++i) *(u32x4*)(swa + i * 64 * SROW) = ra[i];
#pragma unroll
  for (int i = 0; i < 2; ++i) *(u32x4*)(swb + i * 64 * SROW) = rb[i];
  __syncthreads();
  const int nk = K >> 6;
  const char* sra = smem + (wm * 64 + fr) * SROW + fq * 16;
  const char* srb = smem + A_ST + (wn * 64 + fr) * SROW + fq * 16;
  for (int kt = 0; kt < nk; ++kt) {
    const int cur = kt & 1;
    if (kt + 1 < nk) {
#pragma unroll
      for (int i = 0; i < 4; ++i) ra[i] = *(const u32x4*)(ga + (size_t)(64 * i) * lda + (kt + 1) * 64);
#pragma unroll
      for (int i = 0; i < 2; ++i) rb[i] = *(const u32x4*)(gb + (size_t)(64 * i) * ldb + (kt + 1) * 64);
    }
#pragma unroll
    for (int ks = 0; ks < 2; ++ks) {
      bf16x8 af[4], bfr[4];
#pragma unroll
      for (int mi = 0; mi < 4; ++mi) af[mi] = *(const bf16x8*)(sra + cur * ST_BYTES + mi * 16 * SROW + ks * 64);
#pragma unroll
      for (int ni = 0; ni < 4; ++ni) bfr[ni] = *(const bf16x8*)(srb + cur * ST_BYTES + ni * 16 * SROW + ks * 64);
#pragma unroll
      for (int mi = 0; mi < 4; ++mi)
#pragma unroll
        for (int ni = 0; ni < 4; ++ni)
          acc[mi][ni] = __builtin_amdgcn_mfma_f32_16x16x32_bf16(bfr[ni], af[mi], acc[mi][ni], 0, 0, 0);
    }
    if (kt + 1 < nk) {
      const int nx = cur ^ 1;
#pragma unroll
      for (int i = 0; i < 4; ++i) *(u32x4*)(swa + nx * ST_BYTES + i * 64 * SROW) = ra[i];
#pragma unroll
      for (int i = 0; i < 2; ++i) *(u32x4*)(swb + nx * ST_BYTES + i * 64 * SROW) = rb[i];
    }
    __syncthreads();
  }
}
DEV void zero_acc(f32x4 (&acc)[4][4]) {
#pragma unroll
  for (int a = 0; a < 4; ++a)
#pragma unroll
    for (int b = 0; b < 4; ++b) acc[a][b] = (f32x4){0.f, 0.f, 0.f, 0.f};
}
DEV void tile_pm_pn(int L, int nN, int& pm, int& pn) {
  const int g = L / (4 * nN), wi = L % (4 * nN);
  pm = g * 4 + (wi & 3);
  pn = wi >> 2;
}

DEV int conv_srccol(int n) {
  const int tile = n >> 8, w = n & 255;
  return w < 128 ? tile * 128 + w : 512 + tile * 128 + (w - 128);
}
DEV void cvt_job(const float* __restrict__ src, int K, int N, int ldsrc, bf16_t* __restrict__ dst, int nperm, int& tbase, char* smem) {
  float* lds = (float*)smem;
  const int nkt = K >> 6, nnt = N >> 6, cnt = nkt * nnt;
  const int G = gridDim.x;
  const int first = (int)((blockIdx.x + G - (tbase % G)) % G);
  const int tid = ltid();
  for (int t = first; t < cnt; t += G) {
    const int kt = t % nkt, nt = t / nkt;
    const int ty = tid >> 4, tx = tid & 15;
    const int n = nt * 64 + tx * 4;
    const int sc = (n < nperm) ? conv_srccol(n) : n;
#pragma unroll
    for (int i = 0; i < 2; ++i) {
      const int k = ty + 32 * i;
      const float4 v = *(const float4*)(src + (size_t)(kt * 64 + k) * ldsrc + sc);
      float* d = lds + k * 65 + tx * 4;
      d[0] = v.x; d[1] = v.y; d[2] = v.z; d[3] = v.w;
    }
    __syncthreads();
    {
      const int nn = tid >> 3, kc = tid & 7;
      float v[8];
#pragma unroll
      for (int j = 0; j < 8; ++j) v[j] = lds[(kc * 8 + j) * 65 + nn];
      uint4 o;
      o.x = pk2(v[0], v[1]); o.y = pk2(v[2], v[3]); o.z = pk2(v[4], v[5]); o.w = pk2(v[6], v[7]);
      *(uint4*)(dst + (size_t)(nt * 64 + nn) * K + kt * 64 + kc * 8) = o;
    }
    __syncthreads();
  }
  tbase += cnt;
}
DEV void cvt_phase(const Params& p, int l, char* smem) {
  char* wb = p.ws + O_WB;
  int tb = 0;
  const float* win = p.w_in + (size_t)l * 1024 * DIN;
  cvt_job(win, 1024, NZ, DIN, (bf16_t*)(wb + W_WIN), 1024, tb, smem);
  cvt_job(win + NZ, 1024, 3072, DIN, (bf16_t*)(wb + W_WIN) + (size_t)NZP * 1024, 0, tb, smem);
  cvt_job(p.mlp_w1 + (size_t)l * 1024 * 4096, 1024, 4096, 4096, (bf16_t*)(wb + W_W1), 0, tb, smem);
  cvt_job(p.mlp_w2 + (size_t)l * 4096 * 1024, 4096, 1024, 1024, (bf16_t*)(wb + W_W2), 0, tb, smem);
  cvt_job(p.w_out + (size_t)l * 1024 * 1024, 1024, 1024, 1024, (bf16_t*)(wb + W_WOUT), 0, tb, smem);
  cvt_job(p.p_conv + (size_t)l * 512 * 1024, 512, 1024, 1024, (bf16_t*)(wb + W_PCV), 0, tb, smem);
  cvt_job(p.p_att + (size_t)l * 512 * 1024, 512, 1024, 1024, (bf16_t*)(wb + W_PAT), 0, tb, smem);
  cvt_job(p.p_rwkv + (size_t)l * 512 * 1024, 512, 1024, 1024, (bf16_t*)(wb + W_PRW), 0, tb, smem);
  for (int d = 0; d < 2; ++d) {
    cvt_job(p.rwkv_w2 + (size_t)(l * 2 + d) * 64 * 512, 64, 512, 512, (bf16_t*)(wb + W_LW2) + d * 512 * 64, 0, tb, smem);
    cvt_job(p.rwkv_a2 + (size_t)(l * 2 + d) * 64 * 512, 64, 512, 512, (bf16_t*)(wb + W_LA2) + d * 512 * 64, 0, tb, smem);
  }
  cvt_job(p.rwkv_g2 + (size_t)l * 128 * 512, 128, 512, 512, (bf16_t*)(wb + W_LG2), 0, tb, smem);
}

DEV void mod_phase(const Params& p, char* smem) {
  float* sc = (float*)smem;
  float* red = sc + 9 * 1024;
  float* MOD = (float*)(p.ws + O_MOD);
  const int tid = ltid();
  if ((int)blockIdx.x >= 192) return;
  for (int i = tid; i < 9 * 1024; i += 512) {
    const int r = i >> 10, k = i & 1023;
    const float v = r < 8 ? p.c[r * 1024 + k] : p.c_ctx[k];
    sc[i] = v * __builtin_amdgcn_rcpf(1.f + __expf(-v));
  }
  __syncthreads();
  for (int tile = blockIdx.x; tile < 192; tile += gridDim.x) {
    const int l = tile / 96, n0 = (tile % 96) * 64;
    const int kq = tid >> 6, col = tid & 63;
    float acc[9];
#pragma unroll
    for (int r = 0; r < 9; ++r) acc[r] = 0.f;
    const float* wp = p.mod_w + ((size_t)l * 1024 + kq * 128) * 6144 + n0 + col;
#pragma unroll 32
    for (int k = 0; k < 128; ++k) {
      const float wv = wp[(size_t)k * 6144];
#pragma unroll
      for (int r = 0; r < 9; ++r) acc[r] += sc[r * 1024 + kq * 128 + k] * wv;
    }
#pragma unroll
    for (int r = 0; r < 9; ++r) red[(kq * 9 + r) * 64 + col] = acc[r];
    __syncthreads();
    for (int idx = tid; idx < 576; idx += 512) {
      const int r = idx >> 6, cc = idx & 63;
      float s = p.mod_b[l * 6144 + n0 + cc];
#pragma unroll
      for (int q = 0; q < 8; ++q) s += red[(q * 9 + r) * 64 + cc];
      MOD[(size_t)(l * 9 + r) * 6144 + n0 + cc] = s;
    }
    __syncthreads();
  }
}

DEV void norm_phase(const Params& p, int l, int which, bf16_t* __restrict__ Hd, bool first, int nrows = T_ALL) {
  const float* g = (which ? p.norm2_g : p.norm1_g) + l * 1024;
  const float* MOD = (const float*)(p.ws + O_MOD);
  const int lane = ltid() & 63, w = ltid() >> 6;
  const int stride = gridDim.x * 8;
  f32x4 gg[4];
#pragma unroll
  for (int i = 0; i < 4; ++i) gg[i] = *(const f32x4*)(g + i * 256 + lane * 4);
  auto srcp = [&](int row) -> const float* {
    if (first) return row < T_LAT ? p.x + (size_t)row * DM : p.ctx + (size_t)(row - T_LAT) * DM;
    return xrow(p, row);
  };
  int row = blockIdx.x * 8 + w;
  f32x4 nv[4];
  if (row < nrows) {
    const float* s = srcp(row);
#pragma unroll
    for (int i = 0; i < 4; ++i) nv[i] = *(const f32x4*)(s + i * 256 + lane * 4);
  }
  for (; row < nrows; row += stride) {
    f32x4 v[4];
#pragma unroll
    for (int i = 0; i < 4; ++i) v[i] = nv[i];
    if (row + stride < nrows) {
      const float* s = srcp(row + stride);
#pragma unroll
      for (int i = 0; i < 4; ++i) nv[i] = *(const f32x4*)(s + i * 256 + lane * 4);
    }
    const float* md = MOD + (size_t)(l * 9 + modrow(row)) * 6144 + which * 3072;
    f32x4 sh[4], scl[4];
#pragma unroll
    for (int i = 0; i < 4; ++i) { sh[i] = *(const f32x4*)(md + i * 256 + lane * 4); scl[i] = *(const f32x4*)(md + 1024 + i * 256 + lane * 4); }
    float ss = 0.f;
#pragma unroll
    for (int i = 0; i < 4; ++i) ss += v[i][0] * v[i][0] + v[i][1] * v[i][1] + v[i][2] * v[i][2] + v[i][3] * v[i][3];
    const float rs = __builtin_amdgcn_rsqf(wsum(ss) * (1.f / 1024.f) + 1e-6f);
#pragma unroll
    for (int i = 0; i < 4; ++i) {
      const int c = i * 256 + lane * 4;
      const f32x4 h = v[i] * rs * gg[i] * (scl[i] + 1.f) + sh[i];
      uint2 o;
      o.x = pk2(h[0], h[1]); o.y = pk2(h[2], h[3]);
      *(uint2*)(Hd + (size_t)row * DM + c) = o;
    }
  }
}

DEV void rope2(float a, float b, float ang, float& o0, float& o1) {
  const float cs = __cosf(ang), sn = __sinf(ang);
  o0 = a * cs - b * sn;
  o1 = a * sn + b * cs;
}
struct EpiIn {
  static constexpr bool PERM = true, AFTER_DRAIN = false;
  bf16_t *ZU, *ZQ, *ZK, *VT, *ZRW;
  DEV void operator()(const f32x4 (&acc)[2][2][4][2], const pg8::Unit& u, int wr, int wc, int fr, int fq) const {
    const int row0 = u.pm * 256 + wr * 64 + fr, cl = wc * 32 + 8 * fq, pn = u.pn;
    if (pn < 4) {
#pragma unroll
      for (int ai = 0; ai < 2; ++ai)
#pragma unroll
        for (int m = 0; m < 4; ++m) {
          const int row = row0 + ai * 128 + m * 16;
          const f32x4 a0 = acc[ai][0][m][0], a1 = acc[ai][0][m][1], b0 = acc[ai][1][m][0], b1 = acc[ai][1][m][1];
          u32x4 o;
          o[0] = pk2(a0[0] * sigmoidf_(b0[0]), a0[1] * sigmoidf_(b0[1]));
          o[1] = pk2(a0[2] * sigmoidf_(b0[2]), a0[3] * sigmoidf_(b0[3]));
          o[2] = pk2(a1[0] * sigmoidf_(b1[0]), a1[1] * sigmoidf_(b1[1]));
          o[3] = pk2(a1[2] * sigmoidf_(b1[2]), a1[3] * sigmoidf_(b1[3]));
          *(u32x4*)(ZU + (size_t)row * 512 + pn * 128 + cl) = o;
        }
    } else if (pn < 8) {
      const bool isq = pn < 6;
      bf16_t* Z = isq ? ZQ : ZK;
      const float qs = isq ? 0.125f * 1.4426950408889634f : 1.f;
      const int cbase = (pn - (isq ? 4 : 6)) * 256 + cl;
#pragma unroll
      for (int ai = 0; ai < 2; ++ai)
#pragma unroll
        for (int m = 0; m < 4; ++m) {
          const int row = row0 + ai * 128 + m * 16;
#pragma unroll
          for (int bj = 0; bj < 2; ++bj) {
            const int c = cbase + bj * 128;
            float v[8];
#pragma unroll
            for (int j = 0; j < 4; ++j) { v[j] = acc[ai][bj][m][0][j]; v[4 + j] = acc[ai][bj][m][1][j]; }
            if (row < T_LAT) {
              const int t = row & 4095, d = c & 63, p0 = d >> 1;
              const float pos = (float)((p0 < 16) ? (t >> 6) : (t & 63));
              const int fi = p0 & 15;
#pragma unroll
              for (int q = 0; q < 4; ++q) {
                const float fr_ = __builtin_amdgcn_exp2f(-(float)(fi + q) * 0.8304820237218406f);
                float o0, o1;
                rope2(v[2 * q], v[2 * q + 1], pos * fr_, o0, o1);
                v[2 * q] = o0; v[2 * q + 1] = o1;
              }
            }
            u32x4 o;
            o[0] = pk2(v[0] * qs, v[1] * qs); o[1] = pk2(v[2] * qs, v[3] * qs);
            o[2] = pk2(v[4] * qs, v[5] * qs); o[3] = pk2(v[6] * qs, v[7] * qs);
            *(u32x4*)(Z + (size_t)row * 512 + c) = o;
          }
        }
    } else if (pn < 10) {
#pragma unroll
      for (int ai = 0; ai < 2; ++ai)
#pragma unroll
        for (int m = 0; m < 4; ++m) {
          const int row = row0 + ai * 128 + m * 16;
          int b, kidx;
          if (row < T_LAT) { b = row >> 12; kidx = 256 + (row & 4095); } else { b = (row - T_LAT) >> 8; kidx = (row - T_LAT) & 255; }
#pragma unroll
          for (int bj = 0; bj < 2; ++bj) {
            const int head = (pn - 8) * 2 + bj;
            bf16_t* dst = VT + ((size_t)((b * 4 + head) * 128 + cl)) * TK + kidx;
#pragma unroll
            for (int j = 0; j < 4; ++j) {
              dst[(size_t)j * TK] = f2bf(acc[ai][bj][m][0][j]);
              dst[(size_t)(4 + j) * TK] = f2bf(acc[ai][bj][m][1][j]);
            }
          }
        }
    } else {
#pragma unroll
      for (int ai = 0; ai < 2; ++ai)
#pragma unroll
        for (int m = 0; m < 4; ++m) {
          const int row = row0 + ai * 128 + m * 16;
#pragma unroll
          for (int bj = 0; bj < 2; ++bj) {
            const int c = (pn - 10) * 256 + bj * 128 + cl;
            if (c < 1920) {
              u32x4 o;
              o[0] = pk2(acc[ai][bj][m][0][0], acc[ai][bj][m][0][1]); o[1] = pk2(acc[ai][bj][m][0][2], acc[ai][bj][m][0][3]);
              o[2] = pk2(acc[ai][bj][m][1][0], acc[ai][bj][m][1][1]); o[3] = pk2(acc[ai][bj][m][1][2], acc[ai][bj][m][1][3]);
              *(u32x4*)(ZRW + (size_t)row * 1920 + c) = o;
            }
          }
        }
    }
  }
};
DEV void gemm_in_phase(const Params& p, char* smem) {
  EpiIn E;
  E.ZU = (bf16_t*)(p.ws + O_ZU); E.ZQ = (bf16_t*)(p.ws + O_ZQ); E.ZK = (bf16_t*)(p.ws + O_ZK);
  E.VT = (bf16_t*)(p.ws + O_VT); E.ZRW = (bf16_t*)(p.ws + O_ZRW);
  pg8::Gemm g;
  g.A = (const bf16_t*)(p.ws + O_H0); g.Bt = (const bf16_t*)(p.ws + O_WB + W_WIN); g.M = T_ALL; g.N = NZP; g.K = 1024;
  pg8::StaticOrder S;
  S.init(g.M, g.N, (int)gridDim.x, (int)blockIdx.x);
  __syncthreads();
  pg8::gemm_phase<EpiIn, pg8::StaticOrder>((PG8_LAS unsigned char*)smem, g, S, E);
  __syncthreads();
}

constexpr int KROW = 272, VROW = 144, ATT_ST = 64 * KROW + 128 * VROW;
constexpr int ATT2_ST = 2 * 128 * KROW;
DEV int key_of_slot(int x) { return (x & 0x13) | ((x & 8) >> 1) | ((x & 4) << 1); }

DEV void attn_tile(const Params& p, int l, int tile, char* smem, bool do_store = true) {
  bf16_t* ZQ = (bf16_t*)(p.ws + O_ZQ);
  const bf16_t* ZK = (const bf16_t*)(p.ws + O_ZK);
  const bf16_t* VT = (const bf16_t*)(p.ws + O_VT);
  int b, head, q0, nkeys, qbase;
  if (tile < 1024) { b = tile >> 7; head = (tile >> 5) & 3; q0 = (tile & 31) * 128; nkeys = TK; qbase = b * SEQ; }
  else { const int tt = tile - 1024; b = tt >> 3; head = (tt >> 1) & 3; q0 = (tt & 1) * 128; nkeys = CTXL; qbase = T_LAT + b * CTXL; }
  const int tid = ltid(), lane = tid & 63, w = tid >> 6, ql = lane & 31, hh = lane >> 5, map = w >> 2, qg = w & 3;
  const int qrow = qbase + q0 + qg * 32 + ql;
  const float lam_init = l == 0 ? 0.2f : 0.35550907f;
  float lam;
  {
    const float a1 = p.att_lq1[l * 64 + lane] * p.att_lk1[l * 64 + lane];
    const float a2 = p.att_lq2[l * 64 + lane] * p.att_lk2[l * 64 + lane];
    lam = __expf(wsum(a1)) - __expf(wsum(a2)) + lam_init;
  }
  bf16x8 qf[4];
#pragma unroll
  for (int s = 0; s < 4; ++s) qf[s] = *(const bf16x8*)(ZQ + (size_t)qrow * 512 + head * 128 + map * 64 + s * 16 + hh * 8);
  f32x16 o[4];
#pragma unroll
  for (int dt = 0; dt < 4; ++dt)
#pragma unroll
    for (int e = 0; e < 16; ++e) o[dt][e] = 0.f;
  float m = -1e30f, lsum = 0.f;
  const int kr0 = tid >> 4, kch = tid & 15;
  const int vr0 = tid >> 4, vch = tid & 15;
  const bf16_t* vtb = VT + ((size_t)((b * 4 + head) * 128)) * TK;
  u32x4 kreg[4], vreg[4];
  auto gload = [&](int kt) {
    const int k0 = kt * 128;
#pragma unroll
    for (int i = 0; i < 4; ++i) {
      const int kidx = k0 + kr0 + 32 * i;
      const int krow = kidx < CTXL ? T_LAT + b * CTXL + kidx : b * SEQ + kidx - CTXL;
      kreg[i] = *(const u32x4*)(ZK + (size_t)krow * 512 + head * 128 + kch * 8);
      vreg[i] = *(const u32x4*)(vtb + (size_t)(vr0 + 32 * i) * TK + k0 + vch * 8);
    }
  };
  auto lstore = [&](int st) {
    char* Ks = smem + st * ATT2_ST;
    char* Vs = Ks + 128 * KROW;
#pragma unroll
    for (int i = 0; i < 4; ++i) {
      *(u32x4*)(Ks + (kr0 + 32 * i) * KROW + kch * 16) = kreg[i];
      *(u32x4*)(Vs + (vr0 + 32 * i) * KROW + vch * 16) = vreg[i];
    }
  };
  const int nkt = nkeys >> 7;
  gload(0);
  __syncthreads();
  lstore(0);
  __syncthreads();
  const int kos = key_of_slot(ql);
  for (int kt = 0; kt < nkt; ++kt) {
    const int cur = kt & 1;
    if (kt + 1 < nkt) gload(kt + 1);
    const char* Ks = smem + cur * ATT2_ST;
    const char* Vs = Ks + 128 * KROW;
#pragma unroll
    for (int h2 = 0; h2 < 2; ++h2) {
    const char* kp = Ks + (h2 * 64 + kos) * KROW + (map * 64 + hh * 8) * 2;
    const char* vp = Vs + ql * KROW + hh * 16 + h2 * 128;
    bf16x8 kf0[4], kf1[4];
#pragma unroll
    for (int ks = 0; ks < 4; ++ks) { kf0[ks] = *(const bf16x8*)(kp + ks * 32); kf1[ks] = *(const bf16x8*)(kp + 32 * KROW + ks * 32); }
    f32x16 s0, s1;
#pragma unroll
    for (int e = 0; e < 16; ++e) { s0[e] = 0.f; s1[e] = 0.f; }
#pragma unroll
    for (int ks = 0; ks < 4; ++ks) s0 = __builtin_amdgcn_mfma_f32_32x32x16_bf16(kf0[ks], qf[ks], s0, 0, 0, 0);
#pragma unroll
    for (int ks = 0; ks < 4; ++ks) s1 = __builtin_amdgcn_mfma_f32_32x32x16_bf16(kf1[ks], qf[ks], s1, 0, 0, 0);
    bf16x8 vf[8];
#pragma unroll
    for (int dt = 0; dt < 4; ++dt)
#pragma unroll
      for (int k2 = 0; k2 < 2; ++k2) vf[dt * 2 + k2] = *(const bf16x8*)(vp + dt * 32 * KROW + (k2 * 16) * 2);
    float mx = fmaxf(s0[0], s1[0]);
#pragma unroll
    for (int e = 1; e < 16; ++e) mx = fmaxf(mx, fmaxf(s0[e], s1[e]));
    mx = xor32_max(mx);
    const float mnew = (mx > m + 8.f) ? mx : m;
    if (__any(mnew > m)) {
      const float alpha = __builtin_amdgcn_exp2f(m - mnew);
      lsum *= alpha;
#pragma unroll
      for (int dt = 0; dt < 4; ++dt)
#pragma unroll
        for (int e = 0; e < 16; ++e) o[dt][e] *= alpha;
    }
    m = mnew;
    bf16x8 pb0[2], pb1[2];
    {
      float pe[16];
#pragma unroll
      for (int e = 0; e < 16; ++e) { pe[e] = __builtin_amdgcn_exp2f(s0[e] - m); lsum += pe[e]; }
#pragma unroll
      for (int k2 = 0; k2 < 2; ++k2) {
        u32x4 u;
        u[0] = pk2(pe[8 * k2 + 0], pe[8 * k2 + 1]); u[1] = pk2(pe[8 * k2 + 2], pe[8 * k2 + 3]);
        u[2] = pk2(pe[8 * k2 + 4], pe[8 * k2 + 5]); u[3] = pk2(pe[8 * k2 + 6], pe[8 * k2 + 7]);
        pb0[k2] = __builtin_bit_cast(bf16x8, u);
      }
    }
#pragma unroll
    for (int dt = 0; dt < 4; ++dt)
#pragma unroll
      for (int k2 = 0; k2 < 2; ++k2) o[dt] = __builtin_amdgcn_mfma_f32_32x32x16_bf16(vf[dt * 2 + k2], pb0[k2], o[dt], 0, 0, 0);
#pragma unroll
    for (int dt = 0; dt < 4; ++dt)
#pragma unroll
      for (int k2 = 0; k2 < 2; ++k2) vf[dt * 2 + k2] = *(const bf16x8*)(vp + dt * 32 * KROW + (32 + k2 * 16) * 2);
    {
      float pe[16];
#pragma unroll
      for (int e = 0; e < 16; ++e) { pe[e] = __builtin_amdgcn_exp2f(s1[e] - m); lsum += pe[e]; }
#pragma unroll
      for (int k2 = 0; k2 < 2; ++k2) {
        u32x4 u;
        u[0] = pk2(pe[8 * k2 + 0], pe[8 * k2 + 1]); u[1] = pk2(pe[8 * k2 + 2], pe[8 * k2 + 3]);
        u[2] = pk2(pe[8 * k2 + 4], pe[8 * k2 + 5]); u[3] = pk2(pe[8 * k2 + 6], pe[8 * k2 + 7]);
        pb1[k2] = __builtin_bit_cast(bf16x8, u);
      }
    }
#pragma unroll
    for (int dt = 0; dt < 4; ++dt)
#pragma unroll
      for (int k2 = 0; k2 < 2; ++k2) o[dt] = __builtin_amdgcn_mfma_f32_32x32x16_bf16(vf[dt * 2 + k2], pb1[k2], o[dt], 0, 0, 0);
    }
    if (kt + 1 < nkt) lstore(cur ^ 1);
    __syncthreads();
  }
  const float ltot = xor32_sum(lsum);
  float* ex = (float*)smem;
  if (map == 1) {
    const float c2 = lam / ltot;
#pragma unroll
    for (int dt = 0; dt < 4; ++dt)
#pragma unroll
      for (int e = 0; e < 16; ++e) {
        const int dv = dt * 32 + 8 * (e >> 2) + 4 * hh + (e & 3);
        ex[(qg * 128 + dv) * 32 + ql] = o[dt][e] * c2;
      }
  }
  __syncthreads();
  if (map == 0 && do_store) {
    const float c1 = 1.f / ltot;
    float ss = 0.f;
#pragma unroll
    for (int dt = 0; dt < 4; ++dt)
#pragma unroll
      for (int e = 0; e < 16; ++e) {
        const int dv = dt * 32 + 8 * (e >> 2) + 4 * hh + (e & 3);
        const float v = o[dt][e] * c1 - ex[(qg * 128 + dv) * 32 + ql];
        o[dt][e] = v;
        ss += v * v;
      }
    ss = xor32_sum(ss);
    const float rs = __builtin_amdgcn_rsqf(ss * (1.f / 128.f) + 1e-5f) * (1.f - lam_init);
    const float* sg = p.att_subln_g + l * 128;
#pragma unroll
    for (int dt = 0; dt < 4; ++dt)
#pragma unroll
      for (int i = 0; i < 4; ++i) {
        const int dv = dt * 32 + 8 * i + 4 * hh;
        const float4 g4 = *(const float4*)(sg + dv);
        uint2 u;
        u.x = pk2(o[dt][4 * i + 0] * rs * g4.x, o[dt][4 * i + 1] * rs * g4.y);
        u.y = pk2(o[dt][4 * i + 2] * rs * g4.z, o[dt][4 * i + 3] * rs * g4.w);
        *(uint2*)(ZQ + (size_t)qrow * 512 + head * 128 + dv) = u;
      }
  }
  __syncthreads();
}

DEV void conv_tile(const Params& p, int l, int tile, char* smem) {
  const bf16_t* ZU = (const bf16_t*)(p.ws + O_ZU);
  bf16_t* YCV = (bf16_t*)(p.ws + O_YCV);
  const int r0 = tile * 64;
  int s_lo, s_hi;
  if (r0 < T_LAT) { s_lo = r0 & ~4095; s_hi = s_lo + SEQ; } else { s_lo = T_LAT + ((r0 - T_LAT) & ~255); s_hi = s_lo + CTXL; }
  const int tid = ltid(), lane = tid & 63, w = tid >> 6, c0 = lane * 8;
  const int t0 = r0 + w * 8;
  const float* wp = p.conv_dw_w + (size_t)l * 31 * 512 + c0;
  float acc[8][8];
  {
    const f32x4 b0 = *(const f32x4*)(p.conv_dw_b + l * 512 + c0), b1 = *(const f32x4*)(p.conv_dw_b + l * 512 + c0 + 4);
#pragma unroll
    for (int t = 0; t < 8; ++t)
#pragma unroll
      for (int j = 0; j < 4; ++j) { acc[t][j] = b0[j]; acc[t][4 + j] = b1[j]; }
  }
  f32x4 wk[8][2];
#pragma unroll
  for (int q = 0; q < 8; ++q) { wk[q][0] = (f32x4){0.f, 0.f, 0.f, 0.f}; wk[q][1] = (f32x4){0.f, 0.f, 0.f, 0.f}; }
#pragma unroll 4
  for (int s = 0; s < 40; ++s) {
    const int rr = t0 - 15 + s;
    u32x4 uv = {0u, 0u, 0u, 0u};
    if (rr >= s_lo && rr < s_hi) uv = *(const u32x4*)(ZU + (size_t)rr * 512 + c0);
    float u[8];
#pragma unroll
    for (int q = 0; q < 4; ++q) { u[2 * q] = lo_bf(uv[q]); u[2 * q + 1] = hi_bf(uv[q]); }
#pragma unroll
    for (int q = 7; q > 0; --q) { wk[q][0] = wk[q - 1][0]; wk[q][1] = wk[q - 1][1]; }
    wk[0][0] = (f32x4){0.f, 0.f, 0.f, 0.f}; wk[0][1] = (f32x4){0.f, 0.f, 0.f, 0.f};
    if (s <= 30) { wk[0][0] = *(const f32x4*)(wp + s * 512); wk[0][1] = *(const f32x4*)(wp + s * 512 + 4); }
#pragma unroll
    for (int t = 0; t < 8; ++t) {
#pragma unroll
      for (int j = 0; j < 4; ++j) { acc[t][j] += wk[t][0][j] * u[j]; acc[t][4 + j] += wk[t][1][j] * u[4 + j]; }
    }
  }
  const f32x4 g0 = *(const f32x4*)(p.conv_ln_g + l * 512 + c0), g1 = *(const f32x4*)(p.conv_ln_g + l * 512 + c0 + 4);
  const f32x4 e0 = *(const f32x4*)(p.conv_ln_b + l * 512 + c0), e1 = *(const f32x4*)(p.conv_ln_b + l * 512 + c0 + 4);
#pragma unroll
  for (int t = 0; t < 8; ++t) {
    float s1 = 0.f;
#pragma unroll
    for (int j = 0; j < 8; ++j) s1 += acc[t][j];
    const float mu = wsum(s1) * (1.f / 512.f);
    float s2 = 0.f;
#pragma unroll
    for (int j = 0; j < 8; ++j) { acc[t][j] -= mu; s2 += acc[t][j] * acc[t][j]; }
    const float rs = __builtin_amdgcn_rsqf(wsum(s2) * (1.f / 512.f) + 1e-5f);
    float y[8];
#pragma unroll
    for (int j = 0; j < 4; ++j) {
      const float z0 = acc[t][j] * rs * g0[j] + e0[j], z1 = acc[t][4 + j] * rs * g1[j] + e1[j];
      y[j] = z0 * sigmoidf_(z0); y[4 + j] = z1 * sigmoidf_(z1);
    }
    u32x4 o;
    o[0] = pk2(y[0], y[1]); o[1] = pk2(y[2], y[3]); o[2] = pk2(y[4], y[5]); o[3] = pk2(y[6], y[7]);
    *(u32x4*)(YCV + (size_t)(t0 + t) * 512 + c0) = o;
  }
}

DEV void shift_tile(const Params& p, int l, int tile) {
  const bf16_t* ZRW = (const bf16_t*)(p.ws + O_ZRW);
  bf16_t* ZRS = (bf16_t*)(p.ws + O_ZRS);
  const int r0 = tile * 32;
  int s_lo, s_hi;
  if (r0 < T_LAT) { s_lo = r0 & ~4095; s_hi = s_lo + SEQ; } else { s_lo = T_LAT + ((r0 - T_LAT) & ~255); s_hi = s_lo + CTXL; }
  const int tid = ltid();
  if (tid >= 480) return;
  const int half = tid >= 240 ? 1 : 0, ch = tid - half * 240, col = ch * 8;
  const int rb = r0 + half * 16;
  u32x4 rows[18];
#pragma unroll
  for (int i = 0; i < 18; ++i) {
    const int rr = rb - 1 + i;
    rows[i] = (u32x4){0u, 0u, 0u, 0u};
    if (rr >= s_lo && rr < s_hi) rows[i] = *(const u32x4*)(ZRW + (size_t)rr * 1920 + col);
  }
  const float* sw = p.rwkv_shift + (size_t)l * 3 * 1920 + col;
  float w0[8], w1[8], w2[8];
#pragma unroll
  for (int j = 0; j < 8; ++j) { w0[j] = sw[j]; w1[j] = sw[1920 + j]; w2[j] = sw[3840 + j]; }
  const int act = (col >= 1536 && col < 1664) ? 1 : (col >= 1792 ? 2 : 0);
#pragma unroll
  for (int i = 0; i < 16; ++i) {
    const int row = rb + i;
    const u32x4 pv = rows[i], cu = rows[i + 1], nx = rows[i + 2];
    float y[8];
#pragma unroll
    for (int q = 0; q < 4; ++q) {
      y[2 * q] = w0[2 * q] * lo_bf(pv[q]) + w1[2 * q] * lo_bf(cu[q]) + w2[2 * q] * lo_bf(nx[q]);
      y[2 * q + 1] = w0[2 * q + 1] * hi_bf(pv[q]) + w1[2 * q + 1] * hi_bf(cu[q]) + w2[2 * q + 1] * hi_bf(nx[q]);
    }
    if (act == 1) {
#pragma unroll
      for (int j = 0; j < 8; ++j) y[j] = 1.f - 2.f * __builtin_amdgcn_rcpf(1.f + __expf(2.f * y[j]));
    } else if (act == 2) {
#pragma unroll
      for (int j = 0; j < 8; ++j) y[j] = sigmoidf_(y[j]);
    }
    u32x4 o;
    o[0] = pk2(y[0], y[1]); o[1] = pk2(y[2], y[3]); o[2] = pk2(y[4], y[5]); o[3] = pk2(y[6], y[7]);
    if (col < 1536) *(u32x4*)(ZRS + (size_t)row * 1536 + col) = o;
    else if (col < 1792) *(u32x4*)((bf16_t*)(p.ws + O_LIN) + (size_t)row * 256 + (col - 1536)) = o;
    else *(u32x4*)((bf16_t*)(p.ws + O_GIN) + (size_t)row * 128 + (col - 1792)) = o;
  }
}

DEV void branch_phase(const Params& p, int l, char* smem) {
  const bool last = (l == 1);
  for (int L = vblock(); L < 1088 + 544 + 1088; L += gridDim.x) {
    if (L < 1088) { if (!(last && L >= 1024)) attn_tile(p, l, L, smem); }
    else if (L < 1632) { if (!(last && L - 1088 >= 512)) conv_tile(p, l, L - 1088, smem); }
    else shift_tile(p, l, L - 1632);
  }
}

DEV void lora_phase(const Params& p, int l, char* smem, bool gjob) {
  const bf16_t* LIN = (const bf16_t*)(p.ws + O_LIN);
  const int lane = ltid() & 63, w = ltid() >> 6, wm = w >> 1, wn = w & 1, fr = lane & 15, fq = lane >> 4;
  const int ntile = gjob ? 544 : 4 * 544;
  for (int L = vblock(); L < ntile; L += gridDim.x) {
    const int job = gjob ? 4 : L / 544, t = L - (gjob ? 0 : job * 544), pm = t >> 2, pn = t & 3;
    const int row0 = pm * 256, col0 = pn * 128;
    const bf16_t* A;
    const bf16_t* Bt;
    bf16_t* O;
    int K = 64, lda = 256;
    const float* bias = nullptr;
    if (job == 0) { A = LIN; Bt = (const bf16_t*)(p.ws + O_WB + W_LW2); O = (bf16_t*)(p.ws + O_EF); bias = p.rwkv_w0 + (l * 2 + 0) * 512; }
    else if (job == 1) { A = LIN + 64; Bt = (const bf16_t*)(p.ws + O_WB + W_LW2) + 512 * 64; O = (bf16_t*)(p.ws + O_EB); bias = p.rwkv_w0 + (l * 2 + 1) * 512; }
    else if (job == 2) { A = LIN + 128; Bt = (const bf16_t*)(p.ws + O_WB + W_LA2); O = (bf16_t*)(p.ws + O_AF); bias = p.rwkv_a0 + (l * 2 + 0) * 512; }
    else if (job == 3) { A = LIN + 192; Bt = (const bf16_t*)(p.ws + O_WB + W_LA2) + 512 * 64; O = (bf16_t*)(p.ws + O_AB); bias = p.rwkv_a0 + (l * 2 + 1) * 512; }
    else { A = (const bf16_t*)(p.ws + O_GIN); Bt = (const bf16_t*)(p.ws + O_WB + W_LG2); O = (bf16_t*)(p.ws + O_G); K = 128; lda = 128; }
    f32x4 acc[4][4];
    zero_acc(acc);
    gemm_kloop(acc, A + (size_t)row0 * lda, lda, Bt + (size_t)col0 * K, K, K, smem);
#pragma unroll
    for (int mi = 0; mi < 4; ++mi) {
      const int row = row0 + wm * 64 + mi * 16 + fr;
#pragma unroll
      for (int ni = 0; ni < 4; ++ni) {
        const int c = col0 + wn * 64 + ni * 16 + fq * 4;
        float v[4];
#pragma unroll
        for (int j = 0; j < 4; ++j) {
          float z = acc[mi][ni][j];
          if (job < 4) z = sigmoidf_(z + bias[c + j]);
          if (job < 2) z *= 0.6065306597126334f;
          v[j] = z;
        }
        uint2 o;
        o.x = pk2(v[0], v[1]); o.y = pk2(v[2], v[3]);
        *(uint2*)(O + (size_t)row * 512 + c) = o;
      }
    }
  }
}

DEV void lora64_phase(const Params& p, int l, char* smem) {
  const bf16_t* LIN = (const bf16_t*)(p.ws + O_LIN);
  const int tid = ltid(), lane = tid & 63, w = tid >> 6, wm = w >> 1, wn = w & 1, fr = lane & 15, fq = lane >> 4;
  const int lrow = tid >> 3, lch = tid & 7;
  u32x4 ra[4], rb[2];
  auto issue = [&](int L) {
    const int job = L / 544, t = L - job * 544, pm = t >> 2, pn = t & 3;
    const bf16_t* A = LIN + job * 64 + (size_t)(pm * 256 + lrow) * 256 + lch * 8;
    const bf16_t* Bt = (const bf16_t*)(p.ws + O_WB + ((job & 2) ? W_LA2 : W_LW2)) + (job & 1) * 512 * 64 + (size_t)(pn * 128 + lrow) * 64 + lch * 8;
#pragma unroll
    for (int i = 0; i < 4; ++i) ra[i] = *(const u32x4*)(A + (size_t)(64 * i) * 256);
#pragma unroll
    for (int i = 0; i < 2; ++i) rb[i] = *(const u32x4*)(Bt + (size_t)(64 * i) * 64);
  };
  char* swa = smem + lrow * SROW + lch * 16;
  char* swb = swa + A_ST;
  const char* sra = smem + (wm * 64 + fr) * SROW + fq * 16;
  const char* srb = smem + A_ST + (wn * 64 + fr) * SROW + fq * 16;
  int L = vblock();
  if (L < 4 * 544) issue(L);
  for (; L < 4 * 544; L += gridDim.x) {
    const int job = L / 544, t = L - job * 544, pm = t >> 2, pn = t & 3;
    const int row0 = pm * 256, col0 = pn * 128;
    __syncthreads();
#pragma unroll
    for (int i = 0; i < 4; ++i) *(u32x4*)(swa + i * 64 * SROW) = ra[i];
#pragma unroll
    for (int i = 0; i < 2; ++i) *(u32x4*)(swb + i * 64 * SROW) = rb[i];
    __syncthreads();
    if (L + (int)gridDim.x < 4 * 544) issue(L + gridDim.x);
    f32x4 acc[4][4];
    zero_acc(acc);
#pragma unroll
    for (int ks = 0; ks < 2; ++ks) {
      bf16x8 af[4], bfr[4];
#pragma unroll
      for (int mi = 0; mi < 4; ++mi) af[mi] = *(const bf16x8*)(sra + mi * 16 * SROW + ks * 64);
#pragma unroll
      for (int ni = 0; ni < 4; ++ni) bfr[ni] = *(const bf16x8*)(srb + ni * 16 * SROW + ks * 64);
#pragma unroll
      for (int mi = 0; mi < 4; ++mi)
#pragma unroll
        for (int ni = 0; ni < 4; ++ni) acc[mi][ni] = __builtin_amdgcn_mfma_f32_16x16x32_bf16(bfr[ni], af[mi], acc[mi][ni], 0, 0, 0);
    }
    bf16_t* O = (bf16_t*)(p.ws + (job == 0 ? O_EF : (job == 1 ? O_EB : (job == 2 ? O_AF : O_AB))));
    const float* bias = ((job & 2) ? p.rwkv_a0 : p.rwkv_w0) + (l * 2 + (job & 1)) * 512;
    const float sc = job < 2 ? 0.6065306597126334f : 1.f;
    f32x4 bv[4];
#pragma unroll
    for (int ni = 0; ni < 4; ++ni) bv[ni] = *(const f32x4*)(bias + col0 + wn * 64 + ni * 16 + fq * 4);
#pragma unroll
    for (int mi = 0; mi < 4; ++mi) {
      const int row = row0 + wm * 64 + mi * 16 + fr;
#pragma unroll
      for (int ni = 0; ni < 4; ++ni) {
        const int c = col0 + wn * 64 + ni * 16 + fq * 4;
        const f32x4 z = acc[mi][ni] + bv[ni];
        uint2 o;
        o.x = pk2(sc * sigmoidf_(z[0]), sc * sigmoidf_(z[1])); o.y = pk2(sc * sigmoidf_(z[2]), sc * sigmoidf_(z[3]));
        *(uint2*)(O + (size_t)row * 512 + c) = o;
      }
    }
  }
  __syncthreads();
}

DEV int scan_row(int step, int dir, int b) {
  if (step < CTXL) { const int t = dir ? (CTXL - 1 - step) : step; return T_LAT + b * CTXL + t; }
  const int s2 = step - CTXL;
  const int t = dir ? (SEQ - 1 - s2) : s2;
  return b * SEQ + t;
}
DEV float red8(float v) {
  v += dppf<0xB1>(v);
  v += dppf<0x4E>(v);
  v += dppf<0x141>(v);
  return v;
}
struct ScanOps { f32x4 nkk0, nkk1, w0, w1, kka0, kka1, kd0, kd1, r0, r1; float v; };
DEV void scan_tile(const Params& p, int l, int tile, char* smem) {
  const int half = tile & 1, dir = (tile >> 1) & 1, h = (tile >> 2) & 7, b = tile >> 5;
  float* arr = (float*)smem;
  float* ybuf = arr + 2 * 32 * 384;
  const bf16_t* ZRS = (const bf16_t*)(p.ws + O_ZRS);
  const bf16_t* E = (const bf16_t*)(p.ws + (dir ? O_EB : O_EF));
  const bf16_t* Aa = (const bf16_t*)(p.ws + (dir ? O_AB : O_AF));
  bf16_t* YS = (bf16_t*)(p.ws + (dir ? O_YSB : O_YSF));
  const int tid = ltid(), lane = tid & 63;
  const int w = __builtin_amdgcn_readfirstlane(tid >> 6);
  const int col = h * 64 + lane;
  const float kkp = p.rwkv_kk[l * 512 + col], kap = p.rwkv_ka[l * 512 + col];
  auto produce = [&](int ch, int buf, int pw, int npw) {
#pragma unroll
    for (int i0 = 0; i0 < 32; i0 += 4 * npw) {
      bf16_t rr[4], rk[4], rv[4], re[4], ra[4];
#pragma unroll
      for (int i = 0; i < 4; ++i) {
        const int R = scan_row(ch * 32 + i0 + pw + npw * i, dir, b);
        rr[i] = ZRS[(size_t)R * 1536 + col];
        rk[i] = ZRS[(size_t)R * 1536 + 512 + col];
        rv[i] = ZRS[(size_t)R * 1536 + 1024 + col];
        re[i] = E[(size_t)R * 512 + col];
        ra[i] = Aa[(size_t)R * 512 + col];
      }
#pragma unroll
      for (int i = 0; i < 4; ++i) {
        const int sl = i0 + pw + npw * i;
        const float r = bf2f(rr[i]), k = bf2f(rk[i]), v = bf2f(rv[i]), e = bf2f(re[i]), a = bf2f(ra[i]);
        const float kkv = k * kkp;
        const float inv = __builtin_amdgcn_rsqf(fmaxf(wsum(kkv * kkv), 1e-24f));
        const float kk = kkv * inv;
        float* d = arr + (buf * 32 + sl) * 384 + lane;
        d[0] = -kk;
        d[64] = __expf(-e);
        d[128] = kk * a;
        d[192] = k * (1.f + (a - 1.f) * kap);
        d[256] = r;
        d[320] = v;
      }
    }
  };
  auto flush = [&](int ch, int buf, int t256) {
#pragma unroll
    for (int q = 0; q < 2; ++q) {
      const int idx = t256 + 256 * q, sl = idx >> 4, rp = (idx & 15) * 2;
      const int R = scan_row(ch * 32 + sl, dir, b);
      const float* yb = ybuf + buf * 1024 + sl * 32 + rp;
      *(unsigned*)(YS + (size_t)R * 512 + h * 64 + half * 32 + rp) = pk2(yb[0], yb[1]);
    }
  };
  __syncthreads();
  produce(0, 0, w, 8);
  __syncthreads();
  f32x4 S0 = {0.f, 0.f, 0.f, 0.f}, S1 = {0.f, 0.f, 0.f, 0.f};
  const int r8 = lane >> 3, cg = lane & 7;
  for (int ch = 0; ch < 136; ++ch) {
    const int buf = ch & 1;
    if (w < 4) {
      const float* cb = arr + buf * 32 * 384;
      const int vo = 320 + half * 32 + w * 8 + r8;
      float* yw = ybuf + buf * 1024 + cg * 32 + w * 8 + r8;
      auto ldops = [&](ScanOps& o, int sl) {
        const f32x4* b4 = (const f32x4*)(cb + sl * 384);
        o.nkk0 = b4[cg * 2]; o.nkk1 = b4[cg * 2 + 1];
        o.w0 = b4[16 + cg * 2]; o.w1 = b4[16 + cg * 2 + 1];
        o.kka0 = b4[32 + cg * 2]; o.kka1 = b4[32 + cg * 2 + 1];
        o.kd0 = b4[48 + cg * 2]; o.kd1 = b4[48 + cg * 2 + 1];
        o.r0 = b4[64 + cg * 2]; o.r1 = b4[64 + cg * 2 + 1];
        o.v = cb[sl * 384 + vo];
      };
      float ykeep = 0.f;
      auto step = [&](const ScanOps& o, int sl) {
        const f32x4 sA = S0 * o.nkk0 + S1 * o.nkk1;
        const float sa = red8((sA[0] + sA[1]) + (sA[2] + sA[3]));
        S0 = S0 * o.w0 + (o.kka0 * sa + o.kd0 * o.v);
        S1 = S1 * o.w1 + (o.kka1 * sa + o.kd1 * o.v);
        const f32x4 yA = S0 * o.r0 + S1 * o.r1;
        const float y = red8((yA[0] + yA[1]) + (yA[2] + yA[3]));
        ykeep = (cg == (sl & 7)) ? y : ykeep;
      };
      ScanOps oa, ob;
      ldops(oa, 0);
#pragma unroll
      for (int s8 = 0; s8 < 32; s8 += 8) {
#pragma unroll
        for (int q = 0; q < 8; q += 2) {
          ldops(ob, s8 + q + 1);
          step(oa, s8 + q);
          ldops(oa, (s8 + q + 2) & 31);
          step(ob, s8 + q + 1);
        }
        yw[s8 * 32] = ykeep;
      }
    } else {
      const int pw = w - 4;
      if (ch > 0) flush(ch - 1, buf ^ 1, tid - 256);
      if (ch + 1 < 136) produce(ch + 1, buf ^ 1, pw, 4);
    }
    __syncthreads();
  }
  if (w >= 4) flush(135, 1, tid - 256);
  __syncthreads();
}
DEV void scan_phase(const Params& p, int l, char* smem) {
  for (int L = blockIdx.x; L < 256; L += gridDim.x) scan_tile(p, l, L, smem);
}

DEV void unpack8(const u32x4 u, float (&f)[8]) {
#pragma unroll
  for (int q = 0; q < 4; ++q) { f[2 * q] = lo_bf(u[q]); f[2 * q + 1] = hi_bf(u[q]); }
}
DEV void post_phase(const Params& p, int l, int nrows) {
  const bf16_t* ZRS = (const bf16_t*)(p.ws + O_ZRS);
  const bf16_t* AF = (const bf16_t*)(p.ws + O_AF);
  const bf16_t* AB = (const bf16_t*)(p.ws + O_AB);
  const bf16_t* G = (const bf16_t*)(p.ws + O_G);
  bf16_t* YSF = (bf16_t*)(p.ws + O_YSF);
  const bf16_t* YSB = (const bf16_t*)(p.ws + O_YSB);
  const int lane = ltid() & 63, w = ltid() >> 6, c0 = lane * 8;
  float gng[8], gnb[8], kaw[8], rkw[8];
#pragma unroll
  for (int j = 0; j < 8; ++j) {
    gng[j] = p.rwkv_gn_g[l * 512 + c0 + j]; gnb[j] = p.rwkv_gn_b[l * 512 + c0 + j];
    kaw[j] = p.rwkv_ka[l * 512 + c0 + j]; rkw[j] = p.rwkv_rk[l * 512 + c0 + j];
  }
  const int stride = gridDim.x * 8;
  int row = blockIdx.x * 8 + w;
  u32x4 q_ysf, q_ysb, q_r, q_k, q_v, q_af, q_ab, q_g;
  auto gl = [&](int rw) {
    q_ysf = *(const u32x4*)(YSF + (size_t)rw * 512 + c0); q_ysb = *(const u32x4*)(YSB + (size_t)rw * 512 + c0);
    q_r = *(const u32x4*)(ZRS + (size_t)rw * 1536 + c0); q_k = *(const u32x4*)(ZRS + (size_t)rw * 1536 + 512 + c0);
    q_v = *(const u32x4*)(ZRS + (size_t)rw * 1536 + 1024 + c0);
    q_af = *(const u32x4*)(AF + (size_t)rw * 512 + c0); q_ab = *(const u32x4*)(AB + (size_t)rw * 512 + c0);
    q_g = *(const u32x4*)(G + (size_t)rw * 512 + c0);
  };
  if (row < nrows) gl(row);
  for (; row < nrows; row += stride) {
    float ysf[8], ysb[8], r[8], k[8], v[8], af[8], ab[8], g[8];
    unpack8(q_ysf, ysf); unpack8(q_ysb, ysb); unpack8(q_r, r); unpack8(q_k, k); unpack8(q_v, v);
    unpack8(q_af, af); unpack8(q_ab, ab); unpack8(q_g, g);
    if (row + stride < nrows) gl(row + stride);
    float ys[8], s1 = 0.f, bp = 0.f;
#pragma unroll
    for (int j = 0; j < 8; ++j) {
      ys[j] = ysf[j] + ysb[j]; s1 += ys[j];
      bp += r[j] * k[j] * rkw[j] * (2.f + (af[j] + ab[j] - 2.f) * kaw[j]);
    }
    const float mu = red8(s1) * (1.f / 64.f);
    const float bon = red8(bp);
    float s2 = 0.f;
#pragma unroll
    for (int j = 0; j < 8; ++j) { ys[j] -= mu; s2 += ys[j] * ys[j]; }
    const float rs = __builtin_amdgcn_rsqf(red8(s2) * (1.f / 64.f) + 64e-5f);
    float o[8];
#pragma unroll
    for (int j = 0; j < 8; ++j) o[j] = (ys[j] * rs * gng[j] + gnb[j] + bon * v[j]) * g[j];
    u32x4 ov;
    ov[0] = pk2(o[0], o[1]); ov[1] = pk2(o[2], o[3]); ov[2] = pk2(o[4], o[5]); ov[3] = pk2(o[6], o[7]);
    *(u32x4*)(YSF + (size_t)row * 512 + c0) = ov;
  }
}

struct EpiGate {
  static constexpr bool PERM = true, AFTER_DRAIN = false;
  char* ws;
  DEV void operator()(const f32x4 (&acc)[2][2][4][2], const pg8::Unit& u, int wr, int wc, int fr, int fq) const {
    const int b = u.pn >> 2, pn = u.pn & 3;
    bf16_t* G = (bf16_t*)(ws + (b == 0 ? O_G1 : (b == 1 ? O_G2 : O_G3)));
    const int row0 = u.pm * 256 + wr * 64 + fr, col0 = pn * 256 + wc * 32 + 8 * fq;
#pragma unroll
    for (int ai = 0; ai < 2; ++ai)
#pragma unroll
      for (int m = 0; m < 4; ++m) {
        const int row = row0 + ai * 128 + m * 16;
#pragma unroll
        for (int bj = 0; bj < 2; ++bj) {
          const f32x4 a0 = acc[ai][bj][m][0], a1 = acc[ai][bj][m][1];
          u32x4 o;
          o[0] = pk2(sigmoidf_(a0[0]), sigmoidf_(a0[1])); o[1] = pk2(sigmoidf_(a0[2]), sigmoidf_(a0[3]));
          o[2] = pk2(sigmoidf_(a1[0]), sigmoidf_(a1[1])); o[3] = pk2(sigmoidf_(a1[2]), sigmoidf_(a1[3]));
          *(u32x4*)(G + (size_t)row * DM + col0 + bj * 128) = o;
        }
      }
  }
};
DEV void gate_phase(const Params& p, int nrows, char* smem) {
  EpiGate E;
  E.ws = p.ws;
  pg8::Gemm g;
  g.A = (const bf16_t*)(p.ws + O_HM); g.Bt = (const bf16_t*)(p.ws + O_WB + W_WIN) + (size_t)NZP * 1024; g.M = nrows; g.N = 3072; g.K = 1024;
  pg8::StaticOrder S;
  S.init(g.M, g.N, (int)gridDim.x, (int)blockIdx.x);
  __syncthreads();
  pg8::gemm_phase<EpiGate, pg8::StaticOrder>((PG8_LAS unsigned char*)smem, g, S, E);
  __syncthreads();
}
struct MergeOrder {
  pg8::StaticOrder base;
  DEV bool next(int i, pg8::Unit& u) const {
    const int j = i / 3, b = i - 3 * j;
    pg8::Unit t;
    if (!base.next(j, t)) return false;
    u.pm = t.pm + 136 * (b == 0 ? 11 : (b == 1 ? 12 : 6));
    u.pn = t.pn + 4 * b;
    return true;
  }
  DEV void a_ready(const pg8::Unit&) const {}
  DEV void done(const pg8::Unit&) const {}
};
struct EpiMerge {
  static constexpr bool PERM = true, AFTER_DRAIN = false;
  char* ws;
  DEV void operator()(const f32x4 (&acc)[2][2][4][2], const pg8::Unit& u, int wr, int wc, int fr, int fq) const {
    const int b = u.pn >> 2, pn = u.pn & 3, pm = u.pm - 136 * (b == 0 ? 11 : (b == 1 ? 12 : 6));
    const bf16_t* G = (const bf16_t*)(ws + (b == 0 ? O_G1 : (b == 1 ? O_G2 : O_G3)));
    bf16_t* M = (bf16_t*)(ws + O_M);
    const int row0 = pm * 256 + wr * 64 + fr, col0 = pn * 256 + wc * 32 + 8 * fq;
#pragma unroll
    for (int ai = 0; ai < 2; ++ai) {
      u32x4 gv[4][2], mv[4][2];
#pragma unroll
      for (int m = 0; m < 4; ++m)
#pragma unroll
        for (int bj = 0; bj < 2; ++bj) {
          const size_t off = (size_t)(row0 + ai * 128 + m * 16) * DM + col0 + bj * 128;
          gv[m][bj] = *(const u32x4*)(G + off);
          mv[m][bj] = (u32x4){0u, 0u, 0u, 0u};
          if (b > 0) mv[m][bj] = *(const u32x4*)(M + off);
        }
#pragma unroll
      for (int m = 0; m < 4; ++m)
#pragma unroll
        for (int bj = 0; bj < 2; ++bj) {
          const size_t off = (size_t)(row0 + ai * 128 + m * 16) * DM + col0 + bj * 128;
          const f32x4 a0 = acc[ai][bj][m][0], a1 = acc[ai][bj][m][1];
          const u32x4 g4 = gv[m][bj], m4 = mv[m][bj];
          u32x4 o;
          o[0] = pk2(lo_bf(m4[0]) + lo_bf(g4[0]) * a0[0], hi_bf(m4[0]) + hi_bf(g4[0]) * a0[1]);
          o[1] = pk2(lo_bf(m4[1]) + lo_bf(g4[1]) * a0[2], hi_bf(m4[1]) + hi_bf(g4[1]) * a0[3]);
          o[2] = pk2(lo_bf(m4[2]) + lo_bf(g4[2]) * a1[0], hi_bf(m4[2]) + hi_bf(g4[2]) * a1[1]);
          o[3] = pk2(lo_bf(m4[3]) + lo_bf(g4[3]) * a1[2], hi_bf(m4[3]) + hi_bf(g4[3]) * a1[3]);
          *(u32x4*)(M + off) = o;
        }
    }
  }
};
DEV void merge_phase(const Params& p, int nrows, char* smem) {
  EpiMerge E;
  E.ws = p.ws;
  pg8::Gemm g;
  g.A = (const bf16_t*)p.ws; g.Bt = (const bf16_t*)(p.ws + O_WB + W_PCV); g.M = nrows; g.N = 1024; g.K = 512;
  MergeOrder S;
  S.base.init(g.M, g.N, (int)gridDim.x, (int)blockIdx.x);
  __syncthreads();
  pg8::gemm_phase<EpiMerge, MergeOrder>((PG8_LAS unsigned char*)smem, g, S, E);
  __syncthreads();
}

struct EpiResid {
  static constexpr bool PERM = false, AFTER_DRAIN = false;
  float* out; float* xc; const float* rin_lat; const float* rin_ctx; const float* mod; bool store;
  DEV void operator()(const f32x4 (&acc)[2][2][4][2], const pg8::Unit& u, int wr, int wc, int fr, int fq) const {
    const int row0 = u.pm * 256 + wr * 64 + fr, col0 = u.pn * 256 + wc * 32 + 4 * fq;
    const float* gt = mod + (size_t)modrow(row0) * 6144;
    f32x4 g4[2][2];
#pragma unroll
    for (int bj = 0; bj < 2; ++bj)
#pragma unroll
      for (int n = 0; n < 2; ++n) g4[bj][n] = *(const f32x4*)(gt + col0 + bj * 128 + n * 16);
#pragma unroll
    for (int ai = 0; ai < 2; ++ai) {
      f32x4 xv[4][2][2];
#pragma unroll
      for (int m = 0; m < 4; ++m) {
        const int row = row0 + ai * 128 + m * 16;
        const float* xi = row < T_LAT ? rin_lat + (size_t)row * DM : rin_ctx + (size_t)(row - T_LAT) * DM;
#pragma unroll
        for (int bj = 0; bj < 2; ++bj)
#pragma unroll
          for (int n = 0; n < 2; ++n) xv[m][bj][n] = *(const f32x4*)(xi + col0 + bj * 128 + n * 16);
      }
#pragma unroll
      for (int m = 0; m < 4; ++m) {
        const int row = row0 + ai * 128 + m * 16;
        float* xr = row < T_LAT ? out + (size_t)row * DM : xc + (size_t)(row - T_LAT) * DM;
#pragma unroll
        for (int bj = 0; bj < 2; ++bj)
#pragma unroll
          for (int n = 0; n < 2; ++n) {
            const f32x4 r = xv[m][bj][n] + g4[bj][n] * acc[ai][bj][m][n];
            if (store) *(f32x4*)(xr + col0 + bj * 128 + n * 16) = r;
          }
      }
    }
  }
};
DEV void resid_gemm_phase(const Params& p, int l, const bf16_t* A, int K, const bf16_t* Wt, int goff, int nrows, char* smem, bool from_inputs = false) {
  EpiResid E;
  E.store = true;
  E.rin_lat = from_inputs ? p.x : p.out; E.rin_ctx = from_inputs ? p.ctx : (const float*)(p.ws + O_XC);
  E.out = p.out; E.xc = (float*)(p.ws + O_XC); E.mod = (const float*)(p.ws + O_MOD) + (size_t)l * 9 * 6144 + goff;
  pg8::Gemm g;
  g.A = A; g.Bt = Wt; g.M = nrows; g.N = 1024; g.K = K;
  pg8::StaticOrder S;
  S.init(g.M, g.N, (int)gridDim.x, (int)blockIdx.x);
  __syncthreads();
  pg8::gemm_phase<EpiResid, pg8::StaticOrder>((PG8_LAS unsigned char*)smem, g, S, E);
  __syncthreads();
}

struct EpiMlp1 {
  static constexpr bool PERM = true, AFTER_DRAIN = false;
  bf16_t* HID;
  DEV void operator()(const f32x4 (&acc)[2][2][4][2], const pg8::Unit& u, int wr, int wc, int fr, int fq) const {
    const int row0 = u.pm * 256 + wr * 64 + fr, col0 = u.pn * 256 + wc * 32 + 8 * fq;
#pragma unroll
    for (int ai = 0; ai < 2; ++ai)
#pragma unroll
      for (int m = 0; m < 4; ++m) {
        const int row = row0 + ai * 128 + m * 16;
#pragma unroll
        for (int bj = 0; bj < 2; ++bj) {
          float v[8];
#pragma unroll
          for (int j = 0; j < 4; ++j) {
            const float r0 = fmaxf(acc[ai][bj][m][0][j], 0.f), r1 = fmaxf(acc[ai][bj][m][1][j], 0.f);
            v[j] = r0 * r0; v[4 + j] = r1 * r1;
          }
          u32x4 o;
          o[0] = pk2(v[0], v[1]); o[1] = pk2(v[2], v[3]); o[2] = pk2(v[4], v[5]); o[3] = pk2(v[6], v[7]);
          *(u32x4*)(HID + (size_t)row * 4096 + col0 + bj * 128) = o;
        }
      }
  }
};
DEV void mlp1_phase(const Params& p, int nrows, char* smem) {
  EpiMlp1 E;
  E.HID = (bf16_t*)(p.ws + O_HID);
  pg8::Gemm g;
  g.A = (const bf16_t*)(p.ws + O_HM); g.Bt = (const bf16_t*)(p.ws + O_WB + W_W1); g.M = nrows; g.N = 4096; g.K = 1024;
  pg8::StaticOrder S;
  S.init(g.M, g.N, (int)gridDim.x, (int)blockIdx.x);
  __syncthreads();
  pg8::gemm_phase<EpiMlp1, pg8::StaticOrder>((PG8_LAS unsigned char*)smem, g, S, E);
  __syncthreads();
}

DEV void final_phase(const Params& p) {
  const int lane = ltid() & 63, w = ltid() >> 6;
  const int stride = gridDim.x * 8;
  f32x4 g[4];
#pragma unroll
  for (int i = 0; i < 4; ++i) g[i] = *(const f32x4*)(p.final_g + i * 256 + lane * 4);
  int row = blockIdx.x * 8 + w;
  f32x4 nv[4];
  if (row < T_LAT) {
#pragma unroll
    for (int i = 0; i < 4; ++i) nv[i] = *(const f32x4*)(p.out + (size_t)row * DM + i * 256 + lane * 4);
  }
  for (; row < T_LAT; row += stride) {
    float* xr = p.out + (size_t)row * DM;
    f32x4 v[4];
#pragma unroll
    for (int i = 0; i < 4; ++i) v[i] = nv[i];
    if (row + stride < T_LAT) {
#pragma unroll
      for (int i = 0; i < 4; ++i) nv[i] = *(const f32x4*)(p.out + (size_t)(row + stride) * DM + i * 256 + lane * 4);
    }
    float ss = 0.f;
#pragma unroll
    for (int i = 0; i < 4; ++i) ss += v[i][0] * v[i][0] + v[i][1] * v[i][1] + v[i][2] * v[i][2] + v[i][3] * v[i][3];
    const float rs = __builtin_amdgcn_rsqf(wsum(ss) * (1.f / 1024.f) + 1e-6f);
#pragma unroll
    for (int i = 0; i < 4; ++i) *(f32x4*)(xr + i * 256 + lane * 4) = v[i] * rs * g[i];
  }
}

constexpr int N_PHASES = 26;
__global__ void __launch_bounds__(512) fwd_megakernel(Params p, int ph_lo, int ph_hi) {
  extern __shared__ __attribute__((aligned(16))) char smem[];
  cg::grid_group grid = cg::this_grid();
  volatile XLAS unsigned* st = (volatile XLAS unsigned*)(smem + 139264);
  if (threadIdx.x == 0) { st[0] = 0u; st[1] = 0u; st[2] = 0u; st[3] = 0u; }
  __syncthreads();
  const XcdBarrier xb = xcd_barrier_post((unsigned*)(p.ws + O_BAR), st);
  if (ph_hi > 1000) grid.sync();
  for (int ph = ph_lo; ph < ph_hi; ++ph) {
    if (ph == 0) {
      cvt_phase(p, 0, smem);
      mod_phase(p, smem);
    } else if (ph == N_PHASES - 1) {
      final_phase(p);
    } else {
      const int l = (ph - 1) / 12, sp = (ph - 1) % 12;
      const int nrows = (l == 1) ? T_LAT : T_ALL;
      switch (sp) {
        case 0:
          if (l > 0) cvt_phase(p, l, smem);
          norm_phase(p, l, 0, (bf16_t*)(p.ws + O_H0), l == 0);
          break;
        case 1: gemm_in_phase(p, smem); break;
        case 2: branch_phase(p, l, smem); break;
        case 3:
          lora64_phase(p, l, smem);
          lora_phase(p, l, smem, true);
          break;
        case 4: scan_phase(p, l, smem); break;
        case 5:
          post_phase(p, l, nrows);
          norm_phase(p, l, 0, (bf16_t*)(p.ws + O_HM), l == 0, nrows);
          break;
        case 6: gate_phase(p, nrows, smem); break;
        case 7: merge_phase(p, nrows, smem); break;
        case 8: resid_gemm_phase(p, l, (const bf16_t*)(p.ws + O_M), 1024, (const bf16_t*)(p.ws + O_WB + W_WOUT), 2048, nrows, smem, l == 0); break;
        case 9: norm_phase(p, l, 1, (bf16_t*)(p.ws + O_HM), false, nrows); break;
        case 10: mlp1_phase(p, nrows, smem); break;
        case 11: resid_gemm_phase(p, l, (const bf16_t*)(p.ws + O_HID), 4096, (const bf16_t*)(p.ws + O_WB + W_W2), 5120, nrows, smem); break;
      }
    }
    if (ph + 1 < ph_hi) xcd_barrier(xb);
  }
}

extern "C" void kernel_launch(void* const* d_in, const int* in_sizes, int n_in, void* d_out, int out_size, void* d_ws,
                              size_t ws_size, hipStream_t stream) {
  Params p{};
  const float** pp = (const float**)&p;
  for (int i = 0; i < 36; ++i) pp[i] = (const float*)d_in[i];
  p.out = (float*)d_out;
  p.ws = (char*)d_ws;
  static int grid_blocks = 0;
  if (!grid_blocks) {
    hipFuncSetAttribute((const void*)fwd_megakernel, hipFuncAttributeMaxDynamicSharedMemorySize, LDS_BYTES);
    int dev = 0, cus = 0, per_cu = 0;
    hipGetDevice(&dev);
    hipDeviceGetAttribute(&cus, hipDeviceAttributeMultiprocessorCount, dev);
    hipOccupancyMaxActiveBlocksPerMultiprocessor(&per_cu, fwd_megakernel, 512, LDS_BYTES);
    if (per_cu < 1) per_cu = 1;
    grid_blocks = cus * per_cu;
    grid_blocks &= ~7;
  }
  if (ws_size < WS_NEED) fprintf(stderr, "workspace too small: %zu < %zu\n", ws_size, (size_t)WS_NEED);
#ifndef MULTI_LAUNCH
#define MULTI_LAUNCH 0
#endif
#if MULTI_LAUNCH
  for (int ph = 0; ph < N_PHASES; ++ph)
    hipLaunchKernelGGL(fwd_megakernel, dim3(grid_blocks), dim3(512), LDS_BYTES, stream, p, ph, ph + 1);
#else
  hipMemsetAsync((char*)d_ws + O_BAR, 0, 16384, stream);
  int lo = 0, hi = N_PHASES;
  void* args[] = {&p, &lo, &hi};
  hipError_t e = hipLaunchCooperativeKernel((const void*)fwd_megakernel, dim3(grid_blocks), dim3(512), args, LDS_BYTES, stream);
  if (e != hipSuccess) fprintf(stderr, "cooperative launch failed: %s (grid %d)\n", hipGetErrorString(e), grid_blocks);
#endif
}
```
